# Optimizing an MI355X kernel written in HIP

```python
import math
import jax
import jax.numpy as jnp
from jax import lax
import numpy as np

D_MODEL = 1024
BATCH = 16
SEQ = 256
DEPTH = 4
DEC_BATCH = 4
DEC_SEQ = 1024
PAST_LEN = 512

GRID_W = 64
N_HEADS = 8
N_KV_HEADS = 2
HEAD_DIM = 64
GQA_GROUP = N_HEADS // N_KV_HEADS
ATTN_W = N_HEADS * HEAD_DIM
KV_W = N_KV_HEADS * HEAD_DIM
ATTN_SCALE = HEAD_DIM ** -0.5
WINDOW = 128
BLOCK = 128
ROPE_BASE = 10000.0
FOURIER_HEADS = 4
FOURIER_HEAD_DIM = 64
FOURIER_W = FOURIER_HEADS * FOURIER_HEAD_DIM
S5_GROUPS = 16
S5_GROUP_CH = 16
S5_STATE = 64
S5_W = S5_GROUPS * S5_GROUP_CH
MIX_W = ATTN_W + FOURIER_W + S5_W
IN_W = ATTN_W + 2 * KV_W + FOURIER_W + S5_W
IN_SPLITS = (ATTN_W, ATTN_W + KV_W, ATTN_W + 2 * KV_W, ATTN_W + 2 * KV_W + FOURIER_W)
N_EXPERTS = 16
EXPERT_FF = 1024
CAPACITY_FACTOR = 2
LN_EPS = 1e-5
NEG_INF = -1e30
DEEPNORM_ALPHA = (2 * DEPTH) ** 0.25
DEEPNORM_BETA = (8 * DEPTH) ** -0.25

kernel_name = 'hybrid_diffusion_trunk_step'


def layer_norm(x, g, b):
    xf = x.astype(jnp.float32)
    mu = jnp.mean(xf, axis=-1, keepdims=True)
    var = jnp.mean(jnp.square(xf - mu), axis=-1, keepdims=True)
    return ((xf - mu) * lax.rsqrt(var + LN_EPS)).astype(x.dtype) * g + b


def adaln(cond, w_ada, b_ada):
    m = jax.nn.silu(cond) @ w_ada + b_ada
    return jnp.split(jnp.expand_dims(m, -2), 6, axis=-1)


def axial_rope(x):
    n = x.shape[1]
    rows = n // GRID_W
    row = jnp.repeat(jnp.arange(rows, dtype=jnp.float32), GRID_W)
    col = jnp.tile(jnp.arange(GRID_W, dtype=jnp.float32), rows)
    n_freq = HEAD_DIM // 4
    freqs = ROPE_BASE ** (-jnp.arange(n_freq, dtype=jnp.float32) / n_freq)
    ang = jnp.concatenate([row[:, None] * freqs, col[:, None] * freqs], axis=-1)
    cos = jnp.cos(ang)[None, :, None, :].astype(x.dtype)
    sin = jnp.sin(ang)[None, :, None, :].astype(x.dtype)
    x1, x2 = x[..., 0::2], x[..., 1::2]
    return jnp.stack([x1 * cos - x2 * sin, x1 * sin + x2 * cos], axis=-1).reshape(x.shape)


def attend(q, k, v, valid, sink):
    s = jnp.einsum('bqkgd,bskd->bkgqs', q.astype(jnp.float32), k.astype(jnp.float32)) * ATTN_SCALE
    if valid is not None:
        s = jnp.where(valid, s, NEG_INF)
    sink_l = jnp.broadcast_to(sink.astype(jnp.float32).reshape(1, N_KV_HEADS, GQA_GROUP, 1, 1), s.shape[:-1] + (1,))
    p = jax.nn.softmax(jnp.concatenate([s, sink_l], axis=-1), axis=-1)[..., :-1]
    o = jnp.einsum('bkgqs,bskd->bqkgd', p, v.astype(jnp.float32))
    return o.reshape(o.shape[0], o.shape[1], ATTN_W).astype(q.dtype)


def context_attention(q, k, v, sink):
    b, n = q.shape[:2]
    nb = n // BLOCK
    qb = jnp.moveaxis(q.reshape(b, nb, BLOCK, N_KV_HEADS, GQA_GROUP, HEAD_DIM), 1, 0)
    out = lax.map(lambda qi: attend(qi, k, v, None, sink), qb)
    return jnp.moveaxis(out, 0, 1).reshape(b, n, ATTN_W)


def latent_attention(q, k, v, k_ctx, v_ctx, sink):
    b, n = q.shape[:2]
    nb = n // BLOCK
    n_ctx = k_ctx.shape[1]
    pad = ((0, 0), (BLOCK, BLOCK), (0, 0), (0, 0))
    k_pad = jnp.pad(k, pad)
    v_pad = jnp.pad(v, pad)
    qb = jnp.moveaxis(q.reshape(b, nb, BLOCK, N_KV_HEADS, GQA_GROUP, HEAD_DIM), 1, 0)
    key_off = jnp.arange(3 * BLOCK) - BLOCK
    rel = key_off[None, :] - jnp.arange(BLOCK)[:, None]
    ctx_valid = jnp.ones((BLOCK, n_ctx), dtype=bool)

    def block(args):
        qi, i = args
        start = i * BLOCK
        kb = lax.dynamic_slice_in_dim(k_pad, start, 3 * BLOCK, axis=1)
        vb = lax.dynamic_slice_in_dim(v_pad, start, 3 * BLOCK, axis=1)
        kpos = start + key_off
        band = (jnp.abs(rel) <= WINDOW) & (kpos >= 0)[None, :] & (kpos < n)[None, :]
        valid = jnp.concatenate([band, ctx_valid], axis=1)
        keys = jnp.concatenate([kb, k_ctx.astype(kb.dtype)], axis=1)
        vals = jnp.concatenate([vb, v_ctx.astype(vb.dtype)], axis=1)
        return attend(qi, keys, vals, valid, sink)

    out = lax.map(block, (qb, jnp.arange(nb)))
    return jnp.moveaxis(out, 0, 1).reshape(b, n, ATTN_W)


def fourier_mixer(u, w_fourier):
    b, n = u.shape[:2]
    uh = u.astype(jnp.float32).reshape(b, n, FOURIER_HEADS, FOURIER_HEAD_DIM)
    f = jnp.fft.fft2(uh, axes=(1, 3), norm='ortho').real
    return f.reshape(b, n, FOURIER_W).astype(u.dtype) @ w_fourier


def _ssm_combine(left, right):
    a_l, b_l = left
    a_r, b_r = right
    return a_r * a_l, a_r * b_l + b_r


def s5_discretise(a_re, a_im, log_dt, b_re, b_im):
    a = lax.complex(a_re.astype(jnp.float32), a_im.astype(jnp.float32))
    dt = jnp.exp(log_dt.astype(jnp.float32))[:, None]
    a_bar = jnp.exp(a * dt)
    b = lax.complex(b_re.astype(jnp.float32), b_im.astype(jnp.float32))
    b_bar = ((a_bar - 1.0) / a)[..., None] * b
    return a_bar, b_bar


def s5_scan(u, a_bar, b_bar, s0, reverse):
    bu = jnp.einsum('gph,bngh->bngp', b_bar, u.astype(jnp.complex64))
    if s0 is not None:
        edge = -1 if reverse else 0
        bu = bu.at[:, edge].add(a_bar * s0)
    a_seq = jnp.broadcast_to(a_bar, bu.shape)
    _, states = lax.associative_scan(_ssm_combine, (a_seq, bu), reverse=reverse, axis=1)
    return states


def s5_mixer(u, p, s0_fwd, s0_bwd):
    b, n = u.shape[:2]
    uf = u.astype(jnp.float32).reshape(b, n, S5_GROUPS, S5_GROUP_CH)
    y = uf * p['s5_d'].astype(jnp.float32).reshape(S5_GROUPS, S5_GROUP_CH)
    finals = []
    for direction, (reverse, s0) in enumerate(((False, s0_fwd), (True, s0_bwd))):
        a_bar, b_bar = s5_discretise(p['s5_a_re'][direction], p['s5_a_im'][direction], p['s5_log_dt'][direction],
                                     p['s5_b_re'][direction], p['s5_b_im'][direction])
        states = s5_scan(uf, a_bar, b_bar, s0, reverse)
        c = lax.complex(p['s5_c_re'][direction].astype(jnp.float32), p['s5_c_im'][direction].astype(jnp.float32))
        y = y + jnp.einsum('ghp,bngp->bngh', c, states).real
        finals.append(states[:, 0] if reverse else states[:, -1])
    g = jax.nn.gelu(y.reshape(b, n, S5_W)).astype(u.dtype)
    return g * jax.nn.sigmoid(g @ p['s5_w_glu']), finals


def expert_choice_moe(h, w_router, w_gate, w_up, w_down):
    b, n, d = h.shape
    cap = CAPACITY_FACTOR * n // N_EXPERTS
    aff = jax.nn.softmax((h @ w_router).astype(jnp.float32), axis=-1)
    gate, idx = lax.top_k(jnp.swapaxes(aff, 1, 2), cap)
    bidx = jnp.arange(b)[:, None, None]
    xs = h[bidx, idx]
    hid = jax.nn.silu(jnp.einsum('becd,edf->becf', xs, w_gate)) * jnp.einsum('becd,edf->becf', xs, w_up)
    ys = jnp.einsum('becf,efd->becd', hid, w_down) * gate[..., None].astype(h.dtype)
    flat = (bidx * n + idx).reshape(-1)
    out = jnp.zeros((b * n, d), h.dtype).at[flat].add(ys.reshape(-1, d))
    return out.reshape(b, n, d)


def trunk_layer(x, p, mod, ctx=None):
    shift1, scale1, gate1, shift2, scale2, gate2 = mod
    b, n = x.shape[:2]
    h = x * (1 + scale1) + shift1
    q, k, v, u_four, u_s5 = jnp.split(h @ p['w_in'], IN_SPLITS, axis=-1)
    q = q.reshape(b, n, N_HEADS, HEAD_DIM)
    k = k.reshape(b, n, N_KV_HEADS, HEAD_DIM)
    v = v.reshape(b, n, N_KV_HEADS, HEAD_DIM)
    if ctx is None:
        attn = context_attention(q.reshape(b, n, N_KV_HEADS, GQA_GROUP, HEAD_DIM), k, v, p['attn_sink'])
        s5_out, finals = s5_mixer(u_s5, p, None, None)
    else:
        k_ctx, v_ctx, s0_fwd, s0_bwd = ctx
        q = axial_rope(q)
        k = axial_rope(k)
        attn = latent_attention(q.reshape(b, n, N_KV_HEADS, GQA_GROUP, HEAD_DIM), k, v, k_ctx, v_ctx, p['attn_sink'])
        s5_out, finals = s5_mixer(u_s5, p, s0_fwd, s0_bwd)
    four = fourier_mixer(u_four, p['w_fourier'])
    mix = jnp.concatenate([attn, four, s5_out], axis=-1) @ p['w_out']
    x = layer_norm(DEEPNORM_ALPHA * x + gate1 * mix, p['ln1_g'], p['ln1_b'])
    h = x * (1 + scale2) + shift2
    moe = expert_choice_moe(h, p['w_router'], p['w_gate'], p['w_up'], p['w_down'])
    x = layer_norm(DEEPNORM_ALPHA * x + gate2 * moe, p['ln2_g'], p['ln2_b'])
    return x, k, v, finals


def setup_inputs(seed: int = 0) -> dict:
    key = jax.random.key(seed)
    ks = jax.random.split(key, 36)
    f32 = jnp.float32
    L, D, E, F = DEPTH, D_MODEL, N_EXPERTS, EXPERT_FF
    G, P, H = S5_GROUPS, S5_STATE, S5_GROUP_CH

    def nrm(k, shape, scale):
        return scale * jax.random.normal(k, shape, f32)

    n_idx = jnp.arange(P, dtype=f32)
    return {
        'x_prompt': nrm(ks[0], (BATCH, SEQ, D), 1.0),
        'x_sample': nrm(ks[1], (DEC_BATCH, DEC_SEQ, D), 1.0),
        'cache_k': nrm(ks[2], (DEC_BATCH, L, PAST_LEN, N_KV_HEADS, HEAD_DIM), 1.0),
        'cache_v': nrm(ks[3], (DEC_BATCH, L, PAST_LEN, N_KV_HEADS, HEAD_DIM), 1.0),
        'state_s5_re': nrm(ks[4], (DEC_BATCH, L, 2, G, P), 0.1),
        'state_s5_im': nrm(ks[5], (DEC_BATCH, L, 2, G, P), 0.1),
        'c': nrm(ks[6], (DEC_BATCH, D), 1.0),
        'c_ctx': nrm(ks[7], (D,), 1.0),
        'ln_in_g': 1.0 + nrm(ks[8], (D,), 0.02),
        'ln_in_b': nrm(ks[9], (D,), 0.02),
        'w_ada': nrm(ks[10], (L, D, 6 * D), 0.5 * D ** -0.5),
        'b_ada': nrm(ks[11], (L, 6 * D), 0.02),
        'w_in': nrm(ks[12], (L, D, IN_W), D ** -0.5),
        'w_fourier': nrm(ks[13], (L, FOURIER_W, FOURIER_W), FOURIER_W ** -0.5),
        'attn_sink': nrm(ks[14], (L, N_HEADS), 0.5),
        's5_a_re': -0.5 + nrm(ks[15], (L, 2, G, P), 0.01),
        's5_a_im': math.pi * n_idx + nrm(ks[16], (L, 2, G, P), 0.01),
        's5_log_dt': jnp.log(jax.random.uniform(ks[17], (L, 2, G), f32, 1e-3, 1e-1)),
        's5_b_re': nrm(ks[18], (L, 2, G, P, H), (2 * H) ** -0.5),
        's5_b_im': nrm(ks[19], (L, 2, G, P, H), (2 * H) ** -0.5),
        's5_c_re': nrm(ks[20], (L, 2, G, H, P), P ** -0.5),
        's5_c_im': nrm(ks[21], (L, 2, G, H, P), P ** -0.5),
        's5_d': nrm(ks[22], (L, S5_W), 1.0),
        's5_w_glu': nrm(ks[23], (L, S5_W, S5_W), S5_W ** -0.5),
        'w_out': nrm(ks[24], (L, MIX_W, D), DEEPNORM_BETA * MIX_W ** -0.5),
        'ln1_g': 1.0 + nrm(ks[25], (L, D), 0.02),
        'ln1_b': nrm(ks[26], (L, D), 0.02),
        'w_router': nrm(ks[27], (L, D, E), D ** -0.5),
        'w_gate': nrm(ks[28], (L, E, D, F), D ** -0.5),
        'w_up': nrm(ks[29], (L, E, D, F), D ** -0.5),
        'w_down': nrm(ks[30], (L, E, F, D), DEEPNORM_BETA * F ** -0.5),
        'ln2_g': 1.0 + nrm(ks[31], (L, D), 0.02),
        'ln2_b': nrm(ks[32], (L, D), 0.02),
    }


def reference(x_prompt, x_sample, cache_k, cache_v, state_s5_re, state_s5_im, c, c_ctx,
              ln_in_g, ln_in_b, w_ada, b_ada, w_in, w_fourier, attn_sink,
              s5_a_re, s5_a_im, s5_log_dt, s5_b_re, s5_b_im, s5_c_re, s5_c_im, s5_d, s5_w_glu,
              w_out, ln1_g, ln1_b, w_router, w_gate, w_up, w_down, ln2_g, ln2_b):
    xp = layer_norm(x_prompt, ln_in_g, ln_in_b)
    xs = layer_norm(x_sample, ln_in_g, ln_in_b)
    new_ks, new_vs, new_ss = [], [], []
    for l in range(DEPTH):
        p = {
            'w_in': w_in[l], 'w_fourier': w_fourier[l], 'attn_sink': attn_sink[l],
            's5_a_re': s5_a_re[l], 's5_a_im': s5_a_im[l], 's5_log_dt': s5_log_dt[l],
            's5_b_re': s5_b_re[l], 's5_b_im': s5_b_im[l], 's5_c_re': s5_c_re[l], 's5_c_im': s5_c_im[l],
            's5_d': s5_d[l], 's5_w_glu': s5_w_glu[l], 'w_out': w_out[l],
            'ln1_g': ln1_g[l], 'ln1_b': ln1_b[l], 'w_router': w_router[l],
            'w_gate': w_gate[l], 'w_up': w_up[l], 'w_down': w_down[l],
            'ln2_g': ln2_g[l], 'ln2_b': ln2_b[l],
        }
        xp, k_l, v_l, finals = trunk_layer(xp, p, adaln(c_ctx, w_ada[l], b_ada[l]))
        new_ks.append(k_l)
        new_vs.append(v_l)
        new_ss.append(jnp.stack(finals, axis=1))
        s0_fwd = lax.complex(state_s5_re[:, l, 0].astype(jnp.float32), state_s5_im[:, l, 0].astype(jnp.float32))
        s0_bwd = lax.complex(state_s5_re[:, l, 1].astype(jnp.float32), state_s5_im[:, l, 1].astype(jnp.float32))
        xs = trunk_layer(xs, p, adaln(c, w_ada[l], b_ada[l]), ctx=(cache_k[:, l], cache_v[:, l], s0_fwd, s0_bwd))[0]
    new_k = jnp.stack(new_ks, axis=1)
    new_v = jnp.stack(new_vs, axis=1)
    new_s = jnp.stack(new_ss, axis=1)
    return (xp, xs, new_k, new_v, new_s.real, new_s.imag)
```

```cpp
#include <hip/hip_runtime.h>
#include <hip/hip_cooperative_groups.h>
#include <cstdio>
#include <cstdint>
namespace cg = cooperative_groups;
#define DEVFN __device__ __forceinline__
#define PHASE_BEGIN int tidx_ = threadIdx.x; int bidx_ = blockIdx.x; asm volatile("" : "+v"(tidx_), "+s"(bidx_))
#define GTID ((long)bidx_ * 256 + tidx_)
#define GSIZE ((long)gridDim.x * 256)
#define ACT_BF16 1
#define HAVE_FAST 1

#ifdef CFG_SMALL
constexpr int D = 128, BATCH = 2, SEQ = 64, DEPTH = 2, DB = 2, DSEQ = 384, PAST = 64, FF = 64;
#else
constexpr int D = 1024, BATCH = 16, SEQ = 256, DEPTH = 4, DB = 4, DSEQ = 1024, PAST = 512, FF = 1024;
#endif
constexpr int GRID_W = 64, NH = 8, NKV = 2, HD = 64, GQA = 4, ATTN_W = 512, KV_W = 128, WINDOW = 128;
constexpr int FOUR_W = 256, S5_W = 256, SG = 16, SH = 16, SP = 64;
constexpr int MIX_W = 1024, IN_W = 1280, NE = 16;
constexpr int NP = 1536;
constexpr int PC_Q = 0, PC_K = 512, PC_V = 640, PC_P = 768, PC_QQ = 1024, PC_U = 1280;
constexpr int NPJ = 1024, PJ_Q = 0, PJ_K = 512, PJ_V = 640, PJ_U = 768;
constexpr int TC = BATCH * SEQ, TL = DB * DSEQ, T = TC + TL;
constexpr int NCOND = 1 + DB;
constexpr int CAPC = 2 * SEQ / NE, CAPL = 2 * DSEQ / NE;
constexpr int NS = BATCH * CAPC + DB * CAPL;
constexpr int NSEQ = BATCH + DB;
constexpr float LN_EPS = 1e-5f;
#ifdef CFG_SMALL
constexpr float ALPHA = 1.4142135623730951f;
#else
constexpr float ALPHA = 1.681792830507429f;
#endif

constexpr long O_YP = 0, O_YS = (long)TC * D, O_K = (long)T * D, O_V = O_K + (long)BATCH * DEPTH * SEQ * KV_W,
               O_SRE = O_V + (long)BATCH * DEPTH * SEQ * KV_W, O_SIM = O_SRE + (long)BATCH * DEPTH * 2 * SG * SP,
               O_END = O_SIM + (long)BATCH * DEPTH * 2 * SG * SP;

typedef unsigned short bf16_t;
#ifdef HOST_EMU
static inline unsigned f_as_u(float f) { unsigned u; memcpy(&u, &f, 4); return u; }
static inline float u_as_f(unsigned u) { float f; memcpy(&f, &u, 4); return f; }
#else
DEVFN unsigned f_as_u(float f) { return __float_as_uint(f); }
DEVFN float u_as_f(unsigned u) { return __uint_as_float(u); }
#endif
DEVFN bf16_t f2bf(float f) { unsigned u = f_as_u(f); u += 0x7fffu + ((u >> 16) & 1u); return (bf16_t)(u >> 16); }
DEVFN float bf2f(bf16_t b) { return u_as_f((unsigned)b << 16); }
#ifdef ACT_BF16
typedef bf16_t act_t;
DEVFN float lda(const act_t* p) { return bf2f(*p); }
DEVFN void sta(act_t* p, float v) { *p = f2bf(v); }
#else
typedef float act_t;
DEVFN float lda(const act_t* p) { return *p; }
DEVFN void sta(act_t* p, float v) { *p = v; }
#endif
struct Params {
  const float *x_prompt, *x_sample, *cache_k, *cache_v, *st_re, *st_im, *c, *c_ctx, *ln_in_g, *ln_in_b, *w_ada, *b_ada,
      *w_in, *w_fourier, *attn_sink, *s5_a_re, *s5_a_im, *s5_log_dt, *s5_b_re, *s5_b_im, *s5_c_re, *s5_c_im, *s5_d,
      *s5_w_glu, *w_out, *ln1_g, *ln1_b, *w_router, *w_gate, *w_up, *w_down, *ln2_g, *ln2_b;
  float* out;
  float *x, *mod, *states, *ybuf, *aff, *wcs, *win2, *abar, *bbar, *twc, *twl, *selgate, *modpart, *rope, *afft, *ypart;
  act_t *h, *proj, *pqt, *mixcat, *gbuf, *h2, *hid, *ys;
  bf16_t *win2t, *woutt, *wglut, *dftc, *dftl, *bbn, *cn, *wcst, *wgt, *wut, *wdt;
  int *seltok, *inv;
  unsigned* bar;
};

DEVFN float silu_f(float x) { return x / (1.f + expf(-x)); }
DEVFN float sigmoid_f(float x) { return 1.f / (1.f + expf(-x)); }
DEVFN float gelu_f(float x) { return 0.5f * x * (1.f + tanhf(0.7978845608028654f * (x + 0.044715f * x * x * x))); }

struct TokInfo { int lat, b, n, N, ci, t0; };
DEVFN TokInfo tokinfo(int t) {
  TokInfo r;
  if (t < TC) { r.lat = 0; r.b = t / SEQ; r.n = t % SEQ; r.N = SEQ; r.ci = 0; r.t0 = r.b * SEQ; }
  else { int tl = t - TC; r.lat = 1; r.b = tl / DSEQ; r.n = tl % DSEQ; r.N = DSEQ; r.ci = 1 + r.b; r.t0 = TC + r.b * DSEQ; }
  return r;
}
DEVFN const float* modp(const Params& p, int l, int ci, int chunk) { return p.mod + (((long)l * NCOND + ci) * 6 + chunk) * D; }

DEVFN void ph_init0(const Params& p) {
  PHASE_BEGIN;
  const long gt = GTID, gs = GSIZE;
#ifndef HAVE_FAST
  for (long idx = gt; idx < (long)DEPTH * 6 * D; idx += gs) {
    int l = idx / (6 * D), j = idx % (6 * D);
    float acc[NCOND];
#pragma unroll
    for (int c = 0; c < NCOND; ++c) acc[c] = 0.f;
    const float* w = p.w_ada + (long)l * D * 6 * D + j;
    for (int d = 0; d < D; ++d) {
      float wv = w[(long)d * 6 * D];
      acc[0] += silu_f(p.c_ctx[d]) * wv;
#pragma unroll
      for (int c = 1; c < NCOND; ++c) acc[c] += silu_f(p.c[(c - 1) * D + d]) * wv;
    }
    float bb = p.b_ada[(long)l * 6 * D + j];
#pragma unroll
    for (int c = 0; c < NCOND; ++c) p.mod[((long)l * NCOND + c) * 6 * D + j] = acc[c] + bb;
  }
#endif
  for (long idx = gt; idx < (long)DEPTH * 2 * SG * SP; idx += gs) {
    int pp = idx % SP; int g = (idx / SP) % SG; long ld = idx / (SP * SG);
    double are = p.s5_a_re[idx], aim = p.s5_a_im[idx];
    double dt = exp((double)p.s5_log_dt[ld * SG + g]);
    double er = exp(are * dt), cr = er * cos(aim * dt), ci = er * sin(aim * dt);
    p.abar[idx * 2] = (float)cr; p.abar[idx * 2 + 1] = (float)ci;
    double nr = cr - 1.0, ni = ci, den = are * are + aim * aim;
    double fr = (nr * are + ni * aim) / den, fi = (ni * are - nr * aim) / den;
    for (int h = 0; h < SH; ++h) {
      double br = p.s5_b_re[idx * SH + h], bi = p.s5_b_im[idx * SH + h];
      p.bbar[(idx * SH + h) * 2] = (float)(fr * br - fi * bi);
      p.bbar[(idx * SH + h) * 2 + 1] = (float)(fr * bi + fi * br);
#ifdef HAVE_FAST
      p.bbn[((ld * SG + g) * 128 + 2 * pp) * 16 + h] = f2bf((float)(fr * br - fi * bi));
      p.bbn[((ld * SG + g) * 128 + 2 * pp + 1) * 16 + h] = f2bf((float)(fr * bi + fi * br));
#endif
    }
  }
#ifdef HAVE_FAST
  for (long idx = gt; idx < (long)DEPTH * 2 * SG * SH * 128; idx += gs) {
    int k = idx % 128; long row = idx / 128;
    p.cn[idx] = f2bf((k & 1) ? -p.s5_c_im[row * SP + (k >> 1)] : p.s5_c_re[row * SP + (k >> 1)]);
  }
#endif
  for (long idx = gt; idx < SEQ; idx += gs) {
    double a = 6.283185307179586476925 * (double)idx / SEQ;
    p.twc[idx * 2] = (float)cos(a); p.twc[idx * 2 + 1] = (float)sin(a);
  }
  for (long idx = gt; idx < DSEQ; idx += gs) {
    double a = 6.283185307179586476925 * (double)idx / DSEQ;
    p.twl[idx * 2] = (float)cos(a); p.twl[idx * 2 + 1] = (float)sin(a);
  }
  for (long idx = gt; idx < (long)DEPTH * 256 * 256; idx += gs) {
    int j = idx % 256; int i = (idx / 256) % 256; int l = idx / (256 * 256);
    int hd = i / 64, c = i % 64;
    float sc = 0.f, ss = 0.f;
    for (int m = 0; m < 64; ++m) {
      int k = (m * c) & 63;
      float ang = 6.283185307179586f * (float)k / 64.f;
      float wv = p.w_fourier[((long)l * 256 + hd * 64 + m) * 256 + j];
      sc += cosf(ang) * wv; ss += sinf(ang) * wv;
    }
    p.wcs[((long)l * 256 + i) * 512 + j] = sc * 0.125f;
    p.wcs[((long)l * 256 + i) * 512 + 256 + j] = ss * 0.125f;
  }
}
DEVFN void ph_init1(const Params& p) {
  PHASE_BEGIN;
  const long gt = GTID, gs = GSIZE;
  for (long idx = gt; idx < (long)DEPTH * D * NP; idx += gs) {
    int j = idx % NP; int d = (idx / NP) % D; int l = idx / ((long)NP * D);
    const float* wrow = p.w_in + ((long)l * D + d) * IN_W;
    float v;
    if (j < PC_P) v = wrow[j];
    else if (j >= PC_U) v = wrow[1024 + (j - PC_U)];
    else {
      int jj = j - PC_P;
      float acc = 0.f;
      for (int i = 0; i < 256; ++i) acc += wrow[768 + i] * p.wcs[((long)l * 256 + i) * 512 + jj];
      v = acc;
    }
    p.win2[idx] = v;
#ifdef HAVE_FAST
    p.win2t[((long)l * NP + j) * D + d] = f2bf(v);
#endif
  }
}

DEVFN long pqt_base(int lat, int b) { return lat ? (long)TC * 512 + (long)b * 512 * DSEQ : (long)b * 512 * SEQ; }
DEVFN void ph_row1(const Params& p, int l) {
  PHASE_BEGIN;
  for (long t = GTID; t < T; t += GSIZE) {
    TokInfo ti = tokinfo((int)t);
    float* yb = p.ybuf + t * D;
    const float *g, *b;
    float sum = 0.f;
    if (l == 0) {
      const float* src = ti.lat ? p.x_sample + (t - TC) * D : p.x_prompt + t * D;
      for (int d = 0; d < D; ++d) { float v = src[d]; yb[d] = v; sum += v; }
      g = p.ln_in_g; b = p.ln_in_b;
    } else {
      const float* gate2 = modp(p, l - 1, ti.ci, 5);
      const float* xr = p.x + t * D;
      for (int d = 0; d < D; ++d) {
        float m = 0.f;
        for (int e = 0; e < NE; ++e) {
          int s = p.inv[t * NE + e];
          if (s >= 0) m += lda(p.ys + ((long)e * NS + s) * D + d);
        }
        float v = ALPHA * xr[d] + gate2[d] * m;
        yb[d] = v; sum += v;
      }
      g = p.ln2_g + (long)(l - 1) * D; b = p.ln2_b + (long)(l - 1) * D;
    }
    float mu = sum / D, var = 0.f;
    for (int d = 0; d < D; ++d) { float dv = yb[d] - mu; var += dv * dv; }
    float rs = 1.f / sqrtf(var / D + LN_EPS);
    if (l < DEPTH) {
      const float* sh = modp(p, l, ti.ci, 0); const float* sc = modp(p, l, ti.ci, 1);
      for (int d = 0; d < D; ++d) {
        float xv = (yb[d] - mu) * rs * g[d] + b[d];
        p.x[t * D + d] = xv;
        sta(p.h + t * D + d, xv * (1.f + sc[d]) + sh[d]);
      }
    } else {
      float* o = p.out + (ti.lat ? O_YS + (t - TC) * D : O_YP + t * D);
      for (int d = 0; d < D; ++d) o[d] = (yb[d] - mu) * rs * g[d] + b[d];
    }
  }
}

DEVFN void inproj_store(const Params& p, int l, long t, const TokInfo& ti, int j, float a0, float a1) {
  if (ti.lat && j < PC_V) {
    int i = (j % HD) / 2;
    int pos = (i < 16) ? (ti.n / GRID_W) : (ti.n % GRID_W);
    int fi = i & 15;
    float freq = powf(10000.f, -(float)fi / 16.f);
    float ang = (float)pos * freq;
    float cs = cosf(ang), sn = sinf(ang);
    float r0 = a0 * cs - a1 * sn, r1 = a0 * sn + a1 * cs;
    a0 = r0; a1 = r1;
  }
  if (j < PC_P) { sta(p.proj + t * NPJ + j, a0); sta(p.proj + t * NPJ + j + 1, a1); }
  else if (j >= PC_U) { sta(p.proj + t * NPJ + PJ_U + (j - PC_U), a0); sta(p.proj + t * NPJ + PJ_U + (j - PC_U) + 1, a1); }
  else {
    int jj = j - PC_P; int isq = jj >= 256; int jc = jj & 255;
    act_t* dst = p.pqt + pqt_base(ti.lat, ti.b) + (long)jc * 2 * ti.N + (isq ? ti.N : 0) + ti.n;
    sta(dst, a0); sta(dst + 2 * ti.N, a1);
  }
  if (!ti.lat && j >= PC_K && j < PC_P) {
    long base = (((long)ti.b * DEPTH + l) * SEQ + ti.n) * KV_W;
    if (j < PC_V) { p.out[O_K + base + (j - PC_K)] = a0; p.out[O_K + base + (j - PC_K) + 1] = a1; }
    else { p.out[O_V + base + (j - PC_V)] = a0; p.out[O_V + base + (j - PC_V) + 1] = a1; }
  }
}
DEVFN void ph_gemm_in(const Params& p, int l) {
  PHASE_BEGIN;
  for (long idx = GTID; idx < (long)T * (NP / 2); idx += GSIZE) {
    int jp = idx % (NP / 2); long t = idx / (NP / 2);
    int j = jp * 2;
    const act_t* hr = p.h + t * D;
    const float* w = p.win2 + (long)l * D * NP + j;
    float a0 = 0.f, a1 = 0.f;
    for (int d = 0; d < D; ++d) { float hv = lda(hr + d); a0 += hv * w[(long)d * NP]; a1 += hv * w[(long)d * NP + 1]; }
    TokInfo ti = tokinfo((int)t);
    inproj_store(p, l, t, ti, j, a0, a1);
  }
}

DEVFN float ldv(const float* p) { return *p; }
#ifdef ACT_BF16
DEVFN float ldv(const bf16_t* p) { return bf2f(*p); }
#endif
template <class KT>
DEVFN void attn_key(const float* q, const KT* kr, const KT* vr, float& m, float& den, float* acc) {
  float s = 0.f;
#pragma unroll
  for (int d = 0; d < HD; ++d) s += q[d] * ldv(kr + d);
  s *= 0.125f;
  if (s > m) {
    float f = expf(m - s);
    den *= f;
#pragma unroll
    for (int d = 0; d < HD; ++d) acc[d] *= f;
    m = s;
  }
  float pw = expf(s - m);
  den += pw;
#pragma unroll
  for (int d = 0; d < HD; ++d) acc[d] += pw * ldv(vr + d);
}
DEVFN void ph_attn(const Params& p, int l) {
  PHASE_BEGIN;
  for (long idx = GTID; idx < (long)T * NH; idx += GSIZE) {
    int hh = idx % NH; long t = idx / NH;
    TokInfo ti = tokinfo((int)t);
    int kvh = hh / GQA;
    float q[HD], acc[HD];
#pragma unroll
    for (int d = 0; d < HD; ++d) { q[d] = lda(p.proj + t * NPJ + PJ_Q + hh * HD + d); acc[d] = 0.f; }
    float m = p.attn_sink[l * NH + hh], den = 1.f;
    int j0 = 0, j1 = ti.N;
    if (ti.lat) { j0 = ti.n - WINDOW < 0 ? 0 : ti.n - WINDOW; j1 = ti.n + WINDOW + 1 > ti.N ? ti.N : ti.n + WINDOW + 1; }
    for (int j = j0; j < j1; ++j) {
      const act_t* kr = p.proj + (long)(ti.t0 + j) * NPJ + PJ_K + kvh * HD;
      const act_t* vr = p.proj + (long)(ti.t0 + j) * NPJ + PJ_V + kvh * HD;
      attn_key(q, kr, vr, m, den, acc);
    }
    if (ti.lat) {
      for (int s_ = 0; s_ < PAST; ++s_) {
        long base = ((((long)ti.b * DEPTH + l) * PAST + s_) * NKV + kvh) * HD;
        attn_key(q, p.cache_k + base, p.cache_v + base, m, den, acc);
      }
    }
    float inv = 1.f / den;
#pragma unroll
    for (int d = 0; d < HD; ++d) sta(p.mixcat + t * MIX_W + hh * HD + d, acc[d] * inv);
  }
}
DEVFN void ph_fourier(const Params& p, int l) {
  PHASE_BEGIN;
  for (long idx = GTID; idx < (long)T * FOUR_W; idx += GSIZE) {
    int j = idx % FOUR_W; long t = idx / FOUR_W;
    TokInfo ti = tokinfo((int)t);
    const float* tw = ti.lat ? p.twl : p.twc;
    const act_t* pr = p.pqt + pqt_base(ti.lat, ti.b) + (long)j * 2 * ti.N;
    float acc = 0.f;
    for (int n = 0; n < ti.N; ++n) {
      int k = (int)(((long)ti.n * n) % ti.N);
      acc += tw[k * 2] * lda(pr + n) - tw[k * 2 + 1] * lda(pr + ti.N + n);
    }
    sta(p.mixcat + t * MIX_W + ATTN_W + j, acc / sqrtf((float)ti.N));
  }
}
DEVFN void ph_s5scan(const Params& p, int l) {
  PHASE_BEGIN;
  for (long idx = GTID; idx < (long)NSEQ * 2 * SG * SP; idx += GSIZE) {
    int pp = idx % SP; int g = (idx / SP) % SG; int dir = (idx / (SP * SG)) % 2; int sq = idx / (SP * SG * 2);
    int lat = sq >= BATCH; int b = lat ? sq - BATCH : sq; int N = lat ? DSEQ : SEQ; int t0 = lat ? TC + b * DSEQ : b * SEQ;
    long pi = (((long)l * 2 + dir) * SG + g) * SP + pp;
    float ar = p.abar[pi * 2], ai = p.abar[pi * 2 + 1];
    float br[SH], bi[SH];
#pragma unroll
    for (int h = 0; h < SH; ++h) { br[h] = p.bbar[(pi * SH + h) * 2]; bi[h] = p.bbar[(pi * SH + h) * 2 + 1]; }
    float sr = 0.f, si = 0.f;
    if (lat) {
      long si0 = ((((long)b * DEPTH + l) * 2 + dir) * SG + g) * SP + pp;
      sr = p.st_re[si0]; si = p.st_im[si0];
    }
    for (int k = 0; k < N; ++k) {
      int n = dir ? N - 1 - k : k;
      const act_t* u = p.proj + (long)(t0 + n) * NPJ + PJ_U + g * SH;
      float bur = 0.f, bui = 0.f;
#pragma unroll
      for (int h = 0; h < SH; ++h) { float uv = lda(u + h); bur += br[h] * uv; bui += bi[h] * uv; }
      float nr = ar * sr - ai * si + bur, ni = ar * si + ai * sr + bui;
      sr = nr; si = ni;
      long so = ((((long)(t0 + n) * 2 + dir) * SG + g) * SP + pp) * 2;
      p.states[so] = sr; p.states[so + 1] = si;
    }
    if (!lat) {
      long oo = ((((long)b * DEPTH + l) * 2 + dir) * SG + g) * SP + pp;
      p.out[O_SRE + oo] = sr; p.out[O_SIM + oo] = si;
    }
  }
}
DEVFN void ph_s5y(const Params& p, int l) {
  PHASE_BEGIN;
  for (long idx = GTID; idx < (long)T * S5_W; idx += GSIZE) {
    int c = idx % S5_W; long t = idx / S5_W;
    int g = c / SH, h = c % SH;
    float y = p.s5_d[l * S5_W + c] * lda(p.proj + t * NPJ + PJ_U + c);
    for (int dir = 0; dir < 2; ++dir) {
      const float* cre = p.s5_c_re + ((((long)l * 2 + dir) * SG + g) * SH + h) * SP;
      const float* cim = p.s5_c_im + ((((long)l * 2 + dir) * SG + g) * SH + h) * SP;
      const float* st = p.states + ((((long)t * 2 + dir) * SG + g) * SP) * 2;
      for (int pp = 0; pp < SP; ++pp) y += cre[pp] * st[pp * 2] - cim[pp] * st[pp * 2 + 1];
    }
    sta(p.gbuf + t * S5_W + c, gelu_f(y));
  }
}
DEVFN void ph_s5glu(const Params& p, int l) {
  PHASE_BEGIN;
  for (long idx = GTID; idx < (long)T * S5_W; idx += GSIZE) {
    int j = idx % S5_W; long t = idx / S5_W;
    const act_t* gr = p.gbuf + t * S5_W;
    const float* w = p.s5_w_glu + (long)l * S5_W * S5_W + j;
    float z = 0.f;
    for (int i = 0; i < S5_W; ++i) z += lda(gr + i) * w[(long)i * S5_W];
    sta(p.mixcat + t * MIX_W + ATTN_W + FOUR_W + j, lda(gr + j) * sigmoid_f(z));
  }
}
DEVFN void ph_gemm_out(const Params& p, int l) {
  PHASE_BEGIN;
  for (long idx = GTID; idx < (long)T * D; idx += GSIZE) {
    int j = idx % D; long t = idx / D;
    const act_t* mr = p.mixcat + t * MIX_W;
    const float* w = p.w_out + (long)l * MIX_W * D + j;
    float acc = 0.f;
    for (int i = 0; i < MIX_W; ++i) acc += lda(mr + i) * w[(long)i * D];
    TokInfo ti = tokinfo((int)t);
    p.ybuf[idx] = ALPHA * p.x[idx] + modp(p, l, ti.ci, 2)[j] * acc;
  }
}
DEVFN void ph_row2(const Params& p, int l) {
  PHASE_BEGIN;
  for (long t = GTID; t < T; t += GSIZE) {
    TokInfo ti = tokinfo((int)t);
    const float* yb = p.ybuf + t * D;
    float sum = 0.f;
    for (int d = 0; d < D; ++d) sum += yb[d];
    float mu = sum / D, var = 0.f;
    for (int d = 0; d < D; ++d) { float dv = yb[d] - mu; var += dv * dv; }
    float rs = 1.f / sqrtf(var / D + LN_EPS);
    const float* g = p.ln1_g + (long)l * D; const float* b = p.ln1_b + (long)l * D;
    const float* sh = modp(p, l, ti.ci, 3); const float* sc = modp(p, l, ti.ci, 4);
    float lg[NE];
#pragma unroll
    for (int e = 0; e < NE; ++e) lg[e] = 0.f;
    for (int d = 0; d < D; ++d) {
      float xv = (yb[d] - mu) * rs * g[d] + b[d];
      p.x[t * D + d] = xv;
      float hv = xv * (1.f + sc[d]) + sh[d];
      sta(p.h2 + t * D + d, hv);
      const float* wr = p.w_router + ((long)l * D + d) * NE;
#pragma unroll
      for (int e = 0; e < NE; ++e) lg[e] += hv * wr[e];
    }
    float mx = lg[0];
#pragma unroll
    for (int e = 1; e < NE; ++e) mx = fmaxf(mx, lg[e]);
    float se = 0.f;
#pragma unroll
    for (int e = 0; e < NE; ++e) { lg[e] = expf(lg[e] - mx); se += lg[e]; }
    float is = 1.f / se;
#pragma unroll
    for (int e = 0; e < NE; ++e) p.aff[t * NE + e] = lg[e] * is;
  }
}
DEVFN void ph_topk(const Params& p, int l) {
  PHASE_BEGIN;
  for (long idx = GTID; idx < (long)T * NE; idx += GSIZE) {
    int e = idx % NE; long t = idx / NE;
    TokInfo ti = tokinfo((int)t);
    float a = p.aff[t * NE + e];
    int rank = 0;
    for (int j = 0; j < ti.N; ++j) {
      float aj = p.aff[(long)(ti.t0 + j) * NE + e];
      rank += (aj > a || (aj == a && j < ti.n)) ? 1 : 0;
    }
    int cap = ti.lat ? CAPL : CAPC;
    int slot = -1;
    if (rank < cap) {
      slot = ti.lat ? BATCH * CAPC + ti.b * CAPL + rank : ti.b * CAPC + rank;
      p.seltok[e * NS + slot] = (int)t;
      p.selgate[e * NS + slot] = a;
    }
    p.inv[t * NE + e] = slot;
  }
}
DEVFN void ph_moe1(const Params& p, int l) {
  PHASE_BEGIN;
  for (long idx = GTID; idx < (long)NE * NS * FF; idx += GSIZE) {
    int f = idx % FF; int s = (idx / FF) % NS; int e = idx / ((long)FF * NS);
    int tok = p.seltok[e * NS + s];
    const act_t* hr = p.h2 + (long)tok * D;
    const float* wg = p.w_gate + (((long)l * NE + e) * D) * FF + f;
    const float* wu = p.w_up + (((long)l * NE + e) * D) * FF + f;
    float ag = 0.f, au = 0.f;
    for (int d = 0; d < D; ++d) { float hv = lda(hr + d); ag += hv * wg[(long)d * FF]; au += hv * wu[(long)d * FF]; }
    sta(p.hid + idx, silu_f(ag) * au);
  }
}
DEVFN void ph_moe2(const Params& p, int l) {
  PHASE_BEGIN;
  for (long idx = GTID; idx < (long)NE * NS * D; idx += GSIZE) {
    int d = idx % D; int s = (idx / D) % NS; int e = idx / ((long)D * NS);
    const act_t* hr = p.hid + ((long)e * NS + s) * FF;
    const float* wd = p.w_down + (((long)l * NE + e) * FF) * D + d;
    float acc = 0.f;
    for (int f = 0; f < FF; ++f) acc += lda(hr + f) * wd[(long)f * D];
    sta(p.ys + idx, acc * p.selgate[e * NS + s]);
  }
}

constexpr int PH_PER_LAYER = 10;
constexpr int NPHASE = 2 + PH_PER_LAYER * DEPTH + 1;
#ifndef HAVE_FAST
DEVFN void run_phase(const Params& p, int ph) {
  if (ph == 0) { ph_init0(p); return; }
  if (ph == 1) { ph_init1(p); return; }
  int l = (ph - 2) / PH_PER_LAYER, s = (ph - 2) % PH_PER_LAYER;
  if (l == DEPTH) { ph_row1(p, DEPTH); return; }
  switch (s) {
    case 0: ph_row1(p, l); break;
    case 1: ph_gemm_in(p, l); break;
    case 2: ph_attn(p, l); ph_fourier(p, l); ph_s5scan(p, l); break;
    case 3: ph_s5y(p, l); break;
    case 4: ph_s5glu(p, l); break;
    case 5: ph_gemm_out(p, l); break;
    case 6: ph_row2(p, l); break;
    case 7: ph_topk(p, l); break;
    case 8: ph_moe1(p, l); break;
    case 9: ph_moe2(p, l); break;
  }
}
#endif
#define XB_TMO      128
#define XB_XCNT(j)  (256  + 64 * (j))
#define XB_XSUB(j)  (1280 + 64 * (j))
#define XB_XGEN(j)  (2304 + 64 * (j))
#define XB_TOP      3328
#define XB_TOPGEN   3392
#define XCD_BAR_WORDS 3456
#define XB_SPIN_CAP (1u << 20)
#define LAS __attribute__((address_space(3)))
DEVFN unsigned xb_ld(unsigned* p)              { return __hip_atomic_load(p, __ATOMIC_RELAXED, __HIP_MEMORY_SCOPE_AGENT); }
DEVFN unsigned xb_add(unsigned* p, unsigned v) { return __hip_atomic_fetch_add(p, v, __ATOMIC_RELAXED, __HIP_MEMORY_SCOPE_AGENT); }
DEVFN unsigned xb_xcc_id() { return (unsigned)__builtin_amdgcn_s_getreg((3 << 11) | 20) & 0xFu; }
#define XB_SPIN(cond, bar) do { unsigned _sp = 0; while (cond) { __builtin_amdgcn_s_sleep(1); \
    if ((++_sp & 255u) == 0u) { if (xb_ld(&(bar)[XB_TMO])) break; if (_sp > XB_SPIN_CAP) { atomicAdd(&(bar)[XB_TMO], 1u); break; } } } } while (0)
struct XcdBarrier { unsigned* bar; unsigned x; volatile LAS unsigned* st; };
DEVFN XcdBarrier xcd_barrier_post(unsigned* bar, volatile LAS unsigned* st) {
    XcdBarrier b; b.bar = bar; b.x = xb_xcc_id(); b.st = st;
    if (threadIdx.x == 0) (void)xb_add(&bar[XB_XCNT(b.x)], 1u);
    return b;
}
DEVFN void xcd_barrier_complete(unsigned* bar, unsigned x, unsigned& nloc, unsigned& nx) {
    const unsigned G = gridDim.x * gridDim.y * gridDim.z;
    unsigned sum, cnt, mine, sp = 0u;
    for (;;) {
        sum = 0u; cnt = 0u; mine = 0u;
#pragma unroll
        for (unsigned j = 0; j < 16; ++j) { const unsigned c = xb_ld(&bar[XB_XCNT(j)]); sum += c; cnt += (c > 0u) ? 1u : 0u; mine = (j == x) ? c : mine; }
        if (sum == G) break;
        __builtin_amdgcn_s_sleep(1);
        if ((++sp & 255u) == 0u) { if (xb_ld(&bar[XB_TMO])) break; if (sp > XB_SPIN_CAP) { atomicAdd(&bar[XB_TMO], 1u); break; } }
    }
    nloc = mine > 0u ? mine : 1u; nx = cnt > 0u ? cnt : 1u;
}
DEVFN void xcd_barrier(const XcdBarrier& b) {
    asm volatile("s_waitcnt vmcnt(0)" ::: "memory");
    __syncthreads();
    if (threadIdx.x == 0) {
        unsigned* bar = b.bar;
        __builtin_amdgcn_s_waitcnt(0);
        unsigned nloc = b.st[0], nx = b.st[1];
        if (nloc == 0u) { xcd_barrier_complete(bar, b.x, nloc, nx); b.st[0] = nloc; b.st[1] = nx; }
        const unsigned old = xb_add(&bar[XB_XSUB(b.x)], 1u);
        const unsigned gen = old / nloc;
        if (old + 1u == (gen + 1u) * nloc) {
            __builtin_amdgcn_fence(__ATOMIC_RELEASE, "agent");
            asm volatile("s_waitcnt vmcnt(0)" ::: "memory");
            const unsigned og = xb_add(&bar[XB_TOP], 1u);
            const unsigned tg = og / nx;
            if (og + 1u == (tg + 1u) * nx) xb_add(&bar[XB_TOPGEN], 1u);
            else XB_SPIN(xb_ld(&bar[XB_TOPGEN]) == tg, bar);
            __builtin_amdgcn_fence(__ATOMIC_ACQUIRE, "agent");
            xb_add(&bar[XB_XGEN(b.x)], 1u);
            asm volatile("s_waitcnt vmcnt(0)" ::: "memory");
        } else {
            XB_SPIN(xb_ld(&bar[XB_XGEN(b.x)]) == gen, bar);
            __builtin_amdgcn_fence(__ATOMIC_ACQUIRE, "agent");
            asm volatile("s_waitcnt vmcnt(0)" ::: "memory");
        }
    }
    __syncthreads();
}
typedef __attribute__((ext_vector_type(8))) short bf16x8;
typedef __attribute__((ext_vector_type(16))) float f32x16;
typedef __attribute__((ext_vector_type(4))) float f32x4;

DEVFN float sigmoid_fast(float x) { return __frcp_rn(1.f + __expf(-x)); }
DEVFN float silu_fast(float x) { return x * sigmoid_fast(x); }
DEVFN float gelu_fast(float x) { float u = 0.7978845608028654f * (x + 0.044715f * x * x * x); return x * sigmoid_fast(2.f * u); }
typedef __attribute__((ext_vector_type(2))) float f32x2_t;
typedef __attribute__((ext_vector_type(2))) __bf16 bf16x2_t;
DEVFN unsigned cvtpk(float lo, float hi) { f32x2_t v = {lo, hi}; bf16x2_t b = __builtin_convertvector(v, bf16x2_t); return __builtin_bit_cast(unsigned, b); }

constexpr int G_ROWB = 144, G_TILEB = 128 * G_ROWB, G_STAGEB = 2 * G_TILEB;
constexpr int SMEM_BYTES = 2 * G_STAGEB;

struct U4x4 { uint4 a, b, c, d; };
struct F4x8 { f32x4 f0, f1, f2, f3, f4, f5, f6, f7; };
struct RowLoader {
  const bf16_t *r0, *r1, *r2, *r3;
  DEVFN U4x4 operator()(int kt) const {
    U4x4 v;
    v.a = *(const uint4*)(r0 + kt * 64); v.b = *(const uint4*)(r1 + kt * 64);
    v.c = *(const uint4*)(r2 + kt * 64); v.d = *(const uint4*)(r3 + kt * 64);
    return v;
  }
};
struct BF32Loader { const float* bp; long ldb; };

DEVFN void rl_store(char* tile, int tid, const U4x4& v) {
  char* d = tile + (tid >> 3) * G_ROWB + (tid & 7) * 16;
  *(uint4*)(d) = v.a; *(uint4*)(d + 32 * G_ROWB) = v.b; *(uint4*)(d + 64 * G_ROWB) = v.c; *(uint4*)(d + 96 * G_ROWB) = v.d;
}
DEVFN F4x8 bf_load(const BF32Loader& L, int kt) {
  F4x8 f;
  const float* b = L.bp + (long)(kt * 64) * L.ldb;
  f.f0 = *(const f32x4*)(b); f.f1 = *(const f32x4*)(b + L.ldb); f.f2 = *(const f32x4*)(b + 2 * L.ldb); f.f3 = *(const f32x4*)(b + 3 * L.ldb);
  f.f4 = *(const f32x4*)(b + 4 * L.ldb); f.f5 = *(const f32x4*)(b + 5 * L.ldb); f.f6 = *(const f32x4*)(b + 6 * L.ldb); f.f7 = *(const f32x4*)(b + 7 * L.ldb);
  return f;
}
template <int I>
DEVFN uint4 bf_pack(const F4x8& f) {
  uint4 wv;
  wv.x = cvtpk(f.f0[I], f.f1[I]); wv.y = cvtpk(f.f2[I], f.f3[I]); wv.z = cvtpk(f.f4[I], f.f5[I]); wv.w = cvtpk(f.f6[I], f.f7[I]);
  return wv;
}
DEVFN void bf_store(char* tile, int tid, const F4x8& f) {
  int lane = tid & 63, w = tid >> 6, kg = lane & 7, ng = w * 8 + (lane >> 3);
  char* d = tile + (4 * ng) * G_ROWB + kg * 16;
  *(uint4*)(d) = bf_pack<0>(f); *(uint4*)(d + G_ROWB) = bf_pack<1>(f); *(uint4*)(d + 2 * G_ROWB) = bf_pack<2>(f); *(uint4*)(d + 3 * G_ROWB) = bf_pack<3>(f);
}

DEVFN void gemm_compute(const char* st, int wm, int wn, int fro, f32x16 (&acc)[2][2]) {
  const char* sA = st + wm * 64 * G_ROWB + fro;
  const char* sB = st + G_TILEB + wn * 64 * G_ROWB + fro;
#pragma unroll
  for (int ks = 0; ks < 4; ++ks) {
    bf16x8 a0 = *(const bf16x8*)(sA + ks * 32);
    bf16x8 a1 = *(const bf16x8*)(sA + 32 * G_ROWB + ks * 32);
    bf16x8 b0 = *(const bf16x8*)(sB + ks * 32);
    bf16x8 b1 = *(const bf16x8*)(sB + 32 * G_ROWB + ks * 32);
    acc[0][0] = __builtin_amdgcn_mfma_f32_32x32x16_bf16(a0, b0, acc[0][0], 0, 0, 0);
    acc[0][1] = __builtin_amdgcn_mfma_f32_32x32x16_bf16(a0, b1, acc[0][1], 0, 0, 0);
    acc[1][0] = __builtin_amdgcn_mfma_f32_32x32x16_bf16(a1, b0, acc[1][0], 0, 0, 0);
    acc[1][1] = __builtin_amdgcn_mfma_f32_32x32x16_bf16(a1, b1, acc[1][1], 0, 0, 0);
  }
}
template <class ALd, class BLd, class Epi>
DEVFN void gemm_tile(char* smem, int tidx_, const ALd& A, const BLd& B, int KT, Epi epi) {
  const int tid = tidx_, lane = tid & 63, wave = tid >> 6, wm = wave >> 1, wn = wave & 1;
  f32x16 acc[2][2];
#pragma unroll
  for (int i = 0; i < 2; ++i)
#pragma unroll
    for (int j = 0; j < 2; ++j)
#pragma unroll
      for (int r = 0; r < 16; ++r) acc[i][j][r] = 0.f;
  const int fro = (lane & 31) * G_ROWB + (lane >> 5) * 16;
  U4x4 a0 = A(0), b0 = B(0);
  U4x4 a1 = A(1), b1 = B(1);
  rl_store(smem, tid, a0); rl_store(smem + G_TILEB, tid, b0);
  __syncthreads();
  for (int kt = 0; kt < KT; kt += 2) {
    if (kt + 2 < KT) { a0 = A(kt + 2); b0 = B(kt + 2); }
    gemm_compute(smem, wm, wn, fro, acc);
    rl_store(smem + G_STAGEB, tid, a1); rl_store(smem + G_STAGEB + G_TILEB, tid, b1);
    __syncthreads();
    if (kt + 3 < KT) { a1 = A(kt + 3); b1 = B(kt + 3); }
    gemm_compute(smem + G_STAGEB, wm, wn, fro, acc);
    if (kt + 2 < KT) { rl_store(smem, tid, a0); rl_store(smem + G_TILEB, tid, b0); }
    __syncthreads();
  }
#pragma unroll
  for (int mt = 0; mt < 2; ++mt)
#pragma unroll
    for (int q = 0; q < 4; ++q)
#pragma unroll
      for (int nt = 0; nt < 2; ++nt) {
        int row = wm * 64 + mt * 32 + 8 * q + 4 * (lane >> 5);
        int col = wn * 64 + nt * 32 + (lane & 31);
        epi(nt, row, col, acc[mt][nt][4 * q], acc[mt][nt][4 * q + 1], acc[mt][nt][4 * q + 2], acc[mt][nt][4 * q + 3]);
      }
}

template <class ALd, class BLd, class Epi>
DEVFN void gemm_tile1(char* smem, int tidx_, const ALd& A, const BLd& B, int KT, Epi epi) {
  const int tid = tidx_, lane = tid & 63, wave = tid >> 6, wm = wave >> 1, wn = wave & 1;
  f32x16 acc[2][2];
#pragma unroll
  for (int i = 0; i < 2; ++i)
#pragma unroll
    for (int j = 0; j < 2; ++j)
#pragma unroll
      for (int r = 0; r < 16; ++r) acc[i][j][r] = 0.f;
  const int fro = (lane & 31) * G_ROWB + (lane >> 5) * 16;
  U4x4 av = A(0), bv = B(0);
  rl_store(smem, tid, av); rl_store(smem + G_TILEB, tid, bv);
  __syncthreads();
  for (int kt = 0; kt < KT; ++kt) {
    const int cur = kt & 1;
    const bool more = kt + 1 < KT;
    if (more) { av = A(kt + 1); bv = B(kt + 1); }
    gemm_compute(smem + cur * G_STAGEB, wm, wn, fro, acc);
    if (more) { char* st = smem + (cur ^ 1) * G_STAGEB; rl_store(st, tid, av); rl_store(st + G_TILEB, tid, bv); }
    __syncthreads();
  }
#pragma unroll
  for (int mt = 0; mt < 2; ++mt)
#pragma unroll
    for (int q = 0; q < 4; ++q)
#pragma unroll
      for (int nt = 0; nt < 2; ++nt) {
        int row = wm * 64 + mt * 32 + 8 * q + 4 * (lane >> 5);
        int col = wn * 64 + nt * 32 + (lane & 31);
        epi(nt, row, col, acc[mt][nt][4 * q], acc[mt][nt][4 * q + 1], acc[mt][nt][4 * q + 2], acc[mt][nt][4 * q + 3]);
      }
}

constexpr int GL_TILEB = 128 * 128, GL_STAGEB = 2 * GL_TILEB;
struct GRows { const bf16_t *r0, *r1, *r2, *r3; };
DEVFN int g_chunk(int tid) { return ((tid & 7) ^ ((tid >> 4) & 7)) * 8; }
DEVFN GRows make_grows(int tid, const bf16_t* base, long row0, long ld) {
  GRows L;
  const bf16_t* b0 = base + (row0 + (tid >> 3)) * ld + g_chunk(tid);
  L.r0 = b0; L.r1 = b0 + 32 * ld; L.r2 = b0 + 64 * ld; L.r3 = b0 + 96 * ld;
  return L;
}
DEVFN void glds16(const bf16_t* src, unsigned lds_dst) {
  unsigned keep;
  asm volatile("s_mov_b32 %0, m0\n\ts_mov_b32 m0, %2\n\ts_nop 0\n\tglobal_load_lds_dwordx4 %1, off\n\ts_mov_b32 m0, %0"
               : "=&s"(keep) : "v"(src), "s"(lds_dst));
}
DEVFN unsigned lds_addr(const char* p) { return (unsigned)(unsigned long)(const __attribute__((address_space(3))) char*)p; }
DEVFN void g_stage(char* st, int wave, const GRows& A, const GRows& B, int kt) {
  const unsigned sa = (unsigned)__builtin_amdgcn_readfirstlane((int)(lds_addr(st) + wave * 1024));
  const unsigned sb = sa + GL_TILEB;
  glds16(A.r0 + kt * 64, sa); glds16(A.r1 + kt * 64, sa + 4096); glds16(A.r2 + kt * 64, sa + 8192); glds16(A.r3 + kt * 64, sa + 12288);
  glds16(B.r0 + kt * 64, sb); glds16(B.r1 + kt * 64, sb + 4096); glds16(B.r2 + kt * 64, sb + 8192); glds16(B.r3 + kt * 64, sb + 12288);
}
template <int I>
DEVFN void g_stage_part(unsigned sa, const GRows& A, const GRows& B, int kt) {
  const bf16_t* ar = I == 0 ? A.r0 : I == 1 ? A.r1 : I == 2 ? A.r2 : A.r3;
  const bf16_t* br = I == 0 ? B.r0 : I == 1 ? B.r1 : I == 2 ? B.r2 : B.r3;
  glds16(ar + kt * 64, sa + I * 4096);
  glds16(br + kt * 64, sa + GL_TILEB + I * 4096);
}
template <class Epi>
DEVFN void gemm_tile_g(char* smem, int tidx_, const GRows& A, const GRows& B, int KT, Epi epi, int koff = 0) {
  const int tid = tidx_, lane = tid & 63, wave = tid >> 6, wm = wave >> 1, wn = wave & 1;
  f32x16 acc[2][2];
#pragma unroll
  for (int i = 0; i < 2; ++i)
#pragma unroll
    for (int j = 0; j < 2; ++j)
#pragma unroll
      for (int r = 0; r < 16; ++r) acc[i][j][r] = 0.f;
  const int sw = (lane >> 1) & 7, h = lane >> 5;
  int off[4];
#pragma unroll
  for (int ks = 0; ks < 4; ++ks) off[ks] = (lane & 31) * 128 + ((((2 * ks) ^ (sw & 6)) | (h ^ (sw & 1))) * 16);
  const unsigned sbase = (unsigned)__builtin_amdgcn_readfirstlane((int)(lds_addr(smem) + wave * 1024));
  g_stage(smem, wave, A, B, koff & (KT - 1));
  asm volatile("s_waitcnt vmcnt(0)" ::: "memory");
  __syncthreads();
  for (int kt = 0; kt < KT; ++kt) {
    const int cur = kt & 1;
    const bool more = kt + 1 < KT;
    const int ktn = (kt + 1 + koff) & (KT - 1);
    const unsigned san = sbase + (cur ^ 1) * GL_STAGEB;
    const char* sA = smem + cur * GL_STAGEB + wm * 64 * 128;
    const char* sB = smem + cur * GL_STAGEB + GL_TILEB + wn * 64 * 128;
    bf16x8 fa0[2], fa1[2], fb0[2], fb1[2];
    fa0[0] = *(const bf16x8*)(sA + off[0]); fa1[0] = *(const bf16x8*)(sA + 32 * 128 + off[0]);
    fb0[0] = *(const bf16x8*)(sB + off[0]); fb1[0] = *(const bf16x8*)(sB + 32 * 128 + off[0]);
#pragma unroll
    for (int ks = 0; ks < 4; ++ks) {
      const int c = ks & 1, n = c ^ 1;
      if (ks < 3) {
        fa0[n] = *(const bf16x8*)(sA + off[ks + 1]); fa1[n] = *(const bf16x8*)(sA + 32 * 128 + off[ks + 1]);
        fb0[n] = *(const bf16x8*)(sB + off[ks + 1]); fb1[n] = *(const bf16x8*)(sB + 32 * 128 + off[ks + 1]);
      }
      __builtin_amdgcn_sched_barrier(0);
      if (more) {
        if (ks == 0) { g_stage_part<0>(san, A, B, ktn); g_stage_part<1>(san, A, B, ktn); }
        else if (ks == 1) { g_stage_part<2>(san, A, B, ktn); g_stage_part<3>(san, A, B, ktn); }
      }
      acc[0][0] = __builtin_amdgcn_mfma_f32_32x32x16_bf16(fa0[c], fb0[c], acc[0][0], 0, 0, 0);
      acc[0][1] = __builtin_amdgcn_mfma_f32_32x32x16_bf16(fa0[c], fb1[c], acc[0][1], 0, 0, 0);
      acc[1][0] = __builtin_amdgcn_mfma_f32_32x32x16_bf16(fa1[c], fb0[c], acc[1][0], 0, 0, 0);
      acc[1][1] = __builtin_amdgcn_mfma_f32_32x32x16_bf16(fa1[c], fb1[c], acc[1][1], 0, 0, 0);
      __builtin_amdgcn_sched_barrier(0);
    }
    asm volatile("s_waitcnt vmcnt(0)" ::: "memory");
    __syncthreads();
  }
#pragma unroll
  for (int mt = 0; mt < 2; ++mt)
#pragma unroll
    for (int q = 0; q < 4; ++q)
#pragma unroll
      for (int nt = 0; nt < 2; ++nt) {
        int row = wm * 64 + mt * 32 + 8 * q + 4 * (lane >> 5);
        int col = wn * 64 + nt * 32 + (lane & 31);
        epi(nt, row, col, acc[mt][nt][4 * q], acc[mt][nt][4 * q + 1], acc[mt][nt][4 * q + 2], acc[mt][nt][4 * q + 3]);
      }
}

DEVFN int xcd_order(int v, int nblocks, int grp) {
  if (nblocks != 512) return v;
  const int it = v / nblocks, b = v % nblocks;
  const int x = b & 7, slot = b >> 3, per = nblocks >> 3;
  const int q = it * per + slot;
  return ((q / grp) * 8 + x) * grp + (q % grp);
}
struct PatchTile { int tm, tn, koff; };
DEVFN PatchTile patch8(int v, int nblocks, int& pidx) {
  const int it = v / nblocks, b = v % nblocks;
  const int x = b & 7, slot = b >> 3;
  PatchTile t; t.tm = slot & 7; t.tn = slot >> 3; t.koff = (t.tm + t.tn) & 7;
  pidx = it * 8 + x;
  return t;
}
DEVFN RowLoader make_rows(int tidx_, const bf16_t* base, long row0, long ld) {
  RowLoader L; int tid = tidx_;
  const bf16_t* b0 = base + (row0 + (tid >> 3)) * ld + (tid & 7) * 8;
  L.r0 = b0; L.r1 = b0 + 32 * ld; L.r2 = b0 + 64 * ld; L.r3 = b0 + 96 * ld;
  return L;
}
DEVFN float shx1(float v) { return __builtin_bit_cast(float, __builtin_amdgcn_mov_dpp(__builtin_bit_cast(int, v), 0xB1, 0xF, 0xF, true)); }
DEVFN void store4_bf16(bf16_t* p0, long ld, bool odd, float v0, float v1, float v2, float v3) {
  bf16_t* q = odd ? p0 + ld - 1 : p0;
  const float y0 = shx1(odd ? v0 : v1), y1 = shx1(odd ? v2 : v3);
  *(unsigned*)q = cvtpk(odd ? y0 : v0, odd ? v1 : y0);
  *(unsigned*)(q + 2 * ld) = cvtpk(odd ? y1 : v2, odd ? v3 : y1);
}

DEVFN void ph_init_fast(const Params& p) {
  PHASE_BEGIN;
  const long gt = GTID, gs = GSIZE;
  for (long idx = gt; idx < (long)DEPTH * D * MIX_W; idx += gs) {
    int k = idx % MIX_W; int n = (idx / MIX_W) % D; int l = idx / ((long)MIX_W * D);
    p.woutt[idx] = f2bf(p.w_out[((long)l * MIX_W + k) * D + n]);
  }
  for (long idx = gt; idx < (long)DEPTH * S5_W * S5_W; idx += gs) {
    int k = idx % S5_W; int n = (idx / S5_W) % S5_W; int l = idx / (S5_W * S5_W);
    p.wglut[idx] = f2bf(p.s5_w_glu[((long)l * S5_W + k) * S5_W + n]);
  }
  for (long idx = gt; idx < (long)SEQ * 2 * SEQ; idx += gs) {
    int n2 = idx % (2 * SEQ), k = idx / (2 * SEQ); int n = n2 % SEQ;
    double a = 6.283185307179586476925 * (double)(((long)k * n) % SEQ) / SEQ;
    double v = (n2 < SEQ ? cos(a) : -sin(a)) / sqrt((double)SEQ);
    p.dftc[idx] = f2bf((float)v);
  }
  for (long idx = gt; idx < (long)DSEQ * 2 * DSEQ; idx += gs) {
    int n2 = idx % (2 * DSEQ), k = idx / (2 * DSEQ); int n = n2 % DSEQ;
    double a = 6.283185307179586476925 * (double)(((long)k * n) % DSEQ) / DSEQ;
    double v = (n2 < DSEQ ? cos(a) : -sin(a)) / sqrt((double)DSEQ);
    p.dftl[idx] = f2bf((float)v);
  }
  for (long idx = gt; idx < 64 * 16; idx += gs) {
    int fi = idx % 16, pos = idx / 16;
    float freq = powf(10000.f, -(float)fi / 16.f);
    float ang = (float)pos * freq;
    p.rope[idx * 2] = cosf(ang); p.rope[idx * 2 + 1] = sinf(ang);
  }
}
DEVFN void ph_init_fast2(const Params& p) {
  PHASE_BEGIN;
  const long gt = GTID, gs = GSIZE;
  for (long idx = gt; idx < (long)DEPTH * NP * D; idx += gs) {
    int k = idx % D; int n = (idx / D) % NP; int l = idx / ((long)D * NP);
    p.win2t[idx] = f2bf(p.win2[((long)l * D + k) * NP + n]);
  }
}

constexpr int CONV_EARLY = 14;
DEVFN void conv_range(const Params& p, int l, int first, int count, char* smem, int tid);
DEVFN void ph_gemm_in_fast(const Params& p, int l, char* smem) {
  PHASE_BEGIN;
  constexpr int NT_N = NP / 128, NT_M = T / 128;
  float* ropes = (float*)(smem + 2 * GL_STAGEB);
  for (int i = tidx_; i < 64 * 16 * 2 / 4; i += 256) ((f32x4*)ropes)[i] = ((const f32x4*)p.rope)[i];
  __syncthreads();
  for (int v = bidx_; v < NT_M * NT_N; v += gridDim.x) {
    const int tile = xcd_order(v, gridDim.x, 8 * NT_N);
    const int tm = tile / NT_N, tn = tile % NT_N;
    const int koff = gridDim.x == 512 ? (tm + tn) & 15 : 0;
    const int m0 = tm * 128, n0 = tn * 128;
    GRows A = make_grows(tidx_, p.h, m0, D);
    GRows B = make_grows(tidx_, p.win2t + (long)l * NP * D, n0, D);
    const TokInfo t0i = tokinfo(m0);
    const int lane = tidx_ & 63;
    const bool odd = lane & 1;
    gemm_tile_g(smem, tidx_, A, B, D / 64, [&](int nt, int row, int col, float v0, float v1, float v2, float v3) {
      const int j = n0 + col;
      const long t = m0 + row;
      const int n = t0i.n + row;
      float v[4] = {v0, v1, v2, v3};
      if (n0 >= PC_P && n0 < PC_U) {
        int jj = j - PC_P; int isq = jj >= 256; int jc = jj & 255;
        bf16_t* dst = p.pqt + pqt_base(t0i.lat, t0i.b) + (long)jc * 2 * t0i.N + (isq ? t0i.N : 0) + n;
        uint2 pk; pk.x = cvtpk(v[0], v[1]); pk.y = cvtpk(v[2], v[3]);
        *(uint2*)dst = pk;
        return;
      }
      float pr[4];
#pragma unroll
      for (int i = 0; i < 4; ++i) pr[i] = shx1(v[i]);
      if (t0i.lat && n0 < PC_V) {
        int pi = (j & 63) >> 1; int fi = pi & 15;
#pragma unroll
        for (int i = 0; i < 4; ++i) {
          int pos = (pi < 16) ? ((n + i) >> 6) : ((n + i) & 63);
          const f32x2_t csn = *(const f32x2_t*)(ropes + (pos * 16 + fi) * 2); const float cs = csn[0], sn = csn[1];
          float x1 = odd ? pr[i] : v[i], x2 = odd ? v[i] : pr[i];
          float r0 = x1 * cs - x2 * sn, r1 = x1 * sn + x2 * cs;
          v[i] = odd ? r1 : r0; pr[i] = odd ? r0 : r1;
        }
      }
      const int pj = (n0 < PC_P) ? j : PJ_U + (j - PC_U);
      {
        bf16_t* q = p.proj + (t + (odd ? 1 : 0)) * NPJ + (pj & ~1);
        *(unsigned*)q = odd ? cvtpk(pr[1], v[1]) : cvtpk(v[0], pr[0]);
        *(unsigned*)(q + 2 * NPJ) = odd ? cvtpk(pr[3], v[3]) : cvtpk(v[2], pr[2]);
      }
      if (!t0i.lat && n0 >= PC_K && n0 < PC_P) {
        float* ob = p.out + (n0 < PC_V ? O_K + (j - PC_K) : O_V + (j - PC_V));
#pragma unroll
        for (int i = 0; i < 4; ++i) ob[(((long)t0i.b * DEPTH + l) * SEQ + n + i) * KV_W] = v[i];
      }
    }, koff);
  }
}
DEVFN void ph_gemm_out_fast(const Params& p, int l, char* smem) {
  PHASE_BEGIN;
  constexpr int NT_N = D / 128, NT_M = T / 128;
  for (int v = bidx_; v < NT_M * NT_N; v += gridDim.x) {
    int tm, tn, koff = 0;
    if (gridDim.x == 512) { int pidx; PatchTile pt = patch8(v, 512, pidx); tm = pidx * 8 + pt.tm; tn = pt.tn; koff = pt.koff; }
    else { tm = v / NT_N; tn = v % NT_N; }
    const int m0 = tm * 128, n0 = tn * 128;
    GRows A = make_grows(tidx_, p.mixcat, m0, MIX_W);
    GRows B = make_grows(tidx_, p.woutt + (long)l * D * MIX_W, n0, MIX_W);
    const TokInfo t0i = tokinfo(m0);
    const float* gate1 = modp(p, l, t0i.ci, 2);
    const int lane_ = tidx_ & 63, cb = n0 + ((tidx_ >> 6) & 1) * 64 + (lane_ & 31);
    const float g0 = gate1[cb], g1 = gate1[cb + 32];
    gemm_tile_g(smem, tidx_, A, B, MIX_W / 64, [&](int nt, int row, int col, float v0, float v1, float v2, float v3) {
      const float g = nt ? g1 : g0;
      store4_bf16((bf16_t*)p.ybuf + (long)(m0 + row) * D + n0 + col, D, lane_ & 1, g * v0, g * v1, g * v2, g * v3);
    }, koff);
  }
}
DEVFN void ph_glu_fast(const Params& p, int l, char* smem) {
  PHASE_BEGIN;
  constexpr int NT_N = S5_W / 128, NT_M = T / 128;
  for (int tile = bidx_; tile < NT_M * NT_N; tile += gridDim.x) {
    const int tm = tile / NT_N, tn = tile % NT_N;
    const int m0 = tm * 128, n0 = tn * 128;
    RowLoader A = make_rows(tidx_, p.gbuf, m0, S5_W);
    RowLoader B = make_rows(tidx_, p.wglut + (long)l * S5_W * S5_W, n0, S5_W);
    const bool odd = tidx_ & 1;
    gemm_tile(smem, tidx_, A, B, S5_W / 64, [&](int nt, int row, int col, float v0, float v1, float v2, float v3) {
      const int j = n0 + col;
      float v[4] = {v0, v1, v2, v3};
#pragma unroll
      for (int i = 0; i < 4; ++i) {
        long t = m0 + row + i;
        float g = bf2f(p.gbuf[t * S5_W + j]);
        float r = g * sigmoid_f(v[i]);
        float pr = shx1(r);
        if (!odd) *(unsigned*)(p.mixcat + t * MIX_W + ATTN_W + FOUR_W + j) = cvtpk(r, pr);
      }
    });
  }
}
DEVFN void fourier_tile(const Params& p, int item, char* smem, int tidx_) {
  constexpr int NL = DB * (DSEQ / 128) * 2 * 2;
  int lat, b, tm, tn, N, hk, KT;
  if (item < NL) { lat = 1; N = DSEQ; hk = item & 1; tn = (item >> 1) & 1; tm = (item >> 2) % (DSEQ / 128); b = item / (4 * (DSEQ / 128)); KT = DSEQ / 64; }
  else { int it = item - NL; lat = 0; N = SEQ; hk = 0; tn = it & 1; tm = (it >> 1) % (SEQ / 128); b = it / (2 * (SEQ / 128)); KT = 2 * SEQ / 64; }
  const int t0 = lat ? TC + b * DSEQ : b * SEQ;
  GRows A = make_grows(tidx_, (lat ? p.dftl : p.dftc) + hk * DSEQ, tm * 128, 2 * N);
  GRows B = make_grows(tidx_, p.pqt + pqt_base(lat, b) + hk * DSEQ, tn * 128, 2 * N);
  const bool odd = tidx_ & 1;
  float* dst = p.win2 + ((long)hk * DB * DSEQ + b * DSEQ + tm * 128) * FOUR_W + tn * 128;
  gemm_tile_g(smem, tidx_, A, B, KT, [&](int nt, int row, int col, float v0, float v1, float v2, float v3) {
    if (lat) {
      float* d = dst + (long)row * FOUR_W + col;
      d[0] = v0; d[FOUR_W] = v1; d[2 * FOUR_W] = v2; d[3 * FOUR_W] = v3;
    } else {
      store4_bf16(p.mixcat + (long)(t0 + tm * 128 + row) * MIX_W + ATTN_W + tn * 128 + col, MIX_W, odd, v0, v1, v2, v3);
    }
  });
}
constexpr int N_FOURIER_ITEMS = DB * (DSEQ / 128) * 2 + BATCH * (SEQ / 128) * 2;
DEVFN void ph_fourier_fast(const Params& p, int l, char* smem) {
  PHASE_BEGIN;
  for (int item = bidx_; item < N_FOURIER_ITEMS; item += gridDim.x) fourier_tile(p, item, smem, tidx_);
}
DEVFN void ph_moe1_fast(const Params& p, int l, char* smem) {
  PHASE_BEGIN;
  constexpr int NT_M = NS / 128, NT_N = FF / 64;
  const int tid = tidx_, lane = tid & 63;
  auto decode = [&](int v, int& tm, int& tn, int& e, int& koff) {
    koff = 0;
    if (gridDim.x == 512) { int pidx; PatchTile pt = patch8(v, 512, pidx); e = pidx >> 1; tm = pt.tm; tn = (pidx & 1) * 8 + pt.tn; koff = pt.koff; }
    else { tm = v % NT_M; tn = (v / NT_M) % NT_N; e = v / (NT_M * NT_N); }
  };
  int sn0 = 0, sn1 = 0, sn2 = 0, sn3 = 0;
  if (bidx_ < NE * NT_M * NT_N) {
    int tm, tn, e, koff; decode(bidx_, tm, tn, e, koff);
    const int* stp = p.seltok + e * NS + tm * 128 + (tid >> 3);
    sn0 = stp[0]; sn1 = stp[32]; sn2 = stp[64]; sn3 = stp[96];
  }
  for (int v = bidx_; v < NE * NT_M * NT_N; v += gridDim.x) {
    int tm, tn, e, koff;
    decode(v, tm, tn, e, koff);
    const int s0 = tm * 128, f0 = tn * 64;
    GRows A;
    {
      const bf16_t* hb = p.h2 + g_chunk(tid);
      A.r0 = hb + (long)sn0 * D; A.r1 = hb + (long)sn1 * D; A.r2 = hb + (long)sn2 * D; A.r3 = hb + (long)sn3 * D;
    }
    if (v + (int)gridDim.x < NE * NT_M * NT_N) {
      int tm2, tn2, e2, koff2; decode(v + gridDim.x, tm2, tn2, e2, koff2);
      const int* stp = p.seltok + e2 * NS + tm2 * 128 + (tid >> 3);
      sn0 = stp[0]; sn1 = stp[32]; sn2 = stp[64]; sn3 = stp[96];
    }
    GRows B;
    {
      const long o = ((long)e * FF + f0 + (tid >> 3)) * D + g_chunk(tid);
      B.r0 = p.wgt + o; B.r1 = p.wut + o; B.r2 = p.wgt + o + 32L * D; B.r3 = p.wut + o + 32L * D;
    }
    const bool odd = lane & 1;
    float gsave[4];
    gemm_tile_g(smem, tidx_, A, B, D / 64, [&](int nt, int row, int col, float v0, float v1, float v2, float v3) {
      if (nt == 0) { gsave[0] = v0; gsave[1] = v1; gsave[2] = v2; gsave[3] = v3; return; }
      float v[4] = {v0, v1, v2, v3};
      const int ff = f0 + 32 * (col >> 6) + (col & 31);
      store4_bf16(p.hid + ((long)e * NS + s0 + row) * FF + ff, FF, odd, silu_fast(gsave[0]) * v[0], silu_fast(gsave[1]) * v[1],
                  silu_fast(gsave[2]) * v[2], silu_fast(gsave[3]) * v[3]);
    }, koff);
  }
}
DEVFN void ph_moe2_fast(const Params& p, int l, char* smem) {
  PHASE_BEGIN;
  constexpr int NT_M = NS / 128, NT_N = D / 128;
  const int lane = tidx_ & 63;
  for (int v = bidx_; v < NE * NT_M * NT_N; v += gridDim.x) {
    int tm, tn, e, koff = 0;
    if (gridDim.x == 512) { int pidx; PatchTile pt = patch8(v, 512, pidx); e = pidx; tm = pt.tm; tn = pt.tn; koff = pt.koff; }
    else { tm = v % NT_M; tn = (v / NT_M) % NT_N; e = v / (NT_M * NT_N); }
    const int s0 = tm * 128, n0 = tn * 128;
    GRows A = make_grows(tidx_, p.hid + (long)e * NS * FF, s0, FF);
    GRows B = make_grows(tidx_, p.wdt + (long)e * D * FF, n0, FF);
    const bool odd = lane & 1;
    gemm_tile_g(smem, tidx_, A, B, FF / 64, [&](int nt, int row, int col, float v0, float v1, float v2, float v3) {
      store4_bf16(p.ys + ((long)e * NS + s0 + row) * D + n0 + col, D, odd, v0, v1, v2, v3);
    }, koff);
  }
}
template <int CTRL> DEVFN float dppf(float v) {
  return __builtin_bit_cast(float, __builtin_amdgcn_mov_dpp(__builtin_bit_cast(int, v), CTRL, 0xF, 0xF, true));
}
DEVFN float rdlane(float v, int l) { return __builtin_bit_cast(float, __builtin_amdgcn_readlane(__builtin_bit_cast(int, v), l)); }
DEVFN float wave_sum(float v) {
  v += dppf<0xB1>(v);
  v += dppf<0x4E>(v);
  v += dppf<0x141>(v);
  v += dppf<0x140>(v);
  return (rdlane(v, 0) + rdlane(v, 16)) + (rdlane(v, 32) + rdlane(v, 48));
}
DEVFN float bflo(unsigned u) { return u_as_f(u << 16); }
DEVFN float bfhi(unsigned u) { return u_as_f(u & 0xffff0000u); }

struct RowX { f32x4 a0, a1, a2, a3; };
struct RowG { uint2 u00, u01, u02, u03, u10, u11, u12, u13, u20, u21, u22, u23, u30, u31, u32, u33; float g0, g1, g2, g3; unsigned rest; };
DEVFN void ph_row1_fast(const Params& p, int l, char* smem) {
  PHASE_BEGIN;
  const int lane = tidx_ & 63, d0 = 4 * lane;
  float* prm = (float*)smem;
  for (int t4 = (bidx_ * 4 + (tidx_ >> 6)) * 4; t4 < T; t4 += gridDim.x * 16) {
    TokInfo ti = tokinfo(t4);
    const float *pxs = p.x_sample, *pxp = p.x_prompt, *px = p.x, *pg0 = p.ln_in_g, *pb0 = p.ln_in_b, *pg2 = p.ln2_g, *pb2 = p.ln2_b;
    asm volatile("" : "+s"(pxs), "+s"(pxp), "+s"(px), "+s"(pg0), "+s"(pb0), "+s"(pg2), "+s"(pb2));
    const float* src4 = l == 0 ? (ti.lat ? pxs + (long)(t4 - TC) * D : pxp + (long)t4 * D) : px + (long)t4 * D;
    const float* g = l == 0 ? pg0 : pg2 + (long)(l - 1) * D;
    const float* b = l == 0 ? pb0 : pb2 + (long)(l - 1) * D;
    const float* gate2 = modp(p, l > 0 ? l - 1 : 0, ti.ci, 5);
    const int lm = l < DEPTH ? l : DEPTH - 1;
    const float* sh = modp(p, lm, ti.ci, 0); const float* sc = modp(p, lm, ti.ci, 1);
    int iv0 = -1, iv1 = -1, iv2 = -1, iv3 = -1;
    if (l > 0 && lane < NE) {
      const int* ip = p.inv + (long)t4 * NE + lane;
      iv0 = ip[0]; iv1 = ip[NE]; iv2 = ip[2 * NE]; iv3 = ip[3 * NE];
    }
    __syncthreads();
    {
      const f32x4 a0 = *(const f32x4*)(g + 4 * tidx_), a1 = *(const f32x4*)(b + 4 * tidx_), a2 = *(const f32x4*)(gate2 + 4 * tidx_);
      const f32x4 a3 = *(const f32x4*)(sh + 4 * tidx_), a4 = *(const f32x4*)(sc + 4 * tidx_);
      *(f32x4*)(prm + 4 * tidx_) = a0; *(f32x4*)(prm + D + 4 * tidx_) = a1; *(f32x4*)(prm + 2 * D + 4 * tidx_) = a2;
      *(f32x4*)(prm + 3 * D + 4 * tidx_) = a3; *(f32x4*)(prm + 4 * D + 4 * tidx_) = a4;
    }
    __syncthreads();
    auto xload = [&](int k) -> RowX {
      const float* s_ = src4 + (long)k * D + d0;
      RowX r; r.a0 = *(const f32x4*)s_; r.a1 = *(const f32x4*)(s_ + 256); r.a2 = *(const f32x4*)(s_ + 512); r.a3 = *(const f32x4*)(s_ + 768);
      return r;
    };
    auto gather = [&](int myinv) -> RowG {
      RowG r;
      const uint2 z = make_uint2(0u, 0u);
      r.u00 = r.u01 = r.u02 = r.u03 = r.u10 = r.u11 = r.u12 = r.u13 = r.u20 = r.u21 = r.u22 = r.u23 = r.u30 = r.u31 = r.u32 = r.u33 = z;
      r.g0 = r.g1 = r.g2 = r.g3 = 0.f;
      unsigned mask = (unsigned)__ballot(myinv >= 0) & 0xffffu;
      if (mask) {
        const int e = __builtin_ctz(mask); mask &= mask - 1; const int s_ = __builtin_amdgcn_readlane(myinv, e);
        const bf16_t* yr = p.ys + ((long)e * NS + s_) * D + d0; r.g0 = p.selgate[e * NS + s_];
        r.u00 = *(const uint2*)yr; r.u01 = *(const uint2*)(yr + 256); r.u02 = *(const uint2*)(yr + 512); r.u03 = *(const uint2*)(yr + 768);
      }
      if (mask) {
        const int e = __builtin_ctz(mask); mask &= mask - 1; const int s_ = __builtin_amdgcn_readlane(myinv, e);
        const bf16_t* yr = p.ys + ((long)e * NS + s_) * D + d0; r.g1 = p.selgate[e * NS + s_];
        r.u10 = *(const uint2*)yr; r.u11 = *(const uint2*)(yr + 256); r.u12 = *(const uint2*)(yr + 512); r.u13 = *(const uint2*)(yr + 768);
      }
      if (mask) {
        const int e = __builtin_ctz(mask); mask &= mask - 1; const int s_ = __builtin_amdgcn_readlane(myinv, e);
        const bf16_t* yr = p.ys + ((long)e * NS + s_) * D + d0; r.g2 = p.selgate[e * NS + s_];
        r.u20 = *(const uint2*)yr; r.u21 = *(const uint2*)(yr + 256); r.u22 = *(const uint2*)(yr + 512); r.u23 = *(const uint2*)(yr + 768);
      }
      if (mask) {
        const int e = __builtin_ctz(mask); mask &= mask - 1; const int s_ = __builtin_amdgcn_readlane(myinv, e);
        const bf16_t* yr = p.ys + ((long)e * NS + s_) * D + d0; r.g3 = p.selgate[e * NS + s_];
        r.u30 = *(const uint2*)yr; r.u31 = *(const uint2*)(yr + 256); r.u32 = *(const uint2*)(yr + 512); r.u33 = *(const uint2*)(yr + 768);
      }
      r.rest = mask;
      return r;
    };
    RowX xc = xload(0);
    RowG gc; gc.rest = 0u;
    if (l > 0) gc = gather(iv0);
#pragma unroll 1
    for (int k = 0; k < 4; ++k) {
      const int t = t4 + k;
      const int ivc = k == 0 ? iv0 : k == 1 ? iv1 : k == 2 ? iv2 : iv3;
      const int ivn = k == 0 ? iv1 : k == 1 ? iv2 : iv3;
      RowX xn = xc; RowG gn = gc;
      if (k < 3) { xn = xload(k + 1); if (l > 0) gn = gather(ivn); }
      const f32x4 xa[4] = {xc.a0, xc.a1, xc.a2, xc.a3};
      float v[16];
      if (l == 0) {
#pragma unroll
        for (int i = 0; i < 4; ++i) { v[4 * i] = xa[i][0]; v[4 * i + 1] = xa[i][1]; v[4 * i + 2] = xa[i][2]; v[4 * i + 3] = xa[i][3]; }
      } else {
        float m[16];
        {
          const uint2 u0[4] = {gc.u00, gc.u01, gc.u02, gc.u03}, u1[4] = {gc.u10, gc.u11, gc.u12, gc.u13};
          const uint2 u2[4] = {gc.u20, gc.u21, gc.u22, gc.u23}, u3[4] = {gc.u30, gc.u31, gc.u32, gc.u33};
#pragma unroll
          for (int i = 0; i < 4; ++i) {
            m[4 * i] = gc.g0 * bflo(u0[i].x) + gc.g1 * bflo(u1[i].x) + gc.g2 * bflo(u2[i].x) + gc.g3 * bflo(u3[i].x);
            m[4 * i + 1] = gc.g0 * bfhi(u0[i].x) + gc.g1 * bfhi(u1[i].x) + gc.g2 * bfhi(u2[i].x) + gc.g3 * bfhi(u3[i].x);
            m[4 * i + 2] = gc.g0 * bflo(u0[i].y) + gc.g1 * bflo(u1[i].y) + gc.g2 * bflo(u2[i].y) + gc.g3 * bflo(u3[i].y);
            m[4 * i + 3] = gc.g0 * bfhi(u0[i].y) + gc.g1 * bfhi(u1[i].y) + gc.g2 * bfhi(u2[i].y) + gc.g3 * bfhi(u3[i].y);
          }
        }
        unsigned mask = gc.rest;
        while (mask) {
          const int e = __builtin_ctz(mask); mask &= mask - 1;
          const int s_ = __builtin_amdgcn_readlane(ivc, e);
          const bf16_t* yr = p.ys + ((long)e * NS + s_) * D + d0;
          const float gk = p.selgate[e * NS + s_];
#pragma unroll
          for (int i = 0; i < 4; ++i) {
            const uint2 u = *(const uint2*)(yr + 256 * i);
            m[4 * i] += gk * bflo(u.x); m[4 * i + 1] += gk * bfhi(u.x); m[4 * i + 2] += gk * bflo(u.y); m[4 * i + 3] += gk * bfhi(u.y);
          }
        }
#pragma unroll
        for (int i = 0; i < 4; ++i) {
          const f32x4 g2 = *(const f32x4*)(prm + 2 * D + 256 * i + d0);
#pragma unroll
          for (int c = 0; c < 4; ++c) v[4 * i + c] = ALPHA * xa[i][c] + g2[c] * m[4 * i + c];
        }
      }
      float s = 0.f;
#pragma unroll
      for (int i = 0; i < 16; ++i) s += v[i];
      const float mu = wave_sum(s) * (1.f / D);
      float q = 0.f;
#pragma unroll
      for (int i = 0; i < 16; ++i) { float dv = v[i] - mu; q += dv * dv; }
      const float rs = 1.f / sqrtf(wave_sum(q) * (1.f / D) + LN_EPS);
      if (l < DEPTH) {
#pragma unroll
        for (int i = 0; i < 4; ++i) {
          f32x4 xo; float hv[4];
          const f32x4 lg = *(const f32x4*)(prm + 256 * i + d0), lb = *(const f32x4*)(prm + D + 256 * i + d0);
          const f32x4 ls = *(const f32x4*)(prm + 3 * D + 256 * i + d0), lc = *(const f32x4*)(prm + 4 * D + 256 * i + d0);
#pragma unroll
          for (int c = 0; c < 4; ++c) { xo[c] = (v[4 * i + c] - mu) * rs * lg[c] + lb[c]; hv[c] = xo[c] * (1.f + lc[c]) + ls[c]; }
          *(f32x4*)(p.x + (long)t * D + 256 * i + d0) = xo;
          uint2 pk; pk.x = cvtpk(hv[0], hv[1]); pk.y = cvtpk(hv[2], hv[3]);
          *(uint2*)(p.h + (long)t * D + 256 * i + d0) = pk;
        }
      } else {
        float* o = p.out + (ti.lat ? O_YS + (long)(t - TC) * D : O_YP + (long)t * D);
#pragma unroll
        for (int i = 0; i < 4; ++i) {
          f32x4 xo;
          const f32x4 lg = *(const f32x4*)(prm + 256 * i + d0), lb = *(const f32x4*)(prm + D + 256 * i + d0);
#pragma unroll
          for (int c = 0; c < 4; ++c) xo[c] = (v[4 * i + c] - mu) * rs * lg[c] + lb[c];
          *(f32x4*)(o + 256 * i + d0) = xo;
        }
      }
      xc = xn; gc = gn;
    }
  }
}

DEVFN void ph_row2_fast(const Params& p, int l, char* smem) {
  PHASE_BEGIN;
  const int lane = tidx_ & 63;
  float* wrt = (float*)smem;
#pragma unroll
  for (int q = tidx_; q < D * NE / 4; q += 256) {
    f32x4 v = *(const f32x4*)(p.w_router + (long)l * D * NE + q * 4);
    const int d = q >> 2, e4 = (q & 3) * 4;
    wrt[(e4 + 0) * D + d] = v[0]; wrt[(e4 + 1) * D + d] = v[1]; wrt[(e4 + 2) * D + d] = v[2]; wrt[(e4 + 3) * D + d] = v[3];
  }
  __syncthreads();
  for (int t4 = (bidx_ * 4 + (tidx_ >> 6)) * 4; t4 < T; t4 += gridDim.x * 16) {
    TokInfo ti = tokinfo(t4);
    const float* g = p.ln1_g + (long)l * D; const float* b = p.ln1_b + (long)l * D;
    const float* sh = modp(p, l, ti.ci, 3); const float* sc = modp(p, l, ti.ci, 4);
    uint2 ya[4]; f32x4 xa[4], lg[4], lb[4], ls[4], lc[4];
#pragma unroll
    for (int i = 0; i < 4; ++i) {
      const int dd = 256 * i + 4 * lane;
      ya[i] = *(const uint2*)((const bf16_t*)p.ybuf + (long)t4 * D + dd); xa[i] = *(const f32x4*)(p.x + (long)t4 * D + dd);
      lg[i] = *(const f32x4*)(g + dd); lb[i] = *(const f32x4*)(b + dd); ls[i] = *(const f32x4*)(sh + dd); lc[i] = *(const f32x4*)(sc + dd);
    }
#pragma unroll 1
   for (int k = 0; k < 4; ++k) {
    const int t = t4 + k;
    uint2 yn[4]; f32x4 xn[4];
#pragma unroll
    for (int i = 0; i < 4; ++i) { yn[i] = ya[i]; xn[i] = xa[i]; }
    if (k < 3) {
#pragma unroll
      for (int i = 0; i < 4; ++i) {
        const int dd = 256 * i + 4 * lane;
        yn[i] = *(const uint2*)((const bf16_t*)p.ybuf + (long)(t + 1) * D + dd); xn[i] = *(const f32x4*)(p.x + (long)(t + 1) * D + dd);
      }
    }
    float v[16];
#pragma unroll
    for (int i = 0; i < 4; ++i) {
      v[4 * i] = ALPHA * xa[i][0] + bflo(ya[i].x); v[4 * i + 1] = ALPHA * xa[i][1] + bfhi(ya[i].x);
      v[4 * i + 2] = ALPHA * xa[i][2] + bflo(ya[i].y); v[4 * i + 3] = ALPHA * xa[i][3] + bfhi(ya[i].y);
    }
    float s = 0.f;
#pragma unroll
    for (int i = 0; i < 16; ++i) s += v[i];
    const float mu = wave_sum(s) * (1.f / D);
    float q = 0.f;
#pragma unroll
    for (int i = 0; i < 16; ++i) { float dv = v[i] - mu; q += dv * dv; }
    const float rs = 1.f / sqrtf(wave_sum(q) * (1.f / D) + LN_EPS);
    float lgt[NE];
#pragma unroll
    for (int e = 0; e < NE; ++e) lgt[e] = 0.f;
#pragma unroll
    for (int i = 0; i < 4; ++i) {
      const int d0 = 256 * i + 4 * lane;
      f32x4 xo; float hv[4];
#pragma unroll
      for (int c = 0; c < 4; ++c) { xo[c] = (v[4 * i + c] - mu) * rs * lg[i][c] + lb[i][c]; hv[c] = xo[c] * (1.f + lc[i][c]) + ls[i][c]; }
      *(f32x4*)(p.x + (long)t * D + d0) = xo;
      uint2 pk; pk.x = cvtpk(hv[0], hv[1]); pk.y = cvtpk(hv[2], hv[3]);
      *(uint2*)(p.h2 + (long)t * D + d0) = pk;
#pragma unroll
      for (int e = 0; e < NE; ++e) {
        f32x4 w = *(const f32x4*)(wrt + e * D + d0);
        lgt[e] += hv[0] * w[0] + hv[1] * w[1] + hv[2] * w[2] + hv[3] * w[3];
      }
      asm volatile("" ::: "memory");
    }
#pragma unroll
    for (int e = 0; e < NE; ++e) lgt[e] = wave_sum(lgt[e]);
    float mx = lgt[0];
#pragma unroll
    for (int e = 1; e < NE; ++e) mx = fmaxf(mx, lgt[e]);
    float se = 0.f;
#pragma unroll
    for (int e = 0; e < NE; ++e) { lgt[e] = expf(lgt[e] - mx); se += lgt[e]; }
    const float is = 1.f / se;
    float mine = 0.f;
#pragma unroll
    for (int e = 0; e < NE; ++e) mine = (lane == e) ? lgt[e] * is : mine;
    if (lane < NE) { p.aff[(long)t * NE + lane] = mine; p.afft[(long)lane * T + t] = mine; }
#pragma unroll
    for (int i = 0; i < 4; ++i) { ya[i] = yn[i]; xa[i] = xn[i]; }
   }
  }
  __syncthreads();
}

DEVFN void ph_topk_fast(const Params& p, int l, char* smem) {
  PHASE_BEGIN;
  float* vals = (float*)smem;
  constexpr int NITEM = BATCH * NE * (SEQ / 256) + DB * NE * (DSEQ / 256);
  for (int item = bidx_; item < NITEM; item += gridDim.x) {
    int lat, b, e, chunk, N;
    if (item < BATCH * NE * (SEQ / 256)) { lat = 0; N = SEQ; e = item % NE; chunk = (item / NE) % (SEQ / 256); b = item / (NE * (SEQ / 256)); }
    else { int it = item - BATCH * NE * (SEQ / 256); lat = 1; N = DSEQ; e = it % NE; chunk = (it / NE) % (DSEQ / 256); b = it / (NE * (DSEQ / 256)); }
    const int t0 = lat ? TC + b * DSEQ : b * SEQ;
    {
      const float* src = p.afft + (long)e * T + t0 + tidx_;
      if (lat) {
        const float a0 = src[0], a1 = src[256], a2 = src[512], a3 = src[768];
        vals[tidx_] = a0; vals[tidx_ + 256] = a1; vals[tidx_ + 512] = a2; vals[tidx_ + 768] = a3;
      } else {
        vals[tidx_] = src[0];
      }
    }
    __syncthreads();
    const int n = chunk * 256 + tidx_;
    const float a = vals[n];
    const int w16 = __builtin_amdgcn_readfirstlane((chunk * 256 + (tidx_ & 192)) >> 4);
    int rank = 0;
    for (int j16 = 0; j16 < w16; ++j16) {
      f32x4 vv[4];
#pragma unroll
      for (int q = 0; q < 4; ++q) vv[q] = ((const f32x4*)vals)[4 * j16 + q];
#pragma unroll
      for (int q = 0; q < 4; ++q)
#pragma unroll
        for (int c = 0; c < 4; ++c) rank += (int)(vv[q][c] >= a);
    }
#pragma unroll
    for (int j16 = 0; j16 < 4; ++j16) {
      f32x4 vv[4];
#pragma unroll
      for (int q = 0; q < 4; ++q) vv[q] = ((const f32x4*)vals)[4 * (w16 + j16) + q];
#pragma unroll
      for (int q = 0; q < 4; ++q)
#pragma unroll
        for (int c = 0; c < 4; ++c) {
          const int jl = 16 * j16 + 4 * q + c;
          rank += (int)(vv[q][c] > a) | ((int)(vv[q][c] == a) & (int)(jl < (tidx_ & 63)));
        }
    }
    for (int j16 = w16 + 4; j16 < N / 16; ++j16) {
      f32x4 vv[4];
#pragma unroll
      for (int q = 0; q < 4; ++q) vv[q] = ((const f32x4*)vals)[4 * j16 + q];
#pragma unroll
      for (int q = 0; q < 4; ++q)
#pragma unroll
        for (int c = 0; c < 4; ++c) rank += (int)(vv[q][c] > a);
    }
    const int cap = lat ? CAPL : CAPC;
    int slot = -1;
    if (rank < cap) {
      slot = lat ? BATCH * CAPC + b * CAPL + rank : b * CAPC + rank;
      p.seltok[e * NS + slot] = t0 + n;
      p.selgate[e * NS + slot] = a;
    }
    p.inv[(long)(t0 + n) * NE + e] = slot;
    __syncthreads();
  }
}

constexpr int ADA_KC = 16, ADA_ROWS = D / ADA_KC;
DEVFN void ph_adaln_part(const Params& p, char* smem) {
  PHASE_BEGIN;
  float* sil = (float*)smem;
  constexpr int NJG = 6 * D / 4 / 256;
  constexpr int NITEM = DEPTH * NJG * ADA_KC;
  if (bidx_ < NITEM) {
#pragma unroll
    for (int i = tidx_; i < NCOND * D; i += 256) {
      int c = i / D, d = i % D;
      sil[i] = silu_f(c == 0 ? p.c_ctx[d] : p.c[(c - 1) * D + d]);
    }
    __syncthreads();
  }
  for (int item = bidx_; item < NITEM; item += gridDim.x) {
    const int kc = item % ADA_KC, jb = (item / ADA_KC) % NJG, l = item / (ADA_KC * NJG);
    const int j0 = (jb * 256 + tidx_) * 4;
    const float* w = p.w_ada + ((long)l * D + kc * ADA_ROWS) * 6 * D + j0;
    f32x4 acc[NCOND];
#pragma unroll
    for (int c = 0; c < NCOND; ++c) acc[c] = (f32x4){0.f, 0.f, 0.f, 0.f};
#pragma unroll 16
    for (int r = 0; r < ADA_ROWS; ++r) {
      f32x4 wv = *(const f32x4*)(w + (long)r * 6 * D);
#pragma unroll
      for (int c = 0; c < NCOND; ++c) { float sv = sil[c * D + kc * ADA_ROWS + r]; acc[c] += sv * wv; }
    }
#pragma unroll
    for (int c = 0; c < NCOND; ++c) *(f32x4*)(p.modpart + (((long)kc * DEPTH + l) * NCOND + c) * 6 * D + j0) = acc[c];
  }
  __syncthreads();
}
DEVFN void ph_adaln_reduce(const Params& p) {
  PHASE_BEGIN;
  for (long idx = GTID; idx < (long)DEPTH * NCOND * 6 * D; idx += GSIZE) {
    int j = idx % (6 * D); int l = idx / ((long)NCOND * 6 * D);
    float s = p.b_ada[(long)l * 6 * D + j];
#pragma unroll
    for (int kc = 0; kc < ADA_KC; ++kc) s += p.modpart[(long)kc * DEPTH * NCOND * 6 * D + idx];
    p.mod[idx] = s;
  }
}
DEVFN void transpose_tile(const float* src, long ld_src, bf16_t* dst, long ld_dst, int k0, int n0, float* tl, int tid) {
#pragma unroll
  for (int i = 0; i < 4; ++i) {
    const int r = (tid >> 4) + 16 * i, c4 = (tid & 15) * 4;
    f32x4 v = *(const f32x4*)(src + (long)(k0 + r) * ld_src + n0 + c4);
    tl[r * 65 + c4] = v[0]; tl[r * 65 + c4 + 1] = v[1]; tl[r * 65 + c4 + 2] = v[2]; tl[r * 65 + c4 + 3] = v[3];
  }
  __syncthreads();
#pragma unroll
  for (int i = 0; i < 2; ++i) {
    const int n = (tid >> 3) + 32 * i, kc = (tid & 7) * 8;
    uint4 w;
    w.x = cvtpk(tl[(kc + 0) * 65 + n], tl[(kc + 1) * 65 + n]); w.y = cvtpk(tl[(kc + 2) * 65 + n], tl[(kc + 3) * 65 + n]);
    w.z = cvtpk(tl[(kc + 4) * 65 + n], tl[(kc + 5) * 65 + n]); w.w = cvtpk(tl[(kc + 6) * 65 + n], tl[(kc + 7) * 65 + n]);
    *(uint4*)(dst + (long)(n0 + n) * ld_dst + k0 + kc) = w;
  }
  __syncthreads();
}
constexpr int TR_WOUT = DEPTH * (MIX_W / 64) * (D / 64);
constexpr int TR_WIN = DEPTH * (D / 64) * 16;
constexpr int TR_WGLU = DEPTH * (S5_W / 64) * (S5_W / 64);
DEVFN void ph_init_tr(const Params& p, char* smem) {
  PHASE_BEGIN;
  float* tl = (float*)smem;
  for (int item = bidx_; item < TR_WOUT + TR_WIN + TR_WGLU; item += gridDim.x) {
    if (item < TR_WOUT) {
      const int nt = item % (D / 64), kt = (item / (D / 64)) % (MIX_W / 64), l = item / ((D / 64) * (MIX_W / 64));
      transpose_tile(p.w_out + (long)l * MIX_W * D, D, p.woutt + (long)l * D * MIX_W, MIX_W, kt * 64, nt * 64, tl, tidx_);
    } else if (item < TR_WOUT + TR_WIN) {
      const int it = item - TR_WOUT;
      const int ct = it % 16, kt = (it / 16) % (D / 64), l = it / (16 * (D / 64));
      const int nsrc = ct < 12 ? ct * 64 : 1024 + (ct - 12) * 64;
      const int ndst = ct < 12 ? ct * 64 : PC_U + (ct - 12) * 64;
      transpose_tile(p.w_in + (long)l * D * IN_W + nsrc, IN_W, p.win2t + ((long)l * NP + ndst) * D, D, kt * 64, 0, tl, tidx_);
    } else {
      const int it = item - TR_WOUT - TR_WIN;
      const int nt = it % (S5_W / 64), kt = (it / (S5_W / 64)) % (S5_W / 64), l = it / ((S5_W / 64) * (S5_W / 64));
      transpose_tile(p.s5_w_glu + (long)l * S5_W * S5_W, S5_W, p.wglut + (long)l * S5_W * S5_W, S5_W, kt * 64, nt * 64, tl, tidx_);
    }
  }
}
DEVFN void ph_init_tab(const Params& p, char* smem) {
  PHASE_BEGIN;
  float* tab = (float*)smem;
  const long gt = GTID, gs = GSIZE;
  for (int j = tidx_; j < DSEQ; j += 256) {
    float s, c;
    sincosf(6.283185307179586f * (float)j / (float)DSEQ, &s, &c);
    tab[2 * j] = c; tab[2 * j + 1] = s;
  }
  __syncthreads();
  const float isl = 1.f / sqrtf((float)DSEQ), isc = 1.f / sqrtf((float)SEQ);
  for (long idx = gt; idx < (long)DSEQ * 2 * DSEQ; idx += gs) {
    const int n2 = idx % (2 * DSEQ), k = idx / (2 * DSEQ), n = n2 % DSEQ;
    const int j = (k * n) & (DSEQ - 1);
    p.dftl[idx] = f2bf((n2 < DSEQ ? tab[2 * j] : -tab[2 * j + 1]) * isl);
  }
  for (long idx = gt; idx < (long)SEQ * 2 * SEQ; idx += gs) {
    const int n2 = idx % (2 * SEQ), k = idx / (2 * SEQ), n = n2 % SEQ;
    const int j = ((k * n) & (SEQ - 1)) * (DSEQ / SEQ);
    p.dftc[idx] = f2bf((n2 < SEQ ? tab[2 * j] : -tab[2 * j + 1]) * isc);
  }
  for (long idx = gt; idx < (long)DEPTH * 256 * 256; idx += gs) {
    const int i = idx % 256, j = (idx / 256) % 256, l = idx / (256 * 256);
    const int hd = i >> 6, c = i & 63;
    const float* wf = p.w_fourier + ((long)l * 256 + hd * 64) * 256 + j;
    float w[64];
#pragma unroll
    for (int m = 0; m < 64; ++m) w[m] = wf[(long)m * 256];
    float ac = 0.f, as = 0.f;
#pragma unroll
    for (int m = 0; m < 64; ++m) {
      const f32x2_t cs = *(const f32x2_t*)(tab + 2 * (((m * c) & 63) * (DSEQ / 64)));
      ac += cs[0] * w[m]; as += cs[1] * w[m];
    }
    p.wcst[((long)l * 512 + j) * 256 + i] = f2bf(ac * 0.125f);
    p.wcst[((long)l * 512 + 256 + j) * 256 + i] = f2bf(as * 0.125f);
  }
  for (long idx = gs - 1 - gt - (long)DEPTH * 2 * SG * SP; idx >= 0 && idx < 64 * 16; idx += gs) {
    int fi = idx % 16, pos = idx / 16;
    float freq = powf(10000.f, -(float)fi / 16.f);
    float ang = (float)pos * freq;
    p.rope[idx * 2] = cosf(ang); p.rope[idx * 2 + 1] = sinf(ang);
  }
  for (long idx = gs - 1 - gt; idx < (long)DEPTH * 2 * SG * SP; idx += gs) {
    int pp = idx % SP; int g = (idx / SP) % SG; long ld = idx / (SP * SG);
    double are = p.s5_a_re[idx], aim = p.s5_a_im[idx];
    double dt = exp((double)p.s5_log_dt[ld * SG + g]);
    double er = exp(are * dt), cr = er * cos(aim * dt), ci = er * sin(aim * dt);
    p.abar[idx * 2] = (float)cr; p.abar[idx * 2 + 1] = (float)ci;
    double nr = cr - 1.0, ni = ci, den = are * are + aim * aim;
    double fr = (nr * are + ni * aim) / den, fi = (ni * are - nr * aim) / den;
    for (int h = 0; h < SH; ++h) {
      double br = p.s5_b_re[idx * SH + h], bi = p.s5_b_im[idx * SH + h];
      p.bbn[((ld * SG + g) * 128 + 2 * pp) * 16 + h] = f2bf((float)(fr * br - fi * bi));
      p.bbn[((ld * SG + g) * 128 + 2 * pp + 1) * 16 + h] = f2bf((float)(fr * bi + fi * br));
    }
  }
  for (long idx = gt; idx < (long)DEPTH * 2 * SG * SH * 128; idx += gs) {
    int k = idx % 128; long row = idx / 128;
    p.cn[idx] = f2bf((k & 1) ? -p.s5_c_im[row * SP + (k >> 1)] : p.s5_c_re[row * SP + (k >> 1)]);
  }
}
struct RowLoaderF32 {
  const float *r0, *r1, *r2, *r3;
  DEVFN uint4 one(const float* r, int kt) const {
    f32x4 a = *(const f32x4*)(r + kt * 64), b = *(const f32x4*)(r + kt * 64 + 4);
    uint4 w; w.x = cvtpk(a[0], a[1]); w.y = cvtpk(a[2], a[3]); w.z = cvtpk(b[0], b[1]); w.w = cvtpk(b[2], b[3]);
    return w;
  }
  DEVFN U4x4 operator()(int kt) const { U4x4 v; v.a = one(r0, kt); v.b = one(r1, kt); v.c = one(r2, kt); v.d = one(r3, kt); return v; }
};
DEVFN void ph_init_fold(const Params& p, char* smem) {
  PHASE_BEGIN;
  constexpr int NT_M = 512 / 128, NT_N = D / 128;
  for (int tile = bidx_; tile < DEPTH * NT_M * NT_N; tile += gridDim.x) {
    const int tn = tile % NT_N, tm = (tile / NT_N) % NT_M, l = tile / (NT_N * NT_M);
    RowLoader A = make_rows(tidx_, p.wcst + (long)l * 512 * 256, tm * 128, 256);
    RowLoaderF32 B;
    {
      const float* b0 = p.w_in + ((long)l * D + tn * 128 + (tidx_ >> 3)) * IN_W + 768 + (tidx_ & 7) * 8;
      B.r0 = b0; B.r1 = b0 + 32L * IN_W; B.r2 = b0 + 64L * IN_W; B.r3 = b0 + 96L * IN_W;
    }
    const bool odd = tidx_ & 1;
    bf16_t* dst = p.win2t + ((long)l * NP + PC_P + tm * 128) * D + tn * 128;
    gemm_tile1(smem, tidx_, A, B, 256 / 64, [&](int nt, int row, int col, float v0, float v1, float v2, float v3) {
      float v[4] = {v0, v1, v2, v3};
#pragma unroll
      for (int i = 0; i < 4; ++i) {
        float pr = shx1(v[i]);
        if (!odd) *(unsigned*)(dst + (long)(row + i) * D + col) = cvtpk(v[i], pr);
      }
    });
  }
}

constexpr int TR_EXP = NE * 3 * (D / 64) * (FF / 64);
struct ConvTile { const float* src; bf16_t* dst; };
DEVFN ConvTile conv_tile(const Params& p, int l, int item) {
  const int nt = item % 16, kt = (item / 16) % 16, m = (item / 256) % 3, e = item / 768;
  ConvTile c;
  const float* sb = (m == 0 ? p.w_gate : m == 1 ? p.w_up : p.w_down) + ((long)l * NE + e) * D * FF;
  bf16_t* db = (m == 0 ? p.wgt : m == 1 ? p.wut : p.wdt) + (long)e * FF * D;
  c.src = sb + (long)(kt * 64) * FF + nt * 64;
  c.dst = db + (long)(nt * 64) * D + kt * 64;
  return c;
}
DEVFN void conv_range(const Params& p, int l, int first, int count, char* smem, int tid) {
  static_assert(D == FF, "expert matrices assumed square");
  float* tl = (float*)smem;
  const int lr = tid >> 4, lc = (tid & 15) * 4;
  int item = first; const int end = first + count;
  f32x4 v0, v1, v2, v3;
  ConvTile c = conv_tile(p, l, item);
  {
    const float* s = c.src + (long)lr * FF + lc;
    v0 = *(const f32x4*)s; v1 = *(const f32x4*)(s + 16L * FF); v2 = *(const f32x4*)(s + 32L * FF); v3 = *(const f32x4*)(s + 48L * FF);
  }
  while (item < end) {
    float* t0 = tl + lr * 65 + lc;
    t0[0] = v0[0]; t0[1] = v0[1]; t0[2] = v0[2]; t0[3] = v0[3];
    t0[16 * 65] = v1[0]; t0[16 * 65 + 1] = v1[1]; t0[16 * 65 + 2] = v1[2]; t0[16 * 65 + 3] = v1[3];
    t0[32 * 65] = v2[0]; t0[32 * 65 + 1] = v2[1]; t0[32 * 65 + 2] = v2[2]; t0[32 * 65 + 3] = v2[3];
    t0[48 * 65] = v3[0]; t0[48 * 65 + 1] = v3[1]; t0[48 * 65 + 2] = v3[2]; t0[48 * 65 + 3] = v3[3];
    __syncthreads();
    bf16_t* dst = c.dst;
    const int nxt = item + 1;
    if (nxt < end) {
      c = conv_tile(p, l, nxt);
      const float* s = c.src + (long)lr * FF + lc;
      v0 = *(const f32x4*)s; v1 = *(const f32x4*)(s + 16L * FF); v2 = *(const f32x4*)(s + 32L * FF); v3 = *(const f32x4*)(s + 48L * FF);
    }
#pragma unroll
    for (int i = 0; i < 2; ++i) {
      const int n = (tid >> 3) + 32 * i, kc = (tid & 7) * 8;
      uint4 w;
      w.x = cvtpk(tl[(kc + 0) * 65 + n], tl[(kc + 1) * 65 + n]); w.y = cvtpk(tl[(kc + 2) * 65 + n], tl[(kc + 3) * 65 + n]);
      w.z = cvtpk(tl[(kc + 4) * 65 + n], tl[(kc + 5) * 65 + n]); w.w = cvtpk(tl[(kc + 6) * 65 + n], tl[(kc + 7) * 65 + n]);
      *(uint4*)(dst + (long)n * D + kc) = w;
    }
    __syncthreads();
    item = nxt;
  }
}

DEVFN void conv_wait(int n) {
  switch (n) {
    case 0:  asm volatile("s_waitcnt vmcnt(0) lgkmcnt(0)\n\ts_barrier" ::: "memory"); break;
    case 4:  asm volatile("s_waitcnt vmcnt(4) lgkmcnt(0)\n\ts_barrier" ::: "memory"); break;
    case 8:  asm volatile("s_waitcnt vmcnt(8) lgkmcnt(0)\n\ts_barrier" ::: "memory"); break;
    case 12: asm volatile("s_waitcnt vmcnt(12) lgkmcnt(0)\n\ts_barrier" ::: "memory"); break;
    case 16: asm volatile("s_waitcnt vmcnt(16) lgkmcnt(0)\n\ts_barrier" ::: "memory"); break;
    default: asm volatile("s_waitcnt vmcnt(20) lgkmcnt(0)\n\ts_barrier" ::: "memory"); break;
  }
}
DEVFN void conv_issue(const Params& p, int l, int item, unsigned lds_ws, int lane, int wave) {
  ConvTile c = conv_tile(p, l, item);
#pragma unroll
  for (int i = 0; i < 4; ++i) {
    const int k = 16 * wave + 4 * i + (lane >> 4);
    const int chunk = ((lane & 15) - (4 * wave + i)) & 15;
    glds16((const bf16_t*)(c.src + (long)k * FF + chunk * 4), lds_ws + i * 1024);
  }
}
template <int MODE>
DEVFN void conv_ring(const Params& p, int l, int first, int count, char* smem, int tid) {
  constexpr int LPT = MODE == 2 ? 0 : 4, SPT = MODE == 1 ? 0 : 4;
  const int lane = tid & 63, wave = tid >> 6;
  const int kq = tid & 15, nq = tid >> 4;
  const unsigned lbase = (unsigned)__builtin_amdgcn_readfirstlane((int)(lds_addr(smem) + wave * 4096));
  __syncthreads();
  if (LPT) for (int s = 0; s < 3 && s < count; ++s) conv_issue(p, l, first + s, lbase + s * 16384, lane, wave);
  for (int t = 0; t < count; ++t) {
    const int st = t < 3 ? t : 3;
    int ld = count - 1 - t; if (ld > 2) ld = 2;
    conv_wait(SPT * st + LPT * ld);
    if (LPT && t + 3 < count) conv_issue(p, l, first + t + 3, lbase + ((t + 3) & 3) * 16384, lane, wave);
    const char* sl = smem + (t & 3) * 16384 + (4 * kq) * 256 + ((nq + kq) & 15) * 16;
    f32x4 v0 = *(const f32x4*)sl, v1 = *(const f32x4*)(sl + 256), v2 = *(const f32x4*)(sl + 512), v3 = *(const f32x4*)(sl + 768);
    bf16_t* d = conv_tile(p, l, first + t).dst + (long)(4 * nq) * D + 4 * kq;
#pragma unroll
    for (int i = 0; i < 4; ++i) {
      uint2 w; w.x = cvtpk(v0[i], v1[i]); w.y = cvtpk(v2[i], v3[i]);
      if (SPT) *(uint2*)(d + (long)i * D) = w;
    }
  }
}

DEVFN void ph_conv_experts(const Params& p, int l, char* smem) {
  PHASE_BEGIN;
  constexpr int PER = TR_EXP / 512;
  const int nb = gridDim.x;
  const int done = 0;
  const int per = (TR_EXP - done + nb - 1) / nb;
  const int first = done + bidx_ * per;
  int count = TR_EXP - first; if (count > per) count = per;
  #ifdef PROBE_MODE
  if (count > 0) conv_ring<PROBE_MODE>(p, l, first, count, smem, tidx_);
#endif
  if (count > 0) conv_ring<0>(p, l, first, count, smem, tidx_);
  (void)PER;
}
constexpr int S5_SROW = 288;
constexpr int N_S5_LAT = DB * SG * 2 / 2, N_S5_CTX = BATCH * SG * 2 / 4;
template <int DIR, int CH>
DEVFN void s5_wave(const Params& p, int l, int lat, int u, char* wl, int lane) {
  constexpr int BU_BYTES = CH * 128 * 4;
  const int g = (u >> 1) % SG, b = u / (2 * SG);
  const int N = lat ? DSEQ : SEQ, t0 = lat ? TC + b * DSEQ : b * SEQ, nch = N / CH;
  float* BU = (float*)wl;
  char* SS = wl + BU_BYTES;
  const long pidx = (((long)l * 2 + DIR) * SG + g);
  const float ar = p.abar[(pidx * SP + lane) * 2], ai = p.abar[(pidx * SP + lane) * 2 + 1];
  const float nai = -ai;
  float sr = 0.f, si = 0.f;
  if (lat) { long si0 = ((((long)b * DEPTH + l) * 2 + DIR) * SG + g) * SP + lane; sr = p.st_re[si0]; si = p.st_im[si0]; }
  bf16x8 bfr[4], cfr[4];
#pragma unroll
  for (int nt = 0; nt < 4; ++nt) bfr[nt] = *(const bf16x8*)(p.bbn + ((pidx * 128 + nt * 32 + (lane & 31)) * 16 + 8 * (lane >> 5)));
#pragma unroll
  for (int ks = 0; ks < 4; ++ks) cfr[ks] = *(const bf16x8*)(p.cn + ((pidx * 16 + (lane & 15)) * 128 + ks * 32 + 8 * (lane >> 4)));
  const bf16_t* ub = p.proj + (long)t0 * NPJ + PJ_U + g * 16 + 8 * (lane >> 5);
  const int urow = lane & (CH - 1);
  bf16x8 ufr = *(const bf16x8*)(ub + (long)((DIR ? N - CH : 0) + urow) * NPJ);
  float* const ybase = p.ypart + ((long)DIR * T + t0 + (lane >> 4) * 4) * S5_W + g * 16 + (lane & 15);
  for (int c = 0; c <= nch; ++c) {
    if (c < nch) {
      const bf16x8 ucur = ufr;
      if (c + 1 < nch) ufr = *(const bf16x8*)(ub + (long)((DIR ? N - CH * (c + 2) : CH * (c + 1)) + urow) * NPJ);
#pragma unroll
      for (int np = 0; np < 2; ++np) {
        f32x16 z0, z1;
#pragma unroll
        for (int r = 0; r < 16; ++r) { z0[r] = 0.f; z1[r] = 0.f; }
        z0 = __builtin_amdgcn_mfma_f32_32x32x16_bf16(ucur, bfr[2 * np], z0, 0, 0, 0);
        z1 = __builtin_amdgcn_mfma_f32_32x32x16_bf16(ucur, bfr[2 * np + 1], z1, 0, 0, 0);
#pragma unroll
        for (int r = 0; r < CH / 2; ++r) {
          const int row = (r & 3) + 8 * (r >> 2) + 4 * (lane >> 5);
          BU[row * 128 + (2 * np) * 32 + (lane & 31)] = z0[r];
          BU[row * 128 + (2 * np + 1) * 32 + (lane & 31)] = z1[r];
        }
      }
    }
    __builtin_amdgcn_fence(__ATOMIC_RELEASE, "wavefront");
    __builtin_amdgcn_wave_barrier();
    __builtin_amdgcn_fence(__ATOMIC_ACQUIRE, "wavefront");
    if (c >= 1) {
      const char* ss = SS + ((c - 1) & 1) * (CH * S5_SROW);
      const int pb = DIR ? N - CH * c : CH * (c - 1);
#pragma unroll
      for (int mt = 0; mt < CH / 16; ++mt) {
        f32x4 acc = {0.f, 0.f, 0.f, 0.f};
#pragma unroll
        for (int ks = 0; ks < 4; ++ks) {
          bf16x8 a = *(const bf16x8*)(ss + (mt * 16 + (lane & 15)) * S5_SROW + ks * 64 + 16 * (lane >> 4));
          acc = __builtin_amdgcn_mfma_f32_16x16x32_bf16(a, cfr[ks], acc, 0, 0, 0);
        }
        float* yo = ybase + (long)(pb + mt * 16) * S5_W;
#pragma unroll
        for (int r = 0; r < 4; ++r) yo[(long)r * S5_W] = acc[r];
      }
    }
    if (c < nch) {
      char* ss = SS + (c & 1) * (CH * S5_SROW);
      f32x2_t bu[CH];
#pragma unroll
      for (int k = 0; k < CH; ++k) { const int r = DIR ? CH - 1 - k : k; bu[k] = *(const f32x2_t*)(BU + r * 128 + 2 * lane); }
#pragma unroll
      for (int k = 0; k < CH; ++k) {
        const int r = DIR ? CH - 1 - k : k;
        const float nr = __builtin_fmaf(ar, sr, __builtin_fmaf(nai, si, bu[k][0]));
        const float ni = __builtin_fmaf(ar, si, __builtin_fmaf(ai, sr, bu[k][1]));
        sr = nr; si = ni;
        *(unsigned*)(ss + r * S5_SROW + lane * 4) = cvtpk(sr, si);
      }
    }
    __builtin_amdgcn_fence(__ATOMIC_RELEASE, "wavefront");
    __builtin_amdgcn_wave_barrier();
    __builtin_amdgcn_fence(__ATOMIC_ACQUIRE, "wavefront");
  }
  if (!lat) {
    long oo = ((((long)b * DEPTH + l) * 2 + DIR) * SG + g) * SP + lane;
    p.out[O_SRE + oo] = sr; p.out[O_SIM + oo] = si;
  }
}
DEVFN void s5_unit(const Params& p, int l, int lat, int item, char* smem, int tidx_) {
  const int wave = tidx_ >> 6, lane = tidx_ & 63;
  if (lat) {
    if (wave < 2) {
      const int u = item * 2 + wave;
      char* wl = smem + wave * (32 * 128 * 4 + 2 * 32 * S5_SROW);
      if (u & 1) s5_wave<1, 32>(p, l, 1, u, wl, lane); else s5_wave<0, 32>(p, l, 1, u, wl, lane);
    }
  } else {
    const int u = item * 4 + wave;
    char* wl = smem + wave * (16 * 128 * 4 + 2 * 16 * S5_SROW);
    if (u & 1) s5_wave<1, 16>(p, l, 0, u, wl, lane); else s5_wave<0, 16>(p, l, 0, u, wl, lane);
  }
  __syncthreads();
}

constexpr int AT_KROW = 144, AT_VROW = 72, AT_KB = 32 * AT_KROW, AT_STAGE = AT_KB + 64 * AT_VROW;
constexpr int N_AT_LAT = DB * NKV * (DSEQ / 32), N_AT_CTX = BATCH * NKV * (SEQ / 32);
DEVFN void attn_item(const Params& p, int l, int lat, int item, char* smem, int tidx_) {
  const int NQB = (lat ? DSEQ : SEQ) / 32;
  const int qb = item % NQB, kvh = (item / NQB) % NKV, b = item / (NQB * NKV);
  const int N = lat ? DSEQ : SEQ, t0 = lat ? TC + b * DSEQ : b * SEQ, q0 = qb * 32;
  const int wave = tidx_ >> 6, lane = tidx_ & 63, hl = lane >> 5, head = kvh * GQA + wave;
  bf16x8 qf[4];
#pragma unroll
  for (int s = 0; s < 4; ++s) qf[s] = *(const bf16x8*)(p.proj + (long)(t0 + q0 + (lane & 31)) * NPJ + PJ_Q + head * HD + 16 * s + 8 * hl);
  const int ks0 = lat ? (q0 - WINDOW < 0 ? 0 : q0 - WINDOW) : 0;
  const int ke0 = lat ? (q0 + 32 + WINDOW > N ? N : q0 + 32 + WINDOW) : N;
  const int nwin = (ke0 - ks0) / 32, ntiles = nwin + (lat ? PAST / 32 : 0);
  float m = p.attn_sink[l * NH + head], lsum = 1.f;
  f32x16 O[2];
#pragma unroll
  for (int i = 0; i < 2; ++i)
#pragma unroll
    for (int r = 0; r < 16; ++r) O[i][r] = 0.f;
  const int kkey = tidx_ >> 3, kch = tidx_ & 7;
  const int vkey = tidx_ & 31, vch = tidx_ >> 5;
  struct KV { f32x4 k0, k1, v0, v1; };
  auto tile_load = [&](int ti) -> KV {
    KV r; r.k1 = r.k0 = (f32x4){0.f, 0.f, 0.f, 0.f}; r.v1 = r.v0 = r.k0;
    if (ti < nwin) {
      const int kp = ks0 + ti * 32;
      uint4 a = *(const uint4*)(p.proj + (long)(t0 + kp + kkey) * NPJ + PJ_K + kvh * HD + kch * 8);
      uint4 c = *(const uint4*)(p.proj + (long)(t0 + kp + vkey) * NPJ + PJ_V + kvh * HD + vch * 8);
      r.k0 = __builtin_bit_cast(f32x4, a); r.v0 = __builtin_bit_cast(f32x4, c);
    } else {
      const int s0 = (ti - nwin) * 32;
      const float* kb = p.cache_k + ((((long)b * DEPTH + l) * PAST + s0 + kkey) * NKV + kvh) * HD + kch * 8;
      const float* vb = p.cache_v + ((((long)b * DEPTH + l) * PAST + s0 + vkey) * NKV + kvh) * HD + vch * 8;
      r.k0 = *(const f32x4*)kb; r.k1 = *(const f32x4*)(kb + 4);
      r.v0 = *(const f32x4*)vb; r.v1 = *(const f32x4*)(vb + 4);
    }
    return r;
  };
  auto tile_store = [&](int ti, char* st, const KV r) {
    uint4 kq, vq;
    if (ti < nwin) { kq = __builtin_bit_cast(uint4, r.k0); vq = __builtin_bit_cast(uint4, r.v0); }
    else {
      kq.x = cvtpk(r.k0[0], r.k0[1]); kq.y = cvtpk(r.k0[2], r.k0[3]); kq.z = cvtpk(r.k1[0], r.k1[1]); kq.w = cvtpk(r.k1[2], r.k1[3]);
      vq.x = cvtpk(r.v0[0], r.v0[1]); vq.y = cvtpk(r.v0[2], r.v0[3]); vq.z = cvtpk(r.v1[0], r.v1[1]); vq.w = cvtpk(r.v1[2], r.v1[3]);
    }
    *(uint4*)(st + kkey * AT_KROW + kch * 16) = kq;
    char* vt = st + AT_KB + (vch * 8) * AT_VROW + vkey * 2;
    *(bf16_t*)(vt + 0 * AT_VROW) = (bf16_t)(vq.x & 0xffffu); *(bf16_t*)(vt + 1 * AT_VROW) = (bf16_t)(vq.x >> 16);
    *(bf16_t*)(vt + 2 * AT_VROW) = (bf16_t)(vq.y & 0xffffu); *(bf16_t*)(vt + 3 * AT_VROW) = (bf16_t)(vq.y >> 16);
    *(bf16_t*)(vt + 4 * AT_VROW) = (bf16_t)(vq.z & 0xffffu); *(bf16_t*)(vt + 5 * AT_VROW) = (bf16_t)(vq.z >> 16);
    *(bf16_t*)(vt + 6 * AT_VROW) = (bf16_t)(vq.w & 0xffffu); *(bf16_t*)(vt + 7 * AT_VROW) = (bf16_t)(vq.w >> 16);
  };
  KV sa_ = tile_load(0), sb_ = sa_;
  tile_store(0, smem, sa_);
  if (ntiles > 1) sb_ = tile_load(1);
  __syncthreads();
  const int qp = q0 + (lane & 31);
  auto compute = [&](int ti) {
    const char* st = smem + (ti & 1) * AT_STAGE;
    f32x16 sa;
#pragma unroll
    for (int r = 0; r < 16; ++r) sa[r] = 0.f;
#pragma unroll
    for (int s = 0; s < 4; ++s) {
      bf16x8 kf = *(const bf16x8*)(st + (lane & 31) * AT_KROW + (2 * s + hl) * 16);
      sa = __builtin_amdgcn_mfma_f32_32x32x16_bf16(kf, qf[s], sa, 0, 0, 0);
    }
    float tmax = -1e30f;
    if (lat && ti < nwin) {
      const int kp0 = ks0 + ti * 32 + 4 * hl;
#pragma unroll
      for (int r = 0; r < 16; ++r) {
        const int kp = kp0 + (r & 3) + 8 * (r >> 2);
        const int df = kp - qp;
        const bool ok = (df <= WINDOW) && (df >= -WINDOW);
        sa[r] = ok ? sa[r] * 0.125f : -1e30f;
        tmax = fmaxf(tmax, sa[r]);
      }
    } else {
#pragma unroll
      for (int r = 0; r < 16; ++r) { sa[r] *= 0.125f; tmax = fmaxf(tmax, sa[r]); }
    }
    tmax = fmaxf(tmax, __shfl_xor(tmax, 32));
    const float mnew = fmaxf(m, tmax);
    const float sc = __expf(m - mnew);
    float rs = 0.f;
#pragma unroll
    for (int r = 0; r < 16; ++r) { sa[r] = __expf(sa[r] - mnew); rs += sa[r]; }
    rs += __shfl_xor(rs, 32);
    lsum = lsum * sc + rs; m = mnew;
#pragma unroll
    for (int i = 0; i < 2; ++i)
#pragma unroll
      for (int r = 0; r < 16; ++r) O[i][r] *= sc;
    bf16x8 pb[2];
#pragma unroll
    for (int s2 = 0; s2 < 2; ++s2) {
      uint4 w;
      w.x = cvtpk(sa[8 * s2 + 0], sa[8 * s2 + 1]); w.y = cvtpk(sa[8 * s2 + 2], sa[8 * s2 + 3]);
      w.z = cvtpk(sa[8 * s2 + 4], sa[8 * s2 + 5]); w.w = cvtpk(sa[8 * s2 + 6], sa[8 * s2 + 7]);
      pb[s2] = __builtin_bit_cast(bf16x8, w);
    }
#pragma unroll
    for (int mt = 0; mt < 2; ++mt)
#pragma unroll
      for (int s2 = 0; s2 < 2; ++s2) {
        const char* vp = st + AT_KB + (mt * 32 + (lane & 31)) * AT_VROW + (16 * s2 + 4 * hl) * 2;
        uint2 lo = *(const uint2*)vp, hi = *(const uint2*)(vp + 16);
        uint4 w; w.x = lo.x; w.y = lo.y; w.z = hi.x; w.w = hi.y;
        O[mt] = __builtin_amdgcn_mfma_f32_32x32x16_bf16(__builtin_bit_cast(bf16x8, w), pb[s2], O[mt], 0, 0, 0);
      }
  };
  for (int ti = 0; ti < ntiles; ti += 2) {
    if (ti + 2 < ntiles) sa_ = tile_load(ti + 2);
    compute(ti);
    if (ti + 1 < ntiles) tile_store(ti + 1, smem + AT_STAGE, sb_);
    __syncthreads();
    if (ti + 1 >= ntiles) break;
    if (ti + 3 < ntiles) sb_ = tile_load(ti + 3);
    compute(ti + 1);
    if (ti + 2 < ntiles) tile_store(ti + 2, smem, sa_);
    __syncthreads();
  }
  const float inv = 1.f / lsum;
  bf16_t* orow = p.mixcat + (long)(t0 + qp) * MIX_W + head * HD;
#pragma unroll
  for (int mt = 0; mt < 2; ++mt)
#pragma unroll
    for (int q = 0; q < 4; ++q) {
      uint2 w;
      w.x = cvtpk(O[mt][4 * q] * inv, O[mt][4 * q + 1] * inv); w.y = cvtpk(O[mt][4 * q + 2] * inv, O[mt][4 * q + 3] * inv);
      *(uint2*)(orow + mt * 32 + 8 * q + 4 * hl) = w;
    }
}

constexpr int N_FO_LAT = DB * (DSEQ / 128) * 2 * 2, N_FO_CTX = BATCH * (SEQ / 128) * 2;
constexpr int MIX_CORE = N_S5_LAT + N_FO_LAT + N_AT_LAT + N_S5_CTX + N_FO_CTX + N_AT_CTX;
constexpr int CONV_PER_ITEM = 8, N_CONV_ITEMS = TR_EXP / CONV_PER_ITEM;
constexpr int MIX_ITEMS = MIX_CORE;
DEVFN void ph_mix_fast(const Params& p, int l, char* smem, int* s_item, int rep = 0, int lo = 0, int hi = MIX_ITEMS) {
  PHASE_BEGIN;
  unsigned* ctr = p.bar + 4096 + 64 * l + 16 * rep;
  bool first = true;
  for (;;) {
    if (tidx_ == 0) *s_item = lo + (first ? bidx_ : (int)(gridDim.x + atomicAdd(ctr, 1u)));
    first = false;
    __syncthreads();
    int item = *s_item;
    __syncthreads();
    if (item >= hi) break;
    int tidl = tidx_;
    asm volatile("" : "+v"(tidl));
    if (item < N_S5_LAT) { s5_unit(p, l, 1, item, smem, tidl); continue; }
    item -= N_S5_LAT;
    if (item < N_FO_LAT) { fourier_tile(p, item, smem, tidl); continue; }
    item -= N_FO_LAT;
    if (item < N_AT_LAT) { attn_item(p, l, 1, item, smem, tidl); continue; }
    item -= N_AT_LAT;
    if (item < N_S5_CTX) { s5_unit(p, l, 0, item, smem, tidl); continue; }
    item -= N_S5_CTX;
    if (item < N_FO_CTX) { fourier_tile(p, N_FO_LAT + item, smem, tidl); continue; }
    item -= N_FO_CTX;
    if (item < N_AT_CTX) { attn_item(p, l, 0, item, smem, tidl); continue; }
    item -= N_AT_CTX;
    conv_range(p, l, item * CONV_PER_ITEM, CONV_PER_ITEM, smem, tidl);
  }
}

DEVFN float s5_g(const Params& p, int l, long t, int c) {
  float y = p.ypart[t * S5_W + c] + p.ypart[((long)T + t) * S5_W + c] + p.s5_d[l * S5_W + c] * bf2f(p.proj[t * NPJ + PJ_U + c]);
  return gelu_fast(y);
}
struct GluALoader {
  const float* ypart; const float* s5d; const bf16_t* proj; long m0; int tid;
  DEVFN uint4 one(int kt, int i) const {
    const int kc = tid & 7, r0 = tid >> 3;
    const int c0 = kt * 64 + kc * 8;
    f32x4 d0 = *(const f32x4*)(s5d + c0), d1 = *(const f32x4*)(s5d + c0 + 4);
    const long t = m0 + r0 + 32 * i;
    const float* y0 = ypart + t * S5_W + c0; const float* y1 = ypart + ((long)T + t) * S5_W + c0;
    f32x4 a0 = *(const f32x4*)y0, a1 = *(const f32x4*)(y0 + 4), b0 = *(const f32x4*)y1, b1 = *(const f32x4*)(y1 + 4);
    uint4 u = *(const uint4*)(proj + t * NPJ + PJ_U + c0);
    float g0 = gelu_fast(a0[0] + b0[0] + d0[0] * bflo(u.x)), g1 = gelu_fast(a0[1] + b0[1] + d0[1] * bfhi(u.x));
    float g2 = gelu_fast(a0[2] + b0[2] + d0[2] * bflo(u.y)), g3 = gelu_fast(a0[3] + b0[3] + d0[3] * bfhi(u.y));
    float g4 = gelu_fast(a1[0] + b1[0] + d1[0] * bflo(u.z)), g5 = gelu_fast(a1[1] + b1[1] + d1[1] * bfhi(u.z));
    float g6 = gelu_fast(a1[2] + b1[2] + d1[2] * bflo(u.w)), g7 = gelu_fast(a1[3] + b1[3] + d1[3] * bfhi(u.w));
    uint4 w; w.x = cvtpk(g0, g1); w.y = cvtpk(g2, g3); w.z = cvtpk(g4, g5); w.w = cvtpk(g6, g7);
    return w;
  }
  DEVFN U4x4 operator()(int kt) const { U4x4 v; v.a = one(kt, 0); v.b = one(kt, 1); v.c = one(kt, 2); v.d = one(kt, 3); return v; }
};
DEVFN void ph_glu_fast3(const Params& p, int l, char* smem) {
  PHASE_BEGIN;
  const int lane = tidx_ & 63, wave = tidx_ >> 6;
  const bf16_t* wg = p.wglut + (long)l * S5_W * S5_W;
  const GRows B0 = make_grows(tidx_, wg, 0, S5_W), B1 = make_grows(tidx_, wg, 128, S5_W);
  const int sw = (lane >> 1) & 7, h = lane >> 5;
  int off[4];
#pragma unroll
  for (int ks = 0; ks < 4; ++ks) off[ks] = (lane & 31) * 128 + (((2 * ks + h) ^ sw) * 16);
  char* img = smem + GL_STAGEB;
  for (int tile = bidx_; tile < T / 32; tile += gridDim.x) {
    const int m0 = tile * 32;
    __syncthreads();
    g_stage(smem, wave, B0, B1, 0);
    {
      const int c0 = (tidx_ & 31) * 8, r0 = tidx_ >> 5;
      f32x4 d0 = *(const f32x4*)(p.s5_d + l * S5_W + c0), d1 = *(const f32x4*)(p.s5_d + l * S5_W + c0 + 4);
      f32x4 a0[4], a1[4], b0[4], b1[4]; uint4 u[4];
#pragma unroll
      for (int k = 0; k < 4; ++k) {
        const long t = m0 + r0 + 8 * k;
        const float* y0 = p.ypart + t * S5_W + c0; const float* y1 = p.ypart + ((long)T + t) * S5_W + c0;
        a0[k] = *(const f32x4*)y0; a1[k] = *(const f32x4*)(y0 + 4); b0[k] = *(const f32x4*)y1; b1[k] = *(const f32x4*)(y1 + 4);
        u[k] = *(const uint4*)(p.proj + t * NPJ + PJ_U + c0);
      }
      const int kt = (tidx_ & 31) >> 3, c = tidx_ & 7;
#pragma unroll
      for (int k = 0; k < 4; ++k) {
        const int r = r0 + 8 * k;
        float g0 = gelu_fast(a0[k][0] + b0[k][0] + d0[0] * bflo(u[k].x)), g1 = gelu_fast(a0[k][1] + b0[k][1] + d0[1] * bfhi(u[k].x));
        float g2 = gelu_fast(a0[k][2] + b0[k][2] + d0[2] * bflo(u[k].y)), g3 = gelu_fast(a0[k][3] + b0[k][3] + d0[3] * bfhi(u[k].y));
        float g4 = gelu_fast(a1[k][0] + b1[k][0] + d1[0] * bflo(u[k].z)), g5 = gelu_fast(a1[k][1] + b1[k][1] + d1[1] * bfhi(u[k].z));
        float g6 = gelu_fast(a1[k][2] + b1[k][2] + d1[2] * bflo(u[k].w)), g7 = gelu_fast(a1[k][3] + b1[k][3] + d1[3] * bfhi(u[k].w));
        uint4 w; w.x = cvtpk(g0, g1); w.y = cvtpk(g2, g3); w.z = cvtpk(g4, g5); w.w = cvtpk(g6, g7);
        *(uint4*)(img + kt * 4096 + r * 128 + ((c ^ ((r >> 1) & 7)) * 16)) = w;
      }
    }
    __syncthreads();
    bf16x8 af[16];
#pragma unroll
    for (int kt = 0; kt < 4; ++kt)
#pragma unroll
      for (int ks = 0; ks < 4; ++ks) af[kt * 4 + ks] = *(const bf16x8*)(img + kt * 4096 + off[ks]);
    unsigned ge[2][8];
#pragma unroll
    for (int nt = 0; nt < 2; ++nt)
#pragma unroll
      for (int q = 0; q < 4; ++q)
#pragma unroll
        for (int i2 = 0; i2 < 2; ++i2) {
          const int row = 8 * q + 4 * (lane >> 5) + 2 * i2, jc = 32 * nt + (lane & 31);
          const char* gp = img + wave * 4096 + row * 128 + (((jc >> 3) ^ ((row >> 1) & 7)) * 16) + (jc & 7) * 2;
          ge[nt][2 * q + i2] = (unsigned)*(const unsigned short*)gp | ((unsigned)*(const unsigned short*)(gp + 128) << 16);
        }
    asm volatile("s_waitcnt vmcnt(0)" ::: "memory");
    __syncthreads();
    f32x16 acc0, acc1;
#pragma unroll
    for (int r = 0; r < 16; ++r) { acc0[r] = 0.f; acc1[r] = 0.f; }
#pragma unroll
    for (int kt = 0; kt < 4; ++kt) {
      if (kt < 3) g_stage(smem + ((kt + 1) & 1) * GL_STAGEB, wave, B0, B1, kt + 1);
      const char* sB = smem + (kt & 1) * GL_STAGEB + (wave >> 1) * GL_TILEB + (wave & 1) * 64 * 128;
#pragma unroll
      for (int ks = 0; ks < 4; ++ks) {
        const bf16x8 fb0 = *(const bf16x8*)(sB + off[ks]), fb1 = *(const bf16x8*)(sB + 32 * 128 + off[ks]);
        acc0 = __builtin_amdgcn_mfma_f32_32x32x16_bf16(af[kt * 4 + ks], fb0, acc0, 0, 0, 0);
        acc1 = __builtin_amdgcn_mfma_f32_32x32x16_bf16(af[kt * 4 + ks], fb1, acc1, 0, 0, 0);
      }
      asm volatile("s_waitcnt vmcnt(0)" ::: "memory");
      __syncthreads();
    }
    const bool odd = tidx_ & 1;
#pragma unroll
    for (int nt = 0; nt < 2; ++nt)
#pragma unroll
      for (int q = 0; q < 4; ++q) {
        const int row = 8 * q + 4 * (lane >> 5), j = 64 * wave + 32 * nt + (lane & 31);
        float r[4];
#pragma unroll
        for (int i = 0; i < 4; ++i) {
          const float v = nt ? acc1[4 * q + i] : acc0[4 * q + i];
          const unsigned gw = ge[nt][2 * q + (i >> 1)];
          r[i] = ((i & 1) ? bfhi(gw) : bflo(gw)) * sigmoid_fast(v);
        }
        store4_bf16(p.mixcat + (long)(m0 + row) * MIX_W + ATTN_W + FOUR_W + j, MIX_W, odd, r[0], r[1], r[2], r[3]);
      }
  }
}
DEVFN void ph_four_reduce(const Params& p) {
  PHASE_BEGIN;
  {
    const int nb = gridDim.x;
    int ridx = bidx_ - (T / 32) % nb; if (ridx < 0) ridx += nb;
    for (int it = ridx; it < DB * DSEQ / 16; it += nb) {
#pragma unroll
      for (int k = 0; k < 2; ++k) {
        const int ch = it * 512 + k * 256 + tidx_;
        const int row = ch >> 5, c8 = (ch & 31) * 8;
        const float* a = p.win2 + (long)row * FOUR_W + c8; const float* b = a + (long)DB * DSEQ * FOUR_W;
        const f32x4 a0 = *(const f32x4*)a, a1 = *(const f32x4*)(a + 4), b0 = *(const f32x4*)b, b1 = *(const f32x4*)(b + 4);
        uint4 w;
        w.x = cvtpk(a0[0] + b0[0], a0[1] + b0[1]); w.y = cvtpk(a0[2] + b0[2], a0[3] + b0[3]);
        w.z = cvtpk(a1[0] + b1[0], a1[1] + b1[1]); w.w = cvtpk(a1[2] + b1[2], a1[3] + b1[3]);
        *(uint4*)(p.mixcat + (long)(TC + row) * MIX_W + ATTN_W + c8) = w;
      }
    }
  }
}

DEVFN void ph_glu_fast2(const Params& p, int l, char* smem) {
  PHASE_BEGIN;
  constexpr int NT_N = S5_W / 128, NT_M = T / 128;
  for (int tile = bidx_; tile < NT_M * NT_N; tile += gridDim.x) {
    const int tm = tile / NT_N, tn = tile % NT_N;
    const int m0 = tm * 128, n0 = tn * 128;
    {
      const int c0 = (tidx_ & 31) * 8, r0 = tidx_ >> 5;
      f32x4 d0 = *(const f32x4*)(p.s5_d + l * S5_W + c0), d1 = *(const f32x4*)(p.s5_d + l * S5_W + c0 + 4);
#pragma unroll 1
      for (int i4 = 0; i4 < 4; ++i4) {
        f32x4 a0[4], a1[4], b0[4], b1[4]; uint4 u[4];
#pragma unroll
        for (int k = 0; k < 4; ++k) {
          const long t = m0 + r0 + 8 * (4 * i4 + k);
          const float* y0 = p.ypart + t * S5_W + c0; const float* y1 = p.ypart + ((long)T + t) * S5_W + c0;
          a0[k] = *(const f32x4*)y0; a1[k] = *(const f32x4*)(y0 + 4); b0[k] = *(const f32x4*)y1; b1[k] = *(const f32x4*)(y1 + 4);
          u[k] = *(const uint4*)(p.proj + t * NPJ + PJ_U + c0);
        }
#pragma unroll
        for (int k = 0; k < 4; ++k) {
          const long t = m0 + r0 + 8 * (4 * i4 + k);
          float g0 = gelu_fast(a0[k][0] + b0[k][0] + d0[0] * bflo(u[k].x)), g1 = gelu_fast(a0[k][1] + b0[k][1] + d0[1] * bfhi(u[k].x));
          float g2 = gelu_fast(a0[k][2] + b0[k][2] + d0[2] * bflo(u[k].y)), g3 = gelu_fast(a0[k][3] + b0[k][3] + d0[3] * bfhi(u[k].y));
          float g4 = gelu_fast(a1[k][0] + b1[k][0] + d1[0] * bflo(u[k].z)), g5 = gelu_fast(a1[k][1] + b1[k][1] + d1[1] * bfhi(u[k].z));
          float g6 = gelu_fast(a1[k][2] + b1[k][2] + d1[2] * bflo(u[k].w)), g7 = gelu_fast(a1[k][3] + b1[k][3] + d1[3] * bfhi(u[k].w));
          uint4 w; w.x = cvtpk(g0, g1); w.y = cvtpk(g2, g3); w.z = cvtpk(g4, g5); w.w = cvtpk(g6, g7);
          *(uint4*)(p.gbuf + t * S5_W + c0) = w;
        }
      }
    }
    asm volatile("s_waitcnt vmcnt(0)" ::: "memory");
    __syncthreads();
    GRows A = make_grows(tidx_, p.gbuf, m0, S5_W);
    GRows B = make_grows(tidx_, p.wglut + (long)l * S5_W * S5_W, n0, S5_W);
    const bool odd = tidx_ & 1;
    bool staged = false;
    bf16_t* gl = (bf16_t*)smem;
    gemm_tile_g(smem, tidx_, A, B, S5_W / 64, [&](int nt, int row, int col, float v0, float v1, float v2, float v3) {
      if (!staged) {
        uint4 t8[8];
#pragma unroll
        for (int i = 0; i < 8; ++i) { const int c = tidx_ + 256 * i; t8[i] = *(const uint4*)(p.gbuf + (long)(m0 + (c >> 4)) * S5_W + n0 + (c & 15) * 8); }
#pragma unroll
        for (int i = 0; i < 8; ++i) { const int c = tidx_ + 256 * i; *(uint4*)(gl + (c >> 4) * 128 + (c & 15) * 8) = t8[i]; }
        __syncthreads();
        staged = true;
      }
      const int j = n0 + col;
      float v[4] = {v0, v1, v2, v3};
      float gg[4];
#pragma unroll
      for (int i = 0; i < 4; ++i) gg[i] = bf2f(gl[(row + i) * 128 + col]);
#pragma unroll
      for (int i = 0; i < 4; ++i) {
        long t = m0 + row + i;
        float r = gg[i] * sigmoid_fast(v[i]);
        float pr = shx1(r);
        if (!odd) *(unsigned*)(p.mixcat + t * MIX_W + ATTN_W + FOUR_W + j) = cvtpk(r, pr);
      }
    });
  }
}

#define GSYNC() xcd_barrier(xb)
__global__ void __launch_bounds__(256, 2) __attribute__((amdgpu_waves_per_eu(2, 2))) mega(Params p) {
  __shared__ __attribute__((aligned(16))) char smem[SMEM_BYTES];
  __shared__ uint4 xb_words;
  __shared__ int s_item;
  if (threadIdx.x == 0) xb_words = make_uint4(0u, 0u, 0u, 0u);
  __syncthreads();
  XcdBarrier xb = xcd_barrier_post(p.bar, (volatile LAS unsigned*)&xb_words);
  ph_adaln_part(p, smem); ph_init_tr(p, smem); ph_init_tab(p, smem); GSYNC();
  ph_adaln_reduce(p); ph_init_fold(p, smem); GSYNC();
#pragma unroll 1
  for (int l = 0; l <= DEPTH; ++l) {
    ph_row1_fast(p, l, smem);
    if (l == DEPTH) break;
    GSYNC();
    ph_gemm_in_fast(p, l, smem); GSYNC();
    ph_mix_fast(p, l, smem, &s_item); GSYNC();
    ph_glu_fast3(p, l, smem); ph_four_reduce(p); GSYNC();
    ph_gemm_out_fast(p, l, smem); GSYNC();
    ph_row2_fast(p, l, smem); GSYNC();
    ph_topk_fast(p, l, smem); ph_conv_experts(p, l, smem); GSYNC();
    ph_moe1_fast(p, l, smem); GSYNC();
    ph_moe2_fast(p, l, smem); GSYNC();
  }
}

extern "C" void kernel_launch(void* const* d_in, const int* in_sizes, int n_in, void* d_out, int out_size, void* d_ws,
                              size_t ws_size, hipStream_t stream) {
  Params p{};
  const float** pp = (const float**)&p;
  for (int i = 0; i < 33; ++i) pp[i] = (const float*)d_in[i];
  p.out = (float*)d_out;
  char* w = (char*)d_ws;
  size_t off = 0;
  auto al = [&](size_t bytes) { void* r = w + off; off += (bytes + 255) & ~(size_t)255; return r; };
  p.bar = (unsigned*)al(64 * 1024);
  p.x = (float*)al((size_t)T * D * 4); p.mod = (float*)al((size_t)DEPTH * NCOND * 6 * D * 4);
  p.states = nullptr; p.ypart = (float*)al((size_t)2 * T * S5_W * 4); p.ybuf = (float*)al((size_t)T * D * 4); p.aff = (float*)al((size_t)T * NE * 4);
  p.wcs = (float*)al((size_t)DEPTH * 256 * 512 * 4); p.win2 = (float*)al((size_t)DEPTH * D * NP * 4);
  p.abar = (float*)al((size_t)DEPTH * 2 * SG * SP * 2 * 4); p.bbar = (float*)al((size_t)DEPTH * 2 * SG * SP * SH * 2 * 4);
  p.twc = (float*)al(SEQ * 2 * 4); p.twl = (float*)al(DSEQ * 2 * 4); p.selgate = (float*)al((size_t)NE * NS * 4);
  p.modpart = (float*)al((size_t)ADA_KC * DEPTH * NCOND * 6 * D * 4); p.afft = (float*)al((size_t)NE * T * 4); p.rope = (float*)al(64 * 16 * 2 * 4);
  p.h = (act_t*)al((size_t)T * D * sizeof(act_t)); p.proj = (act_t*)al((size_t)T * NPJ * sizeof(act_t));
  p.pqt = (act_t*)al((size_t)T * 512 * sizeof(act_t)); p.mixcat = (act_t*)al((size_t)T * MIX_W * sizeof(act_t));
  p.gbuf = (act_t*)al((size_t)T * S5_W * sizeof(act_t)); p.h2 = (act_t*)al((size_t)T * D * sizeof(act_t));
  p.hid = (act_t*)al((size_t)NE * NS * FF * sizeof(act_t)); p.ys = (act_t*)al((size_t)NE * NS * D * sizeof(act_t));
  p.win2t = (bf16_t*)al((size_t)DEPTH * NP * D * 2); p.woutt = (bf16_t*)al((size_t)DEPTH * D * MIX_W * 2);
  p.wglut = (bf16_t*)al((size_t)DEPTH * S5_W * S5_W * 2); p.dftc = (bf16_t*)al((size_t)SEQ * 2 * SEQ * 2);
  p.dftl = (bf16_t*)al((size_t)DSEQ * 2 * DSEQ * 2); p.wcst = (bf16_t*)al((size_t)DEPTH * 512 * 256 * 2);
  p.wgt = (bf16_t*)al((size_t)NE * FF * D * 2); p.wut = (bf16_t*)al((size_t)NE * FF * D * 2); p.wdt = (bf16_t*)al((size_t)NE * D * FF * 2);
  p.bbn = (bf16_t*)al((size_t)DEPTH * 2 * SG * 128 * 16 * 2); p.cn = (bf16_t*)al((size_t)DEPTH * 2 * SG * SH * 128 * 2);
  p.seltok = (int*)al((size_t)NE * NS * 4); p.inv = (int*)al((size_t)T * NE * 4);
  static int grid_blocks = 0;
  if (!grid_blocks) {
    int dev = 0, cus = 0, per_cu = 0;
    (void)hipGetDevice(&dev);
    (void)hipDeviceGetAttribute(&cus, hipDeviceAttributeMultiprocessorCount, dev);
    (void)hipOccupancyMaxActiveBlocksPerMultiprocessor(&per_cu, mega, 256, 0);
    if (per_cu > 2) per_cu = 2;
    grid_blocks = cus * per_cu;
  }
  (void)hipMemsetAsync(p.bar, 0, 32768, stream);
  void* args[] = {&p};
  hipError_t e = hipLaunchCooperativeKernel((void*)mega, dim3(grid_blocks), dim3(256), args, 0, stream);
  if (e != hipSuccess) fprintf(stderr, "cooperative launch failed: %s (grid %d)\n", hipGetErrorString(e), grid_blocks);
}
```

```cpp
#include <hip/hip_runtime.h>
#include <hip/hip_cooperative_groups.h>
#include <cstdio>
#include <cstdint>
namespace cg = cooperative_groups;
#define DEVFN __device__ __forceinline__
#define PHASE_BEGIN int tidx_ = threadIdx.x; int bidx_ = blockIdx.x; asm volatile("" : "+v"(tidx_), "+s"(bidx_))
#define GTID ((long)bidx_ * 256 + tidx_)
#define GSIZE ((long)gridDim.x * 256)
#define ACT_BF16 1
#define HAVE_FAST 1

#ifdef CFG_SMALL
constexpr int D = 128, BATCH = 2, SEQ = 64, DEPTH = 2, DB = 2, DSEQ = 384, PAST = 64, FF = 64;
#else
constexpr int D = 1024, BATCH = 16, SEQ = 256, DEPTH = 4, DB = 4, DSEQ = 1024, PAST = 512, FF = 1024;
#endif
constexpr int GRID_W = 64, NH = 8, NKV = 2, HD = 64, GQA = 4, ATTN_W = 512, KV_W = 128, WINDOW = 128;
constexpr int FOUR_W = 256, S5_W = 256, SG = 16, SH = 16, SP = 64;
constexpr int MIX_W = 1024, IN_W = 1280, NE = 16;
constexpr int NP = 1536;
constexpr int PC_Q = 0, PC_K = 512, PC_V = 640, PC_P = 768, PC_QQ = 1024, PC_U = 1280;
constexpr int NPJ = 1024, PJ_Q = 0, PJ_K = 512, PJ_V = 640, PJ_U = 768;
constexpr int TC = BATCH * SEQ, TL = DB * DSEQ, T = TC + TL;
constexpr int NCOND = 1 + DB;
constexpr int CAPC = 2 * SEQ / NE, CAPL = 2 * DSEQ / NE;
constexpr int NS = BATCH * CAPC + DB * CAPL;
constexpr int NSEQ = BATCH + DB;
constexpr float LN_EPS = 1e-5f;
#ifdef CFG_SMALL
constexpr float ALPHA = 1.4142135623730951f;
#else
constexpr float ALPHA = 1.681792830507429f;
#endif

constexpr long O_YP = 0, O_YS = (long)TC * D, O_K = (long)T * D, O_V = O_K + (long)BATCH * DEPTH * SEQ * KV_W,
               O_SRE = O_V + (long)BATCH * DEPTH * SEQ * KV_W, O_SIM = O_SRE + (long)BATCH * DEPTH * 2 * SG * SP,
               O_END = O_SIM + (long)BATCH * DEPTH * 2 * SG * SP;

typedef unsigned short bf16_t;
#ifdef HOST_EMU
static inline unsigned f_as_u(float f) { unsigned u; memcpy(&u, &f, 4); return u; }
static inline float u_as_f(unsigned u) { float f; memcpy(&f, &u, 4); return f; }
#else
DEVFN unsigned f_as_u(float f) { return __float_as_uint(f); }
DEVFN float u_as_f(unsigned u) { return __uint_as_float(u); }
#endif
DEVFN bf16_t f2bf(float f) { unsigned u = f_as_u(f); u += 0x7fffu + ((u >> 16) & 1u); return (bf16_t)(u >> 16); }
DEVFN float bf2f(bf16_t b) { return u_as_f((unsigned)b << 16); }
#ifdef ACT_BF16
typedef bf16_t act_t;
DEVFN float lda(const act_t* p) { return bf2f(*p); }
DEVFN void sta(act_t* p, float v) { *p = f2bf(v); }
#else
typedef float act_t;
DEVFN float lda(const act_t* p) { return *p; }
DEVFN void sta(act_t* p, float v) { *p = v; }
#endif
struct Params {
  const float *x_prompt, *x_sample, *cache_k, *cache_v, *st_re, *st_im, *c, *c_ctx, *ln_in_g, *ln_in_b, *w_ada, *b_ada,
      *w_in, *w_fourier, *attn_sink, *s5_a_re, *s5_a_im, *s5_log_dt, *s5_b_re, *s5_b_im, *s5_c_re, *s5_c_im, *s5_d,
      *s5_w_glu, *w_out, *ln1_g, *ln1_b, *w_router, *w_gate, *w_up, *w_down, *ln2_g, *ln2_b;
  float* out;
  float *x, *mod, *states, *ybuf, *aff, *wcs, *win2, *abar, *bbar, *twc, *twl, *selgate, *modpart, *rope, *afft, *ypart;
  act_t *h, *proj, *pqt, *mixcat, *gbuf, *h2, *hid, *ys;
  bf16_t *win2t, *woutt, *wglut, *dftc, *dftl, *bbn, *cn, *wcst, *wgt, *wut, *wdt;
  int *seltok, *inv;
  unsigned* bar;
};

DEVFN float silu_f(float x) { return x / (1.f + expf(-x)); }
DEVFN float sigmoid_f(float x) { return 1.f / (1.f + expf(-x)); }
DEVFN float gelu_f(float x) { return 0.5f * x * (1.f + tanhf(0.7978845608028654f * (x + 0.044715f * x * x * x))); }

struct TokInfo { int lat, b, n, N, ci, t0; };
DEVFN TokInfo tokinfo(int t) {
  TokInfo r;
  if (t < TC) { r.lat = 0; r.b = t / SEQ; r.n = t % SEQ; r.N = SEQ; r.ci = 0; r.t0 = r.b * SEQ; }
  else { int tl = t - TC; r.lat = 1; r.b = tl / DSEQ; r.n = tl % DSEQ; r.N = DSEQ; r.ci = 1 + r.b; r.t0 = TC + r.b * DSEQ; }
  return r;
}
DEVFN const float* modp(const Params& p, int l, int ci, int chunk) { return p.mod + (((long)l * NCOND + ci) * 6 + chunk) * D; }

DEVFN void ph_init0(const Params& p) {
  PHASE_BEGIN;
  const long gt = GTID, gs = GSIZE;
#ifndef HAVE_FAST
  for (long idx = gt; idx < (long)DEPTH * 6 * D; idx += gs) {
    int l = idx / (6 * D), j = idx % (6 * D);
    float acc[NCOND];
#pragma unroll
    for (int c = 0; c < NCOND; ++c) acc[c] = 0.f;
    const float* w = p.w_ada + (long)l * D * 6 * D + j;
    for (int d = 0; d < D; ++d) {
      float wv = w[(long)d * 6 * D];
      acc[0] += silu_f(p.c_ctx[d]) * wv;
#pragma unroll
      for (int c = 1; c < NCOND; ++c) acc[c] += silu_f(p.c[(c - 1) * D + d]) * wv;
    }
    float bb = p.b_ada[(long)l * 6 * D + j];
#pragma unroll
    for (int c = 0; c < NCOND; ++c) p.mod[((long)l * NCOND + c) * 6 * D + j] = acc[c] + bb;
  }
#endif
  for (long idx = gt; idx < (long)DEPTH * 2 * SG * SP; idx += gs) {
    int pp = idx % SP; int g = (idx / SP) % SG; long ld = idx / (SP * SG);
    double are = p.s5_a_re[idx], aim = p.s5_a_im[idx];
    double dt = exp((double)p.s5_log_dt[ld * SG + g]);
    double er = exp(are * dt), cr = er * cos(aim * dt), ci = er * sin(aim * dt);
    p.abar[idx * 2] = (float)cr; p.abar[idx * 2 + 1] = (float)ci;
    double nr = cr - 1.0, ni = ci, den = are * are + aim * aim;
    double fr = (nr * are + ni * aim) / den, fi = (ni * are - nr * aim) / den;
    for (int h = 0; h < SH; ++h) {
      double br = p.s5_b_re[idx * SH + h], bi = p.s5_b_im[idx * SH + h];
      p.bbar[(idx * SH + h) * 2] = (float)(fr * br - fi * bi);
      p.bbar[(idx * SH + h) * 2 + 1] = (float)(fr * bi + fi * br);
#ifdef HAVE_FAST
      p.bbn[((ld * SG + g) * 128 + 2 * pp) * 16 + h] = f2bf((float)(fr * br - fi * bi));
      p.bbn[((ld * SG + g) * 128 + 2 * pp + 1) * 16 + h] = f2bf((float)(fr * bi + fi * br));
#endif
    }
  }
#ifdef HAVE_FAST
  for (long idx = gt; idx < (long)DEPTH * 2 * SG * SH * 128; idx += gs) {
    int k = idx % 128; long row = idx / 128;
    p.cn[idx] = f2bf((k & 1) ? -p.s5_c_im[row * SP + (k >> 1)] : p.s5_c_re[row * SP + (k >> 1)]);
  }
#endif
  for (long idx = gt; idx < SEQ; idx += gs) {
    double a = 6.283185307179586476925 * (double)idx / SEQ;
    p.twc[idx * 2] = (float)cos(a); p.twc[idx * 2 + 1] = (float)sin(a);
  }
  for (long idx = gt; idx < DSEQ; idx += gs) {
    double a = 6.283185307179586476925 * (double)idx / DSEQ;
    p.twl[idx * 2] = (float)cos(a); p.twl[idx * 2 + 1] = (float)sin(a);
  }
  for (long idx = gt; idx < (long)DEPTH * 256 * 256; idx += gs) {
    int j = idx % 256; int i = (idx / 256) % 256; int l = idx / (256 * 256);
    int hd = i / 64, c = i % 64;
    float sc = 0.f, ss = 0.f;
    for (int m = 0; m < 64; ++m) {
      int k = (m * c) & 63;
      float ang = 6.283185307179586f * (float)k / 64.f;
      float wv = p.w_fourier[((long)l * 256 + hd * 64 + m) * 256 + j];
      sc += cosf(ang) * wv; ss += sinf(ang) * wv;
    }
    p.wcs[((long)l * 256 + i) * 512 + j] = sc * 0.125f;
    p.wcs[((long)l * 256 + i) * 512 + 256 + j] = ss * 0.125f;
  }
}
DEVFN void ph_init1(const Params& p) {
  PHASE_BEGIN;
  const long gt = GTID, gs = GSIZE;
  for (long idx = gt; idx < (long)DEPTH * D * NP; idx += gs) {
    int j = idx % NP; int d = (idx / NP) % D; int l = idx / ((long)NP * D);
    const float* wrow = p.w_in + ((long)l * D + d) * IN_W;
    float v;
    if (j < PC_P) v = wrow[j];
    else if (j >= PC_U) v = wrow[1024 + (j - PC_U)];
    else {
      int jj = j - PC_P;
      float acc = 0.f;
      for (int i = 0; i < 256; ++i) acc += wrow[768 + i] * p.wcs[((long)l * 256 + i) * 512 + jj];
      v = acc;
    }
    p.win2[idx] = v;
#ifdef HAVE_FAST
    p.win2t[((long)l * NP + j) * D + d] = f2bf(v);
#endif
  }
}

DEVFN long pqt_base(int lat, int b) { return lat ? (long)TC * 512 + (long)b * 512 * DSEQ : (long)b * 512 * SEQ; }
DEVFN void ph_row1(const Params& p, int l) {
  PHASE_BEGIN;
  for (long t = GTID; t < T; t += GSIZE) {
    TokInfo ti = tokinfo((int)t);
    float* yb = p.ybuf + t * D;
    const float *g, *b;
    float sum = 0.f;
    if (l == 0) {
      const float* src = ti.lat ? p.x_sample + (t - TC) * D : p.x_prompt + t * D;
      for (int d = 0; d < D; ++d) { float v = src[d]; yb[d] = v; sum += v; }
      g = p.ln_in_g; b = p.ln_in_b;
    } else {
      const float* gate2 = modp(p, l - 1, ti.ci, 5);
      const float* xr = p.x + t * D;
      for (int d = 0; d < D; ++d) {
        float m = 0.f;
        for (int e = 0; e < NE; ++e) {
          int s = p.inv[t * NE + e];
          if (s >= 0) m += lda(p.ys + ((long)e * NS + s) * D + d);
        }
        float v = ALPHA * xr[d] + gate2[d] * m;
        yb[d] = v; sum += v;
      }
      g = p.ln2_g + (long)(l - 1) * D; b = p.ln2_b + (long)(l - 1) * D;
    }
    float mu = sum / D, var = 0.f;
    for (int d = 0; d < D; ++d) { float dv = yb[d] - mu; var += dv * dv; }
    float rs = 1.f / sqrtf(var / D + LN_EPS);
    if (l < DEPTH) {
      const float* sh = modp(p, l, ti.ci, 0); const float* sc = modp(p, l, ti.ci, 1);
      for (int d = 0; d < D; ++d) {
        float xv = (yb[d] - mu) * rs * g[d] + b[d];
        p.x[t * D + d] = xv;
        sta(p.h + t * D + d, xv * (1.f + sc[d]) + sh[d]);
      }
    } else {
      float* o = p.out + (ti.lat ? O_YS + (t - TC) * D : O_YP + t * D);
      for (int d = 0; d < D; ++d) o[d] = (yb[d] - mu) * rs * g[d] + b[d];
    }
  }
}

DEVFN void inproj_store(const Params& p, int l, long t, const TokInfo& ti, int j, float a0, float a1) {
  if (ti.lat && j < PC_V) {
    int i = (j % HD) / 2;
    int pos = (i < 16) ? (ti.n / GRID_W) : (ti.n % GRID_W);
    int fi = i & 15;
    float freq = powf(10000.f, -(float)fi / 16.f);
    float ang = (float)pos * freq;
    float cs = cosf(ang), sn = sinf(ang);
    float r0 = a0 * cs - a1 * sn, r1 = a0 * sn + a1 * cs;
    a0 = r0; a1 = r1;
  }
  if (j < PC_P) { sta(p.proj + t * NPJ + j, a0); sta(p.proj + t * NPJ + j + 1, a1); }
  else if (j >= PC_U) { sta(p.proj + t * NPJ + PJ_U + (j - PC_U), a0); sta(p.proj + t * NPJ + PJ_U + (j - PC_U) + 1, a1); }
  else {
    int jj = j - PC_P; int isq = jj >= 256; int jc = jj & 255;
    act_t* dst = p.pqt + pqt_base(ti.lat, ti.b) + (long)jc * 2 * ti.N + (isq ? ti.N : 0) + ti.n;
    sta(dst, a0); sta(dst + 2 * ti.N, a1);
  }
  if (!ti.lat && j >= PC_K && j < PC_P) {
    long base = (((long)ti.b * DEPTH + l) * SEQ + ti.n) * KV_W;
    if (j < PC_V) { p.out[O_K + base + (j - PC_K)] = a0; p.out[O_K + base + (j - PC_K) + 1] = a1; }
    else { p.out[O_V + base + (j - PC_V)] = a0; p.out[O_V + base + (j - PC_V) + 1] = a1; }
  }
}
DEVFN void ph_gemm_in(const Params& p, int l) {
  PHASE_BEGIN;
  for (long idx = GTID; idx < (long)T * (NP / 2); idx += GSIZE) {
    int jp = idx % (NP / 2); long t = idx / (NP / 2);
    int j = jp * 2;
    const act_t* hr = p.h + t * D;
    const float* w = p.win2 + (long)l * D * NP + j;
    float a0 = 0.f, a1 = 0.f;
    for (int d = 0; d < D; ++d) { float hv = lda(hr + d); a0 += hv * w[(long)d * NP]; a1 += hv * w[(long)d * NP + 1]; }
    TokInfo ti = tokinfo((int)t);
    inproj_store(p, l, t, ti, j, a0, a1);
  }
}

DEVFN float ldv(const float* p) { return *p; }
#ifdef ACT_BF16
DEVFN float ldv(const bf16_t* p) { return bf2f(*p); }
#endif
template <class KT>
DEVFN void attn_key(const float* q, const KT* kr, const KT* vr, float& m, float& den, float* acc) {
  float s = 0.f;
#pragma unroll
  for (int d = 0; d < HD; ++d) s += q[d] * ldv(kr + d);
  s *= 0.125f;
  if (s > m) {
    float f = expf(m - s);
    den *= f;
#pragma unroll
    for (int d = 0; d < HD; ++d) acc[d] *= f;
    m = s;
  }
  float pw = expf(s - m);
  den += pw;
#pragma unroll
  for (int d = 0; d < HD; ++d) acc[d] += pw * ldv(vr + d);
}
DEVFN void ph_attn(const Params& p, int l) {
  PHASE_BEGIN;
  for (long idx = GTID; idx < (long)T * NH; idx += GSIZE) {
    int hh = idx % NH; long t = idx / NH;
    TokInfo ti = tokinfo((int)t);
    int kvh = hh / GQA;
    float q[HD], acc[HD];
#pragma unroll
    for (int d = 0; d < HD; ++d) { q[d] = lda(p.proj + t * NPJ + PJ_Q + hh * HD + d); acc[d] = 0.f; }
    float m = p.attn_sink[l * NH + hh], den = 1.f;
    int j0 = 0, j1 = ti.N;
    if (ti.lat) { j0 = ti.n - WINDOW < 0 ? 0 : ti.n - WINDOW; j1 = ti.n + WINDOW + 1 > ti.N ? ti.N : ti.n + WINDOW + 1; }
    for (int j = j0; j < j1; ++j) {
      const act_t* kr = p.proj + (long)(ti.t0 + j) * NPJ + PJ_K + kvh * HD;
      const act_t* vr = p.proj + (long)(ti.t0 + j) * NPJ + PJ_V + kvh * HD;
      attn_key(q, kr, vr, m, den, acc);
    }
    if (ti.lat) {
      for (int s_ = 0; s_ < PAST; ++s_) {
        long base = ((((long)ti.b * DEPTH + l) * PAST + s_) * NKV + kvh) * HD;
        attn_key(q, p.cache_k + base, p.cache_v + base, m, den, acc);
      }
    }
    float inv = 1.f / den;
#pragma unroll
    for (int d = 0; d < HD; ++d) sta(p.mixcat + t * MIX_W + hh * HD + d, acc[d] * inv);
  }
}
DEVFN void ph_fourier(const Params& p, int l) {
  PHASE_BEGIN;
  for (long idx = GTID; idx < (long)T * FOUR_W; idx += GSIZE) {
    int j = idx % FOUR_W; long t = idx / FOUR_W;
    TokInfo ti = tokinfo((int)t);
    const float* tw = ti.lat ? p.twl : p.twc;
    const act_t* pr = p.pqt + pqt_base(ti.lat, ti.b) + (long)j * 2 * ti.N;
    float acc = 0.f;
    for (int n = 0; n < ti.N; ++n) {
      int k = (int)(((long)ti.n * n) % ti.N);
      acc += tw[k * 2] * lda(pr + n) - tw[k * 2 + 1] * lda(pr + ti.N + n);
    }
    sta(p.mixcat + t * MIX_W + ATTN_W + j, acc / sqrtf((float)ti.N));
  }
}
DEVFN void ph_s5scan(const Params& p, int l) {
  PHASE_BEGIN;
  for (long idx = GTID; idx < (long)NSEQ * 2 * SG * SP; idx += GSIZE) {
    int pp = idx % SP; int g = (idx / SP) % SG; int dir = (idx / (SP * SG)) % 2; int sq = idx / (SP * SG * 2);
    int lat = sq >= BATCH; int b = lat ? sq - BATCH : sq; int N = lat ? DSEQ : SEQ; int t0 = lat ? TC + b * DSEQ : b * SEQ;
    long pi = (((long)l * 2 + dir) * SG + g) * SP + pp;
    float ar = p.abar[pi * 2], ai = p.abar[pi * 2 + 1];
    float br[SH], bi[SH];
#pragma unroll
    for (int h = 0; h < SH; ++h) { br[h] = p.bbar[(pi * SH + h) * 2]; bi[h] = p.bbar[(pi * SH + h) * 2 + 1]; }
    float sr = 0.f, si = 0.f;
    if (lat) {
      long si0 = ((((long)b * DEPTH + l) * 2 + dir) * SG + g) * SP + pp;
      sr = p.st_re[si0]; si = p.st_im[si0];
    }
    for (int k = 0; k < N; ++k) {
      int n = dir ? N - 1 - k : k;
      const act_t* u = p.proj + (long)(t0 + n) * NPJ + PJ_U + g * SH;
      float bur = 0.f, bui = 0.f;
#pragma unroll
      for (int h = 0; h < SH; ++h) { float uv = lda(u + h); bur += br[h] * uv; bui += bi[h] * uv; }
      float nr = ar * sr - ai * si + bur, ni = ar * si + ai * sr + bui;
      sr = nr; si = ni;
      long so = ((((long)(t0 + n) * 2 + dir) * SG + g) * SP + pp) * 2;
      p.states[so] = sr; p.states[so + 1] = si;
    }
    if (!lat) {
      long oo = ((((long)b * DEPTH + l) * 2 + dir) * SG + g) * SP + pp;
      p.out[O_SRE + oo] = sr; p.out[O_SIM + oo] = si;
    }
  }
}
DEVFN void ph_s5y(const Params& p, int l) {
  PHASE_BEGIN;
  for (long idx = GTID; idx < (long)T * S5_W; idx += GSIZE) {
    int c = idx % S5_W; long t = idx / S5_W;
    int g = c / SH, h = c % SH;
    float y = p.s5_d[l * S5_W + c] * lda(p.proj + t * NPJ + PJ_U + c);
    for (int dir = 0; dir < 2; ++dir) {
      const float* cre = p.s5_c_re + ((((long)l * 2 + dir) * SG + g) * SH + h) * SP;
      const float* cim = p.s5_c_im + ((((long)l * 2 + dir) * SG + g) * SH + h) * SP;
      const float* st = p.states + ((((long)t * 2 + dir) * SG + g) * SP) * 2;
      for (int pp = 0; pp < SP; ++pp) y += cre[pp] * st[pp * 2] - cim[pp] * st[pp * 2 + 1];
    }
    sta(p.gbuf + t * S5_W + c, gelu_f(y));
  }
}
DEVFN void ph_s5glu(const Params& p, int l) {
  PHASE_BEGIN;
  for (long idx = GTID; idx < (long)T * S5_W; idx += GSIZE) {
    int j = idx % S5_W; long t = idx / S5_W;
    const act_t* gr = p.gbuf + t * S5_W;
    const float* w = p.s5_w_glu + (long)l * S5_W * S5_W + j;
    float z = 0.f;
    for (int i = 0; i < S5_W; ++i) z += lda(gr + i) * w[(long)i * S5_W];
    sta(p.mixcat + t * MIX_W + ATTN_W + FOUR_W + j, lda(gr + j) * sigmoid_f(z));
  }
}
DEVFN void ph_gemm_out(const Params& p, int l) {
  PHASE_BEGIN;
  for (long idx = GTID; idx < (long)T * D; idx += GSIZE) {
    int j = idx % D; long t = idx / D;
    const act_t* mr = p.mixcat + t * MIX_W;
    const float* w = p.w_out + (long)l * MIX_W * D + j;
    float acc = 0.f;
    for (int i = 0; i < MIX_W; ++i) acc += lda(mr + i) * w[(long)i * D];
    TokInfo ti = tokinfo((int)t);
    p.ybuf[idx] = ALPHA * p.x[idx] + modp(p, l, ti.ci, 2)[j] * acc;
  }
}
DEVFN void ph_row2(const Params& p, int l) {
  PHASE_BEGIN;
  for (long t = GTID; t < T; t += GSIZE) {
    TokInfo ti = tokinfo((int)t);
    const float* yb = p.ybuf + t * D;
    float sum = 0.f;
    for (int d = 0; d < D; ++d) sum += yb[d];
    float mu = sum / D, var = 0.f;
    for (int d = 0; d < D; ++d) { float dv = yb[d] - mu; var += dv * dv; }
    float rs = 1.f / sqrtf(var / D + LN_EPS);
    const float* g = p.ln1_g + (long)l * D; const float* b = p.ln1_b + (long)l * D;
    const float* sh = modp(p, l, ti.ci, 3); const float* sc = modp(p, l, ti.ci, 4);
    float lg[NE];
#pragma unroll
    for (int e = 0; e < NE; ++e) lg[e] = 0.f;
    for (int d = 0; d < D; ++d) {
      float xv = (yb[d] - mu) * rs * g[d] + b[d];
      p.x[t * D + d] = xv;
      float hv = xv * (1.f + sc[d]) + sh[d];
      sta(p.h2 + t * D + d, hv);
      const float* wr = p.w_router + ((long)l * D + d) * NE;
#pragma unroll
      for (int e = 0; e < NE; ++e) lg[e] += hv * wr[e];
    }
    float mx = lg[0];
#pragma unroll
    for (int e = 1; e < NE; ++e) mx = fmaxf(mx, lg[e]);
    float se = 0.f;
#pragma unroll
    for (int e = 0; e < NE; ++e) { lg[e] = expf(lg[e] - mx); se += lg[e]; }
    float is = 1.f / se;
#pragma unroll
    for (int e = 0; e < NE; ++e) p.aff[t * NE + e] = lg[e] * is;
  }
}
DEVFN void ph_topk(const Params& p, int l) {
  PHASE_BEGIN;
  for (long idx = GTID; idx < (long)T * NE; idx += GSIZE) {
    int e = idx % NE; long t = idx / NE;
    TokInfo ti = tokinfo((int)t);
    float a = p.aff[t * NE + e];
    int rank = 0;
    for (int j = 0; j < ti.N; ++j) {
      float aj = p.aff[(long)(ti.t0 + j) * NE + e];
      rank += (aj > a || (aj == a && j < ti.n)) ? 1 : 0;
    }
    int cap = ti.lat ? CAPL : CAPC;
    int slot = -1;
    if (rank < cap) {
      slot = ti.lat ? BATCH * CAPC + ti.b * CAPL + rank : ti.b * CAPC + rank;
      p.seltok[e * NS + slot] = (int)t;
      p.selgate[e * NS + slot] = a;
    }
    p.inv[t * NE + e] = slot;
  }
}
DEVFN void ph_moe1(const Params& p, int l) {
  PHASE_BEGIN;
  for (long idx = GTID; idx < (long)NE * NS * FF; idx += GSIZE) {
    int f = idx % FF; int s = (idx / FF) % NS; int e = idx / ((long)FF * NS);
    int tok = p.seltok[e * NS + s];
    const act_t* hr = p.h2 + (long)tok * D;
    const float* wg = p.w_gate + (((long)l * NE + e) * D) * FF + f;
    const float* wu = p.w_up + (((long)l * NE + e) * D) * FF + f;
    float ag = 0.f, au = 0.f;
    for (int d = 0; d < D; ++d) { float hv = lda(hr + d); ag += hv * wg[(long)d * FF]; au += hv * wu[(long)d * FF]; }
    sta(p.hid + idx, silu_f(ag) * au);
  }
}
DEVFN void ph_moe2(const Params& p, int l) {
  PHASE_BEGIN;
  for (long idx = GTID; idx < (long)NE * NS * D; idx += GSIZE) {
    int d = idx % D; int s = (idx / D) % NS; int e = idx / ((long)D * NS);
    const act_t* hr = p.hid + ((long)e * NS + s) * FF;
    const float* wd = p.w_down + (((long)l * NE + e) * FF) * D + d;
    float acc = 0.f;
    for (int f = 0; f < FF; ++f) acc += lda(hr + f) * wd[(long)f * D];
    sta(p.ys + idx, acc * p.selgate[e * NS + s]);
  }
}

constexpr int PH_PER_LAYER = 10;
constexpr int NPHASE = 2 + PH_PER_LAYER * DEPTH + 1;
#ifndef HAVE_FAST
DEVFN void run_phase(const Params& p, int ph) {
  if (ph == 0) { ph_init0(p); return; }
  if (ph == 1) { ph_init1(p); return; }
  int l = (ph - 2) / PH_PER_LAYER, s = (ph - 2) % PH_PER_LAYER;
  if (l == DEPTH) { ph_row1(p, DEPTH); return; }
  switch (s) {
    case 0: ph_row1(p, l); break;
    case 1: ph_gemm_in(p, l); break;
    case 2: ph_attn(p, l); ph_fourier(p, l); ph_s5scan(p, l); break;
    case 3: ph_s5y(p, l); break;
    case 4: ph_s5glu(p, l); break;
    case 5: ph_gemm_out(p, l); break;
    case 6: ph_row2(p, l); break;
    case 7: ph_topk(p, l); break;
    case 8: ph_moe1(p, l); break;
    case 9: ph_moe2(p, l); break;
  }
}
#endif
#define XB_TMO      128
#define XB_XCNT(j)  (256  + 64 * (j))
#define XB_XSUB(j)  (1280 + 64 * (j))
#define XB_XGEN(j)  (2304 + 64 * (j))
#define XB_TOP      3328
#define XB_TOPGEN   3392
#define XCD_BAR_WORDS 3456
#define XB_SPIN_CAP (1u << 20)
#define LAS __attribute__((address_space(3)))
DEVFN unsigned xb_ld(unsigned* p)              { return __hip_atomic_load(p, __ATOMIC_RELAXED, __HIP_MEMORY_SCOPE_AGENT); }
DEVFN unsigned xb_add(unsigned* p, unsigned v) { return __hip_atomic_fetch_add(p, v, __ATOMIC_RELAXED, __HIP_MEMORY_SCOPE_AGENT); }
DEVFN unsigned xb_xcc_id() { return (unsigned)__builtin_amdgcn_s_getreg((3 << 11) | 20) & 0xFu; }
#define XB_SPIN(cond, bar) do { unsigned _sp = 0; while (cond) { __builtin_amdgcn_s_sleep(1); \
    if ((++_sp & 255u) == 0u) { if (xb_ld(&(bar)[XB_TMO])) break; if (_sp > XB_SPIN_CAP) { atomicAdd(&(bar)[XB_TMO], 1u); break; } } } } while (0)
struct XcdBarrier { unsigned* bar; unsigned x; volatile LAS unsigned* st; };
DEVFN XcdBarrier xcd_barrier_post(unsigned* bar, volatile LAS unsigned* st) {
    XcdBarrier b; b.bar = bar; b.x = xb_xcc_id(); b.st = st;
    if (threadIdx.x == 0) (void)xb_add(&bar[XB_XCNT(b.x)], 1u);
    return b;
}
DEVFN void xcd_barrier_complete(unsigned* bar, unsigned x, unsigned& nloc, unsigned& nx) {
    const unsigned G = gridDim.x * gridDim.y * gridDim.z;
    unsigned sum, cnt, mine, sp = 0u;
    for (;;) {
        sum = 0u; cnt = 0u; mine = 0u;
#pragma unroll
        for (unsigned j = 0; j < 16; ++j) { const unsigned c = xb_ld(&bar[XB_XCNT(j)]); sum += c; cnt += (c > 0u) ? 1u : 0u; mine = (j == x) ? c : mine; }
        if (sum == G) break;
        __builtin_amdgcn_s_sleep(1);
        if ((++sp & 255u) == 0u) { if (xb_ld(&bar[XB_TMO])) break; if (sp > XB_SPIN_CAP) { atomicAdd(&bar[XB_TMO], 1u); break; } }
    }
    nloc = mine > 0u ? mine : 1u; nx = cnt > 0u ? cnt : 1u;
}
DEVFN void xcd_barrier(const XcdBarrier& b) {
    asm volatile("s_waitcnt vmcnt(0)" ::: "memory");
    __syncthreads();
    if (threadIdx.x == 0) {
        unsigned* bar = b.bar;
        __builtin_amdgcn_s_waitcnt(0);
        unsigned nloc = b.st[0], nx = b.st[1];
        if (nloc == 0u) { xcd_barrier_complete(bar, b.x, nloc, nx); b.st[0] = nloc; b.st[1] = nx; }
        const unsigned old = xb_add(&bar[XB_XSUB(b.x)], 1u);
        const unsigned gen = old / nloc;
        if (old + 1u == (gen + 1u) * nloc) {
            __builtin_amdgcn_fence(__ATOMIC_RELEASE, "agent");
            asm volatile("s_waitcnt vmcnt(0)" ::: "memory");
            const unsigned og = xb_add(&bar[XB_TOP], 1u);
            const unsigned tg = og / nx;
            if (og + 1u == (tg + 1u) * nx) xb_add(&bar[XB_TOPGEN], 1u);
            else XB_SPIN(xb_ld(&bar[XB_TOPGEN]) == tg, bar);
            __builtin_amdgcn_fence(__ATOMIC_ACQUIRE, "agent");
            xb_add(&bar[XB_XGEN(b.x)], 1u);
            asm volatile("s_waitcnt vmcnt(0)" ::: "memory");
        } else {
            XB_SPIN(xb_ld(&bar[XB_XGEN(b.x)]) == gen, bar);
            __builtin_amdgcn_fence(__ATOMIC_ACQUIRE, "agent");
            asm volatile("s_waitcnt vmcnt(0)" ::: "memory");
        }
    }
    __syncthreads();
}

template <class Fill>
DEVFN void xcd_barrier_fill(const XcdBarrier& b, volatile LAS unsigned* lead, Fill fill) {
    asm volatile("s_waitcnt vmcnt(0)" ::: "memory");
    __syncthreads();
    unsigned gen = 0u, nloc = 1u, nx = 1u;
    unsigned* bar = b.bar; unsigned bx = b.x;
    asm volatile("" : "+s"(bar), "+s"(bx));
    if (threadIdx.x == 0) {
        __builtin_amdgcn_s_waitcnt(0);
        nloc = b.st[0]; nx = b.st[1];
        if (nloc == 0u) { xcd_barrier_complete(bar, bx, nloc, nx); b.st[0] = nloc; b.st[1] = nx; }
        const unsigned old = xb_add(&bar[XB_XSUB(bx)], 1u);
        gen = old / nloc;
        *lead = (old + 1u == (gen + 1u) * nloc) ? 1u : 0u;
    }
    __syncthreads();
    const bool leader = *lead != 0u;
    if (!leader) fill();
    asm volatile("" : "+s"(bar), "+s"(bx));
    if (threadIdx.x == 0) {
        if (leader) {
            __builtin_amdgcn_fence(__ATOMIC_RELEASE, "agent");
            asm volatile("s_waitcnt vmcnt(0)" ::: "memory");
            const unsigned og = xb_add(&bar[XB_TOP], 1u);
            const unsigned tg = og / nx;
            if (og + 1u == (tg + 1u) * nx) xb_add(&bar[XB_TOPGEN], 1u);
            else XB_SPIN(xb_ld(&bar[XB_TOPGEN]) == tg, bar);
            __builtin_amdgcn_fence(__ATOMIC_ACQUIRE, "agent");
            xb_add(&bar[XB_XGEN(bx)], 1u);
            asm volatile("s_waitcnt vmcnt(0)" ::: "memory");
        } else {
            XB_SPIN(xb_ld(&bar[XB_XGEN(bx)]) == gen, bar);
            __builtin_amdgcn_fence(__ATOMIC_ACQUIRE, "agent");
            asm volatile("s_waitcnt vmcnt(0)" ::: "memory");
        }
    }
    __syncthreads();
}
typedef __attribute__((ext_vector_type(8))) short bf16x8;
typedef __attribute__((ext_vector_type(16))) float f32x16;
typedef __attribute__((ext_vector_type(4))) float f32x4;

DEVFN float sigmoid_fast(float x) { return __frcp_rn(1.f + __expf(-x)); }
DEVFN float silu_fast(float x) { return x * sigmoid_fast(x); }
DEVFN float gelu_fast(float x) { float u = 0.7978845608028654f * (x + 0.044715f * x * x * x); return x * sigmoid_fast(2.f * u); }
typedef __attribute__((ext_vector_type(2))) float f32x2_t;
typedef __attribute__((ext_vector_type(2))) __bf16 bf16x2_t;
DEVFN unsigned cvtpk(float lo, float hi) { f32x2_t v = {lo, hi}; bf16x2_t b = __builtin_convertvector(v, bf16x2_t); return __builtin_bit_cast(unsigned, b); }

constexpr int G_ROWB = 144, G_TILEB = 128 * G_ROWB, G_STAGEB = 2 * G_TILEB;
constexpr int SMEM_BYTES = 2 * G_STAGEB;

struct U4x4 { uint4 a, b, c, d; };
struct F4x8 { f32x4 f0, f1, f2, f3, f4, f5, f6, f7; };
struct RowLoader {
  const bf16_t *r0, *r1, *r2, *r3;
  DEVFN U4x4 operator()(int kt) const {
    U4x4 v;
    v.a = *(const uint4*)(r0 + kt * 64); v.b = *(const uint4*)(r1 + kt * 64);
    v.c = *(const uint4*)(r2 + kt * 64); v.d = *(const uint4*)(r3 + kt * 64);
    return v;
  }
};
struct BF32Loader { const float* bp; long ldb; };

DEVFN void rl_store(char* tile, int tid, const U4x4& v) {
  char* d = tile + (tid >> 3) * G_ROWB + (tid & 7) * 16;
  *(uint4*)(d) = v.a; *(uint4*)(d + 32 * G_ROWB) = v.b; *(uint4*)(d + 64 * G_ROWB) = v.c; *(uint4*)(d + 96 * G_ROWB) = v.d;
}
DEVFN F4x8 bf_load(const BF32Loader& L, int kt) {
  F4x8 f;
  const float* b = L.bp + (long)(kt * 64) * L.ldb;
  f.f0 = *(const f32x4*)(b); f.f1 = *(const f32x4*)(b + L.ldb); f.f2 = *(const f32x4*)(b + 2 * L.ldb); f.f3 = *(const f32x4*)(b + 3 * L.ldb);
  f.f4 = *(const f32x4*)(b + 4 * L.ldb); f.f5 = *(const f32x4*)(b + 5 * L.ldb); f.f6 = *(const f32x4*)(b + 6 * L.ldb); f.f7 = *(const f32x4*)(b + 7 * L.ldb);
  return f;
}
template <int I>
DEVFN uint4 bf_pack(const F4x8& f) {
  uint4 wv;
  wv.x = cvtpk(f.f0[I], f.f1[I]); wv.y = cvtpk(f.f2[I], f.f3[I]); wv.z = cvtpk(f.f4[I], f.f5[I]); wv.w = cvtpk(f.f6[I], f.f7[I]);
  return wv;
}
DEVFN void bf_store(char* tile, int tid, const F4x8& f) {
  int lane = tid & 63, w = tid >> 6, kg = lane & 7, ng = w * 8 + (lane >> 3);
  char* d = tile + (4 * ng) * G_ROWB + kg * 16;
  *(uint4*)(d) = bf_pack<0>(f); *(uint4*)(d + G_ROWB) = bf_pack<1>(f); *(uint4*)(d + 2 * G_ROWB) = bf_pack<2>(f); *(uint4*)(d + 3 * G_ROWB) = bf_pack<3>(f);
}

DEVFN void gemm_compute(const char* st, int wm, int wn, int fro, f32x16 (&acc)[2][2]) {
  const char* sA = st + wm * 64 * G_ROWB + fro;
  const char* sB = st + G_TILEB + wn * 64 * G_ROWB + fro;
#pragma unroll
  for (int ks = 0; ks < 4; ++ks) {
    bf16x8 a0 = *(const bf16x8*)(sA + ks * 32);
    bf16x8 a1 = *(const bf16x8*)(sA + 32 * G_ROWB + ks * 32);
    bf16x8 b0 = *(const bf16x8*)(sB + ks * 32);
    bf16x8 b1 = *(const bf16x8*)(sB + 32 * G_ROWB + ks * 32);
    acc[0][0] = __builtin_amdgcn_mfma_f32_32x32x16_bf16(a0, b0, acc[0][0], 0, 0, 0);
    acc[0][1] = __builtin_amdgcn_mfma_f32_32x32x16_bf16(a0, b1, acc[0][1], 0, 0, 0);
    acc[1][0] = __builtin_amdgcn_mfma_f32_32x32x16_bf16(a1, b0, acc[1][0], 0, 0, 0);
    acc[1][1] = __builtin_amdgcn_mfma_f32_32x32x16_bf16(a1, b1, acc[1][1], 0, 0, 0);
  }
}
template <class ALd, class BLd, class Epi>
DEVFN void gemm_tile(char* smem, int tidx_, const ALd& A, const BLd& B, int KT, Epi epi) {
  const int tid = tidx_, lane = tid & 63, wave = tid >> 6, wm = wave >> 1, wn = wave & 1;
  f32x16 acc[2][2];
#pragma unroll
  for (int i = 0; i < 2; ++i)
#pragma unroll
    for (int j = 0; j < 2; ++j)
#pragma unroll
      for (int r = 0; r < 16; ++r) acc[i][j][r] = 0.f;
  const int fro = (lane & 31) * G_ROWB + (lane >> 5) * 16;
  U4x4 a0 = A(0), b0 = B(0);
  U4x4 a1 = A(1), b1 = B(1);
  rl_store(smem, tid, a0); rl_store(smem + G_TILEB, tid, b0);
  __syncthreads();
  for (int kt = 0; kt < KT; kt += 2) {
    if (kt + 2 < KT) { a0 = A(kt + 2); b0 = B(kt + 2); }
    gemm_compute(smem, wm, wn, fro, acc);
    rl_store(smem + G_STAGEB, tid, a1); rl_store(smem + G_STAGEB + G_TILEB, tid, b1);
    __syncthreads();
    if (kt + 3 < KT) { a1 = A(kt + 3); b1 = B(kt + 3); }
    gemm_compute(smem + G_STAGEB, wm, wn, fro, acc);
    if (kt + 2 < KT) { rl_store(smem, tid, a0); rl_store(smem + G_TILEB, tid, b0); }
    __syncthreads();
  }
#pragma unroll
  for (int mt = 0; mt < 2; ++mt)
#pragma unroll
    for (int q = 0; q < 4; ++q)
#pragma unroll
      for (int nt = 0; nt < 2; ++nt) {
        int row = wm * 64 + mt * 32 + 8 * q + 4 * (lane >> 5);
        int col = wn * 64 + nt * 32 + (lane & 31);
        epi(nt, row, col, acc[mt][nt][4 * q], acc[mt][nt][4 * q + 1], acc[mt][nt][4 * q + 2], acc[mt][nt][4 * q + 3]);
      }
}

template <class ALd, class BLd, class Epi>
DEVFN void gemm_tile1(char* smem, int tidx_, const ALd& A, const BLd& B, int KT, Epi epi) {
  const int tid = tidx_, lane = tid & 63, wave = tid >> 6, wm = wave >> 1, wn = wave & 1;
  f32x16 acc[2][2];
#pragma unroll
  for (int i = 0; i < 2; ++i)
#pragma unroll
    for (int j = 0; j < 2; ++j)
#pragma unroll
      for (int r = 0; r < 16; ++r) acc[i][j][r] = 0.f;
  const int fro = (lane & 31) * G_ROWB + (lane >> 5) * 16;
  U4x4 av = A(0), bv = B(0);
  rl_store(smem, tid, av); rl_store(smem + G_TILEB, tid, bv);
  __syncthreads();
  for (int kt = 0; kt < KT; ++kt) {
    const int cur = kt & 1;
    const bool more = kt + 1 < KT;
    if (more) { av = A(kt + 1); bv = B(kt + 1); }
    gemm_compute(smem + cur * G_STAGEB, wm, wn, fro, acc);
    if (more) { char* st = smem + (cur ^ 1) * G_STAGEB; rl_store(st, tid, av); rl_store(st + G_TILEB, tid, bv); }
    __syncthreads();
  }
#pragma unroll
  for (int mt = 0; mt < 2; ++mt)
#pragma unroll
    for (int q = 0; q < 4; ++q)
#pragma unroll
      for (int nt = 0; nt < 2; ++nt) {
        int row = wm * 64 + mt * 32 + 8 * q + 4 * (lane >> 5);
        int col = wn * 64 + nt * 32 + (lane & 31);
        epi(nt, row, col, acc[mt][nt][4 * q], acc[mt][nt][4 * q + 1], acc[mt][nt][4 * q + 2], acc[mt][nt][4 * q + 3]);
      }
}

constexpr int GL_TILEB = 128 * 128, GL_STAGEB = 2 * GL_TILEB;
struct GRows { const bf16_t *r0, *r1, *r2, *r3; };
DEVFN int g_chunk(int tid) { return ((tid & 7) ^ ((tid >> 4) & 7)) * 8; }
DEVFN GRows make_grows(int tid, const bf16_t* base, long row0, long ld) {
  GRows L;
  const bf16_t* b0 = base + (row0 + (tid >> 3)) * ld + g_chunk(tid);
  L.r0 = b0; L.r1 = b0 + 32 * ld; L.r2 = b0 + 64 * ld; L.r3 = b0 + 96 * ld;
  return L;
}
DEVFN void glds16(const bf16_t* src, unsigned lds_dst) {
  unsigned keep;
  asm volatile("s_mov_b32 %0, m0\n\ts_mov_b32 m0, %2\n\ts_nop 0\n\tglobal_load_lds_dwordx4 %1, off\n\ts_mov_b32 m0, %0"
               : "=&s"(keep) : "v"(src), "s"(lds_dst));
}
DEVFN unsigned lds_addr(const char* p) { return (unsigned)(unsigned long)(const __attribute__((address_space(3))) char*)p; }
DEVFN void g_stage(char* st, int wave, const GRows& A, const GRows& B, int kt) {
  const unsigned sa = (unsigned)__builtin_amdgcn_readfirstlane((int)(lds_addr(st) + wave * 1024));
  const unsigned sb = sa + GL_TILEB;
  glds16(A.r0 + kt * 64, sa); glds16(A.r1 + kt * 64, sa + 4096); glds16(A.r2 + kt * 64, sa + 8192); glds16(A.r3 + kt * 64, sa + 12288);
  glds16(B.r0 + kt * 64, sb); glds16(B.r1 + kt * 64, sb + 4096); glds16(B.r2 + kt * 64, sb + 8192); glds16(B.r3 + kt * 64, sb + 12288);
}
template <int I>
DEVFN void g_stage_part(unsigned sa, const GRows& A, const GRows& B, int kt) {
  const bf16_t* ar = I == 0 ? A.r0 : I == 1 ? A.r1 : I == 2 ? A.r2 : A.r3;
  const bf16_t* br = I == 0 ? B.r0 : I == 1 ? B.r1 : I == 2 ? B.r2 : B.r3;
  glds16(ar + kt * 64, sa + I * 4096);
  glds16(br + kt * 64, sa + GL_TILEB + I * 4096);
}
template <class Epi>
DEVFN void gemm_tile_g(char* smem, int tidx_, const GRows& A, const GRows& B, int KT, Epi epi, int koff = 0) {
  const int tid = tidx_, lane = tid & 63, wave = tid >> 6, wm = wave >> 1, wn = wave & 1;
  f32x16 acc[2][2];
#pragma unroll
  for (int i = 0; i < 2; ++i)
#pragma unroll
    for (int j = 0; j < 2; ++j)
#pragma unroll
      for (int r = 0; r < 16; ++r) acc[i][j][r] = 0.f;
  const int sw = (lane >> 1) & 7, h = lane >> 5;
  int off[4];
#pragma unroll
  for (int ks = 0; ks < 4; ++ks) off[ks] = (lane & 31) * 128 + ((((2 * ks) ^ (sw & 6)) | (h ^ (sw & 1))) * 16);
  const unsigned sbase = (unsigned)__builtin_amdgcn_readfirstlane((int)(lds_addr(smem) + wave * 1024));
  g_stage(smem, wave, A, B, koff & (KT - 1));
  asm volatile("s_waitcnt vmcnt(0)" ::: "memory");
  __syncthreads();
  for (int kt = 0; kt < KT; ++kt) {
    const int cur = kt & 1;
    const bool more = kt + 1 < KT;
    const int ktn = (kt + 1 + koff) & (KT - 1);
    const unsigned san = sbase + (cur ^ 1) * GL_STAGEB;
    const char* sA = smem + cur * GL_STAGEB + wm * 64 * 128;
    const char* sB = smem + cur * GL_STAGEB + GL_TILEB + wn * 64 * 128;
    bf16x8 fa0[2], fa1[2], fb0[2], fb1[2];
    fa0[0] = *(const bf16x8*)(sA + off[0]); fa1[0] = *(const bf16x8*)(sA + 32 * 128 + off[0]);
    fb0[0] = *(const bf16x8*)(sB + off[0]); fb1[0] = *(const bf16x8*)(sB + 32 * 128 + off[0]);
#pragma unroll
    for (int ks = 0; ks < 4; ++ks) {
      const int c = ks & 1, n = c ^ 1;
      if (ks < 3) {
        fa0[n] = *(const bf16x8*)(sA + off[ks + 1]); fa1[n] = *(const bf16x8*)(sA + 32 * 128 + off[ks + 1]);
        fb0[n] = *(const bf16x8*)(sB + off[ks + 1]); fb1[n] = *(const bf16x8*)(sB + 32 * 128 + off[ks + 1]);
      }
      __builtin_amdgcn_sched_barrier(0);
      if (more) {
        if (ks == 0) { g_stage_part<0>(san, A, B, ktn); g_stage_part<1>(san, A, B, ktn); }
        else if (ks == 1) { g_stage_part<2>(san, A, B, ktn); g_stage_part<3>(san, A, B, ktn); }
      }
      acc[0][0] = __builtin_amdgcn_mfma_f32_32x32x16_bf16(fa0[c], fb0[c], acc[0][0], 0, 0, 0);
      acc[0][1] = __builtin_amdgcn_mfma_f32_32x32x16_bf16(fa0[c], fb1[c], acc[0][1], 0, 0, 0);
      acc[1][0] = __builtin_amdgcn_mfma_f32_32x32x16_bf16(fa1[c], fb0[c], acc[1][0], 0, 0, 0);
      acc[1][1] = __builtin_amdgcn_mfma_f32_32x32x16_bf16(fa1[c], fb1[c], acc[1][1], 0, 0, 0);
      __builtin_amdgcn_sched_barrier(0);
    }
    asm volatile("s_waitcnt vmcnt(0)" ::: "memory");
    __syncthreads();
  }
#pragma unroll
  for (int mt = 0; mt < 2; ++mt)
#pragma unroll
    for (int q = 0; q < 4; ++q)
#pragma unroll
      for (int nt = 0; nt < 2; ++nt) {
        int row = wm * 64 + mt * 32 + 8 * q + 4 * (lane >> 5);
        int col = wn * 64 + nt * 32 + (lane & 31);
        epi(nt, row, col, acc[mt][nt][4 * q], acc[mt][nt][4 * q + 1], acc[mt][nt][4 * q + 2], acc[mt][nt][4 * q + 3]);
      }
}

DEVFN int xcd_order(int v, int nblocks, int grp) {
  if (nblocks != 512) return v;
  const int it = v / nblocks, b = v % nblocks;
  const int x = b & 7, slot = b >> 3, per = nblocks >> 3;
  const int q = it * per + slot;
  return ((q / grp) * 8 + x) * grp + (q % grp);
}
struct PatchTile { int tm, tn, koff; };
DEVFN PatchTile patch8(int v, int nblocks, int& pidx) {
  const int it = v / nblocks, b = v % nblocks;
  const int x = b & 7, slot = b >> 3;
  PatchTile t; t.tm = slot & 7; t.tn = slot >> 3; t.koff = (t.tm + t.tn) & 7;
  pidx = it * 8 + x;
  return t;
}
DEVFN RowLoader make_rows(int tidx_, const bf16_t* base, long row0, long ld) {
  RowLoader L; int tid = tidx_;
  const bf16_t* b0 = base + (row0 + (tid >> 3)) * ld + (tid & 7) * 8;
  L.r0 = b0; L.r1 = b0 + 32 * ld; L.r2 = b0 + 64 * ld; L.r3 = b0 + 96 * ld;
  return L;
}
DEVFN float shx1(float v) { return __builtin_bit_cast(float, __builtin_amdgcn_mov_dpp(__builtin_bit_cast(int, v), 0xB1, 0xF, 0xF, true)); }
DEVFN void store4_bf16(bf16_t* p0, long ld, bool odd, float v0, float v1, float v2, float v3) {
  bf16_t* q = odd ? p0 + ld - 1 : p0;
  const float y0 = shx1(odd ? v0 : v1), y1 = shx1(odd ? v2 : v3);
  *(unsigned*)q = cvtpk(odd ? y0 : v0, odd ? v1 : y0);
  *(unsigned*)(q + 2 * ld) = cvtpk(odd ? y1 : v2, odd ? v3 : y1);
}

DEVFN void ph_init_fast(const Params& p) {
  PHASE_BEGIN;
  const long gt = GTID, gs = GSIZE;
  for (long idx = gt; idx < (long)DEPTH * D * MIX_W; idx += gs) {
    int k = idx % MIX_W; int n = (idx / MIX_W) % D; int l = idx / ((long)MIX_W * D);
    p.woutt[idx] = f2bf(p.w_out[((long)l * MIX_W + k) * D + n]);
  }
  for (long idx = gt; idx < (long)DEPTH * S5_W * S5_W; idx += gs) {
    int k = idx % S5_W; int n = (idx / S5_W) % S5_W; int l = idx / (S5_W * S5_W);
    p.wglut[idx] = f2bf(p.s5_w_glu[((long)l * S5_W + k) * S5_W + n]);
  }
  for (long idx = gt; idx < (long)SEQ * 2 * SEQ; idx += gs) {
    int n2 = idx % (2 * SEQ), k = idx / (2 * SEQ); int n = n2 % SEQ;
    double a = 6.283185307179586476925 * (double)(((long)k * n) % SEQ) / SEQ;
    double v = (n2 < SEQ ? cos(a) : -sin(a)) / sqrt((double)SEQ);
    p.dftc[idx] = f2bf((float)v);
  }
  for (long idx = gt; idx < (long)DSEQ * 2 * DSEQ; idx += gs) {
    int n2 = idx % (2 * DSEQ), k = idx / (2 * DSEQ); int n = n2 % DSEQ;
    double a = 6.283185307179586476925 * (double)(((long)k * n) % DSEQ) / DSEQ;
    double v = (n2 < DSEQ ? cos(a) : -sin(a)) / sqrt((double)DSEQ);
    p.dftl[idx] = f2bf((float)v);
  }
  for (long idx = gt; idx < 64 * 16; idx += gs) {
    int fi = idx % 16, pos = idx / 16;
    float freq = powf(10000.f, -(float)fi / 16.f);
    float ang = (float)pos * freq;
    p.rope[idx * 2] = cosf(ang); p.rope[idx * 2 + 1] = sinf(ang);
  }
}
DEVFN void ph_init_fast2(const Params& p) {
  PHASE_BEGIN;
  const long gt = GTID, gs = GSIZE;
  for (long idx = gt; idx < (long)DEPTH * NP * D; idx += gs) {
    int k = idx % D; int n = (idx / D) % NP; int l = idx / ((long)D * NP);
    p.win2t[idx] = f2bf(p.win2[((long)l * D + k) * NP + n]);
  }
}

constexpr int CONV_EARLY = 14;
DEVFN void conv_range(const Params& p, int l, int first, int count, char* smem, int tid);
DEVFN void ph_gemm_in_fast(const Params& p, int l, char* smem) {
  PHASE_BEGIN;
  constexpr int NT_N = NP / 128, NT_M = T / 128;
  float* ropes = (float*)(smem + 2 * GL_STAGEB);
  for (int i = tidx_; i < 64 * 16 * 2 / 4; i += 256) ((f32x4*)ropes)[i] = ((const f32x4*)p.rope)[i];
  __syncthreads();
  for (int v = bidx_; v < NT_M * NT_N; v += gridDim.x) {
    const int tile = xcd_order(v, gridDim.x, 8 * NT_N);
    const int tm = tile / NT_N, tn = tile % NT_N;
    const int koff = gridDim.x == 512 ? (tm + tn) & 15 : 0;
    const int m0 = tm * 128, n0 = tn * 128;
    GRows A = make_grows(tidx_, p.h, m0, D);
    GRows B = make_grows(tidx_, p.win2t + (long)l * NP * D, n0, D);
    const TokInfo t0i = tokinfo(m0);
    const int lane = tidx_ & 63;
    const bool odd = lane & 1;
    gemm_tile_g(smem, tidx_, A, B, D / 64, [&](int nt, int row, int col, float v0, float v1, float v2, float v3) {
      const int j = n0 + col;
      const long t = m0 + row;
      const int n = t0i.n + row;
      float v[4] = {v0, v1, v2, v3};
      if (n0 >= PC_P && n0 < PC_U) {
        int jj = j - PC_P; int isq = jj >= 256; int jc = jj & 255;
        bf16_t* dst = p.pqt + pqt_base(t0i.lat, t0i.b) + (long)jc * 2 * t0i.N + (isq ? t0i.N : 0) + n;
        uint2 pk; pk.x = cvtpk(v[0], v[1]); pk.y = cvtpk(v[2], v[3]);
        *(uint2*)dst = pk;
        return;
      }
      float pr[4];
#pragma unroll
      for (int i = 0; i < 4; ++i) pr[i] = shx1(v[i]);
      if (t0i.lat && n0 < PC_V) {
        int pi = (j & 63) >> 1; int fi = pi & 15;
#pragma unroll
        for (int i = 0; i < 4; ++i) {
          int pos = (pi < 16) ? ((n + i) >> 6) : ((n + i) & 63);
          const f32x2_t csn = *(const f32x2_t*)(ropes + (pos * 16 + fi) * 2); const float cs = csn[0], sn = csn[1];
          float x1 = odd ? pr[i] : v[i], x2 = odd ? v[i] : pr[i];
          float r0 = x1 * cs - x2 * sn, r1 = x1 * sn + x2 * cs;
          v[i] = odd ? r1 : r0; pr[i] = odd ? r0 : r1;
        }
      }
      const int pj = (n0 < PC_P) ? j : PJ_U + (j - PC_U);
      {
        bf16_t* q = p.proj + (t + (odd ? 1 : 0)) * NPJ + (pj & ~1);
        *(unsigned*)q = odd ? cvtpk(pr[1], v[1]) : cvtpk(v[0], pr[0]);
        *(unsigned*)(q + 2 * NPJ) = odd ? cvtpk(pr[3], v[3]) : cvtpk(v[2], pr[2]);
      }
      if (!t0i.lat && n0 >= PC_K && n0 < PC_P) {
        float* ob = p.out + (n0 < PC_V ? O_K + (j - PC_K) : O_V + (j - PC_V));
#pragma unroll
        for (int i = 0; i < 4; ++i) ob[(((long)t0i.b * DEPTH + l) * SEQ + n + i) * KV_W] = v[i];
      }
    }, koff);
  }
}
DEVFN void ph_gemm_out_fast(const Params& p, int l, char* smem) {
  PHASE_BEGIN;
  constexpr int NT_N = D / 128, NT_M = T / 128;
  for (int v = bidx_; v < NT_M * NT_N; v += gridDim.x) {
    int tm, tn, koff = 0;
    if (gridDim.x == 512) { int pidx; PatchTile pt = patch8(v, 512, pidx); tm = pidx * 8 + pt.tm; tn = pt.tn; koff = pt.koff; }
    else { tm = v / NT_N; tn = v % NT_N; }
    const int m0 = tm * 128, n0 = tn * 128;
    GRows A = make_grows(tidx_, p.mixcat, m0, MIX_W);
    GRows B = make_grows(tidx_, p.woutt + (long)l * D * MIX_W, n0, MIX_W);
    const TokInfo t0i = tokinfo(m0);
    const float* gate1 = modp(p, l, t0i.ci, 2);
    const int lane_ = tidx_ & 63, cb = n0 + ((tidx_ >> 6) & 1) * 64 + (lane_ & 31);
    const float g0 = gate1[cb], g1 = gate1[cb + 32];
    gemm_tile_g(smem, tidx_, A, B, MIX_W / 64, [&](int nt, int row, int col, float v0, float v1, float v2, float v3) {
      const float g = nt ? g1 : g0;
      store4_bf16((bf16_t*)p.ybuf + (long)(m0 + row) * D + n0 + col, D, lane_ & 1, g * v0, g * v1, g * v2, g * v3);
    }, koff);
  }
}
DEVFN void ph_glu_fast(const Params& p, int l, char* smem) {
  PHASE_BEGIN;
  constexpr int NT_N = S5_W / 128, NT_M = T / 128;
  for (int tile = bidx_; tile < NT_M * NT_N; tile += gridDim.x) {
    const int tm = tile / NT_N, tn = tile % NT_N;
    const int m0 = tm * 128, n0 = tn * 128;
    RowLoader A = make_rows(tidx_, p.gbuf, m0, S5_W);
    RowLoader B = make_rows(tidx_, p.wglut + (long)l * S5_W * S5_W, n0, S5_W);
    const bool odd = tidx_ & 1;
    gemm_tile(smem, tidx_, A, B, S5_W / 64, [&](int nt, int row, int col, float v0, float v1, float v2, float v3) {
      const int j = n0 + col;
      float v[4] = {v0, v1, v2, v3};
#pragma unroll
      for (int i = 0; i < 4; ++i) {
        long t = m0 + row + i;
        float g = bf2f(p.gbuf[t * S5_W + j]);
        float r = g * sigmoid_f(v[i]);
        float pr = shx1(r);
        if (!odd) *(unsigned*)(p.mixcat + t * MIX_W + ATTN_W + FOUR_W + j) = cvtpk(r, pr);
      }
    });
  }
}
DEVFN void fourier_tile(const Params& p, int item, char* smem, int tidx_) {
  constexpr int NL = DB * (DSEQ / 128) * 2 * 2;
  int lat, b, tm, tn, N, hk, KT;
  if (item < NL) { lat = 1; N = DSEQ; hk = item & 1; tn = (item >> 1) & 1; tm = (item >> 2) % (DSEQ / 128); b = item / (4 * (DSEQ / 128)); KT = DSEQ / 64; }
  else { int it = item - NL; lat = 0; N = SEQ; hk = 0; tn = it & 1; tm = (it >> 1) % (SEQ / 128); b = it / (2 * (SEQ / 128)); KT = 2 * SEQ / 64; }
  const int t0 = lat ? TC + b * DSEQ : b * SEQ;
  GRows A = make_grows(tidx_, (lat ? p.dftl : p.dftc) + hk * DSEQ, tm * 128, 2 * N);
  GRows B = make_grows(tidx_, p.pqt + pqt_base(lat, b) + hk * DSEQ, tn * 128, 2 * N);
  const bool odd = tidx_ & 1;
  float* dst = p.win2 + ((long)hk * DB * DSEQ + b * DSEQ + tm * 128) * FOUR_W + tn * 128;
  gemm_tile_g(smem, tidx_, A, B, KT, [&](int nt, int row, int col, float v0, float v1, float v2, float v3) {
    if (lat) {
      float* d = dst + (long)row * FOUR_W + col;
      d[0] = v0; d[FOUR_W] = v1; d[2 * FOUR_W] = v2; d[3 * FOUR_W] = v3;
    } else {
      store4_bf16(p.mixcat + (long)(t0 + tm * 128 + row) * MIX_W + ATTN_W + tn * 128 + col, MIX_W, odd, v0, v1, v2, v3);
    }
  });
}
constexpr int N_FOURIER_ITEMS = DB * (DSEQ / 128) * 2 + BATCH * (SEQ / 128) * 2;
DEVFN void ph_fourier_fast(const Params& p, int l, char* smem) {
  PHASE_BEGIN;
  for (int item = bidx_; item < N_FOURIER_ITEMS; item += gridDim.x) fourier_tile(p, item, smem, tidx_);
}
DEVFN void ph_moe1_fast(const Params& p, int l, char* smem) {
  PHASE_BEGIN;
  constexpr int NT_M = NS / 128, NT_N = FF / 64;
  const int tid = tidx_, lane = tid & 63;
  auto decode = [&](int v, int& tm, int& tn, int& e, int& koff) {
    koff = 0;
    if (gridDim.x == 512) { int pidx; PatchTile pt = patch8(v, 512, pidx); e = pidx >> 1; tm = pt.tm; tn = (pidx & 1) * 8 + pt.tn; koff = pt.koff; }
    else { tm = v % NT_M; tn = (v / NT_M) % NT_N; e = v / (NT_M * NT_N); }
  };
  int sn0 = 0, sn1 = 0, sn2 = 0, sn3 = 0;
  if (bidx_ < NE * NT_M * NT_N) {
    int tm, tn, e, koff; decode(bidx_, tm, tn, e, koff);
    const int* stp = p.seltok + e * NS + tm * 128 + (tid >> 3);
    sn0 = stp[0]; sn1 = stp[32]; sn2 = stp[64]; sn3 = stp[96];
  }
  for (int v = bidx_; v < NE * NT_M * NT_N; v += gridDim.x) {
    int tm, tn, e, koff;
    decode(v, tm, tn, e, koff);
    const int s0 = tm * 128, f0 = tn * 64;
    GRows A;
    {
      const bf16_t* hb = p.h2 + g_chunk(tid);
      A.r0 = hb + (long)sn0 * D; A.r1 = hb + (long)sn1 * D; A.r2 = hb + (long)sn2 * D; A.r3 = hb + (long)sn3 * D;
    }
    if (v + (int)gridDim.x < NE * NT_M * NT_N) {
      int tm2, tn2, e2, koff2; decode(v + gridDim.x, tm2, tn2, e2, koff2);
      const int* stp = p.seltok + e2 * NS + tm2 * 128 + (tid >> 3);
      sn0 = stp[0]; sn1 = stp[32]; sn2 = stp[64]; sn3 = stp[96];
    }
    GRows B;
    {
      const long o = (((long)(l & 1) * NE + e) * FF + f0 + (tid >> 3)) * D + g_chunk(tid);
      B.r0 = p.wgt + o; B.r1 = p.wut + o; B.r2 = p.wgt + o + 32L * D; B.r3 = p.wut + o + 32L * D;
    }
    const bool odd = lane & 1;
    float gsave[4];
    gemm_tile_g(smem, tidx_, A, B, D / 64, [&](int nt, int row, int col, float v0, float v1, float v2, float v3) {
      if (nt == 0) { gsave[0] = v0; gsave[1] = v1; gsave[2] = v2; gsave[3] = v3; return; }
      float v[4] = {v0, v1, v2, v3};
      const int ff = f0 + 32 * (col >> 6) + (col & 31);
      store4_bf16(p.hid + ((long)e * NS + s0 + row) * FF + ff, FF, odd, silu_fast(gsave[0]) * v[0], silu_fast(gsave[1]) * v[1],
                  silu_fast(gsave[2]) * v[2], silu_fast(gsave[3]) * v[3]);
    }, koff);
  }
}
DEVFN void ph_moe2_fast(const Params& p, int l, char* smem) {
  PHASE_BEGIN;
  constexpr int NT_M = NS / 128, NT_N = D / 128;
  const int lane = tidx_ & 63;
  for (int v = bidx_; v < NE * NT_M * NT_N; v += gridDim.x) {
    int tm, tn, e, koff = 0;
    if (gridDim.x == 512) { int pidx; PatchTile pt = patch8(v, 512, pidx); e = pidx; tm = pt.tm; tn = pt.tn; koff = pt.koff; }
    else { tm = v % NT_M; tn = (v / NT_M) % NT_N; e = v / (NT_M * NT_N); }
    const int s0 = tm * 128, n0 = tn * 128;
    GRows A = make_grows(tidx_, p.hid + (long)e * NS * FF, s0, FF);
    GRows B = make_grows(tidx_, p.wdt + ((long)(l & 1) * NE + e) * D * FF, n0, FF);
    const bool odd = lane & 1;
    gemm_tile_g(smem, tidx_, A, B, FF / 64, [&](int nt, int row, int col, float v0, float v1, float v2, float v3) {
      store4_bf16(p.ys + ((long)e * NS + s0 + row) * D + n0 + col, D, odd, v0, v1, v2, v3);
    }, koff);
  }
}
template <int CTRL> DEVFN float dppf(float v) {
  return __builtin_bit_cast(float, __builtin_amdgcn_mov_dpp(__builtin_bit_cast(int, v), CTRL, 0xF, 0xF, true));
}
DEVFN float rdlane(float v, int l) { return __builtin_bit_cast(float, __builtin_amdgcn_readlane(__builtin_bit_cast(int, v), l)); }
DEVFN float wave_sum(float v) {
  v += dppf<0xB1>(v);
  v += dppf<0x4E>(v);
  v += dppf<0x141>(v);
  v += dppf<0x140>(v);
  return (rdlane(v, 0) + rdlane(v, 16)) + (rdlane(v, 32) + rdlane(v, 48));
}
DEVFN float bflo(unsigned u) { return u_as_f(u << 16); }
DEVFN float bfhi(unsigned u) { return u_as_f(u & 0xffff0000u); }

struct RowX { f32x4 a0, a1, a2, a3; };
struct RowG { uint2 u00, u01, u02, u03, u10, u11, u12, u13, u20, u21, u22, u23, u30, u31, u32, u33; float g0, g1, g2, g3; unsigned rest; };
DEVFN void ph_row1_fast(const Params& p, int l, char* smem) {
  PHASE_BEGIN;
  const int lane = tidx_ & 63, d0 = 4 * lane;
  float* prm = (float*)smem;
  for (int t4 = (bidx_ * 4 + (tidx_ >> 6)) * 4; t4 < T; t4 += gridDim.x * 16) {
    TokInfo ti = tokinfo(t4);
    const float *pxs = p.x_sample, *pxp = p.x_prompt, *px = p.x, *pg0 = p.ln_in_g, *pb0 = p.ln_in_b, *pg2 = p.ln2_g, *pb2 = p.ln2_b;
    asm volatile("" : "+s"(pxs), "+s"(pxp), "+s"(px), "+s"(pg0), "+s"(pb0), "+s"(pg2), "+s"(pb2));
    const float* src4 = l == 0 ? (ti.lat ? pxs + (long)(t4 - TC) * D : pxp + (long)t4 * D) : px + (long)t4 * D;
    const float* g = l == 0 ? pg0 : pg2 + (long)(l - 1) * D;
    const float* b = l == 0 ? pb0 : pb2 + (long)(l - 1) * D;
    const float* gate2 = modp(p, l > 0 ? l - 1 : 0, ti.ci, 5);
    const int lm = l < DEPTH ? l : DEPTH - 1;
    const float* sh = modp(p, lm, ti.ci, 0); const float* sc = modp(p, lm, ti.ci, 1);
    int iv0 = -1, iv1 = -1, iv2 = -1, iv3 = -1;
    if (l > 0 && lane < NE) {
      const int* ip = p.inv + (long)t4 * NE + lane;
      iv0 = ip[0]; iv1 = ip[NE]; iv2 = ip[2 * NE]; iv3 = ip[3 * NE];
    }
    __syncthreads();
    {
      const f32x4 a0 = *(const f32x4*)(g + 4 * tidx_), a1 = *(const f32x4*)(b + 4 * tidx_), a2 = *(const f32x4*)(gate2 + 4 * tidx_);
      const f32x4 a3 = *(const f32x4*)(sh + 4 * tidx_), a4 = *(const f32x4*)(sc + 4 * tidx_);
      *(f32x4*)(prm + 4 * tidx_) = a0; *(f32x4*)(prm + D + 4 * tidx_) = a1; *(f32x4*)(prm + 2 * D + 4 * tidx_) = a2;
      *(f32x4*)(prm + 3 * D + 4 * tidx_) = a3; *(f32x4*)(prm + 4 * D + 4 * tidx_) = a4;
    }
    __syncthreads();
    auto xload = [&](int k) -> RowX {
      const float* s_ = src4 + (long)k * D + d0;
      RowX r; r.a0 = *(const f32x4*)s_; r.a1 = *(const f32x4*)(s_ + 256); r.a2 = *(const f32x4*)(s_ + 512); r.a3 = *(const f32x4*)(s_ + 768);
      return r;
    };
    auto gather = [&](int myinv) -> RowG {
      RowG r;
      const uint2 z = make_uint2(0u, 0u);
      r.u00 = r.u01 = r.u02 = r.u03 = r.u10 = r.u11 = r.u12 = r.u13 = r.u20 = r.u21 = r.u22 = r.u23 = r.u30 = r.u31 = r.u32 = r.u33 = z;
      r.g0 = r.g1 = r.g2 = r.g3 = 0.f;
      unsigned mask = (unsigned)__ballot(myinv >= 0) & 0xffffu;
      if (mask) {
        const int e = __builtin_ctz(mask); mask &= mask - 1; const int s_ = __builtin_amdgcn_readlane(myinv, e);
        const bf16_t* yr = p.ys + ((long)e * NS + s_) * D + d0; r.g0 = p.selgate[e * NS + s_];
        r.u00 = *(const uint2*)yr; r.u01 = *(const uint2*)(yr + 256); r.u02 = *(const uint2*)(yr + 512); r.u03 = *(const uint2*)(yr + 768);
      }
      if (mask) {
        const int e = __builtin_ctz(mask); mask &= mask - 1; const int s_ = __builtin_amdgcn_readlane(myinv, e);
        const bf16_t* yr = p.ys + ((long)e * NS + s_) * D + d0; r.g1 = p.selgate[e * NS + s_];
        r.u10 = *(const uint2*)yr; r.u11 = *(const uint2*)(yr + 256); r.u12 = *(const uint2*)(yr + 512); r.u13 = *(const uint2*)(yr + 768);
      }
      if (mask) {
        const int e = __builtin_ctz(mask); mask &= mask - 1; const int s_ = __builtin_amdgcn_readlane(myinv, e);
        const bf16_t* yr = p.ys + ((long)e * NS + s_) * D + d0; r.g2 = p.selgate[e * NS + s_];
        r.u20 = *(const uint2*)yr; r.u21 = *(const uint2*)(yr + 256); r.u22 = *(const uint2*)(yr + 512); r.u23 = *(const uint2*)(yr + 768);
      }
      if (mask) {
        const int e = __builtin_ctz(mask); mask &= mask - 1; const int s_ = __builtin_amdgcn_readlane(myinv, e);
        const bf16_t* yr = p.ys + ((long)e * NS + s_) * D + d0; r.g3 = p.selgate[e * NS + s_];
        r.u30 = *(const uint2*)yr; r.u31 = *(const uint2*)(yr + 256); r.u32 = *(const uint2*)(yr + 512); r.u33 = *(const uint2*)(yr + 768);
      }
      r.rest = mask;
      return r;
    };
    RowX xc = xload(0);
    RowG gc; gc.rest = 0u;
    if (l > 0) gc = gather(iv0);
#pragma unroll 1
    for (int k = 0; k < 4; ++k) {
      const int t = t4 + k;
      const int ivc = k == 0 ? iv0 : k == 1 ? iv1 : k == 2 ? iv2 : iv3;
      const int ivn = k == 0 ? iv1 : k == 1 ? iv2 : iv3;
      RowX xn = xc; RowG gn = gc;
      if (k < 3) { xn = xload(k + 1); if (l > 0) gn = gather(ivn); }
      const f32x4 xa[4] = {xc.a0, xc.a1, xc.a2, xc.a3};
      float v[16];
      if (l == 0) {
#pragma unroll
        for (int i = 0; i < 4; ++i) { v[4 * i] = xa[i][0]; v[4 * i + 1] = xa[i][1]; v[4 * i + 2] = xa[i][2]; v[4 * i + 3] = xa[i][3]; }
      } else {
        float m[16];
        {
          const uint2 u0[4] = {gc.u00, gc.u01, gc.u02, gc.u03}, u1[4] = {gc.u10, gc.u11, gc.u12, gc.u13};
          const uint2 u2[4] = {gc.u20, gc.u21, gc.u22, gc.u23}, u3[4] = {gc.u30, gc.u31, gc.u32, gc.u33};
#pragma unroll
          for (int i = 0; i < 4; ++i) {
            m[4 * i] = gc.g0 * bflo(u0[i].x) + gc.g1 * bflo(u1[i].x) + gc.g2 * bflo(u2[i].x) + gc.g3 * bflo(u3[i].x);
            m[4 * i + 1] = gc.g0 * bfhi(u0[i].x) + gc.g1 * bfhi(u1[i].x) + gc.g2 * bfhi(u2[i].x) + gc.g3 * bfhi(u3[i].x);
            m[4 * i + 2] = gc.g0 * bflo(u0[i].y) + gc.g1 * bflo(u1[i].y) + gc.g2 * bflo(u2[i].y) + gc.g3 * bflo(u3[i].y);
            m[4 * i + 3] = gc.g0 * bfhi(u0[i].y) + gc.g1 * bfhi(u1[i].y) + gc.g2 * bfhi(u2[i].y) + gc.g3 * bfhi(u3[i].y);
          }
        }
        unsigned mask = gc.rest;
        while (mask) {
          const int e = __builtin_ctz(mask); mask &= mask - 1;
          const int s_ = __builtin_amdgcn_readlane(ivc, e);
          const bf16_t* yr = p.ys + ((long)e * NS + s_) * D + d0;
          const float gk = p.selgate[e * NS + s_];
#pragma unroll
          for (int i = 0; i < 4; ++i) {
            const uint2 u = *(const uint2*)(yr + 256 * i);
            m[4 * i] += gk * bflo(u.x); m[4 * i + 1] += gk * bfhi(u.x); m[4 * i + 2] += gk * bflo(u.y); m[4 * i + 3] += gk * bfhi(u.y);
          }
        }
#pragma unroll
        for (int i = 0; i < 4; ++i) {
          const f32x4 g2 = *(const f32x4*)(prm + 2 * D + 256 * i + d0);
#pragma unroll
          for (int c = 0; c < 4; ++c) v[4 * i + c] = ALPHA * xa[i][c] + g2[c] * m[4 * i + c];
        }
      }
      float s = 0.f;
#pragma unroll
      for (int i = 0; i < 16; ++i) s += v[i];
      const float mu = wave_sum(s) * (1.f / D);
      float q = 0.f;
#pragma unroll
      for (int i = 0; i < 16; ++i) { float dv = v[i] - mu; q += dv * dv; }
      const float rs = 1.f / sqrtf(wave_sum(q) * (1.f / D) + LN_EPS);
      if (l < DEPTH) {
#pragma unroll
        for (int i = 0; i < 4; ++i) {
          f32x4 xo; float hv[4];
          const f32x4 lg = *(const f32x4*)(prm + 256 * i + d0), lb = *(const f32x4*)(prm + D + 256 * i + d0);
          const f32x4 ls = *(const f32x4*)(prm + 3 * D + 256 * i + d0), lc = *(const f32x4*)(prm + 4 * D + 256 * i + d0);
#pragma unroll
          for (int c = 0; c < 4; ++c) { xo[c] = (v[4 * i + c] - mu) * rs * lg[c] + lb[c]; hv[c] = xo[c] * (1.f + lc[c]) + ls[c]; }
          *(f32x4*)(p.x + (long)t * D + 256 * i + d0) = xo;
          uint2 pk; pk.x = cvtpk(hv[0], hv[1]); pk.y = cvtpk(hv[2], hv[3]);
          *(uint2*)(p.h + (long)t * D + 256 * i + d0) = pk;
        }
      } else {
        float* o = p.out + (ti.lat ? O_YS + (long)(t - TC) * D : O_YP + (long)t * D);
#pragma unroll
        for (int i = 0; i < 4; ++i) {
          f32x4 xo;
          const f32x4 lg = *(const f32x4*)(prm + 256 * i + d0), lb = *(const f32x4*)(prm + D + 256 * i + d0);
#pragma unroll
          for (int c = 0; c < 4; ++c) xo[c] = (v[4 * i + c] - mu) * rs * lg[c] + lb[c];
          *(f32x4*)(o + 256 * i + d0) = xo;
        }
      }
      xc = xn; gc = gn;
    }
  }
}

DEVFN void ph_row2_fast(const Params& p, int l, char* smem) {
  PHASE_BEGIN;
  const int lane = tidx_ & 63;
  float* wrt = (float*)smem;
#pragma unroll
  for (int q = tidx_; q < D * NE / 4; q += 256) {
    f32x4 v = *(const f32x4*)(p.w_router + (long)l * D * NE + q * 4);
    const int d = q >> 2, e4 = (q & 3) * 4;
    wrt[(e4 + 0) * D + d] = v[0]; wrt[(e4 + 1) * D + d] = v[1]; wrt[(e4 + 2) * D + d] = v[2]; wrt[(e4 + 3) * D + d] = v[3];
  }
  __syncthreads();
  for (int t4 = (bidx_ * 4 + (tidx_ >> 6)) * 4; t4 < T; t4 += gridDim.x * 16) {
    TokInfo ti = tokinfo(t4);
    const float* g = p.ln1_g + (long)l * D; const float* b = p.ln1_b + (long)l * D;
    const float* sh = modp(p, l, ti.ci, 3); const float* sc = modp(p, l, ti.ci, 4);
    uint2 ya[4]; f32x4 xa[4], lg[4], lb[4], ls[4], lc[4];
#pragma unroll
    for (int i = 0; i < 4; ++i) {
      const int dd = 256 * i + 4 * lane;
      ya[i] = *(const uint2*)((const bf16_t*)p.ybuf + (long)t4 * D + dd); xa[i] = *(const f32x4*)(p.x + (long)t4 * D + dd);
      lg[i] = *(const f32x4*)(g + dd); lb[i] = *(const f32x4*)(b + dd); ls[i] = *(const f32x4*)(sh + dd); lc[i] = *(const f32x4*)(sc + dd);
    }
#pragma unroll 1
   for (int k = 0; k < 4; ++k) {
    const int t = t4 + k;
    uint2 yn[4]; f32x4 xn[4];
#pragma unroll
    for (int i = 0; i < 4; ++i) { yn[i] = ya[i]; xn[i] = xa[i]; }
    if (k < 3) {
#pragma unroll
      for (int i = 0; i < 4; ++i) {
        const int dd = 256 * i + 4 * lane;
        yn[i] = *(const uint2*)((const bf16_t*)p.ybuf + (long)(t + 1) * D + dd); xn[i] = *(const f32x4*)(p.x + (long)(t + 1) * D + dd);
      }
    }
    float v[16];
#pragma unroll
    for (int i = 0; i < 4; ++i) {
      v[4 * i] = ALPHA * xa[i][0] + bflo(ya[i].x); v[4 * i + 1] = ALPHA * xa[i][1] + bfhi(ya[i].x);
      v[4 * i + 2] = ALPHA * xa[i][2] + bflo(ya[i].y); v[4 * i + 3] = ALPHA * xa[i][3] + bfhi(ya[i].y);
    }
    float s = 0.f;
#pragma unroll
    for (int i = 0; i < 16; ++i) s += v[i];
    const float mu = wave_sum(s) * (1.f / D);
    float q = 0.f;
#pragma unroll
    for (int i = 0; i < 16; ++i) { float dv = v[i] - mu; q += dv * dv; }
    const float rs = 1.f / sqrtf(wave_sum(q) * (1.f / D) + LN_EPS);
    float lgt[NE];
#pragma unroll
    for (int e = 0; e < NE; ++e) lgt[e] = 0.f;
#pragma unroll
    for (int i = 0; i < 4; ++i) {
      const int d0 = 256 * i + 4 * lane;
      f32x4 xo; float hv[4];
#pragma unroll
      for (int c = 0; c < 4; ++c) { xo[c] = (v[4 * i + c] - mu) * rs * lg[i][c] + lb[i][c]; hv[c] = xo[c] * (1.f + lc[i][c]) + ls[i][c]; }
      *(f32x4*)(p.x + (long)t * D + d0) = xo;
      uint2 pk; pk.x = cvtpk(hv[0], hv[1]); pk.y = cvtpk(hv[2], hv[3]);
      *(uint2*)(p.h2 + (long)t * D + d0) = pk;
#pragma unroll
      for (int e = 0; e < NE; ++e) {
        f32x4 w = *(const f32x4*)(wrt + e * D + d0);
        lgt[e] += hv[0] * w[0] + hv[1] * w[1] + hv[2] * w[2] + hv[3] * w[3];
      }
      asm volatile("" ::: "memory");
    }
#pragma unroll
    for (int e = 0; e < NE; ++e) lgt[e] = wave_sum(lgt[e]);
    float mx = lgt[0];
#pragma unroll
    for (int e = 1; e < NE; ++e) mx = fmaxf(mx, lgt[e]);
    float se = 0.f;
#pragma unroll
    for (int e = 0; e < NE; ++e) { lgt[e] = expf(lgt[e] - mx); se += lgt[e]; }
    const float is = 1.f / se;
    float mine = 0.f;
#pragma unroll
    for (int e = 0; e < NE; ++e) mine = (lane == e) ? lgt[e] * is : mine;
    if (lane < NE) { p.aff[(long)t * NE + lane] = mine; p.afft[(long)lane * T + t] = mine; }
#pragma unroll
    for (int i = 0; i < 4; ++i) { ya[i] = yn[i]; xa[i] = xn[i]; }
   }
  }
  __syncthreads();
}

DEVFN void ph_topk_fast(const Params& p, int l, char* smem) {
  PHASE_BEGIN;
  float* vals = (float*)smem;
  constexpr int NITEM = BATCH * NE * (SEQ / 256) + DB * NE * (DSEQ / 256);
  for (int item = bidx_; item < NITEM; item += gridDim.x) {
    int lat, b, e, chunk, N;
    if (item < BATCH * NE * (SEQ / 256)) { lat = 0; N = SEQ; e = item % NE; chunk = (item / NE) % (SEQ / 256); b = item / (NE * (SEQ / 256)); }
    else { int it = item - BATCH * NE * (SEQ / 256); lat = 1; N = DSEQ; e = it % NE; chunk = (it / NE) % (DSEQ / 256); b = it / (NE * (DSEQ / 256)); }
    const int t0 = lat ? TC + b * DSEQ : b * SEQ;
    {
      const float* src = p.afft + (long)e * T + t0 + tidx_;
      if (lat) {
        const float a0 = src[0], a1 = src[256], a2 = src[512], a3 = src[768];
        vals[tidx_] = a0; vals[tidx_ + 256] = a1; vals[tidx_ + 512] = a2; vals[tidx_ + 768] = a3;
      } else {
        vals[tidx_] = src[0];
      }
    }
    __syncthreads();
    const int n = chunk * 256 + tidx_;
    const float a = vals[n];
    const int w16 = __builtin_amdgcn_readfirstlane((chunk * 256 + (tidx_ & 192)) >> 4);
    int rank = 0;
    for (int j16 = 0; j16 < w16; ++j16) {
      f32x4 vv[4];
#pragma unroll
      for (int q = 0; q < 4; ++q) vv[q] = ((const f32x4*)vals)[4 * j16 + q];
#pragma unroll
      for (int q = 0; q < 4; ++q)
#pragma unroll
        for (int c = 0; c < 4; ++c) rank += (int)(vv[q][c] >= a);
    }
#pragma unroll
    for (int j16 = 0; j16 < 4; ++j16) {
      f32x4 vv[4];
#pragma unroll
      for (int q = 0; q < 4; ++q) vv[q] = ((const f32x4*)vals)[4 * (w16 + j16) + q];
#pragma unroll
      for (int q = 0; q < 4; ++q)
#pragma unroll
        for (int c = 0; c < 4; ++c) {
          const int jl = 16 * j16 + 4 * q + c;
          rank += (int)(vv[q][c] > a) | ((int)(vv[q][c] == a) & (int)(jl < (tidx_ & 63)));
        }
    }
    for (int j16 = w16 + 4; j16 < N / 16; ++j16) {
      f32x4 vv[4];
#pragma unroll
      for (int q = 0; q < 4; ++q) vv[q] = ((const f32x4*)vals)[4 * j16 + q];
#pragma unroll
      for (int q = 0; q < 4; ++q)
#pragma unroll
        for (int c = 0; c < 4; ++c) rank += (int)(vv[q][c] > a);
    }
    const int cap = lat ? CAPL : CAPC;
    int slot = -1;
    if (rank < cap) {
      slot = lat ? BATCH * CAPC + b * CAPL + rank : b * CAPC + rank;
      p.seltok[e * NS + slot] = t0 + n;
      p.selgate[e * NS + slot] = a;
    }
    p.inv[(long)(t0 + n) * NE + e] = slot;
    __syncthreads();
  }
}

constexpr int ADA_KC = 16, ADA_ROWS = D / ADA_KC;
DEVFN void ph_adaln_part(const Params& p, char* smem) {
  PHASE_BEGIN;
  float* sil = (float*)smem;
  constexpr int NJG = 6 * D / 4 / 256;
  constexpr int NITEM = DEPTH * NJG * ADA_KC;
  if (bidx_ < NITEM) {
#pragma unroll
    for (int i = tidx_; i < NCOND * D; i += 256) {
      int c = i / D, d = i % D;
      sil[i] = silu_f(c == 0 ? p.c_ctx[d] : p.c[(c - 1) * D + d]);
    }
    __syncthreads();
  }
  for (int item = bidx_; item < NITEM; item += gridDim.x) {
    const int kc = item % ADA_KC, jb = (item / ADA_KC) % NJG, l = item / (ADA_KC * NJG);
    const int j0 = (jb * 256 + tidx_) * 4;
    const float* w = p.w_ada + ((long)l * D + kc * ADA_ROWS) * 6 * D + j0;
    f32x4 acc[NCOND];
#pragma unroll
    for (int c = 0; c < NCOND; ++c) acc[c] = (f32x4){0.f, 0.f, 0.f, 0.f};
#pragma unroll 16
    for (int r = 0; r < ADA_ROWS; ++r) {
      f32x4 wv = *(const f32x4*)(w + (long)r * 6 * D);
#pragma unroll
      for (int c = 0; c < NCOND; ++c) { float sv = sil[c * D + kc * ADA_ROWS + r]; acc[c] += sv * wv; }
    }
#pragma unroll
    for (int c = 0; c < NCOND; ++c) *(f32x4*)(p.modpart + (((long)kc * DEPTH + l) * NCOND + c) * 6 * D + j0) = acc[c];
  }
  __syncthreads();
}
DEVFN void ph_adaln_reduce(const Params& p) {
  PHASE_BEGIN;
  for (long idx = GTID; idx < (long)DEPTH * NCOND * 6 * D; idx += GSIZE) {
    int j = idx % (6 * D); int l = idx / ((long)NCOND * 6 * D);
    float s = p.b_ada[(long)l * 6 * D + j];
#pragma unroll
    for (int kc = 0; kc < ADA_KC; ++kc) s += p.modpart[(long)kc * DEPTH * NCOND * 6 * D + idx];
    p.mod[idx] = s;
  }
}
DEVFN void transpose_tile(const float* src, long ld_src, bf16_t* dst, long ld_dst, int k0, int n0, float* tl, int tid) {
#pragma unroll
  for (int i = 0; i < 4; ++i) {
    const int r = (tid >> 4) + 16 * i, c4 = (tid & 15) * 4;
    f32x4 v = *(const f32x4*)(src + (long)(k0 + r) * ld_src + n0 + c4);
    tl[r * 65 + c4] = v[0]; tl[r * 65 + c4 + 1] = v[1]; tl[r * 65 + c4 + 2] = v[2]; tl[r * 65 + c4 + 3] = v[3];
  }
  __syncthreads();
#pragma unroll
  for (int i = 0; i < 2; ++i) {
    const int n = (tid >> 3) + 32 * i, kc = (tid & 7) * 8;
    uint4 w;
    w.x = cvtpk(tl[(kc + 0) * 65 + n], tl[(kc + 1) * 65 + n]); w.y = cvtpk(tl[(kc + 2) * 65 + n], tl[(kc + 3) * 65 + n]);
    w.z = cvtpk(tl[(kc + 4) * 65 + n], tl[(kc + 5) * 65 + n]); w.w = cvtpk(tl[(kc + 6) * 65 + n], tl[(kc + 7) * 65 + n]);
    *(uint4*)(dst + (long)(n0 + n) * ld_dst + k0 + kc) = w;
  }
  __syncthreads();
}
constexpr int TR_WOUT = DEPTH * (MIX_W / 64) * (D / 64);
constexpr int TR_WIN = DEPTH * (D / 64) * 16;
constexpr int TR_WGLU = DEPTH * (S5_W / 64) * (S5_W / 64);
DEVFN void ph_init_tr(const Params& p, char* smem) {
  PHASE_BEGIN;
  float* tl = (float*)smem;
  for (int item = bidx_; item < TR_WOUT + TR_WIN + TR_WGLU; item += gridDim.x) {
    if (item < TR_WOUT) {
      const int nt = item % (D / 64), kt = (item / (D / 64)) % (MIX_W / 64), l = item / ((D / 64) * (MIX_W / 64));
      transpose_tile(p.w_out + (long)l * MIX_W * D, D, p.woutt + (long)l * D * MIX_W, MIX_W, kt * 64, nt * 64, tl, tidx_);
    } else if (item < TR_WOUT + TR_WIN) {
      const int it = item - TR_WOUT;
      const int ct = it % 16, kt = (it / 16) % (D / 64), l = it / (16 * (D / 64));
      const int nsrc = ct < 12 ? ct * 64 : 1024 + (ct - 12) * 64;
      const int ndst = ct < 12 ? ct * 64 : PC_U + (ct - 12) * 64;
      transpose_tile(p.w_in + (long)l * D * IN_W + nsrc, IN_W, p.win2t + ((long)l * NP + ndst) * D, D, kt * 64, 0, tl, tidx_);
    } else {
      const int it = item - TR_WOUT - TR_WIN;
      const int nt = it % (S5_W / 64), kt = (it / (S5_W / 64)) % (S5_W / 64), l = it / ((S5_W / 64) * (S5_W / 64));
      transpose_tile(p.s5_w_glu + (long)l * S5_W * S5_W, S5_W, p.wglut + (long)l * S5_W * S5_W, S5_W, kt * 64, nt * 64, tl, tidx_);
    }
  }
}
DEVFN void ph_init_tab(const Params& p, char* smem) {
  PHASE_BEGIN;
  float* tab = (float*)smem;
  const long gt = GTID, gs = GSIZE;
  for (int j = tidx_; j < DSEQ; j += 256) {
    float s, c;
    sincosf(6.283185307179586f * (float)j / (float)DSEQ, &s, &c);
    tab[2 * j] = c; tab[2 * j + 1] = s;
  }
  __syncthreads();
  const float isl = 1.f / sqrtf((float)DSEQ), isc = 1.f / sqrtf((float)SEQ);
  for (long idx = gt; idx < (long)DSEQ * 2 * DSEQ; idx += gs) {
    const int n2 = idx % (2 * DSEQ), k = idx / (2 * DSEQ), n = n2 % DSEQ;
    const int j = (k * n) & (DSEQ - 1);
    p.dftl[idx] = f2bf((n2 < DSEQ ? tab[2 * j] : -tab[2 * j + 1]) * isl);
  }
  for (long idx = gt; idx < (long)SEQ * 2 * SEQ; idx += gs) {
    const int n2 = idx % (2 * SEQ), k = idx / (2 * SEQ), n = n2 % SEQ;
    const int j = ((k * n) & (SEQ - 1)) * (DSEQ / SEQ);
    p.dftc[idx] = f2bf((n2 < SEQ ? tab[2 * j] : -tab[2 * j + 1]) * isc);
  }
  for (long idx = gt; idx < (long)DEPTH * 256 * 256; idx += gs) {
    const int i = idx % 256, j = (idx / 256) % 256, l = idx / (256 * 256);
    const int hd = i >> 6, c = i & 63;
    const float* wf = p.w_fourier + ((long)l * 256 + hd * 64) * 256 + j;
    float w[64];
#pragma unroll
    for (int m = 0; m < 64; ++m) w[m] = wf[(long)m * 256];
    float ac = 0.f, as = 0.f;
#pragma unroll
    for (int m = 0; m < 64; ++m) {
      const f32x2_t cs = *(const f32x2_t*)(tab + 2 * (((m * c) & 63) * (DSEQ / 64)));
      ac += cs[0] * w[m]; as += cs[1] * w[m];
    }
    p.wcst[((long)l * 512 + j) * 256 + i] = f2bf(ac * 0.125f);
    p.wcst[((long)l * 512 + 256 + j) * 256 + i] = f2bf(as * 0.125f);
  }
  for (long idx = gs - 1 - gt - (long)DEPTH * 2 * SG * SP; idx >= 0 && idx < 64 * 16; idx += gs) {
    int fi = idx % 16, pos = idx / 16;
    float freq = powf(10000.f, -(float)fi / 16.f);
    float ang = (float)pos * freq;
    p.rope[idx * 2] = cosf(ang); p.rope[idx * 2 + 1] = sinf(ang);
  }
  for (long idx = gs - 1 - gt; idx < (long)DEPTH * 2 * SG * SP; idx += gs) {
    int pp = idx % SP; int g = (idx / SP) % SG; long ld = idx / (SP * SG);
    double are = p.s5_a_re[idx], aim = p.s5_a_im[idx];
    double dt = exp((double)p.s5_log_dt[ld * SG + g]);
    double er = exp(are * dt), cr = er * cos(aim * dt), ci = er * sin(aim * dt);
    p.abar[idx * 2] = (float)cr; p.abar[idx * 2 + 1] = (float)ci;
    double nr = cr - 1.0, ni = ci, den = are * are + aim * aim;
    double fr = (nr * are + ni * aim) / den, fi = (ni * are - nr * aim) / den;
    for (int h = 0; h < SH; ++h) {
      double br = p.s5_b_re[idx * SH + h], bi = p.s5_b_im[idx * SH + h];
      p.bbn[((ld * SG + g) * 128 + 2 * pp) * 16 + h] = f2bf((float)(fr * br - fi * bi));
      p.bbn[((ld * SG + g) * 128 + 2 * pp + 1) * 16 + h] = f2bf((float)(fr * bi + fi * br));
    }
  }
  for (long idx = gt; idx < (long)DEPTH * 2 * SG * SH * 128; idx += gs) {
    int k = idx % 128; long row = idx / 128;
    p.cn[idx] = f2bf((k & 1) ? -p.s5_c_im[row * SP + (k >> 1)] : p.s5_c_re[row * SP + (k >> 1)]);
  }
}
struct RowLoaderF32 {
  const float *r0, *r1, *r2, *r3;
  DEVFN uint4 one(const float* r, int kt) const {
    f32x4 a = *(const f32x4*)(r + kt * 64), b = *(const f32x4*)(r + kt * 64 + 4);
    uint4 w; w.x = cvtpk(a[0], a[1]); w.y = cvtpk(a[2], a[3]); w.z = cvtpk(b[0], b[1]); w.w = cvtpk(b[2], b[3]);
    return w;
  }
  DEVFN U4x4 operator()(int kt) const { U4x4 v; v.a = one(r0, kt); v.b = one(r1, kt); v.c = one(r2, kt); v.d = one(r3, kt); return v; }
};
DEVFN void ph_init_fold(const Params& p, char* smem) {
  PHASE_BEGIN;
  constexpr int NT_M = 512 / 128, NT_N = D / 128;
  for (int tile = bidx_; tile < DEPTH * NT_M * NT_N; tile += gridDim.x) {
    const int tn = tile % NT_N, tm = (tile / NT_N) % NT_M, l = tile / (NT_N * NT_M);
    RowLoader A = make_rows(tidx_, p.wcst + (long)l * 512 * 256, tm * 128, 256);
    RowLoaderF32 B;
    {
      const float* b0 = p.w_in + ((long)l * D + tn * 128 + (tidx_ >> 3)) * IN_W + 768 + (tidx_ & 7) * 8;
      B.r0 = b0; B.r1 = b0 + 32L * IN_W; B.r2 = b0 + 64L * IN_W; B.r3 = b0 + 96L * IN_W;
    }
    const bool odd = tidx_ & 1;
    bf16_t* dst = p.win2t + ((long)l * NP + PC_P + tm * 128) * D + tn * 128;
    gemm_tile1(smem, tidx_, A, B, 256 / 64, [&](int nt, int row, int col, float v0, float v1, float v2, float v3) {
      float v[4] = {v0, v1, v2, v3};
#pragma unroll
      for (int i = 0; i < 4; ++i) {
        float pr = shx1(v[i]);
        if (!odd) *(unsigned*)(dst + (long)(row + i) * D + col) = cvtpk(v[i], pr);
      }
    });
  }
}

constexpr int TR_EXP = NE * 3 * (D / 64) * (FF / 64);
struct ConvTile { const float* src; bf16_t* dst; };
DEVFN ConvTile conv_tile(const Params& p, int l, int item) {
  const int nt = item % 16, kt = (item / 16) % 16, m = (item / 256) % 3, e = item / 768;
  ConvTile c;
  const float* sb = (m == 0 ? p.w_gate : m == 1 ? p.w_up : p.w_down) + ((long)l * NE + e) * D * FF;
  bf16_t* db = (m == 0 ? p.wgt : m == 1 ? p.wut : p.wdt) + ((long)(l & 1) * NE + e) * FF * D;
  c.src = sb + (long)(kt * 64) * FF + nt * 64;
  c.dst = db + (long)(nt * 64) * D + kt * 64;
  return c;
}
DEVFN void conv_range(const Params& p, int l, int first, int count, char* smem, int tid) {
  static_assert(D == FF, "expert matrices assumed square");
  float* tl = (float*)smem;
  const int lr = tid >> 4, lc = (tid & 15) * 4;
  int item = first; const int end = first + count;
  f32x4 v0, v1, v2, v3;
  ConvTile c = conv_tile(p, l, item);
  {
    const float* s = c.src + (long)lr * FF + lc;
    v0 = *(const f32x4*)s; v1 = *(const f32x4*)(s + 16L * FF); v2 = *(const f32x4*)(s + 32L * FF); v3 = *(const f32x4*)(s + 48L * FF);
  }
  while (item < end) {
    float* t0 = tl + lr * 65 + lc;
    t0[0] = v0[0]; t0[1] = v0[1]; t0[2] = v0[2]; t0[3] = v0[3];
    t0[16 * 65] = v1[0]; t0[16 * 65 + 1] = v1[1]; t0[16 * 65 + 2] = v1[2]; t0[16 * 65 + 3] = v1[3];
    t0[32 * 65] = v2[0]; t0[32 * 65 + 1] = v2[1]; t0[32 * 65 + 2] = v2[2]; t0[32 * 65 + 3] = v2[3];
    t0[48 * 65] = v3[0]; t0[48 * 65 + 1] = v3[1]; t0[48 * 65 + 2] = v3[2]; t0[48 * 65 + 3] = v3[3];
    __syncthreads();
    bf16_t* dst = c.dst;
    const int nxt = item + 1;
    if (nxt < end) {
      c = conv_tile(p, l, nxt);
      const float* s = c.src + (long)lr * FF + lc;
      v0 = *(const f32x4*)s; v1 = *(const f32x4*)(s + 16L * FF); v2 = *(const f32x4*)(s + 32L * FF); v3 = *(const f32x4*)(s + 48L * FF);
    }
#pragma unroll
    for (int i = 0; i < 2; ++i) {
      const int n = (tid >> 3) + 32 * i, kc = (tid & 7) * 8;
      uint4 w;
      w.x = cvtpk(tl[(kc + 0) * 65 + n], tl[(kc + 1) * 65 + n]); w.y = cvtpk(tl[(kc + 2) * 65 + n], tl[(kc + 3) * 65 + n]);
      w.z = cvtpk(tl[(kc + 4) * 65 + n], tl[(kc + 5) * 65 + n]); w.w = cvtpk(tl[(kc + 6) * 65 + n], tl[(kc + 7) * 65 + n]);
      *(uint4*)(dst + (long)n * D + kc) = w;
    }
    __syncthreads();
    item = nxt;
  }
}

DEVFN void conv_wait(int n) {
  switch (n) {
    case 0:  asm volatile("s_waitcnt vmcnt(0) lgkmcnt(0)\n\ts_barrier" ::: "memory"); break;
    case 4:  asm volatile("s_waitcnt vmcnt(4) lgkmcnt(0)\n\ts_barrier" ::: "memory"); break;
    case 8:  asm volatile("s_waitcnt vmcnt(8) lgkmcnt(0)\n\ts_barrier" ::: "memory"); break;
    case 12: asm volatile("s_waitcnt vmcnt(12) lgkmcnt(0)\n\ts_barrier" ::: "memory"); break;
    case 16: asm volatile("s_waitcnt vmcnt(16) lgkmcnt(0)\n\ts_barrier" ::: "memory"); break;
    default: asm volatile("s_waitcnt vmcnt(20) lgkmcnt(0)\n\ts_barrier" ::: "memory"); break;
  }
}
DEVFN void conv_issue(const Params& p, int l, int item, unsigned lds_ws, int lane, int wave) {
  ConvTile c = conv_tile(p, l, item);
#pragma unroll
  for (int i = 0; i < 4; ++i) {
    const int k = 16 * wave + 4 * i + (lane >> 4);
    const int chunk = ((lane & 15) - (4 * wave + i)) & 15;
    glds16((const bf16_t*)(c.src + (long)k * FF + chunk * 4), lds_ws + i * 1024);
  }
}
template <int MODE>
DEVFN void conv_ring(const Params& p, int l, int first, int count, char* smem, int tid) {
  constexpr int LPT = MODE == 2 ? 0 : 4, SPT = MODE == 1 ? 0 : 4;
  const int lane = tid & 63, wave = tid >> 6;
  const int kq = tid & 15, nq = tid >> 4;
  const unsigned lbase = (unsigned)__builtin_amdgcn_readfirstlane((int)(lds_addr(smem) + wave * 4096));
  __syncthreads();
  if (LPT) for (int s = 0; s < 3 && s < count; ++s) conv_issue(p, l, first + s, lbase + s * 16384, lane, wave);
  for (int t = 0; t < count; ++t) {
    const int st = t < 3 ? t : 3;
    int ld = count - 1 - t; if (ld > 2) ld = 2;
    conv_wait(SPT * st + LPT * ld);
    if (LPT && t + 3 < count) conv_issue(p, l, first + t + 3, lbase + ((t + 3) & 3) * 16384, lane, wave);
    const char* sl = smem + (t & 3) * 16384 + (4 * kq) * 256 + ((nq + kq) & 15) * 16;
    f32x4 v0 = *(const f32x4*)sl, v1 = *(const f32x4*)(sl + 256), v2 = *(const f32x4*)(sl + 512), v3 = *(const f32x4*)(sl + 768);
    bf16_t* d = conv_tile(p, l, first + t).dst + (long)(4 * nq) * D + 4 * kq;
#pragma unroll
    for (int i = 0; i < 4; ++i) {
      uint2 w; w.x = cvtpk(v0[i], v1[i]); w.y = cvtpk(v2[i], v3[i]);
      if (SPT) *(uint2*)(d + (long)i * D) = w;
    }
  }
}

constexpr int CONV_FILL = 3;
DEVFN void conv_span(const Params& p, int L, int idx, int n, char* smem, int tid, int bidx) {
  const int nb = gridDim.x, per = (TR_EXP + nb - 1) / nb, first = bidx * per;
  int cnt = TR_EXP - first; if (cnt > per) cnt = per;
  int nv = cnt - idx; if (nv > n) nv = n;
  if (nv > 0) conv_ring<0>(p, L, first + idx, nv, smem, tid);
}
DEVFN void conv_fill(const Params& p, int l, int& cdone, char* smem, int tid, int bidx) {
  const int nb = gridDim.x, per = (TR_EXP + nb - 1) / nb;
  const int L = cdone / per;
  if (L > l + 1 || L >= DEPTH) return;
  const int idx = cdone - L * per;
  int n = per - idx; if (n > CONV_FILL) n = CONV_FILL;
  conv_span(p, L, idx, n, smem, tid, bidx);
  cdone += n;
}
DEVFN void ph_conv_catchup(const Params& p, int l, int& cdone, char* smem) {
  PHASE_BEGIN;
  const int nb = gridDim.x, per = (TR_EXP + nb - 1) / nb;
  const int target = (l + 1) * per;
  if (cdone < target) {
    const int idx = cdone - l * per;
    conv_span(p, l, idx, per - idx, smem, tidx_, bidx_);
    cdone = target;
  }
}
constexpr int S5_SROW = 288;
constexpr int N_S5_LAT = DB * SG * 2 / 2, N_S5_CTX = BATCH * SG * 2 / 4;
template <int DIR, int CH>
DEVFN void s5_wave(const Params& p, int l, int lat, int u, char* wl, int lane) {
  constexpr int BU_BYTES = CH * 128 * 4;
  const int g = (u >> 1) % SG, b = u / (2 * SG);
  const int N = lat ? DSEQ : SEQ, t0 = lat ? TC + b * DSEQ : b * SEQ, nch = N / CH;
  float* BU = (float*)wl;
  char* SS = wl + BU_BYTES;
  const long pidx = (((long)l * 2 + DIR) * SG + g);
  const float ar = p.abar[(pidx * SP + lane) * 2], ai = p.abar[(pidx * SP + lane) * 2 + 1];
  const float nai = -ai;
  float sr = 0.f, si = 0.f;
  if (lat) { long si0 = ((((long)b * DEPTH + l) * 2 + DIR) * SG + g) * SP + lane; sr = p.st_re[si0]; si = p.st_im[si0]; }
  bf16x8 bfr[4], cfr[4];
#pragma unroll
  for (int nt = 0; nt < 4; ++nt) bfr[nt] = *(const bf16x8*)(p.bbn + ((pidx * 128 + nt * 32 + (lane & 31)) * 16 + 8 * (lane >> 5)));
#pragma unroll
  for (int ks = 0; ks < 4; ++ks) cfr[ks] = *(const bf16x8*)(p.cn + ((pidx * 16 + (lane & 15)) * 128 + ks * 32 + 8 * (lane >> 4)));
  const bf16_t* ub = p.proj + (long)t0 * NPJ + PJ_U + g * 16 + 8 * (lane >> 5);
  const int urow = lane & (CH - 1);
  bf16x8 ufr = *(const bf16x8*)(ub + (long)((DIR ? N - CH : 0) + urow) * NPJ);
  float* const ybase = p.ypart + ((long)DIR * T + t0 + (lane >> 4) * 4) * S5_W + g * 16 + (lane & 15);
  for (int c = 0; c <= nch; ++c) {
    if (c < nch) {
      const bf16x8 ucur = ufr;
      if (c + 1 < nch) ufr = *(const bf16x8*)(ub + (long)((DIR ? N - CH * (c + 2) : CH * (c + 1)) + urow) * NPJ);
#pragma unroll
      for (int np = 0; np < 2; ++np) {
        f32x16 z0, z1;
#pragma unroll
        for (int r = 0; r < 16; ++r) { z0[r] = 0.f; z1[r] = 0.f; }
        z0 = __builtin_amdgcn_mfma_f32_32x32x16_bf16(ucur, bfr[2 * np], z0, 0, 0, 0);
        z1 = __builtin_amdgcn_mfma_f32_32x32x16_bf16(ucur, bfr[2 * np + 1], z1, 0, 0, 0);
#pragma unroll
        for (int r = 0; r < CH / 2; ++r) {
          const int row = (r & 3) + 8 * (r >> 2) + 4 * (lane >> 5);
          BU[row * 128 + (2 * np) * 32 + (lane & 31)] = z0[r];
          BU[row * 128 + (2 * np + 1) * 32 + (lane & 31)] = z1[r];
        }
      }
    }
    __builtin_amdgcn_fence(__ATOMIC_RELEASE, "wavefront");
    __builtin_amdgcn_wave_barrier();
    __builtin_amdgcn_fence(__ATOMIC_ACQUIRE, "wavefront");
    if (c >= 1) {
      const char* ss = SS + ((c - 1) & 1) * (CH * S5_SROW);
      const int pb = DIR ? N - CH * c : CH * (c - 1);
#pragma unroll
      for (int mt = 0; mt < CH / 16; ++mt) {
        f32x4 acc = {0.f, 0.f, 0.f, 0.f};
#pragma unroll
        for (int ks = 0; ks < 4; ++ks) {
          bf16x8 a = *(const bf16x8*)(ss + (mt * 16 + (lane & 15)) * S5_SROW + ks * 64 + 16 * (lane >> 4));
          acc = __builtin_amdgcn_mfma_f32_16x16x32_bf16(a, cfr[ks], acc, 0, 0, 0);
        }
        float* yo = ybase + (long)(pb + mt * 16) * S5_W;
#pragma unroll
        for (int r = 0; r < 4; ++r) yo[(long)r * S5_W] = acc[r];
      }
    }
    if (c < nch) {
      char* ss = SS + (c & 1) * (CH * S5_SROW);
      f32x2_t bu[CH];
#pragma unroll
      for (int k = 0; k < CH; ++k) { const int r = DIR ? CH - 1 - k : k; bu[k] = *(const f32x2_t*)(BU + r * 128 + 2 * lane); }
#pragma unroll
      for (int k = 0; k < CH; ++k) {
        const int r = DIR ? CH - 1 - k : k;
        const float nr = __builtin_fmaf(ar, sr, __builtin_fmaf(nai, si, bu[k][0]));
        const float ni = __builtin_fmaf(ar, si, __builtin_fmaf(ai, sr, bu[k][1]));
        sr = nr; si = ni;
        *(unsigned*)(ss + r * S5_SROW + lane * 4) = cvtpk(sr, si);
      }
    }
    __builtin_amdgcn_fence(__ATOMIC_RELEASE, "wavefront");
    __builtin_amdgcn_wave_barrier();
    __builtin_amdgcn_fence(__ATOMIC_ACQUIRE, "wavefront");
  }
  if (!lat) {
    long oo = ((((long)b * DEPTH + l) * 2 + DIR) * SG + g) * SP + lane;
    p.out[O_SRE + oo] = sr; p.out[O_SIM + oo] = si;
  }
}
DEVFN void s5_unit(const Params& p, int l, int lat, int item, char* smem, int tidx_) {
  const int wave = tidx_ >> 6, lane = tidx_ & 63;
  if (lat) {
    if (wave < 2) {
      const int u = item * 2 + wave;
      char* wl = smem + wave * (32 * 128 * 4 + 2 * 32 * S5_SROW);
      if (u & 1) s5_wave<1, 32>(p, l, 1, u, wl, lane); else s5_wave<0, 32>(p, l, 1, u, wl, lane);
    }
  } else {
    const int u = item * 4 + wave;
    char* wl = smem + wave * (16 * 128 * 4 + 2 * 16 * S5_SROW);
    if (u & 1) s5_wave<1, 16>(p, l, 0, u, wl, lane); else s5_wave<0, 16>(p, l, 0, u, wl, lane);
  }
  __syncthreads();
}

constexpr int AT_KROW = 144, AT_VROW = 72, AT_KB = 32 * AT_KROW, AT_STAGE = AT_KB + 64 * AT_VROW;
constexpr int N_AT_LAT = DB * NKV * (DSEQ / 32), N_AT_CTX = BATCH * NKV * (SEQ / 32);
DEVFN void attn_item(const Params& p, int l, int lat, int item, char* smem, int tidx_) {
  const int NQB = (lat ? DSEQ : SEQ) / 32;
  const int qb = item % NQB, kvh = (item / NQB) % NKV, b = item / (NQB * NKV);
  const int N = lat ? DSEQ : SEQ, t0 = lat ? TC + b * DSEQ : b * SEQ, q0 = qb * 32;
  const int wave = tidx_ >> 6, lane = tidx_ & 63, hl = lane >> 5, head = kvh * GQA + wave;
  bf16x8 qf[4];
#pragma unroll
  for (int s = 0; s < 4; ++s) qf[s] = *(const bf16x8*)(p.proj + (long)(t0 + q0 + (lane & 31)) * NPJ + PJ_Q + head * HD + 16 * s + 8 * hl);
  const int ks0 = lat ? (q0 - WINDOW < 0 ? 0 : q0 - WINDOW) : 0;
  const int ke0 = lat ? (q0 + 32 + WINDOW > N ? N : q0 + 32 + WINDOW) : N;
  const int nwin = (ke0 - ks0) / 32, ntiles = nwin + (lat ? PAST / 32 : 0);
  float m = p.attn_sink[l * NH + head], lsum = 1.f;
  f32x16 O[2];
#pragma unroll
  for (int i = 0; i < 2; ++i)
#pragma unroll
    for (int r = 0; r < 16; ++r) O[i][r] = 0.f;
  const int kkey = tidx_ >> 3, kch = tidx_ & 7;
  const int vkey = tidx_ & 31, vch = tidx_ >> 5;
  struct KV { f32x4 k0, k1, v0, v1; };
  auto tile_load = [&](int ti) -> KV {
    KV r; r.k1 = r.k0 = (f32x4){0.f, 0.f, 0.f, 0.f}; r.v1 = r.v0 = r.k0;
    if (ti < nwin) {
      const int kp = ks0 + ti * 32;
      uint4 a = *(const uint4*)(p.proj + (long)(t0 + kp + kkey) * NPJ + PJ_K + kvh * HD + kch * 8);
      uint4 c = *(const uint4*)(p.proj + (long)(t0 + kp + vkey) * NPJ + PJ_V + kvh * HD + vch * 8);
      r.k0 = __builtin_bit_cast(f32x4, a); r.v0 = __builtin_bit_cast(f32x4, c);
    } else {
      const int s0 = (ti - nwin) * 32;
      const float* kb = p.cache_k + ((((long)b * DEPTH + l) * PAST + s0 + kkey) * NKV + kvh) * HD + kch * 8;
      const float* vb = p.cache_v + ((((long)b * DEPTH + l) * PAST + s0 + vkey) * NKV + kvh) * HD + vch * 8;
      r.k0 = *(const f32x4*)kb; r.k1 = *(const f32x4*)(kb + 4);
      r.v0 = *(const f32x4*)vb; r.v1 = *(const f32x4*)(vb + 4);
    }
    return r;
  };
  auto tile_store = [&](int ti, char* st, const KV r) {
    uint4 kq, vq;
    if (ti < nwin) { kq = __builtin_bit_cast(uint4, r.k0); vq = __builtin_bit_cast(uint4, r.v0); }
    else {
      kq.x = cvtpk(r.k0[0], r.k0[1]); kq.y = cvtpk(r.k0[2], r.k0[3]); kq.z = cvtpk(r.k1[0], r.k1[1]); kq.w = cvtpk(r.k1[2], r.k1[3]);
      vq.x = cvtpk(r.v0[0], r.v0[1]); vq.y = cvtpk(r.v0[2], r.v0[3]); vq.z = cvtpk(r.v1[0], r.v1[1]); vq.w = cvtpk(r.v1[2], r.v1[3]);
    }
    *(uint4*)(st + kkey * AT_KROW + kch * 16) = kq;
    char* vt = st + AT_KB + (vch * 8) * AT_VROW + vkey * 2;
    *(bf16_t*)(vt + 0 * AT_VROW) = (bf16_t)(vq.x & 0xffffu); *(bf16_t*)(vt + 1 * AT_VROW) = (bf16_t)(vq.x >> 16);
    *(bf16_t*)(vt + 2 * AT_VROW) = (bf16_t)(vq.y & 0xffffu); *(bf16_t*)(vt + 3 * AT_VROW) = (bf16_t)(vq.y >> 16);
    *(bf16_t*)(vt + 4 * AT_VROW) = (bf16_t)(vq.z & 0xffffu); *(bf16_t*)(vt + 5 * AT_VROW) = (bf16_t)(vq.z >> 16);
    *(bf16_t*)(vt + 6 * AT_VROW) = (bf16_t)(vq.w & 0xffffu); *(bf16_t*)(vt + 7 * AT_VROW) = (bf16_t)(vq.w >> 16);
  };
  KV sa_ = tile_load(0), sb_ = sa_;
  tile_store(0, smem, sa_);
  if (ntiles > 1) sb_ = tile_load(1);
  __syncthreads();
  const int qp = q0 + (lane & 31);
  auto compute = [&](int ti) {
    const char* st = smem + (ti & 1) * AT_STAGE;
    f32x16 sa;
#pragma unroll
    for (int r = 0; r < 16; ++r) sa[r] = 0.f;
#pragma unroll
    for (int s = 0; s < 4; ++s) {
      bf16x8 kf = *(const bf16x8*)(st + (lane & 31) * AT_KROW + (2 * s + hl) * 16);
      sa = __builtin_amdgcn_mfma_f32_32x32x16_bf16(kf, qf[s], sa, 0, 0, 0);
    }
    float tmax = -1e30f;
    if (lat && ti < nwin) {
      const int kp0 = ks0 + ti * 32 + 4 * hl;
#pragma unroll
      for (int r = 0; r < 16; ++r) {
        const int kp = kp0 + (r & 3) + 8 * (r >> 2);
        const int df = kp - qp;
        const bool ok = (df <= WINDOW) && (df >= -WINDOW);
        sa[r] = ok ? sa[r] * 0.125f : -1e30f;
        tmax = fmaxf(tmax, sa[r]);
      }
    } else {
#pragma unroll
      for (int r = 0; r < 16; ++r) { sa[r] *= 0.125f; tmax = fmaxf(tmax, sa[r]); }
    }
    tmax = fmaxf(tmax, __shfl_xor(tmax, 32));
    const float mnew = fmaxf(m, tmax);
    const float sc = __expf(m - mnew);
    float rs = 0.f;
#pragma unroll
    for (int r = 0; r < 16; ++r) { sa[r] = __expf(sa[r] - mnew); rs += sa[r]; }
    rs += __shfl_xor(rs, 32);
    lsum = lsum * sc + rs; m = mnew;
#pragma unroll
    for (int i = 0; i < 2; ++i)
#pragma unroll
      for (int r = 0; r < 16; ++r) O[i][r] *= sc;
    bf16x8 pb[2];
#pragma unroll
    for (int s2 = 0; s2 < 2; ++s2) {
      uint4 w;
      w.x = cvtpk(sa[8 * s2 + 0], sa[8 * s2 + 1]); w.y = cvtpk(sa[8 * s2 + 2], sa[8 * s2 + 3]);
      w.z = cvtpk(sa[8 * s2 + 4], sa[8 * s2 + 5]); w.w = cvtpk(sa[8 * s2 + 6], sa[8 * s2 + 7]);
      pb[s2] = __builtin_bit_cast(bf16x8, w);
    }
#pragma unroll
    for (int mt = 0; mt < 2; ++mt)
#pragma unroll
      for (int s2 = 0; s2 < 2; ++s2) {
        const char* vp = st + AT_KB + (mt * 32 + (lane & 31)) * AT_VROW + (16 * s2 + 4 * hl) * 2;
        uint2 lo = *(const uint2*)vp, hi = *(const uint2*)(vp + 16);
        uint4 w; w.x = lo.x; w.y = lo.y; w.z = hi.x; w.w = hi.y;
        O[mt] = __builtin_amdgcn_mfma_f32_32x32x16_bf16(__builtin_bit_cast(bf16x8, w), pb[s2], O[mt], 0, 0, 0);
      }
  };
  for (int ti = 0; ti < ntiles; ti += 2) {
    if (ti + 2 < ntiles) sa_ = tile_load(ti + 2);
    compute(ti);
    if (ti + 1 < ntiles) tile_store(ti + 1, smem + AT_STAGE, sb_);
    __syncthreads();
    if (ti + 1 >= ntiles) break;
    if (ti + 3 < ntiles) sb_ = tile_load(ti + 3);
    compute(ti + 1);
    if (ti + 2 < ntiles) tile_store(ti + 2, smem, sa_);
    __syncthreads();
  }
  const float inv = 1.f / lsum;
  bf16_t* orow = p.mixcat + (long)(t0 + qp) * MIX_W + head * HD;
#pragma unroll
  for (int mt = 0; mt < 2; ++mt)
#pragma unroll
    for (int q = 0; q < 4; ++q) {
      uint2 w;
      w.x = cvtpk(O[mt][4 * q] * inv, O[mt][4 * q + 1] * inv); w.y = cvtpk(O[mt][4 * q + 2] * inv, O[mt][4 * q + 3] * inv);
      *(uint2*)(orow + mt * 32 + 8 * q + 4 * hl) = w;
    }
}

constexpr int N_FO_LAT = DB * (DSEQ / 128) * 2 * 2, N_FO_CTX = BATCH * (SEQ / 128) * 2;
constexpr int MIX_CORE = N_S5_LAT + N_FO_LAT + N_AT_LAT + N_S5_CTX + N_FO_CTX + N_AT_CTX;
constexpr int CONV_PER_ITEM = 8, N_CONV_ITEMS = TR_EXP / CONV_PER_ITEM;
constexpr int MIX_ITEMS = MIX_CORE;
DEVFN void ph_mix_fast(const Params& p, int l, char* smem, int* s_item, int rep = 0, int lo = 0, int hi = MIX_ITEMS) {
  PHASE_BEGIN;
  unsigned* ctr = p.bar + 4096 + 64 * l + 16 * rep;
  bool first = true;
  for (;;) {
    if (tidx_ == 0) *s_item = lo + (first ? bidx_ : (int)(gridDim.x + atomicAdd(ctr, 1u)));
    first = false;
    __syncthreads();
    int item = *s_item;
    __syncthreads();
    if (item >= hi) break;
    int tidl = tidx_;
    asm volatile("" : "+v"(tidl));
    if (item < N_S5_LAT) { s5_unit(p, l, 1, item, smem, tidl); continue; }
    item -= N_S5_LAT;
    if (item < N_FO_LAT) { fourier_tile(p, item, smem, tidl); continue; }
    item -= N_FO_LAT;
    if (item < N_AT_LAT) { attn_item(p, l, 1, item, smem, tidl); continue; }
    item -= N_AT_LAT;
    if (item < N_S5_CTX) { s5_unit(p, l, 0, item, smem, tidl); continue; }
    item -= N_S5_CTX;
    if (item < N_FO_CTX) { fourier_tile(p, N_FO_LAT + item, smem, tidl); continue; }
    item -= N_FO_CTX;
    if (item < N_AT_CTX) { attn_item(p, l, 0, item, smem, tidl); continue; }
    item -= N_AT_CTX;
    conv_range(p, l, item * CONV_PER_ITEM, CONV_PER_ITEM, smem, tidl);
  }
}

DEVFN float s5_g(const Params& p, int l, long t, int c) {
  float y = p.ypart[t * S5_W + c] + p.ypart[((long)T + t) * S5_W + c] + p.s5_d[l * S5_W + c] * bf2f(p.proj[t * NPJ + PJ_U + c]);
  return gelu_fast(y);
}
struct GluALoader {
  const float* ypart; const float* s5d; const bf16_t* proj; long m0; int tid;
  DEVFN uint4 one(int kt, int i) const {
    const int kc = tid & 7, r0 = tid >> 3;
    const int c0 = kt * 64 + kc * 8;
    f32x4 d0 = *(const f32x4*)(s5d + c0), d1 = *(const f32x4*)(s5d + c0 + 4);
    const long t = m0 + r0 + 32 * i;
    const float* y0 = ypart + t * S5_W + c0; const float* y1 = ypart + ((long)T + t) * S5_W + c0;
    f32x4 a0 = *(const f32x4*)y0, a1 = *(const f32x4*)(y0 + 4), b0 = *(const f32x4*)y1, b1 = *(const f32x4*)(y1 + 4);
    uint4 u = *(const uint4*)(proj + t * NPJ + PJ_U + c0);
    float g0 = gelu_fast(a0[0] + b0[0] + d0[0] * bflo(u.x)), g1 = gelu_fast(a0[1] + b0[1] + d0[1] * bfhi(u.x));
    float g2 = gelu_fast(a0[2] + b0[2] + d0[2] * bflo(u.y)), g3 = gelu_fast(a0[3] + b0[3] + d0[3] * bfhi(u.y));
    float g4 = gelu_fast(a1[0] + b1[0] + d1[0] * bflo(u.z)), g5 = gelu_fast(a1[1] + b1[1] + d1[1] * bfhi(u.z));
    float g6 = gelu_fast(a1[2] + b1[2] + d1[2] * bflo(u.w)), g7 = gelu_fast(a1[3] + b1[3] + d1[3] * bfhi(u.w));
    uint4 w; w.x = cvtpk(g0, g1); w.y = cvtpk(g2, g3); w.z = cvtpk(g4, g5); w.w = cvtpk(g6, g7);
    return w;
  }
  DEVFN U4x4 operator()(int kt) const { U4x4 v; v.a = one(kt, 0); v.b = one(kt, 1); v.c = one(kt, 2); v.d = one(kt, 3); return v; }
};
DEVFN void ph_glu_fast3(const Params& p, int l, char* smem) {
  PHASE_BEGIN;
  const int lane = tidx_ & 63, wave = tidx_ >> 6;
  const bf16_t* wg = p.wglut + (long)l * S5_W * S5_W;
  const bf16_t* const wbase = wg + (long)(tidx_ >> 3) * S5_W + g_chunk(tidx_);
  auto stage_b = [&](char* st, int kt) {
    const bf16_t* bb = wbase;
    asm volatile("" : "+v"(bb));
    GRows X0, X1;
    X0.r0 = bb; X0.r1 = bb + 32 * S5_W; X0.r2 = bb + 64 * S5_W; X0.r3 = bb + 96 * S5_W;
    X1.r0 = bb + 128 * S5_W; X1.r1 = bb + 160 * S5_W; X1.r2 = bb + 192 * S5_W; X1.r3 = bb + 224 * S5_W;
    g_stage(st, wave, X0, X1, kt);
  };
  const int sw = (lane >> 1) & 7, h = lane >> 5;
  int off[4];
#pragma unroll
  for (int ks = 0; ks < 4; ++ks) off[ks] = (lane & 31) * 128 + (((2 * ks + h) ^ sw) * 16);
  char* img = smem + GL_STAGEB;
  for (int tile = bidx_; tile < T / 32; tile += gridDim.x) {
    const int m0 = tile * 32;
    __syncthreads();
    stage_b(smem, 0);
    {
      const int c0 = (tidx_ & 31) * 8, r0 = tidx_ >> 5;
      f32x4 d0 = *(const f32x4*)(p.s5_d + l * S5_W + c0), d1 = *(const f32x4*)(p.s5_d + l * S5_W + c0 + 4);
      f32x4 a0[4], a1[4], b0[4], b1[4]; uint4 u[4];
#pragma unroll
      for (int k = 0; k < 4; ++k) {
        const long t = m0 + r0 + 8 * k;
        const float* y0 = p.ypart + t * S5_W + c0; const float* y1 = p.ypart + ((long)T + t) * S5_W + c0;
        a0[k] = *(const f32x4*)y0; a1[k] = *(const f32x4*)(y0 + 4); b0[k] = *(const f32x4*)y1; b1[k] = *(const f32x4*)(y1 + 4);
        u[k] = *(const uint4*)(p.proj + t * NPJ + PJ_U + c0);
      }
      const int kt = (tidx_ & 31) >> 3, c = tidx_ & 7;
#pragma unroll
      for (int k = 0; k < 4; ++k) {
        const int r = r0 + 8 * k;
        float g0 = gelu_fast(a0[k][0] + b0[k][0] + d0[0] * bflo(u[k].x)), g1 = gelu_fast(a0[k][1] + b0[k][1] + d0[1] * bfhi(u[k].x));
        float g2 = gelu_fast(a0[k][2] + b0[k][2] + d0[2] * bflo(u[k].y)), g3 = gelu_fast(a0[k][3] + b0[k][3] + d0[3] * bfhi(u[k].y));
        float g4 = gelu_fast(a1[k][0] + b1[k][0] + d1[0] * bflo(u[k].z)), g5 = gelu_fast(a1[k][1] + b1[k][1] + d1[1] * bfhi(u[k].z));
        float g6 = gelu_fast(a1[k][2] + b1[k][2] + d1[2] * bflo(u[k].w)), g7 = gelu_fast(a1[k][3] + b1[k][3] + d1[3] * bfhi(u[k].w));
        uint4 w; w.x = cvtpk(g0, g1); w.y = cvtpk(g2, g3); w.z = cvtpk(g4, g5); w.w = cvtpk(g6, g7);
        *(uint4*)(img + kt * 4096 + r * 128 + ((c ^ ((r >> 1) & 7)) * 16)) = w;
      }
    }
    __syncthreads();
    bf16x8 af[16];
#pragma unroll
    for (int kt = 0; kt < 4; ++kt)
#pragma unroll
      for (int ks = 0; ks < 4; ++ks) af[kt * 4 + ks] = *(const bf16x8*)(img + kt * 4096 + off[ks]);
    unsigned ge[2][8];
#pragma unroll
    for (int nt = 0; nt < 2; ++nt)
#pragma unroll
      for (int q = 0; q < 4; ++q)
#pragma unroll
        for (int i2 = 0; i2 < 2; ++i2) {
          const int row = 8 * q + 4 * (lane >> 5) + 2 * i2, jc = 32 * nt + (lane & 31);
          const char* gp = img + wave * 4096 + row * 128 + (((jc >> 3) ^ ((row >> 1) & 7)) * 16) + (jc & 7) * 2;
          ge[nt][2 * q + i2] = (unsigned)*(const unsigned short*)gp | ((unsigned)*(const unsigned short*)(gp + 128) << 16);
        }
    asm volatile("s_waitcnt vmcnt(0)" ::: "memory");
    __syncthreads();
    f32x16 acc0, acc1;
#pragma unroll
    for (int r = 0; r < 16; ++r) { acc0[r] = 0.f; acc1[r] = 0.f; }
#pragma unroll
    for (int kt = 0; kt < 4; ++kt) {
      if (kt < 3) stage_b(smem + ((kt + 1) & 1) * GL_STAGEB, kt + 1);
      const char* sB = smem + (kt & 1) * GL_STAGEB + (wave >> 1) * GL_TILEB + (wave & 1) * 64 * 128;
#pragma unroll
      for (int ks = 0; ks < 4; ++ks) {
        const bf16x8 fb0 = *(const bf16x8*)(sB + off[ks]), fb1 = *(const bf16x8*)(sB + 32 * 128 + off[ks]);
        acc0 = __builtin_amdgcn_mfma_f32_32x32x16_bf16(af[kt * 4 + ks], fb0, acc0, 0, 0, 0);
        acc1 = __builtin_amdgcn_mfma_f32_32x32x16_bf16(af[kt * 4 + ks], fb1, acc1, 0, 0, 0);
      }
      asm volatile("s_waitcnt vmcnt(0)" ::: "memory");
      __syncthreads();
    }
    const bool odd = tidx_ & 1;
#pragma unroll
    for (int nt = 0; nt < 2; ++nt)
#pragma unroll
      for (int q = 0; q < 4; ++q) {
        const int row = 8 * q + 4 * (lane >> 5), j = 64 * wave + 32 * nt + (lane & 31);
        float r[4];
#pragma unroll
        for (int i = 0; i < 4; ++i) {
          const float v = nt ? acc1[4 * q + i] : acc0[4 * q + i];
          const unsigned gw = ge[nt][2 * q + (i >> 1)];
          r[i] = ((i & 1) ? bfhi(gw) : bflo(gw)) * sigmoid_fast(v);
        }
        store4_bf16(p.mixcat + (long)(m0 + row) * MIX_W + ATTN_W + FOUR_W + j, MIX_W, odd, r[0], r[1], r[2], r[3]);
      }
  }
}
DEVFN void ph_four_reduce(const Params& p) {
  PHASE_BEGIN;
  {
    const int nb = gridDim.x;
    int ridx = bidx_ - (T / 32) % nb; if (ridx < 0) ridx += nb;
    for (int it = ridx; it < DB * DSEQ / 16; it += nb) {
#pragma unroll
      for (int k = 0; k < 2; ++k) {
        const int ch = it * 512 + k * 256 + tidx_;
        const int row = ch >> 5, c8 = (ch & 31) * 8;
        const float* a = p.win2 + (long)row * FOUR_W + c8; const float* b = a + (long)DB * DSEQ * FOUR_W;
        const f32x4 a0 = *(const f32x4*)a, a1 = *(const f32x4*)(a + 4), b0 = *(const f32x4*)b, b1 = *(const f32x4*)(b + 4);
        uint4 w;
        w.x = cvtpk(a0[0] + b0[0], a0[1] + b0[1]); w.y = cvtpk(a0[2] + b0[2], a0[3] + b0[3]);
        w.z = cvtpk(a1[0] + b1[0], a1[1] + b1[1]); w.w = cvtpk(a1[2] + b1[2], a1[3] + b1[3]);
        *(uint4*)(p.mixcat + (long)(TC + row) * MIX_W + ATTN_W + c8) = w;
      }
    }
  }
}

DEVFN void ph_glu_fast2(const Params& p, int l, char* smem) {
  PHASE_BEGIN;
  constexpr int NT_N = S5_W / 128, NT_M = T / 128;
  for (int tile = bidx_; tile < NT_M * NT_N; tile += gridDim.x) {
    const int tm = tile / NT_N, tn = tile % NT_N;
    const int m0 = tm * 128, n0 = tn * 128;
    {
      const int c0 = (tidx_ & 31) * 8, r0 = tidx_ >> 5;
      f32x4 d0 = *(const f32x4*)(p.s5_d + l * S5_W + c0), d1 = *(const f32x4*)(p.s5_d + l * S5_W + c0 + 4);
#pragma unroll 1
      for (int i4 = 0; i4 < 4; ++i4) {
        f32x4 a0[4], a1[4], b0[4], b1[4]; uint4 u[4];
#pragma unroll
        for (int k = 0; k < 4; ++k) {
          const long t = m0 + r0 + 8 * (4 * i4 + k);
          const float* y0 = p.ypart + t * S5_W + c0; const float* y1 = p.ypart + ((long)T + t) * S5_W + c0;
          a0[k] = *(const f32x4*)y0; a1[k] = *(const f32x4*)(y0 + 4); b0[k] = *(const f32x4*)y1; b1[k] = *(const f32x4*)(y1 + 4);
          u[k] = *(const uint4*)(p.proj + t * NPJ + PJ_U + c0);
        }
#pragma unroll
        for (int k = 0; k < 4; ++k) {
          const long t = m0 + r0 + 8 * (4 * i4 + k);
          float g0 = gelu_fast(a0[k][0] + b0[k][0] + d0[0] * bflo(u[k].x)), g1 = gelu_fast(a0[k][1] + b0[k][1] + d0[1] * bfhi(u[k].x));
          float g2 = gelu_fast(a0[k][2] + b0[k][2] + d0[2] * bflo(u[k].y)), g3 = gelu_fast(a0[k][3] + b0[k][3] + d0[3] * bfhi(u[k].y));
          float g4 = gelu_fast(a1[k][0] + b1[k][0] + d1[0] * bflo(u[k].z)), g5 = gelu_fast(a1[k][1] + b1[k][1] + d1[1] * bfhi(u[k].z));
          float g6 = gelu_fast(a1[k][2] + b1[k][2] + d1[2] * bflo(u[k].w)), g7 = gelu_fast(a1[k][3] + b1[k][3] + d1[3] * bfhi(u[k].w));
          uint4 w; w.x = cvtpk(g0, g1); w.y = cvtpk(g2, g3); w.z = cvtpk(g4, g5); w.w = cvtpk(g6, g7);
          *(uint4*)(p.gbuf + t * S5_W + c0) = w;
        }
      }
    }
    asm volatile("s_waitcnt vmcnt(0)" ::: "memory");
    __syncthreads();
    GRows A = make_grows(tidx_, p.gbuf, m0, S5_W);
    GRows B = make_grows(tidx_, p.wglut + (long)l * S5_W * S5_W, n0, S5_W);
    const bool odd = tidx_ & 1;
    bool staged = false;
    bf16_t* gl = (bf16_t*)smem;
    gemm_tile_g(smem, tidx_, A, B, S5_W / 64, [&](int nt, int row, int col, float v0, float v1, float v2, float v3) {
      if (!staged) {
        uint4 t8[8];
#pragma unroll
        for (int i = 0; i < 8; ++i) { const int c = tidx_ + 256 * i; t8[i] = *(const uint4*)(p.gbuf + (long)(m0 + (c >> 4)) * S5_W + n0 + (c & 15) * 8); }
#pragma unroll
        for (int i = 0; i < 8; ++i) { const int c = tidx_ + 256 * i; *(uint4*)(gl + (c >> 4) * 128 + (c & 15) * 8) = t8[i]; }
        __syncthreads();
        staged = true;
      }
      const int j = n0 + col;
      float v[4] = {v0, v1, v2, v3};
      float gg[4];
#pragma unroll
      for (int i = 0; i < 4; ++i) gg[i] = bf2f(gl[(row + i) * 128 + col]);
#pragma unroll
      for (int i = 0; i < 4; ++i) {
        long t = m0 + row + i;
        float r = gg[i] * sigmoid_fast(v[i]);
        float pr = shx1(r);
        if (!odd) *(unsigned*)(p.mixcat + t * MIX_W + ATTN_W + FOUR_W + j) = cvtpk(r, pr);
      }
    });
  }
}

__global__ void __launch_bounds__(256, 2) __attribute__((amdgpu_waves_per_eu(2, 2))) mega(Params p) {
  __shared__ __attribute__((aligned(16))) char smem[SMEM_BYTES];
  __shared__ uint4 xb_words;
  __shared__ int s_item;
  if (threadIdx.x == 0) xb_words = make_uint4(0u, 0u, 0u, 0u);
  __syncthreads();
  XcdBarrier xb = xcd_barrier_post(p.bar, (volatile LAS unsigned*)&xb_words);
  volatile LAS unsigned* lead = (volatile LAS unsigned*)&xb_words + 2;
  volatile LAS int* s_cd = (volatile LAS int*)&xb_words + 3;
  ph_adaln_part(p, smem); ph_init_tr(p, smem); ph_init_tab(p, smem); xcd_barrier(xb);
  ph_adaln_reduce(p); ph_init_fold(p, smem); xcd_barrier(xb);
  int l = 0, ph = 0;
#pragma unroll 1
  for (;;) {
    if (ph == 0) { ph_row1_fast(p, l, smem); if (l == DEPTH) break; }
    else if (ph == 1) ph_gemm_in_fast(p, l, smem);
    else if (ph == 2) ph_mix_fast(p, l, smem, &s_item);
    else if (ph == 3) { ph_glu_fast3(p, l, smem); ph_four_reduce(p); }
    else if (ph == 4) ph_gemm_out_fast(p, l, smem);
    else if (ph == 5) ph_row2_fast(p, l, smem);
    else if (ph == 6) { ph_topk_fast(p, l, smem); int cd = *s_cd; __syncthreads(); ph_conv_catchup(p, l, cd, smem); if (threadIdx.x == 0) *s_cd = cd; }
    else if (ph == 7) ph_moe1_fast(p, l, smem);
    else ph_moe2_fast(p, l, smem);
    xcd_barrier_fill(xb, lead, [&]() {
      int tf = threadIdx.x, bf = blockIdx.x;
      asm volatile("" : "+v"(tf), "+s"(bf));
      int cd = *s_cd;
      __syncthreads();
      conv_fill(p, l, cd, smem, tf, bf);
      if (tf == 0) *s_cd = cd;
    });
    if (++ph == 9) { ph = 0; ++l; }
  }
}

extern "C" void kernel_launch(void* const* d_in, const int* in_sizes, int n_in, void* d_out, int out_size, void* d_ws,
                              size_t ws_size, hipStream_t stream) {
  Params p{};
  const float** pp = (const float**)&p;
  for (int i = 0; i < 33; ++i) pp[i] = (const float*)d_in[i];
  p.out = (float*)d_out;
  char* w = (char*)d_ws;
  size_t off = 0;
  auto al = [&](size_t bytes) { void* r = w + off; off += (bytes + 255) & ~(size_t)255; return r; };
  p.bar = (unsigned*)al(64 * 1024);
  p.x = (float*)al((size_t)T * D * 4); p.mod = (float*)al((size_t)DEPTH * NCOND * 6 * D * 4);
  p.states = nullptr; p.ypart = (float*)al((size_t)2 * T * S5_W * 4); p.ybuf = (float*)al((size_t)T * D * 4); p.aff = (float*)al((size_t)T * NE * 4);
  p.wcs = (float*)al((size_t)DEPTH * 256 * 512 * 4); p.win2 = (float*)al((size_t)DEPTH * D * NP * 4);
  p.abar = (float*)al((size_t)DEPTH * 2 * SG * SP * 2 * 4); p.bbar = (float*)al((size_t)DEPTH * 2 * SG * SP * SH * 2 * 4);
  p.twc = (float*)al(SEQ * 2 * 4); p.twl = (float*)al(DSEQ * 2 * 4); p.selgate = (float*)al((size_t)NE * NS * 4);
  p.modpart = (float*)al((size_t)ADA_KC * DEPTH * NCOND * 6 * D * 4); p.afft = (float*)al((size_t)NE * T * 4); p.rope = (float*)al(64 * 16 * 2 * 4);
  p.h = (act_t*)al((size_t)T * D * sizeof(act_t)); p.proj = (act_t*)al((size_t)T * NPJ * sizeof(act_t));
  p.pqt = (act_t*)al((size_t)T * 512 * sizeof(act_t)); p.mixcat = (act_t*)al((size_t)T * MIX_W * sizeof(act_t));
  p.gbuf = (act_t*)al((size_t)T * S5_W * sizeof(act_t)); p.h2 = (act_t*)al((size_t)T * D * sizeof(act_t));
  p.hid = (act_t*)al((size_t)NE * NS * FF * sizeof(act_t)); p.ys = (act_t*)al((size_t)NE * NS * D * sizeof(act_t));
  p.win2t = (bf16_t*)al((size_t)DEPTH * NP * D * 2); p.woutt = (bf16_t*)al((size_t)DEPTH * D * MIX_W * 2);
  p.wglut = (bf16_t*)al((size_t)DEPTH * S5_W * S5_W * 2); p.dftc = (bf16_t*)al((size_t)SEQ * 2 * SEQ * 2);
  p.dftl = (bf16_t*)al((size_t)DSEQ * 2 * DSEQ * 2); p.wcst = (bf16_t*)al((size_t)DEPTH * 512 * 256 * 2);
  p.wgt = (bf16_t*)al((size_t)2 * NE * FF * D * 2); p.wut = (bf16_t*)al((size_t)2 * NE * FF * D * 2); p.wdt = (bf16_t*)al((size_t)2 * NE * D * FF * 2);
  p.bbn = (bf16_t*)al((size_t)DEPTH * 2 * SG * 128 * 16 * 2); p.cn = (bf16_t*)al((size_t)DEPTH * 2 * SG * SH * 128 * 2);
  p.seltok = (int*)al((size_t)NE * NS * 4); p.inv = (int*)al((size_t)T * NE * 4);
  static int grid_blocks = 0;
  if (!grid_blocks) {
    int dev = 0, cus = 0, per_cu = 0;
    (void)hipGetDevice(&dev);
    (void)hipDeviceGetAttribute(&cus, hipDeviceAttributeMultiprocessorCount, dev);
    (void)hipOccupancyMaxActiveBlocksPerMultiprocessor(&per_cu, mega, 256, 0);
    if (per_cu > 2) per_cu = 2;
    grid_blocks = cus * per_cu;
  }
  (void)hipMemsetAsync(p.bar, 0, 32768, stream);
  void* args[] = {&p};
  hipError_t e = hipLaunchCooperativeKernel((void*)mega, dim3(grid_blocks), dim3(256), args, 0, stream);
  if (e != hipSuccess) fprintf(stderr, "cooperative launch failed: %s (grid %d)\n", hipGetErrorString(e), grid_blocks);
}
```

```cpp
#include <hip/hip_runtime.h>
#include <hip/hip_cooperative_groups.h>
#include <cstdio>
#include <cstdint>
namespace cg = cooperative_groups;
#define DEVFN __device__ __forceinline__
#define PHASE_BEGIN int tidx_ = threadIdx.x; int bidx_ = blockIdx.x; asm volatile("" : "+v"(tidx_), "+s"(bidx_))
#define GTID ((long)bidx_ * 256 + tidx_)
#define GSIZE ((long)gridDim.x * 256)
#define ACT_BF16 1
#define HAVE_FAST 1

#ifdef CFG_SMALL
constexpr int D = 128, BATCH = 2, SEQ = 64, DEPTH = 2, DB = 2, DSEQ = 384, PAST = 64, FF = 64;
#else
constexpr int D = 1024, BATCH = 16, SEQ = 256, DEPTH = 4, DB = 4, DSEQ = 1024, PAST = 512, FF = 1024;
#endif
constexpr int GRID_W = 64, NH = 8, NKV = 2, HD = 64, GQA = 4, ATTN_W = 512, KV_W = 128, WINDOW = 128;
constexpr int FOUR_W = 256, S5_W = 256, SG = 16, SH = 16, SP = 64;
constexpr int MIX_W = 1024, IN_W = 1280, NE = 16;
constexpr int NP = 1536;
constexpr int PC_Q = 0, PC_K = 512, PC_V = 640, PC_P = 768, PC_QQ = 1024, PC_U = 1280;
constexpr int NPJ = 1024, PJ_Q = 0, PJ_K = 512, PJ_V = 640, PJ_U = 768;
constexpr int TC = BATCH * SEQ, TL = DB * DSEQ, T = TC + TL;
constexpr int NCOND = 1 + DB;
constexpr int CAPC = 2 * SEQ / NE, CAPL = 2 * DSEQ / NE;
constexpr int NS = BATCH * CAPC + DB * CAPL;
constexpr int NSEQ = BATCH + DB;
constexpr float LN_EPS = 1e-5f;
#ifdef CFG_SMALL
constexpr float ALPHA = 1.4142135623730951f;
#else
constexpr float ALPHA = 1.681792830507429f;
#endif

constexpr long O_YP = 0, O_YS = (long)TC * D, O_K = (long)T * D, O_V = O_K + (long)BATCH * DEPTH * SEQ * KV_W,
               O_SRE = O_V + (long)BATCH * DEPTH * SEQ * KV_W, O_SIM = O_SRE + (long)BATCH * DEPTH * 2 * SG * SP,
               O_END = O_SIM + (long)BATCH * DEPTH * 2 * SG * SP;

typedef unsigned short bf16_t;
#ifdef HOST_EMU
static inline unsigned f_as_u(float f) { unsigned u; memcpy(&u, &f, 4); return u; }
static inline float u_as_f(unsigned u) { float f; memcpy(&f, &u, 4); return f; }
#else
DEVFN unsigned f_as_u(float f) { return __float_as_uint(f); }
DEVFN float u_as_f(unsigned u) { return __uint_as_float(u); }
#endif
DEVFN bf16_t f2bf(float f) { unsigned u = f_as_u(f); u += 0x7fffu + ((u >> 16) & 1u); return (bf16_t)(u >> 16); }
DEVFN float bf2f(bf16_t b) { return u_as_f((unsigned)b << 16); }
#ifdef ACT_BF16
typedef bf16_t act_t;
DEVFN float lda(const act_t* p) { return bf2f(*p); }
DEVFN void sta(act_t* p, float v) { *p = f2bf(v); }
#else
typedef float act_t;
DEVFN float lda(const act_t* p) { return *p; }
DEVFN void sta(act_t* p, float v) { *p = v; }
#endif
struct Params {
  const float *x_prompt, *x_sample, *cache_k, *cache_v, *st_re, *st_im, *c, *c_ctx, *ln_in_g, *ln_in_b, *w_ada, *b_ada,
      *w_in, *w_fourier, *attn_sink, *s5_a_re, *s5_a_im, *s5_log_dt, *s5_b_re, *s5_b_im, *s5_c_re, *s5_c_im, *s5_d,
      *s5_w_glu, *w_out, *ln1_g, *ln1_b, *w_router, *w_gate, *w_up, *w_down, *ln2_g, *ln2_b;
  float* out;
  float *x, *mod, *states, *ybuf, *aff, *wcs, *win2, *abar, *bbar, *twc, *twl, *selgate, *modpart, *rope, *afft, *ypart;
  act_t *h, *proj, *pqt, *mixcat, *gbuf, *h2, *hid, *ys;
  bf16_t *win2t, *woutt, *wglut, *dftc, *dftl, *bbn, *cn, *wcst, *wgt, *wut, *wdt;
  int *seltok, *inv;
  unsigned* bar;
};

DEVFN float silu_f(float x) { return x / (1.f + expf(-x)); }
DEVFN float sigmoid_f(float x) { return 1.f / (1.f + expf(-x)); }
DEVFN float gelu_f(float x) { return 0.5f * x * (1.f + tanhf(0.7978845608028654f * (x + 0.044715f * x * x * x))); }

struct TokInfo { int lat, b, n, N, ci, t0; };
DEVFN TokInfo tokinfo(int t) {
  TokInfo r;
  if (t < TC) { r.lat = 0; r.b = t / SEQ; r.n = t % SEQ; r.N = SEQ; r.ci = 0; r.t0 = r.b * SEQ; }
  else { int tl = t - TC; r.lat = 1; r.b = tl / DSEQ; r.n = tl % DSEQ; r.N = DSEQ; r.ci = 1 + r.b; r.t0 = TC + r.b * DSEQ; }
  return r;
}
DEVFN const float* modp(const Params& p, int l, int ci, int chunk) { return p.mod + (((long)l * NCOND + ci) * 6 + chunk) * D; }

DEVFN void ph_init0(const Params& p) {
  PHASE_BEGIN;
  const long gt = GTID, gs = GSIZE;
#ifndef HAVE_FAST
  for (long idx = gt; idx < (long)DEPTH * 6 * D; idx += gs) {
    int l = idx / (6 * D), j = idx % (6 * D);
    float acc[NCOND];
#pragma unroll
    for (int c = 0; c < NCOND; ++c) acc[c] = 0.f;
    const float* w = p.w_ada + (long)l * D * 6 * D + j;
    for (int d = 0; d < D; ++d) {
      float wv = w[(long)d * 6 * D];
      acc[0] += silu_f(p.c_ctx[d]) * wv;
#pragma unroll
      for (int c = 1; c < NCOND; ++c) acc[c] += silu_f(p.c[(c - 1) * D + d]) * wv;
    }
    float bb = p.b_ada[(long)l * 6 * D + j];
#pragma unroll
    for (int c = 0; c < NCOND; ++c) p.mod[((long)l * NCOND + c) * 6 * D + j] = acc[c] + bb;
  }
#endif
  for (long idx = gt; idx < (long)DEPTH * 2 * SG * SP; idx += gs) {
    int pp = idx % SP; int g = (idx / SP) % SG; long ld = idx / (SP * SG);
    double are = p.s5_a_re[idx], aim = p.s5_a_im[idx];
    double dt = exp((double)p.s5_log_dt[ld * SG + g]);
    double er = exp(are * dt), cr = er * cos(aim * dt), ci = er * sin(aim * dt);
    p.abar[idx * 2] = (float)cr; p.abar[idx * 2 + 1] = (float)ci;
    double nr = cr - 1.0, ni = ci, den = are * are + aim * aim;
    double fr = (nr * are + ni * aim) / den, fi = (ni * are - nr * aim) / den;
    for (int h = 0; h < SH; ++h) {
      double br = p.s5_b_re[idx * SH + h], bi = p.s5_b_im[idx * SH + h];
      p.bbar[(idx * SH + h) * 2] = (float)(fr * br - fi * bi);
      p.bbar[(idx * SH + h) * 2 + 1] = (float)(fr * bi + fi * br);
#ifdef HAVE_FAST
      p.bbn[((ld * SG + g) * 128 + 2 * pp) * 16 + h] = f2bf((float)(fr * br - fi * bi));
      p.bbn[((ld * SG + g) * 128 + 2 * pp + 1) * 16 + h] = f2bf((float)(fr * bi + fi * br));
#endif
    }
  }
#ifdef HAVE_FAST
  for (long idx = gt; idx < (long)DEPTH * 2 * SG * SH * 128; idx += gs) {
    int k = idx % 128; long row = idx / 128;
    p.cn[idx] = f2bf((k & 1) ? -p.s5_c_im[row * SP + (k >> 1)] : p.s5_c_re[row * SP + (k >> 1)]);
  }
#endif
  for (long idx = gt; idx < SEQ; idx += gs) {
    double a = 6.283185307179586476925 * (double)idx / SEQ;
    p.twc[idx * 2] = (float)cos(a); p.twc[idx * 2 + 1] = (float)sin(a);
  }
  for (long idx = gt; idx < DSEQ; idx += gs) {
    double a = 6.283185307179586476925 * (double)idx / DSEQ;
    p.twl[idx * 2] = (float)cos(a); p.twl[idx * 2 + 1] = (float)sin(a);
  }
  for (long idx = gt; idx < (long)DEPTH * 256 * 256; idx += gs) {
    int j = idx % 256; int i = (idx / 256) % 256; int l = idx / (256 * 256);
    int hd = i / 64, c = i % 64;
    float sc = 0.f, ss = 0.f;
    for (int m = 0; m < 64; ++m) {
      int k = (m * c) & 63;
      float ang = 6.283185307179586f * (float)k / 64.f;
      float wv = p.w_fourier[((long)l * 256 + hd * 64 + m) * 256 + j];
      sc += cosf(ang) * wv; ss += sinf(ang) * wv;
    }
    p.wcs[((long)l * 256 + i) * 512 + j] = sc * 0.125f;
    p.wcs[((long)l * 256 + i) * 512 + 256 + j] = ss * 0.125f;
  }
}
DEVFN void ph_init1(const Params& p) {
  PHASE_BEGIN;
  const long gt = GTID, gs = GSIZE;
  for (long idx = gt; idx < (long)DEPTH * D * NP; idx += gs) {
    int j = idx % NP; int d = (idx / NP) % D; int l = idx / ((long)NP * D);
    const float* wrow = p.w_in + ((long)l * D + d) * IN_W;
    float v;
    if (j < PC_P) v = wrow[j];
    else if (j >= PC_U) v = wrow[1024 + (j - PC_U)];
    else {
      int jj = j - PC_P;
      float acc = 0.f;
      for (int i = 0; i < 256; ++i) acc += wrow[768 + i] * p.wcs[((long)l * 256 + i) * 512 + jj];
      v = acc;
    }
    p.win2[idx] = v;
#ifdef HAVE_FAST
    p.win2t[((long)l * NP + j) * D + d] = f2bf(v);
#endif
  }
}

DEVFN long pqt_base(int lat, int b) { return lat ? (long)TC * 512 + (long)b * 512 * DSEQ : (long)b * 512 * SEQ; }
DEVFN void ph_row1(const Params& p, int l) {
  PHASE_BEGIN;
  for (long t = GTID; t < T; t += GSIZE) {
    TokInfo ti = tokinfo((int)t);
    float* yb = p.ybuf + t * D;
    const float *g, *b;
    float sum = 0.f;
    if (l == 0) {
      const float* src = ti.lat ? p.x_sample + (t - TC) * D : p.x_prompt + t * D;
      for (int d = 0; d < D; ++d) { float v = src[d]; yb[d] = v; sum += v; }
      g = p.ln_in_g; b = p.ln_in_b;
    } else {
      const float* gate2 = modp(p, l - 1, ti.ci, 5);
      const float* xr = p.x + t * D;
      for (int d = 0; d < D; ++d) {
        float m = 0.f;
        for (int e = 0; e < NE; ++e) {
          int s = p.inv[t * NE + e];
          if (s >= 0) m += lda(p.ys + ((long)e * NS + s) * D + d);
        }
        float v = ALPHA * xr[d] + gate2[d] * m;
        yb[d] = v; sum += v;
      }
      g = p.ln2_g + (long)(l - 1) * D; b = p.ln2_b + (long)(l - 1) * D;
    }
    float mu = sum / D, var = 0.f;
    for (int d = 0; d < D; ++d) { float dv = yb[d] - mu; var += dv * dv; }
    float rs = 1.f / sqrtf(var / D + LN_EPS);
    if (l < DEPTH) {
      const float* sh = modp(p, l, ti.ci, 0); const float* sc = modp(p, l, ti.ci, 1);
      for (int d = 0; d < D; ++d) {
        float xv = (yb[d] - mu) * rs * g[d] + b[d];
        p.x[t * D + d] = xv;
        sta(p.h + t * D + d, xv * (1.f + sc[d]) + sh[d]);
      }
    } else {
      float* o = p.out + (ti.lat ? O_YS + (t - TC) * D : O_YP + t * D);
      for (int d = 0; d < D; ++d) o[d] = (yb[d] - mu) * rs * g[d] + b[d];
    }
  }
}

DEVFN void inproj_store(const Params& p, int l, long t, const TokInfo& ti, int j, float a0, float a1) {
  if (ti.lat && j < PC_V) {
    int i = (j % HD) / 2;
    int pos = (i < 16) ? (ti.n / GRID_W) : (ti.n % GRID_W);
    int fi = i & 15;
    float freq = powf(10000.f, -(float)fi / 16.f);
    float ang = (float)pos * freq;
    float cs = cosf(ang), sn = sinf(ang);
    float r0 = a0 * cs - a1 * sn, r1 = a0 * sn + a1 * cs;
    a0 = r0; a1 = r1;
  }
  if (j < PC_P) { sta(p.proj + t * NPJ + j, a0); sta(p.proj + t * NPJ + j + 1, a1); }
  else if (j >= PC_U) { sta(p.proj + t * NPJ + PJ_U + (j - PC_U), a0); sta(p.proj + t * NPJ + PJ_U + (j - PC_U) + 1, a1); }
  else {
    int jj = j - PC_P; int isq = jj >= 256; int jc = jj & 255;
    act_t* dst = p.pqt + pqt_base(ti.lat, ti.b) + (long)jc * 2 * ti.N + (isq ? ti.N : 0) + ti.n;
    sta(dst, a0); sta(dst + 2 * ti.N, a1);
  }
  if (!ti.lat && j >= PC_K && j < PC_P) {
    long base = (((long)ti.b * DEPTH + l) * SEQ + ti.n) * KV_W;
    if (j < PC_V) { p.out[O_K + base + (j - PC_K)] = a0; p.out[O_K + base + (j - PC_K) + 1] = a1; }
    else { p.out[O_V + base + (j - PC_V)] = a0; p.out[O_V + base + (j - PC_V) + 1] = a1; }
  }
}
DEVFN void ph_gemm_in(const Params& p, int l) {
  PHASE_BEGIN;
  for (long idx = GTID; idx < (long)T * (NP / 2); idx += GSIZE) {
    int jp = idx % (NP / 2); long t = idx / (NP / 2);
    int j = jp * 2;
    const act_t* hr = p.h + t * D;
    const float* w = p.win2 + (long)l * D * NP + j;
    float a0 = 0.f, a1 = 0.f;
    for (int d = 0; d < D; ++d) { float hv = lda(hr + d); a0 += hv * w[(long)d * NP]; a1 += hv * w[(long)d * NP + 1]; }
    TokInfo ti = tokinfo((int)t);
    inproj_store(p, l, t, ti, j, a0, a1);
  }
}

DEVFN float ldv(const float* p) { return *p; }
#ifdef ACT_BF16
DEVFN float ldv(const bf16_t* p) { return bf2f(*p); }
#endif
template <class KT>
DEVFN void attn_key(const float* q, const KT* kr, const KT* vr, float& m, float& den, float* acc) {
  float s = 0.f;
#pragma unroll
  for (int d = 0; d < HD; ++d) s += q[d] * ldv(kr + d);
  s *= 0.125f;
  if (s > m) {
    float f = expf(m - s);
    den *= f;
#pragma unroll
    for (int d = 0; d < HD; ++d) acc[d] *= f;
    m = s;
  }
  float pw = expf(s - m);
  den += pw;
#pragma unroll
  for (int d = 0; d < HD; ++d) acc[d] += pw * ldv(vr + d);
}
DEVFN void ph_attn(const Params& p, int l) {
  PHASE_BEGIN;
  for (long idx = GTID; idx < (long)T * NH; idx += GSIZE) {
    int hh = idx % NH; long t = idx / NH;
    TokInfo ti = tokinfo((int)t);
    int kvh = hh / GQA;
    float q[HD], acc[HD];
#pragma unroll
    for (int d = 0; d < HD; ++d) { q[d] = lda(p.proj + t * NPJ + PJ_Q + hh * HD + d); acc[d] = 0.f; }
    float m = p.attn_sink[l * NH + hh], den = 1.f;
    int j0 = 0, j1 = ti.N;
    if (ti.lat) { j0 = ti.n - WINDOW < 0 ? 0 : ti.n - WINDOW; j1 = ti.n + WINDOW + 1 > ti.N ? ti.N : ti.n + WINDOW + 1; }
    for (int j = j0; j < j1; ++j) {
      const act_t* kr = p.proj + (long)(ti.t0 + j) * NPJ + PJ_K + kvh * HD;
      const act_t* vr = p.proj + (long)(ti.t0 + j) * NPJ + PJ_V + kvh * HD;
      attn_key(q, kr, vr, m, den, acc);
    }
    if (ti.lat) {
      for (int s_ = 0; s_ < PAST; ++s_) {
        long base = ((((long)ti.b * DEPTH + l) * PAST + s_) * NKV + kvh) * HD;
        attn_key(q, p.cache_k + base, p.cache_v + base, m, den, acc);
      }
    }
    float inv = 1.f / den;
#pragma unroll
    for (int d = 0; d < HD; ++d) sta(p.mixcat + t * MIX_W + hh * HD + d, acc[d] * inv);
  }
}
DEVFN void ph_fourier(const Params& p, int l) {
  PHASE_BEGIN;
  for (long idx = GTID; idx < (long)T * FOUR_W; idx += GSIZE) {
    int j = idx % FOUR_W; long t = idx / FOUR_W;
    TokInfo ti = tokinfo((int)t);
    const float* tw = ti.lat ? p.twl : p.twc;
    const act_t* pr = p.pqt + pqt_base(ti.lat, ti.b) + (long)j * 2 * ti.N;
    float acc = 0.f;
    for (int n = 0; n < ti.N; ++n) {
      int k = (int)(((long)ti.n * n) % ti.N);
      acc += tw[k * 2] * lda(pr + n) - tw[k * 2 + 1] * lda(pr + ti.N + n);
    }
    sta(p.mixcat + t * MIX_W + ATTN_W + j, acc / sqrtf((float)ti.N));
  }
}
DEVFN void ph_s5scan(const Params& p, int l) {
  PHASE_BEGIN;
  for (long idx = GTID; idx < (long)NSEQ * 2 * SG * SP; idx += GSIZE) {
    int pp = idx % SP; int g = (idx / SP) % SG; int dir = (idx / (SP * SG)) % 2; int sq = idx / (SP * SG * 2);
    int lat = sq >= BATCH; int b = lat ? sq - BATCH : sq; int N = lat ? DSEQ : SEQ; int t0 = lat ? TC + b * DSEQ : b * SEQ;
    long pi = (((long)l * 2 + dir) * SG + g) * SP + pp;
    float ar = p.abar[pi * 2], ai = p.abar[pi * 2 + 1];
    float br[SH], bi[SH];
#pragma unroll
    for (int h = 0; h < SH; ++h) { br[h] = p.bbar[(pi * SH + h) * 2]; bi[h] = p.bbar[(pi * SH + h) * 2 + 1]; }
    float sr = 0.f, si = 0.f;
    if (lat) {
      long si0 = ((((long)b * DEPTH + l) * 2 + dir) * SG + g) * SP + pp;
      sr = p.st_re[si0]; si = p.st_im[si0];
    }
    for (int k = 0; k < N; ++k) {
      int n = dir ? N - 1 - k : k;
      const act_t* u = p.proj + (long)(t0 + n) * NPJ + PJ_U + g * SH;
      float bur = 0.f, bui = 0.f;
#pragma unroll
      for (int h = 0; h < SH; ++h) { float uv = lda(u + h); bur += br[h] * uv; bui += bi[h] * uv; }
      float nr = ar * sr - ai * si + bur, ni = ar * si + ai * sr + bui;
      sr = nr; si = ni;
      long so = ((((long)(t0 + n) * 2 + dir) * SG + g) * SP + pp) * 2;
      p.states[so] = sr; p.states[so + 1] = si;
    }
    if (!lat) {
      long oo = ((((long)b * DEPTH + l) * 2 + dir) * SG + g) * SP + pp;
      p.out[O_SRE + oo] = sr; p.out[O_SIM + oo] = si;
    }
  }
}
DEVFN void ph_s5y(const Params& p, int l) {
  PHASE_BEGIN;
  for (long idx = GTID; idx < (long)T * S5_W; idx += GSIZE) {
    int c = idx % S5_W; long t = idx / S5_W;
    int g = c / SH, h = c % SH;
    float y = p.s5_d[l * S5_W + c] * lda(p.proj + t * NPJ + PJ_U + c);
    for (int dir = 0; dir < 2; ++dir) {
      const float* cre = p.s5_c_re + ((((long)l * 2 + dir) * SG + g) * SH + h) * SP;
      const float* cim = p.s5_c_im + ((((long)l * 2 + dir) * SG + g) * SH + h) * SP;
      const float* st = p.states + ((((long)t * 2 + dir) * SG + g) * SP) * 2;
      for (int pp = 0; pp < SP; ++pp) y += cre[pp] * st[pp * 2] - cim[pp] * st[pp * 2 + 1];
    }
    sta(p.gbuf + t * S5_W + c, gelu_f(y));
  }
}
DEVFN void ph_s5glu(const Params& p, int l) {
  PHASE_BEGIN;
  for (long idx = GTID; idx < (long)T * S5_W; idx += GSIZE) {
    int j = idx % S5_W; long t = idx / S5_W;
    const act_t* gr = p.gbuf + t * S5_W;
    const float* w = p.s5_w_glu + (long)l * S5_W * S5_W + j;
    float z = 0.f;
    for (int i = 0; i < S5_W; ++i) z += lda(gr + i) * w[(long)i * S5_W];
    sta(p.mixcat + t * MIX_W + ATTN_W + FOUR_W + j, lda(gr + j) * sigmoid_f(z));
  }
}
DEVFN void ph_gemm_out(const Params& p, int l) {
  PHASE_BEGIN;
  for (long idx = GTID; idx < (long)T * D; idx += GSIZE) {
    int j = idx % D; long t = idx / D;
    const act_t* mr = p.mixcat + t * MIX_W;
    const float* w = p.w_out + (long)l * MIX_W * D + j;
    float acc = 0.f;
    for (int i = 0; i < MIX_W; ++i) acc += lda(mr + i) * w[(long)i * D];
    TokInfo ti = tokinfo((int)t);
    p.ybuf[idx] = ALPHA * p.x[idx] + modp(p, l, ti.ci, 2)[j] * acc;
  }
}
DEVFN void ph_row2(const Params& p, int l) {
  PHASE_BEGIN;
  for (long t = GTID; t < T; t += GSIZE) {
    TokInfo ti = tokinfo((int)t);
    const float* yb = p.ybuf + t * D;
    float sum = 0.f;
    for (int d = 0; d < D; ++d) sum += yb[d];
    float mu = sum / D, var = 0.f;
    for (int d = 0; d < D; ++d) { float dv = yb[d] - mu; var += dv * dv; }
    float rs = 1.f / sqrtf(var / D + LN_EPS);
    const float* g = p.ln1_g + (long)l * D; const float* b = p.ln1_b + (long)l * D;
    const float* sh = modp(p, l, ti.ci, 3); const float* sc = modp(p, l, ti.ci, 4);
    float lg[NE];
#pragma unroll
    for (int e = 0; e < NE; ++e) lg[e] = 0.f;
    for (int d = 0; d < D; ++d) {
      float xv = (yb[d] - mu) * rs * g[d] + b[d];
      p.x[t * D + d] = xv;
      float hv = xv * (1.f + sc[d]) + sh[d];
      sta(p.h2 + t * D + d, hv);
      const float* wr = p.w_router + ((long)l * D + d) * NE;
#pragma unroll
      for (int e = 0; e < NE; ++e) lg[e] += hv * wr[e];
    }
    float mx = lg[0];
#pragma unroll
    for (int e = 1; e < NE; ++e) mx = fmaxf(mx, lg[e]);
    float se = 0.f;
#pragma unroll
    for (int e = 0; e < NE; ++e) { lg[e] = expf(lg[e] - mx); se += lg[e]; }
    float is = 1.f / se;
#pragma unroll
    for (int e = 0; e < NE; ++e) p.aff[t * NE + e] = lg[e] * is;
  }
}
DEVFN void ph_topk(const Params& p, int l) {
  PHASE_BEGIN;
  for (long idx = GTID; idx < (long)T * NE; idx += GSIZE) {
    int e = idx % NE; long t = idx / NE;
    TokInfo ti = tokinfo((int)t);
    float a = p.aff[t * NE + e];
    int rank = 0;
    for (int j = 0; j < ti.N; ++j) {
      float aj = p.aff[(long)(ti.t0 + j) * NE + e];
      rank += (aj > a || (aj == a && j < ti.n)) ? 1 : 0;
    }
    int cap = ti.lat ? CAPL : CAPC;
    int slot = -1;
    if (rank < cap) {
      slot = ti.lat ? BATCH * CAPC + ti.b * CAPL + rank : ti.b * CAPC + rank;
      p.seltok[e * NS + slot] = (int)t;
      p.selgate[e * NS + slot] = a;
    }
    p.inv[t * NE + e] = slot;
  }
}
DEVFN void ph_moe1(const Params& p, int l) {
  PHASE_BEGIN;
  for (long idx = GTID; idx < (long)NE * NS * FF; idx += GSIZE) {
    int f = idx % FF; int s = (idx / FF) % NS; int e = idx / ((long)FF * NS);
    int tok = p.seltok[e * NS + s];
    const act_t* hr = p.h2 + (long)tok * D;
    const float* wg = p.w_gate + (((long)l * NE + e) * D) * FF + f;
    const float* wu = p.w_up + (((long)l * NE + e) * D) * FF + f;
    float ag = 0.f, au = 0.f;
    for (int d = 0; d < D; ++d) { float hv = lda(hr + d); ag += hv * wg[(long)d * FF]; au += hv * wu[(long)d * FF]; }
    sta(p.hid + idx, silu_f(ag) * au);
  }
}
DEVFN void ph_moe2(const Params& p, int l) {
  PHASE_BEGIN;
  for (long idx = GTID; idx < (long)NE * NS * D; idx += GSIZE) {
    int d = idx % D; int s = (idx / D) % NS; int e = idx / ((long)D * NS);
    const act_t* hr = p.hid + ((long)e * NS + s) * FF;
    const float* wd = p.w_down + (((long)l * NE + e) * FF) * D + d;
    float acc = 0.f;
    for (int f = 0; f < FF; ++f) acc += lda(hr + f) * wd[(long)f * D];
    sta(p.ys + idx, acc * p.selgate[e * NS + s]);
  }
}

constexpr int PH_PER_LAYER = 10;
constexpr int NPHASE = 2 + PH_PER_LAYER * DEPTH + 1;
#ifndef HAVE_FAST
DEVFN void run_phase(const Params& p, int ph) {
  if (ph == 0) { ph_init0(p); return; }
  if (ph == 1) { ph_init1(p); return; }
  int l = (ph - 2) / PH_PER_LAYER, s = (ph - 2) % PH_PER_LAYER;
  if (l == DEPTH) { ph_row1(p, DEPTH); return; }
  switch (s) {
    case 0: ph_row1(p, l); break;
    case 1: ph_gemm_in(p, l); break;
    case 2: ph_attn(p, l); ph_fourier(p, l); ph_s5scan(p, l); break;
    case 3: ph_s5y(p, l); break;
    case 4: ph_s5glu(p, l); break;
    case 5: ph_gemm_out(p, l); break;
    case 6: ph_row2(p, l); break;
    case 7: ph_topk(p, l); break;
    case 8: ph_moe1(p, l); break;
    case 9: ph_moe2(p, l); break;
  }
}
#endif
#define XB_TMO      128
#define XB_XCNT(j)  (256  + 64 * (j))
#define XB_XSUB(j)  (1280 + 64 * (j))
#define XB_XGEN(j)  (2304 + 64 * (j))
#define XB_TOP      3328
#define XB_TOPGEN   3392
#define XCD_BAR_WORDS 3456
#define XB_SPIN_CAP (1u << 20)
#define LAS __attribute__((address_space(3)))
DEVFN unsigned xb_ld(unsigned* p)              { return __hip_atomic_load(p, __ATOMIC_RELAXED, __HIP_MEMORY_SCOPE_AGENT); }
DEVFN unsigned xb_add(unsigned* p, unsigned v) { return __hip_atomic_fetch_add(p, v, __ATOMIC_RELAXED, __HIP_MEMORY_SCOPE_AGENT); }
DEVFN unsigned xb_xcc_id() { return (unsigned)__builtin_amdgcn_s_getreg((3 << 11) | 20) & 0xFu; }
#define XB_SPIN(cond, bar) do { unsigned _sp = 0; while (cond) { __builtin_amdgcn_s_sleep(1); \
    if ((++_sp & 255u) == 0u) { if (xb_ld(&(bar)[XB_TMO])) break; if (_sp > XB_SPIN_CAP) { atomicAdd(&(bar)[XB_TMO], 1u); break; } } } } while (0)
struct XcdBarrier { unsigned* bar; unsigned x; volatile LAS unsigned* st; };
DEVFN XcdBarrier xcd_barrier_post(unsigned* bar, volatile LAS unsigned* st) {
    XcdBarrier b; b.bar = bar; b.x = xb_xcc_id(); b.st = st;
    if (threadIdx.x == 0) (void)xb_add(&bar[XB_XCNT(b.x)], 1u);
    return b;
}
DEVFN void xcd_barrier_complete(unsigned* bar, unsigned x, unsigned& nloc, unsigned& nx) {
    const unsigned G = gridDim.x * gridDim.y * gridDim.z;
    unsigned sum, cnt, mine, sp = 0u;
    for (;;) {
        sum = 0u; cnt = 0u; mine = 0u;
#pragma unroll
        for (unsigned j = 0; j < 16; ++j) { const unsigned c = xb_ld(&bar[XB_XCNT(j)]); sum += c; cnt += (c > 0u) ? 1u : 0u; mine = (j == x) ? c : mine; }
        if (sum == G) break;
        __builtin_amdgcn_s_sleep(1);
        if ((++sp & 255u) == 0u) { if (xb_ld(&bar[XB_TMO])) break; if (sp > XB_SPIN_CAP) { atomicAdd(&bar[XB_TMO], 1u); break; } }
    }
    nloc = mine > 0u ? mine : 1u; nx = cnt > 0u ? cnt : 1u;
}
DEVFN void xcd_barrier(const XcdBarrier& b) {
    asm volatile("s_waitcnt vmcnt(0)" ::: "memory");
    __syncthreads();
    if (threadIdx.x == 0) {
        unsigned* bar = b.bar;
        __builtin_amdgcn_s_waitcnt(0);
        unsigned nloc = b.st[0], nx = b.st[1];
        if (nloc == 0u) { xcd_barrier_complete(bar, b.x, nloc, nx); b.st[0] = nloc; b.st[1] = nx; }
        const unsigned old = xb_add(&bar[XB_XSUB(b.x)], 1u);
        const unsigned gen = old / nloc;
        if (old + 1u == (gen + 1u) * nloc) {
            __builtin_amdgcn_fence(__ATOMIC_RELEASE, "agent");
            asm volatile("s_waitcnt vmcnt(0)" ::: "memory");
            const unsigned og = xb_add(&bar[XB_TOP], 1u);
            const unsigned tg = og / nx;
            if (og + 1u == (tg + 1u) * nx) xb_add(&bar[XB_TOPGEN], 1u);
            else XB_SPIN(xb_ld(&bar[XB_TOPGEN]) == tg, bar);
            __builtin_amdgcn_fence(__ATOMIC_ACQUIRE, "agent");
            xb_add(&bar[XB_XGEN(b.x)], 1u);
            asm volatile("s_waitcnt vmcnt(0)" ::: "memory");
        } else {
            XB_SPIN(xb_ld(&bar[XB_XGEN(b.x)]) == gen, bar);
            __builtin_amdgcn_fence(__ATOMIC_ACQUIRE, "agent");
            asm volatile("s_waitcnt vmcnt(0)" ::: "memory");
        }
    }
    __syncthreads();
}

template <class Fill>
DEVFN void xcd_barrier_fill(const XcdBarrier& b, volatile LAS unsigned* lead, Fill fill) {
    asm volatile("s_waitcnt vmcnt(0)" ::: "memory");
    __syncthreads();
    unsigned gen = 0u, nloc = 1u, nx = 1u;
    unsigned* bar = b.bar; unsigned bx = b.x;
    asm volatile("" : "+s"(bar), "+s"(bx));
    if (threadIdx.x == 0) {
        __builtin_amdgcn_s_waitcnt(0);
        nloc = b.st[0]; nx = b.st[1];
        if (nloc == 0u) { xcd_barrier_complete(bar, bx, nloc, nx); b.st[0] = nloc; b.st[1] = nx; }
        const unsigned old = xb_add(&bar[XB_XSUB(bx)], 1u);
        gen = old / nloc;
        *lead = (old + 1u == (gen + 1u) * nloc) ? 1u : 0u;
    }
    __syncthreads();
    const unsigned role = *lead;
    const bool leader = role == 1u;
    if (role == 0u) fill();
    asm volatile("" : "+s"(bar), "+s"(bx));
    if (threadIdx.x == 0) {
        if (leader) {
            __builtin_amdgcn_fence(__ATOMIC_RELEASE, "agent");
            asm volatile("s_waitcnt vmcnt(0)" ::: "memory");
            const unsigned og = xb_add(&bar[XB_TOP], 1u);
            const unsigned tg = og / nx;
            if (og + 1u == (tg + 1u) * nx) xb_add(&bar[XB_TOPGEN], 1u);
            else XB_SPIN(xb_ld(&bar[XB_TOPGEN]) == tg, bar);
            __builtin_amdgcn_fence(__ATOMIC_ACQUIRE, "agent");
            xb_add(&bar[XB_XGEN(bx)], 1u);
            asm volatile("s_waitcnt vmcnt(0)" ::: "memory");
        } else {
            XB_SPIN(xb_ld(&bar[XB_XGEN(bx)]) == gen, bar);
            __builtin_amdgcn_fence(__ATOMIC_ACQUIRE, "agent");
            asm volatile("s_waitcnt vmcnt(0)" ::: "memory");
        }
    }
    __syncthreads();
}
typedef __attribute__((ext_vector_type(8))) short bf16x8;
typedef __attribute__((ext_vector_type(16))) float f32x16;
typedef __attribute__((ext_vector_type(4))) float f32x4;

DEVFN float sigmoid_fast(float x) { return __frcp_rn(1.f + __expf(-x)); }
DEVFN float silu_fast(float x) { return x * sigmoid_fast(x); }
DEVFN float gelu_fast(float x) { float u = 0.7978845608028654f * (x + 0.044715f * x * x * x); return x * sigmoid_fast(2.f * u); }
typedef __attribute__((ext_vector_type(2))) float f32x2_t;
typedef __attribute__((ext_vector_type(2))) __bf16 bf16x2_t;
DEVFN unsigned cvtpk(float lo, float hi) { f32x2_t v = {lo, hi}; bf16x2_t b = __builtin_convertvector(v, bf16x2_t); return __builtin_bit_cast(unsigned, b); }

constexpr int G_ROWB = 144, G_TILEB = 128 * G_ROWB, G_STAGEB = 2 * G_TILEB;
constexpr int SMEM_BYTES = 2 * G_STAGEB;

struct U4x4 { uint4 a, b, c, d; };
struct F4x8 { f32x4 f0, f1, f2, f3, f4, f5, f6, f7; };
struct RowLoader {
  const bf16_t *r0, *r1, *r2, *r3;
  DEVFN U4x4 operator()(int kt) const {
    U4x4 v;
    v.a = *(const uint4*)(r0 + kt * 64); v.b = *(const uint4*)(r1 + kt * 64);
    v.c = *(const uint4*)(r2 + kt * 64); v.d = *(const uint4*)(r3 + kt * 64);
    return v;
  }
};
struct BF32Loader { const float* bp; long ldb; };

DEVFN void rl_store(char* tile, int tid, const U4x4& v) {
  char* d = tile + (tid >> 3) * G_ROWB + (tid & 7) * 16;
  *(uint4*)(d) = v.a; *(uint4*)(d + 32 * G_ROWB) = v.b; *(uint4*)(d + 64 * G_ROWB) = v.c; *(uint4*)(d + 96 * G_ROWB) = v.d;
}
DEVFN F4x8 bf_load(const BF32Loader& L, int kt) {
  F4x8 f;
  const float* b = L.bp + (long)(kt * 64) * L.ldb;
  f.f0 = *(const f32x4*)(b); f.f1 = *(const f32x4*)(b + L.ldb); f.f2 = *(const f32x4*)(b + 2 * L.ldb); f.f3 = *(const f32x4*)(b + 3 * L.ldb);
  f.f4 = *(const f32x4*)(b + 4 * L.ldb); f.f5 = *(const f32x4*)(b + 5 * L.ldb); f.f6 = *(const f32x4*)(b + 6 * L.ldb); f.f7 = *(const f32x4*)(b + 7 * L.ldb);
  return f;
}
template <int I>
DEVFN uint4 bf_pack(const F4x8& f) {
  uint4 wv;
  wv.x = cvtpk(f.f0[I], f.f1[I]); wv.y = cvtpk(f.f2[I], f.f3[I]); wv.z = cvtpk(f.f4[I], f.f5[I]); wv.w = cvtpk(f.f6[I], f.f7[I]);
  return wv;
}
DEVFN void bf_store(char* tile, int tid, const F4x8& f) {
  int lane = tid & 63, w = tid >> 6, kg = lane & 7, ng = w * 8 + (lane >> 3);
  char* d = tile + (4 * ng) * G_ROWB + kg * 16;
  *(uint4*)(d) = bf_pack<0>(f); *(uint4*)(d + G_ROWB) = bf_pack<1>(f); *(uint4*)(d + 2 * G_ROWB) = bf_pack<2>(f); *(uint4*)(d + 3 * G_ROWB) = bf_pack<3>(f);
}

DEVFN void gemm_compute(const char* st, int wm, int wn, int fro, f32x16 (&acc)[2][2]) {
  const char* sA = st + wm * 64 * G_ROWB + fro;
  const char* sB = st + G_TILEB + wn * 64 * G_ROWB + fro;
#pragma unroll
  for (int ks = 0; ks < 4; ++ks) {
    bf16x8 a0 = *(const bf16x8*)(sA + ks * 32);
    bf16x8 a1 = *(const bf16x8*)(sA + 32 * G_ROWB + ks * 32);
    bf16x8 b0 = *(const bf16x8*)(sB + ks * 32);
    bf16x8 b1 = *(const bf16x8*)(sB + 32 * G_ROWB + ks * 32);
    acc[0][0] = __builtin_amdgcn_mfma_f32_32x32x16_bf16(a0, b0, acc[0][0], 0, 0, 0);
    acc[0][1] = __builtin_amdgcn_mfma_f32_32x32x16_bf16(a0, b1, acc[0][1], 0, 0, 0);
    acc[1][0] = __builtin_amdgcn_mfma_f32_32x32x16_bf16(a1, b0, acc[1][0], 0, 0, 0);
    acc[1][1] = __builtin_amdgcn_mfma_f32_32x32x16_bf16(a1, b1, acc[1][1], 0, 0, 0);
  }
}
template <class ALd, class BLd, class Epi>
DEVFN void gemm_tile(char* smem, int tidx_, const ALd& A, const BLd& B, int KT, Epi epi) {
  const int tid = tidx_, lane = tid & 63, wave = tid >> 6, wm = wave >> 1, wn = wave & 1;
  f32x16 acc[2][2];
#pragma unroll
  for (int i = 0; i < 2; ++i)
#pragma unroll
    for (int j = 0; j < 2; ++j)
#pragma unroll
      for (int r = 0; r < 16; ++r) acc[i][j][r] = 0.f;
  const int fro = (lane & 31) * G_ROWB + (lane >> 5) * 16;
  U4x4 a0 = A(0), b0 = B(0);
  U4x4 a1 = A(1), b1 = B(1);
  rl_store(smem, tid, a0); rl_store(smem + G_TILEB, tid, b0);
  __syncthreads();
  for (int kt = 0; kt < KT; kt += 2) {
    if (kt + 2 < KT) { a0 = A(kt + 2); b0 = B(kt + 2); }
    gemm_compute(smem, wm, wn, fro, acc);
    rl_store(smem + G_STAGEB, tid, a1); rl_store(smem + G_STAGEB + G_TILEB, tid, b1);
    __syncthreads();
    if (kt + 3 < KT) { a1 = A(kt + 3); b1 = B(kt + 3); }
    gemm_compute(smem + G_STAGEB, wm, wn, fro, acc);
    if (kt + 2 < KT) { rl_store(smem, tid, a0); rl_store(smem + G_TILEB, tid, b0); }
    __syncthreads();
  }
#pragma unroll
  for (int mt = 0; mt < 2; ++mt)
#pragma unroll
    for (int q = 0; q < 4; ++q)
#pragma unroll
      for (int nt = 0; nt < 2; ++nt) {
        int row = wm * 64 + mt * 32 + 8 * q + 4 * (lane >> 5);
        int col = wn * 64 + nt * 32 + (lane & 31);
        epi(nt, row, col, acc[mt][nt][4 * q], acc[mt][nt][4 * q + 1], acc[mt][nt][4 * q + 2], acc[mt][nt][4 * q + 3]);
      }
}

template <class ALd, class BLd, class Epi>
DEVFN void gemm_tile1(char* smem, int tidx_, const ALd& A, const BLd& B, int KT, Epi epi) {
  const int tid = tidx_, lane = tid & 63, wave = tid >> 6, wm = wave >> 1, wn = wave & 1;
  f32x16 acc[2][2];
#pragma unroll
  for (int i = 0; i < 2; ++i)
#pragma unroll
    for (int j = 0; j < 2; ++j)
#pragma unroll
      for (int r = 0; r < 16; ++r) acc[i][j][r] = 0.f;
  const int fro = (lane & 31) * G_ROWB + (lane >> 5) * 16;
  U4x4 av = A(0), bv = B(0);
  rl_store(smem, tid, av); rl_store(smem + G_TILEB, tid, bv);
  __syncthreads();
  for (int kt = 0; kt < KT; ++kt) {
    const int cur = kt & 1;
    const bool more = kt + 1 < KT;
    if (more) { av = A(kt + 1); bv = B(kt + 1); }
    gemm_compute(smem + cur * G_STAGEB, wm, wn, fro, acc);
    if (more) { char* st = smem + (cur ^ 1) * G_STAGEB; rl_store(st, tid, av); rl_store(st + G_TILEB, tid, bv); }
    __syncthreads();
  }
#pragma unroll
  for (int mt = 0; mt < 2; ++mt)
#pragma unroll
    for (int q = 0; q < 4; ++q)
#pragma unroll
      for (int nt = 0; nt < 2; ++nt) {
        int row = wm * 64 + mt * 32 + 8 * q + 4 * (lane >> 5);
        int col = wn * 64 + nt * 32 + (lane & 31);
        epi(nt, row, col, acc[mt][nt][4 * q], acc[mt][nt][4 * q + 1], acc[mt][nt][4 * q + 2], acc[mt][nt][4 * q + 3]);
      }
}

constexpr int GL_TILEB = 128 * 128, GL_STAGEB = 2 * GL_TILEB;
struct GRows { const bf16_t *r0, *r1, *r2, *r3; };
DEVFN int g_chunk(int tid) { return ((tid & 7) ^ ((tid >> 4) & 7)) * 8; }
DEVFN GRows make_grows(int tid, const bf16_t* base, long row0, long ld) {
  GRows L;
  const bf16_t* b0 = base + (row0 + (tid >> 3)) * ld + g_chunk(tid);
  L.r0 = b0; L.r1 = b0 + 32 * ld; L.r2 = b0 + 64 * ld; L.r3 = b0 + 96 * ld;
  return L;
}
DEVFN void glds16_nt(const bf16_t* src, unsigned lds_dst) {
  unsigned keep;
  asm volatile("s_mov_b32 %0, m0\n\ts_mov_b32 m0, %2\n\ts_nop 0\n\tglobal_load_lds_dwordx4 %1, off nt\n\ts_mov_b32 m0, %0"
               : "=&s"(keep) : "v"(src), "s"(lds_dst));
}
DEVFN void glds16(const bf16_t* src, unsigned lds_dst) {
  unsigned keep;
  asm volatile("s_mov_b32 %0, m0\n\ts_mov_b32 m0, %2\n\ts_nop 0\n\tglobal_load_lds_dwordx4 %1, off\n\ts_mov_b32 m0, %0"
               : "=&s"(keep) : "v"(src), "s"(lds_dst));
}
DEVFN unsigned lds_addr(const char* p) { return (unsigned)(unsigned long)(const __attribute__((address_space(3))) char*)p; }
DEVFN void g_stage(char* st, int wave, const GRows& A, const GRows& B, int kt) {
  const unsigned sa = (unsigned)__builtin_amdgcn_readfirstlane((int)(lds_addr(st) + wave * 1024));
  const unsigned sb = sa + GL_TILEB;
  glds16(A.r0 + kt * 64, sa); glds16(A.r1 + kt * 64, sa + 4096); glds16(A.r2 + kt * 64, sa + 8192); glds16(A.r3 + kt * 64, sa + 12288);
  glds16(B.r0 + kt * 64, sb); glds16(B.r1 + kt * 64, sb + 4096); glds16(B.r2 + kt * 64, sb + 8192); glds16(B.r3 + kt * 64, sb + 12288);
}
template <int I>
DEVFN void g_stage_part(unsigned sa, const GRows& A, const GRows& B, int kt) {
  const bf16_t* ar = I == 0 ? A.r0 : I == 1 ? A.r1 : I == 2 ? A.r2 : A.r3;
  const bf16_t* br = I == 0 ? B.r0 : I == 1 ? B.r1 : I == 2 ? B.r2 : B.r3;
  glds16(ar + kt * 64, sa + I * 4096);
  glds16(br + kt * 64, sa + GL_TILEB + I * 4096);
}
template <class Epi>
DEVFN void gemm_tile_g(char* smem, int tidx_, const GRows& A, const GRows& B, int KT, Epi epi, int koff = 0) {
  const int tid = tidx_, lane = tid & 63, wave = tid >> 6, wm = wave >> 1, wn = wave & 1;
  f32x16 acc[2][2];
#pragma unroll
  for (int i = 0; i < 2; ++i)
#pragma unroll
    for (int j = 0; j < 2; ++j)
#pragma unroll
      for (int r = 0; r < 16; ++r) acc[i][j][r] = 0.f;
  const int sw = (lane >> 1) & 7, h = lane >> 5;
  int off[4];
#pragma unroll
  for (int ks = 0; ks < 4; ++ks) off[ks] = (lane & 31) * 128 + ((((2 * ks) ^ (sw & 6)) | (h ^ (sw & 1))) * 16);
  const unsigned sbase = (unsigned)__builtin_amdgcn_readfirstlane((int)(lds_addr(smem) + wave * 1024));
  g_stage(smem, wave, A, B, koff & (KT - 1));
  asm volatile("s_waitcnt vmcnt(0)" ::: "memory");
  __syncthreads();
  for (int kt = 0; kt < KT; ++kt) {
    const int cur = kt & 1;
    const bool more = kt + 1 < KT;
    const int ktn = (kt + 1 + koff) & (KT - 1);
    const unsigned san = sbase + (cur ^ 1) * GL_STAGEB;
    const char* sA = smem + cur * GL_STAGEB + wm * 64 * 128;
    const char* sB = smem + cur * GL_STAGEB + GL_TILEB + wn * 64 * 128;
    bf16x8 fa0[2], fa1[2], fb0[2], fb1[2];
    fa0[0] = *(const bf16x8*)(sA + off[0]); fa1[0] = *(const bf16x8*)(sA + 32 * 128 + off[0]);
    fb0[0] = *(const bf16x8*)(sB + off[0]); fb1[0] = *(const bf16x8*)(sB + 32 * 128 + off[0]);
#pragma unroll
    for (int ks = 0; ks < 4; ++ks) {
      const int c = ks & 1, n = c ^ 1;
      if (ks < 3) {
        fa0[n] = *(const bf16x8*)(sA + off[ks + 1]); fa1[n] = *(const bf16x8*)(sA + 32 * 128 + off[ks + 1]);
        fb0[n] = *(const bf16x8*)(sB + off[ks + 1]); fb1[n] = *(const bf16x8*)(sB + 32 * 128 + off[ks + 1]);
      }
      __builtin_amdgcn_sched_barrier(0);
      if (more) {
        if (ks == 0) { g_stage_part<0>(san, A, B, ktn); g_stage_part<1>(san, A, B, ktn); }
        else if (ks == 1) { g_stage_part<2>(san, A, B, ktn); g_stage_part<3>(san, A, B, ktn); }
      }
      acc[0][0] = __builtin_amdgcn_mfma_f32_32x32x16_bf16(fa0[c], fb0[c], acc[0][0], 0, 0, 0);
      acc[0][1] = __builtin_amdgcn_mfma_f32_32x32x16_bf16(fa0[c], fb1[c], acc[0][1], 0, 0, 0);
      acc[1][0] = __builtin_amdgcn_mfma_f32_32x32x16_bf16(fa1[c], fb0[c], acc[1][0], 0, 0, 0);
      acc[1][1] = __builtin_amdgcn_mfma_f32_32x32x16_bf16(fa1[c], fb1[c], acc[1][1], 0, 0, 0);
      __builtin_amdgcn_sched_barrier(0);
    }
    asm volatile("s_waitcnt vmcnt(0)" ::: "memory");
    __syncthreads();
  }
#pragma unroll
  for (int mt = 0; mt < 2; ++mt)
#pragma unroll
    for (int q = 0; q < 4; ++q)
#pragma unroll
      for (int nt = 0; nt < 2; ++nt) {
        int row = wm * 64 + mt * 32 + 8 * q + 4 * (lane >> 5);
        int col = wn * 64 + nt * 32 + (lane & 31);
        epi(nt, row, col, acc[mt][nt][4 * q], acc[mt][nt][4 * q + 1], acc[mt][nt][4 * q + 2], acc[mt][nt][4 * q + 3]);
      }
}

DEVFN int xcd_order(int v, int nblocks, int grp) {
  if (nblocks != 512) return v;
  const int it = v / nblocks, b = v % nblocks;
  const int x = b & 7, slot = b >> 3, per = nblocks >> 3;
  const int q = it * per + slot;
  return ((q / grp) * 8 + x) * grp + (q % grp);
}
struct PatchTile { int tm, tn, koff; };
DEVFN PatchTile patch8(int v, int nblocks, int& pidx) {
  const int it = v / nblocks, b = v % nblocks;
  const int x = b & 7, slot = b >> 3;
  PatchTile t; t.tm = slot & 7; t.tn = slot >> 3; t.koff = (t.tm + t.tn) & 7;
  pidx = it * 8 + x;
  return t;
}
DEVFN RowLoader make_rows(int tidx_, const bf16_t* base, long row0, long ld) {
  RowLoader L; int tid = tidx_;
  const bf16_t* b0 = base + (row0 + (tid >> 3)) * ld + (tid & 7) * 8;
  L.r0 = b0; L.r1 = b0 + 32 * ld; L.r2 = b0 + 64 * ld; L.r3 = b0 + 96 * ld;
  return L;
}
DEVFN float shx1(float v) { return __builtin_bit_cast(float, __builtin_amdgcn_mov_dpp(__builtin_bit_cast(int, v), 0xB1, 0xF, 0xF, true)); }
DEVFN void store4_bf16(bf16_t* p0, long ld, bool odd, float v0, float v1, float v2, float v3) {
  bf16_t* q = odd ? p0 + ld - 1 : p0;
  const float y0 = shx1(odd ? v0 : v1), y1 = shx1(odd ? v2 : v3);
  *(unsigned*)q = cvtpk(odd ? y0 : v0, odd ? v1 : y0);
  *(unsigned*)(q + 2 * ld) = cvtpk(odd ? y1 : v2, odd ? v3 : y1);
}

DEVFN void ph_init_fast(const Params& p) {
  PHASE_BEGIN;
  const long gt = GTID, gs = GSIZE;
  for (long idx = gt; idx < (long)DEPTH * D * MIX_W; idx += gs) {
    int k = idx % MIX_W; int n = (idx / MIX_W) % D; int l = idx / ((long)MIX_W * D);
    p.woutt[idx] = f2bf(p.w_out[((long)l * MIX_W + k) * D + n]);
  }
  for (long idx = gt; idx < (long)DEPTH * S5_W * S5_W; idx += gs) {
    int k = idx % S5_W; int n = (idx / S5_W) % S5_W; int l = idx / (S5_W * S5_W);
    p.wglut[idx] = f2bf(p.s5_w_glu[((long)l * S5_W + k) * S5_W + n]);
  }
  for (long idx = gt; idx < (long)SEQ * 2 * SEQ; idx += gs) {
    int n2 = idx % (2 * SEQ), k = idx / (2 * SEQ); int n = n2 % SEQ;
    double a = 6.283185307179586476925 * (double)(((long)k * n) % SEQ) / SEQ;
    double v = (n2 < SEQ ? cos(a) : -sin(a)) / sqrt((double)SEQ);
    p.dftc[idx] = f2bf((float)v);
  }
  for (long idx = gt; idx < (long)DSEQ * 2 * DSEQ; idx += gs) {
    int n2 = idx % (2 * DSEQ), k = idx / (2 * DSEQ); int n = n2 % DSEQ;
    double a = 6.283185307179586476925 * (double)(((long)k * n) % DSEQ) / DSEQ;
    double v = (n2 < DSEQ ? cos(a) : -sin(a)) / sqrt((double)DSEQ);
    p.dftl[idx] = f2bf((float)v);
  }
  for (long idx = gt; idx < 64 * 16; idx += gs) {
    int fi = idx % 16, pos = idx / 16;
    float freq = powf(10000.f, -(float)fi / 16.f);
    float ang = (float)pos * freq;
    p.rope[idx * 2] = cosf(ang); p.rope[idx * 2 + 1] = sinf(ang);
  }
}
DEVFN void ph_init_fast2(const Params& p) {
  PHASE_BEGIN;
  const long gt = GTID, gs = GSIZE;
  for (long idx = gt; idx < (long)DEPTH * NP * D; idx += gs) {
    int k = idx % D; int n = (idx / D) % NP; int l = idx / ((long)D * NP);
    p.win2t[idx] = f2bf(p.win2[((long)l * D + k) * NP + n]);
  }
}

constexpr int CONV_EARLY = 14;
DEVFN void conv_range(const Params& p, int l, int first, int count, char* smem, int tid);
DEVFN void ph_gemm_in_fast(const Params& p, int l, char* smem) {
  PHASE_BEGIN;
  constexpr int NT_N = NP / 128, NT_M = T / 128;
  float* ropes = (float*)(smem + 2 * GL_STAGEB);
  for (int i = tidx_; i < 64 * 16 * 2 / 4; i += 256) ((f32x4*)ropes)[i] = ((const f32x4*)p.rope)[i];
  __syncthreads();
  for (int v = bidx_; v < NT_M * NT_N; v += gridDim.x) {
    const int tile = xcd_order(v, gridDim.x, 8 * NT_N);
    const int tm = tile / NT_N, tn = tile % NT_N;
    const int koff = gridDim.x == 512 ? (tm + tn) & 15 : 0;
    const int m0 = tm * 128, n0 = tn * 128;
    GRows A = make_grows(tidx_, p.h, m0, D);
    GRows B = make_grows(tidx_, p.win2t + (long)l * NP * D, n0, D);
    const TokInfo t0i = tokinfo(m0);
    const int lane = tidx_ & 63;
    const bool odd = lane & 1;
    gemm_tile_g(smem, tidx_, A, B, D / 64, [&](int nt, int row, int col, float v0, float v1, float v2, float v3) {
      const int j = n0 + col;
      const long t = m0 + row;
      const int n = t0i.n + row;
      float v[4] = {v0, v1, v2, v3};
      if (n0 >= PC_P && n0 < PC_U) {
        int jj = j - PC_P; int isq = jj >= 256; int jc = jj & 255;
        bf16_t* dst = p.pqt + pqt_base(t0i.lat, t0i.b) + (long)jc * 2 * t0i.N + (isq ? t0i.N : 0) + n;
        uint2 pk; pk.x = cvtpk(v[0], v[1]); pk.y = cvtpk(v[2], v[3]);
        *(uint2*)dst = pk;
        return;
      }
      float pr[4];
#pragma unroll
      for (int i = 0; i < 4; ++i) pr[i] = shx1(v[i]);
      if (t0i.lat && n0 < PC_V) {
        int pi = (j & 63) >> 1; int fi = pi & 15;
#pragma unroll
        for (int i = 0; i < 4; ++i) {
          int pos = (pi < 16) ? ((n + i) >> 6) : ((n + i) & 63);
          const f32x2_t csn = *(const f32x2_t*)(ropes + (pos * 16 + fi) * 2); const float cs = csn[0], sn = csn[1];
          float x1 = odd ? pr[i] : v[i], x2 = odd ? v[i] : pr[i];
          float r0 = x1 * cs - x2 * sn, r1 = x1 * sn + x2 * cs;
          v[i] = odd ? r1 : r0; pr[i] = odd ? r0 : r1;
        }
      }
      const int pj = (n0 < PC_P) ? j : PJ_U + (j - PC_U);
      {
        bf16_t* q = p.proj + (t + (odd ? 1 : 0)) * NPJ + (pj & ~1);
        *(unsigned*)q = odd ? cvtpk(pr[1], v[1]) : cvtpk(v[0], pr[0]);
        *(unsigned*)(q + 2 * NPJ) = odd ? cvtpk(pr[3], v[3]) : cvtpk(v[2], pr[2]);
      }
      if (!t0i.lat && n0 >= PC_K && n0 < PC_P) {
        float* ob = p.out + (n0 < PC_V ? O_K + (j - PC_K) : O_V + (j - PC_V));
#pragma unroll
        for (int i = 0; i < 4; ++i) ob[(((long)t0i.b * DEPTH + l) * SEQ + n + i) * KV_W] = v[i];
      }
    }, koff);
  }
}
DEVFN void ph_gemm_out_fast(const Params& p, int l, char* smem) {
  PHASE_BEGIN;
  constexpr int NT_N = D / 128, NT_M = T / 128;
  for (int v = bidx_; v < NT_M * NT_N; v += gridDim.x) {
    int tm, tn, koff = 0;
    if (gridDim.x == 512) { int pidx; PatchTile pt = patch8(v, 512, pidx); tm = pidx * 8 + pt.tm; tn = pt.tn; koff = pt.koff; }
    else { tm = v / NT_N; tn = v % NT_N; }
    const int m0 = tm * 128, n0 = tn * 128;
    GRows A = make_grows(tidx_, p.mixcat, m0, MIX_W);
    GRows B = make_grows(tidx_, p.woutt + (long)l * D * MIX_W, n0, MIX_W);
    const TokInfo t0i = tokinfo(m0);
    const float* gate1 = modp(p, l, t0i.ci, 2);
    const int lane_ = tidx_ & 63, cb = n0 + ((tidx_ >> 6) & 1) * 64 + (lane_ & 31);
    const float g0 = gate1[cb], g1 = gate1[cb + 32];
    gemm_tile_g(smem, tidx_, A, B, MIX_W / 64, [&](int nt, int row, int col, float v0, float v1, float v2, float v3) {
      const float g = nt ? g1 : g0;
      store4_bf16((bf16_t*)p.ybuf + (long)(m0 + row) * D + n0 + col, D, lane_ & 1, g * v0, g * v1, g * v2, g * v3);
    }, koff);
  }
}
DEVFN void ph_glu_fast(const Params& p, int l, char* smem) {
  PHASE_BEGIN;
  constexpr int NT_N = S5_W / 128, NT_M = T / 128;
  for (int tile = bidx_; tile < NT_M * NT_N; tile += gridDim.x) {
    const int tm = tile / NT_N, tn = tile % NT_N;
    const int m0 = tm * 128, n0 = tn * 128;
    RowLoader A = make_rows(tidx_, p.gbuf, m0, S5_W);
    RowLoader B = make_rows(tidx_, p.wglut + (long)l * S5_W * S5_W, n0, S5_W);
    const bool odd = tidx_ & 1;
    gemm_tile(smem, tidx_, A, B, S5_W / 64, [&](int nt, int row, int col, float v0, float v1, float v2, float v3) {
      const int j = n0 + col;
      float v[4] = {v0, v1, v2, v3};
#pragma unroll
      for (int i = 0; i < 4; ++i) {
        long t = m0 + row + i;
        float g = bf2f(p.gbuf[t * S5_W + j]);
        float r = g * sigmoid_f(v[i]);
        float pr = shx1(r);
        if (!odd) *(unsigned*)(p.mixcat + t * MIX_W + ATTN_W + FOUR_W + j) = cvtpk(r, pr);
      }
    });
  }
}
DEVFN void fourier_tile(const Params& p, int item, char* smem, int tidx_) {
  constexpr int NL = DB * (DSEQ / 128) * 2 * 2;
  int lat, b, tm, tn, N, hk, KT;
  if (item < NL) { lat = 1; N = DSEQ; hk = item & 1; tn = (item >> 1) & 1; tm = (item >> 2) % (DSEQ / 128); b = item / (4 * (DSEQ / 128)); KT = DSEQ / 64; }
  else { int it = item - NL; lat = 0; N = SEQ; hk = 0; tn = it & 1; tm = (it >> 1) % (SEQ / 128); b = it / (2 * (SEQ / 128)); KT = 2 * SEQ / 64; }
  const int t0 = lat ? TC + b * DSEQ : b * SEQ;
  GRows A = make_grows(tidx_, (lat ? p.dftl : p.dftc) + hk * DSEQ, tm * 128, 2 * N);
  GRows B = make_grows(tidx_, p.pqt + pqt_base(lat, b) + hk * DSEQ, tn * 128, 2 * N);
  const bool odd = tidx_ & 1;
  float* dst = p.win2 + ((long)hk * DB * DSEQ + b * DSEQ + tm * 128) * FOUR_W + tn * 128;
  gemm_tile_g(smem, tidx_, A, B, KT, [&](int nt, int row, int col, float v0, float v1, float v2, float v3) {
    if (lat) {
      float* d = dst + (long)row * FOUR_W + col;
      d[0] = v0; d[FOUR_W] = v1; d[2 * FOUR_W] = v2; d[3 * FOUR_W] = v3;
    } else {
      store4_bf16(p.mixcat + (long)(t0 + tm * 128 + row) * MIX_W + ATTN_W + tn * 128 + col, MIX_W, odd, v0, v1, v2, v3);
    }
  });
}
constexpr int N_FOURIER_ITEMS = DB * (DSEQ / 128) * 2 + BATCH * (SEQ / 128) * 2;
DEVFN void ph_fourier_fast(const Params& p, int l, char* smem) {
  PHASE_BEGIN;
  for (int item = bidx_; item < N_FOURIER_ITEMS; item += gridDim.x) fourier_tile(p, item, smem, tidx_);
}
DEVFN void ph_moe1_fast(const Params& p, int l, char* smem) {
  PHASE_BEGIN;
  constexpr int NT_M = NS / 128, NT_N = FF / 64;
  const int tid = tidx_, lane = tid & 63;
  auto decode = [&](int v, int& tm, int& tn, int& e, int& koff) {
    koff = 0;
    if (gridDim.x == 512) { int pidx; PatchTile pt = patch8(v, 512, pidx); e = pidx >> 1; tm = pt.tm; tn = (pidx & 1) * 8 + pt.tn; koff = pt.koff; }
    else { tm = v % NT_M; tn = (v / NT_M) % NT_N; e = v / (NT_M * NT_N); }
  };
  int sn0 = 0, sn1 = 0, sn2 = 0, sn3 = 0;
  if (bidx_ < NE * NT_M * NT_N) {
    int tm, tn, e, koff; decode(bidx_, tm, tn, e, koff);
    const int* stp = p.seltok + e * NS + tm * 128 + (tid >> 3);
    sn0 = stp[0]; sn1 = stp[32]; sn2 = stp[64]; sn3 = stp[96];
  }
  for (int v = bidx_; v < NE * NT_M * NT_N; v += gridDim.x) {
    int tm, tn, e, koff;
    decode(v, tm, tn, e, koff);
    const int s0 = tm * 128, f0 = tn * 64;
    GRows A;
    {
      const bf16_t* hb = p.h2 + g_chunk(tid);
      A.r0 = hb + (long)sn0 * D; A.r1 = hb + (long)sn1 * D; A.r2 = hb + (long)sn2 * D; A.r3 = hb + (long)sn3 * D;
    }
    if (v + (int)gridDim.x < NE * NT_M * NT_N) {
      int tm2, tn2, e2, koff2; decode(v + gridDim.x, tm2, tn2, e2, koff2);
      const int* stp = p.seltok + e2 * NS + tm2 * 128 + (tid >> 3);
      sn0 = stp[0]; sn1 = stp[32]; sn2 = stp[64]; sn3 = stp[96];
    }
    GRows B;
    {
      const long o = (((long)(l & 1) * NE + e) * FF + f0 + (tid >> 3)) * D + g_chunk(tid);
      B.r0 = p.wgt + o; B.r1 = p.wut + o; B.r2 = p.wgt + o + 32L * D; B.r3 = p.wut + o + 32L * D;
    }
    const bool odd = lane & 1;
    float gsave[4];
    gemm_tile_g(smem, tidx_, A, B, D / 64, [&](int nt, int row, int col, float v0, float v1, float v2, float v3) {
      if (nt == 0) { gsave[0] = v0; gsave[1] = v1; gsave[2] = v2; gsave[3] = v3; return; }
      float v[4] = {v0, v1, v2, v3};
      const int ff = f0 + 32 * (col >> 6) + (col & 31);
      store4_bf16(p.hid + ((long)e * NS + s0 + row) * FF + ff, FF, odd, silu_fast(gsave[0]) * v[0], silu_fast(gsave[1]) * v[1],
                  silu_fast(gsave[2]) * v[2], silu_fast(gsave[3]) * v[3]);
    }, koff);
  }
}
DEVFN void ph_moe2_fast(const Params& p, int l, char* smem) {
  PHASE_BEGIN;
  constexpr int NT_M = NS / 128, NT_N = D / 128;
  const int lane = tidx_ & 63;
  for (int v = bidx_; v < NE * NT_M * NT_N; v += gridDim.x) {
    int tm, tn, e, koff = 0;
    if (gridDim.x == 512) { int pidx; PatchTile pt = patch8(v, 512, pidx); e = pidx; tm = pt.tm; tn = pt.tn; koff = pt.koff; }
    else { tm = v % NT_M; tn = (v / NT_M) % NT_N; e = v / (NT_M * NT_N); }
    const int s0 = tm * 128, n0 = tn * 128;
    GRows A = make_grows(tidx_, p.hid + (long)e * NS * FF, s0, FF);
    GRows B = make_grows(tidx_, p.wdt + ((long)(l & 1) * NE + e) * D * FF, n0, FF);
    const bool odd = lane & 1;
    gemm_tile_g(smem, tidx_, A, B, FF / 64, [&](int nt, int row, int col, float v0, float v1, float v2, float v3) {
      store4_bf16(p.ys + ((long)e * NS + s0 + row) * D + n0 + col, D, odd, v0, v1, v2, v3);
    }, koff);
  }
}
template <int CTRL> DEVFN float dppf(float v) {
  return __builtin_bit_cast(float, __builtin_amdgcn_mov_dpp(__builtin_bit_cast(int, v), CTRL, 0xF, 0xF, true));
}
DEVFN float rdlane(float v, int l) { return __builtin_bit_cast(float, __builtin_amdgcn_readlane(__builtin_bit_cast(int, v), l)); }
DEVFN float wave_sum(float v) {
  v += dppf<0xB1>(v);
  v += dppf<0x4E>(v);
  v += dppf<0x141>(v);
  v += dppf<0x140>(v);
  return (rdlane(v, 0) + rdlane(v, 16)) + (rdlane(v, 32) + rdlane(v, 48));
}
DEVFN float bflo(unsigned u) { return u_as_f(u << 16); }
DEVFN float bfhi(unsigned u) { return u_as_f(u & 0xffff0000u); }

struct RowX { f32x4 a0, a1, a2, a3; };
struct RowG { uint2 u00, u01, u02, u03, u10, u11, u12, u13, u20, u21, u22, u23, u30, u31, u32, u33; float g0, g1, g2, g3; unsigned rest; };
DEVFN void ph_row1_fast(const Params& p, int l, char* smem) {
  PHASE_BEGIN;
  const int lane = tidx_ & 63, d0 = 4 * lane;
  float* prm = (float*)smem;
  for (int t4 = (bidx_ * 4 + (tidx_ >> 6)) * 4; t4 < T; t4 += gridDim.x * 16) {
    TokInfo ti = tokinfo(t4);
    const float *pxs = p.x_sample, *pxp = p.x_prompt, *px = p.x, *pg0 = p.ln_in_g, *pb0 = p.ln_in_b, *pg2 = p.ln2_g, *pb2 = p.ln2_b;
    asm volatile("" : "+s"(pxs), "+s"(pxp), "+s"(px), "+s"(pg0), "+s"(pb0), "+s"(pg2), "+s"(pb2));
    const float* src4 = l == 0 ? (ti.lat ? pxs + (long)(t4 - TC) * D : pxp + (long)t4 * D) : px + (long)t4 * D;
    const float* g = l == 0 ? pg0 : pg2 + (long)(l - 1) * D;
    const float* b = l == 0 ? pb0 : pb2 + (long)(l - 1) * D;
    const float* gate2 = modp(p, l > 0 ? l - 1 : 0, ti.ci, 5);
    const int lm = l < DEPTH ? l : DEPTH - 1;
    const float* sh = modp(p, lm, ti.ci, 0); const float* sc = modp(p, lm, ti.ci, 1);
    int iv0 = -1, iv1 = -1, iv2 = -1, iv3 = -1;
    if (l > 0 && lane < NE) {
      const int* ip = p.inv + (long)t4 * NE + lane;
      iv0 = ip[0]; iv1 = ip[NE]; iv2 = ip[2 * NE]; iv3 = ip[3 * NE];
    }
    __syncthreads();
    {
      const f32x4 a0 = *(const f32x4*)(g + 4 * tidx_), a1 = *(const f32x4*)(b + 4 * tidx_), a2 = *(const f32x4*)(gate2 + 4 * tidx_);
      const f32x4 a3 = *(const f32x4*)(sh + 4 * tidx_), a4 = *(const f32x4*)(sc + 4 * tidx_);
      *(f32x4*)(prm + 4 * tidx_) = a0; *(f32x4*)(prm + D + 4 * tidx_) = a1; *(f32x4*)(prm + 2 * D + 4 * tidx_) = a2;
      *(f32x4*)(prm + 3 * D + 4 * tidx_) = a3; *(f32x4*)(prm + 4 * D + 4 * tidx_) = a4;
    }
    __syncthreads();
    auto xload = [&](int k) -> RowX {
      const float* s_ = src4 + (long)k * D + d0;
      RowX r; r.a0 = *(const f32x4*)s_; r.a1 = *(const f32x4*)(s_ + 256); r.a2 = *(const f32x4*)(s_ + 512); r.a3 = *(const f32x4*)(s_ + 768);
      return r;
    };
    auto gather = [&](int myinv) -> RowG {
      RowG r;
      const uint2 z = make_uint2(0u, 0u);
      r.u00 = r.u01 = r.u02 = r.u03 = r.u10 = r.u11 = r.u12 = r.u13 = r.u20 = r.u21 = r.u22 = r.u23 = r.u30 = r.u31 = r.u32 = r.u33 = z;
      r.g0 = r.g1 = r.g2 = r.g3 = 0.f;
      unsigned mask = (unsigned)__ballot(myinv >= 0) & 0xffffu;
      if (mask) {
        const int e = __builtin_ctz(mask); mask &= mask - 1; const int s_ = __builtin_amdgcn_readlane(myinv, e);
        const bf16_t* yr = p.ys + ((long)e * NS + s_) * D + d0; r.g0 = p.selgate[e * NS + s_];
        r.u00 = *(const uint2*)yr; r.u01 = *(const uint2*)(yr + 256); r.u02 = *(const uint2*)(yr + 512); r.u03 = *(const uint2*)(yr + 768);
      }
      if (mask) {
        const int e = __builtin_ctz(mask); mask &= mask - 1; const int s_ = __builtin_amdgcn_readlane(myinv, e);
        const bf16_t* yr = p.ys + ((long)e * NS + s_) * D + d0; r.g1 = p.selgate[e * NS + s_];
        r.u10 = *(const uint2*)yr; r.u11 = *(const uint2*)(yr + 256); r.u12 = *(const uint2*)(yr + 512); r.u13 = *(const uint2*)(yr + 768);
      }
      if (mask) {
        const int e = __builtin_ctz(mask); mask &= mask - 1; const int s_ = __builtin_amdgcn_readlane(myinv, e);
        const bf16_t* yr = p.ys + ((long)e * NS + s_) * D + d0; r.g2 = p.selgate[e * NS + s_];
        r.u20 = *(const uint2*)yr; r.u21 = *(const uint2*)(yr + 256); r.u22 = *(const uint2*)(yr + 512); r.u23 = *(const uint2*)(yr + 768);
      }
      if (mask) {
        const int e = __builtin_ctz(mask); mask &= mask - 1; const int s_ = __builtin_amdgcn_readlane(myinv, e);
        const bf16_t* yr = p.ys + ((long)e * NS + s_) * D + d0; r.g3 = p.selgate[e * NS + s_];
        r.u30 = *(const uint2*)yr; r.u31 = *(const uint2*)(yr + 256); r.u32 = *(const uint2*)(yr + 512); r.u33 = *(const uint2*)(yr + 768);
      }
      r.rest = mask;
      return r;
    };
    RowX xc = xload(0);
    RowG gc; gc.rest = 0u;
    if (l > 0) gc = gather(iv0);
#pragma unroll 1
    for (int k = 0; k < 4; ++k) {
      const int t = t4 + k;
      const int ivc = k == 0 ? iv0 : k == 1 ? iv1 : k == 2 ? iv2 : iv3;
      const int ivn = k == 0 ? iv1 : k == 1 ? iv2 : iv3;
      RowX xn = xc; RowG gn = gc;
      if (k < 3) { xn = xload(k + 1); if (l > 0) gn = gather(ivn); }
      const f32x4 xa[4] = {xc.a0, xc.a1, xc.a2, xc.a3};
      float v[16];
      if (l == 0) {
#pragma unroll
        for (int i = 0; i < 4; ++i) { v[4 * i] = xa[i][0]; v[4 * i + 1] = xa[i][1]; v[4 * i + 2] = xa[i][2]; v[4 * i + 3] = xa[i][3]; }
      } else {
        float m[16];
        {
          const uint2 u0[4] = {gc.u00, gc.u01, gc.u02, gc.u03}, u1[4] = {gc.u10, gc.u11, gc.u12, gc.u13};
          const uint2 u2[4] = {gc.u20, gc.u21, gc.u22, gc.u23}, u3[4] = {gc.u30, gc.u31, gc.u32, gc.u33};
#pragma unroll
          for (int i = 0; i < 4; ++i) {
            m[4 * i] = gc.g0 * bflo(u0[i].x) + gc.g1 * bflo(u1[i].x) + gc.g2 * bflo(u2[i].x) + gc.g3 * bflo(u3[i].x);
            m[4 * i + 1] = gc.g0 * bfhi(u0[i].x) + gc.g1 * bfhi(u1[i].x) + gc.g2 * bfhi(u2[i].x) + gc.g3 * bfhi(u3[i].x);
            m[4 * i + 2] = gc.g0 * bflo(u0[i].y) + gc.g1 * bflo(u1[i].y) + gc.g2 * bflo(u2[i].y) + gc.g3 * bflo(u3[i].y);
            m[4 * i + 3] = gc.g0 * bfhi(u0[i].y) + gc.g1 * bfhi(u1[i].y) + gc.g2 * bfhi(u2[i].y) + gc.g3 * bfhi(u3[i].y);
          }
        }
        unsigned mask = gc.rest;
        while (mask) {
          const int e = __builtin_ctz(mask); mask &= mask - 1;
          const int s_ = __builtin_amdgcn_readlane(ivc, e);
          const bf16_t* yr = p.ys + ((long)e * NS + s_) * D + d0;
          const float gk = p.selgate[e * NS + s_];
#pragma unroll
          for (int i = 0; i < 4; ++i) {
            const uint2 u = *(const uint2*)(yr + 256 * i);
            m[4 * i] += gk * bflo(u.x); m[4 * i + 1] += gk * bfhi(u.x); m[4 * i + 2] += gk * bflo(u.y); m[4 * i + 3] += gk * bfhi(u.y);
          }
        }
#pragma unroll
        for (int i = 0; i < 4; ++i) {
          const f32x4 g2 = *(const f32x4*)(prm + 2 * D + 256 * i + d0);
#pragma unroll
          for (int c = 0; c < 4; ++c) v[4 * i + c] = ALPHA * xa[i][c] + g2[c] * m[4 * i + c];
        }
      }
      float s = 0.f;
#pragma unroll
      for (int i = 0; i < 16; ++i) s += v[i];
      const float mu = wave_sum(s) * (1.f / D);
      float q = 0.f;
#pragma unroll
      for (int i = 0; i < 16; ++i) { float dv = v[i] - mu; q += dv * dv; }
      const float rs = 1.f / sqrtf(wave_sum(q) * (1.f / D) + LN_EPS);
      if (l < DEPTH) {
#pragma unroll
        for (int i = 0; i < 4; ++i) {
          f32x4 xo; float hv[4];
          const f32x4 lg = *(const f32x4*)(prm + 256 * i + d0), lb = *(const f32x4*)(prm + D + 256 * i + d0);
          const f32x4 ls = *(const f32x4*)(prm + 3 * D + 256 * i + d0), lc = *(const f32x4*)(prm + 4 * D + 256 * i + d0);
#pragma unroll
          for (int c = 0; c < 4; ++c) { xo[c] = (v[4 * i + c] - mu) * rs * lg[c] + lb[c]; hv[c] = xo[c] * (1.f + lc[c]) + ls[c]; }
          *(f32x4*)(p.x + (long)t * D + 256 * i + d0) = xo;
          uint2 pk; pk.x = cvtpk(hv[0], hv[1]); pk.y = cvtpk(hv[2], hv[3]);
          *(uint2*)(p.h + (long)t * D + 256 * i + d0) = pk;
        }
      } else {
        float* o = p.out + (ti.lat ? O_YS + (long)(t - TC) * D : O_YP + (long)t * D);
#pragma unroll
        for (int i = 0; i < 4; ++i) {
          f32x4 xo;
          const f32x4 lg = *(const f32x4*)(prm + 256 * i + d0), lb = *(const f32x4*)(prm + D + 256 * i + d0);
#pragma unroll
          for (int c = 0; c < 4; ++c) xo[c] = (v[4 * i + c] - mu) * rs * lg[c] + lb[c];
          *(f32x4*)(o + 256 * i + d0) = xo;
        }
      }
      xc = xn; gc = gn;
    }
  }
}

DEVFN void ph_row2_fast(const Params& p, int l, char* smem) {
  PHASE_BEGIN;
  const int lane = tidx_ & 63;
  float* wrt = (float*)smem;
#pragma unroll
  for (int q = tidx_; q < D * NE / 4; q += 256) {
    f32x4 v = *(const f32x4*)(p.w_router + (long)l * D * NE + q * 4);
    const int d = q >> 2, e4 = (q & 3) * 4;
    wrt[(e4 + 0) * D + d] = v[0]; wrt[(e4 + 1) * D + d] = v[1]; wrt[(e4 + 2) * D + d] = v[2]; wrt[(e4 + 3) * D + d] = v[3];
  }
  __syncthreads();
  for (int t4 = (bidx_ * 4 + (tidx_ >> 6)) * 4; t4 < T; t4 += gridDim.x * 16) {
    TokInfo ti = tokinfo(t4);
    const float* g = p.ln1_g + (long)l * D; const float* b = p.ln1_b + (long)l * D;
    const float* sh = modp(p, l, ti.ci, 3); const float* sc = modp(p, l, ti.ci, 4);
    uint2 ya[4]; f32x4 xa[4], lg[4], lb[4], ls[4], lc[4];
#pragma unroll
    for (int i = 0; i < 4; ++i) {
      const int dd = 256 * i + 4 * lane;
      ya[i] = *(const uint2*)((const bf16_t*)p.ybuf + (long)t4 * D + dd); xa[i] = *(const f32x4*)(p.x + (long)t4 * D + dd);
      lg[i] = *(const f32x4*)(g + dd); lb[i] = *(const f32x4*)(b + dd); ls[i] = *(const f32x4*)(sh + dd); lc[i] = *(const f32x4*)(sc + dd);
    }
#pragma unroll 1
   for (int k = 0; k < 4; ++k) {
    const int t = t4 + k;
    uint2 yn[4]; f32x4 xn[4];
#pragma unroll
    for (int i = 0; i < 4; ++i) { yn[i] = ya[i]; xn[i] = xa[i]; }
    if (k < 3) {
#pragma unroll
      for (int i = 0; i < 4; ++i) {
        const int dd = 256 * i + 4 * lane;
        yn[i] = *(const uint2*)((const bf16_t*)p.ybuf + (long)(t + 1) * D + dd); xn[i] = *(const f32x4*)(p.x + (long)(t + 1) * D + dd);
      }
    }
    float v[16];
#pragma unroll
    for (int i = 0; i < 4; ++i) {
      v[4 * i] = ALPHA * xa[i][0] + bflo(ya[i].x); v[4 * i + 1] = ALPHA * xa[i][1] + bfhi(ya[i].x);
      v[4 * i + 2] = ALPHA * xa[i][2] + bflo(ya[i].y); v[4 * i + 3] = ALPHA * xa[i][3] + bfhi(ya[i].y);
    }
    float s = 0.f;
#pragma unroll
    for (int i = 0; i < 16; ++i) s += v[i];
    const float mu = wave_sum(s) * (1.f / D);
    float q = 0.f;
#pragma unroll
    for (int i = 0; i < 16; ++i) { float dv = v[i] - mu; q += dv * dv; }
    const float rs = 1.f / sqrtf(wave_sum(q) * (1.f / D) + LN_EPS);
    float lgt[NE];
#pragma unroll
    for (int e = 0; e < NE; ++e) lgt[e] = 0.f;
#pragma unroll
    for (int i = 0; i < 4; ++i) {
      const int d0 = 256 * i + 4 * lane;
      f32x4 xo; float hv[4];
#pragma unroll
      for (int c = 0; c < 4; ++c) { xo[c] = (v[4 * i + c] - mu) * rs * lg[i][c] + lb[i][c]; hv[c] = xo[c] * (1.f + lc[i][c]) + ls[i][c]; }
      *(f32x4*)(p.x + (long)t * D + d0) = xo;
      uint2 pk; pk.x = cvtpk(hv[0], hv[1]); pk.y = cvtpk(hv[2], hv[3]);
      *(uint2*)(p.h2 + (long)t * D + d0) = pk;
#pragma unroll
      for (int e = 0; e < NE; ++e) {
        f32x4 w = *(const f32x4*)(wrt + e * D + d0);
        lgt[e] += hv[0] * w[0] + hv[1] * w[1] + hv[2] * w[2] + hv[3] * w[3];
      }
      asm volatile("" ::: "memory");
    }
#pragma unroll
    for (int e = 0; e < NE; ++e) lgt[e] = wave_sum(lgt[e]);
    float mx = lgt[0];
#pragma unroll
    for (int e = 1; e < NE; ++e) mx = fmaxf(mx, lgt[e]);
    float se = 0.f;
#pragma unroll
    for (int e = 0; e < NE; ++e) { lgt[e] = expf(lgt[e] - mx); se += lgt[e]; }
    const float is = 1.f / se;
    float mine = 0.f;
#pragma unroll
    for (int e = 0; e < NE; ++e) mine = (lane == e) ? lgt[e] * is : mine;
    if (lane < NE) { p.aff[(long)t * NE + lane] = mine; p.afft[(long)lane * T + t] = mine; }
#pragma unroll
    for (int i = 0; i < 4; ++i) { ya[i] = yn[i]; xa[i] = xn[i]; }
   }
  }
  __syncthreads();
}

DEVFN void ph_topk_fast(const Params& p, int l, char* smem) {
  PHASE_BEGIN;
  float* vals = (float*)smem;
  constexpr int NITEM = BATCH * NE * (SEQ / 256) + DB * NE * (DSEQ / 256);
  for (int item = bidx_; item < NITEM; item += gridDim.x) {
    int lat, b, e, chunk, N;
    if (item < BATCH * NE * (SEQ / 256)) { lat = 0; N = SEQ; e = item % NE; chunk = (item / NE) % (SEQ / 256); b = item / (NE * (SEQ / 256)); }
    else { int it = item - BATCH * NE * (SEQ / 256); lat = 1; N = DSEQ; e = it % NE; chunk = (it / NE) % (DSEQ / 256); b = it / (NE * (DSEQ / 256)); }
    const int t0 = lat ? TC + b * DSEQ : b * SEQ;
    {
      const float* src = p.afft + (long)e * T + t0 + tidx_;
      if (lat) {
        const float a0 = src[0], a1 = src[256], a2 = src[512], a3 = src[768];
        vals[tidx_] = a0; vals[tidx_ + 256] = a1; vals[tidx_ + 512] = a2; vals[tidx_ + 768] = a3;
      } else {
        vals[tidx_] = src[0];
      }
    }
    __syncthreads();
    const int n = chunk * 256 + tidx_;
    const float a = vals[n];
    const int w16 = __builtin_amdgcn_readfirstlane((chunk * 256 + (tidx_ & 192)) >> 4);
    int rank = 0;
    for (int j16 = 0; j16 < w16; ++j16) {
      f32x4 vv[4];
#pragma unroll
      for (int q = 0; q < 4; ++q) vv[q] = ((const f32x4*)vals)[4 * j16 + q];
#pragma unroll
      for (int q = 0; q < 4; ++q)
#pragma unroll
        for (int c = 0; c < 4; ++c) rank += (int)(vv[q][c] >= a);
    }
#pragma unroll
    for (int j16 = 0; j16 < 4; ++j16) {
      f32x4 vv[4];
#pragma unroll
      for (int q = 0; q < 4; ++q) vv[q] = ((const f32x4*)vals)[4 * (w16 + j16) + q];
#pragma unroll
      for (int q = 0; q < 4; ++q)
#pragma unroll
        for (int c = 0; c < 4; ++c) {
          const int jl = 16 * j16 + 4 * q + c;
          rank += (int)(vv[q][c] > a) | ((int)(vv[q][c] == a) & (int)(jl < (tidx_ & 63)));
        }
    }
    for (int j16 = w16 + 4; j16 < N / 16; ++j16) {
      f32x4 vv[4];
#pragma unroll
      for (int q = 0; q < 4; ++q) vv[q] = ((const f32x4*)vals)[4 * j16 + q];
#pragma unroll
      for (int q = 0; q < 4; ++q)
#pragma unroll
        for (int c = 0; c < 4; ++c) rank += (int)(vv[q][c] > a);
    }
    const int cap = lat ? CAPL : CAPC;
    int slot = -1;
    if (rank < cap) {
      slot = lat ? BATCH * CAPC + b * CAPL + rank : b * CAPC + rank;
      p.seltok[e * NS + slot] = t0 + n;
      p.selgate[e * NS + slot] = a;
    }
    p.inv[(long)(t0 + n) * NE + e] = slot;
    __syncthreads();
  }
}

constexpr int ADA_KC = 16, ADA_ROWS = D / ADA_KC;
DEVFN void ph_adaln_part(const Params& p, char* smem) {
  PHASE_BEGIN;
  float* sil = (float*)smem;
  constexpr int NJG = 6 * D / 4 / 256;
  constexpr int NITEM = DEPTH * NJG * ADA_KC;
  if (bidx_ < NITEM) {
#pragma unroll
    for (int i = tidx_; i < NCOND * D; i += 256) {
      int c = i / D, d = i % D;
      sil[i] = silu_f(c == 0 ? p.c_ctx[d] : p.c[(c - 1) * D + d]);
    }
    __syncthreads();
  }
  for (int item = bidx_; item < NITEM; item += gridDim.x) {
    const int kc = item % ADA_KC, jb = (item / ADA_KC) % NJG, l = item / (ADA_KC * NJG);
    const int j0 = (jb * 256 + tidx_) * 4;
    const float* w = p.w_ada + ((long)l * D + kc * ADA_ROWS) * 6 * D + j0;
    f32x4 acc[NCOND];
#pragma unroll
    for (int c = 0; c < NCOND; ++c) acc[c] = (f32x4){0.f, 0.f, 0.f, 0.f};
#pragma unroll 16
    for (int r = 0; r < ADA_ROWS; ++r) {
      f32x4 wv = *(const f32x4*)(w + (long)r * 6 * D);
#pragma unroll
      for (int c = 0; c < NCOND; ++c) { float sv = sil[c * D + kc * ADA_ROWS + r]; acc[c] += sv * wv; }
    }
#pragma unroll
    for (int c = 0; c < NCOND; ++c) *(f32x4*)(p.modpart + (((long)kc * DEPTH + l) * NCOND + c) * 6 * D + j0) = acc[c];
  }
  __syncthreads();
}
DEVFN void ph_adaln_reduce(const Params& p) {
  PHASE_BEGIN;
  for (long idx = GTID; idx < (long)DEPTH * NCOND * 6 * D; idx += GSIZE) {
    int j = idx % (6 * D); int l = idx / ((long)NCOND * 6 * D);
    float s = p.b_ada[(long)l * 6 * D + j];
#pragma unroll
    for (int kc = 0; kc < ADA_KC; ++kc) s += p.modpart[(long)kc * DEPTH * NCOND * 6 * D + idx];
    p.mod[idx] = s;
  }
}
DEVFN void transpose_tile(const float* src, long ld_src, bf16_t* dst, long ld_dst, int k0, int n0, float* tl, int tid) {
#pragma unroll
  for (int i = 0; i < 4; ++i) {
    const int r = (tid >> 4) + 16 * i, c4 = (tid & 15) * 4;
    f32x4 v = *(const f32x4*)(src + (long)(k0 + r) * ld_src + n0 + c4);
    tl[r * 65 + c4] = v[0]; tl[r * 65 + c4 + 1] = v[1]; tl[r * 65 + c4 + 2] = v[2]; tl[r * 65 + c4 + 3] = v[3];
  }
  __syncthreads();
#pragma unroll
  for (int i = 0; i < 2; ++i) {
    const int n = (tid >> 3) + 32 * i, kc = (tid & 7) * 8;
    uint4 w;
    w.x = cvtpk(tl[(kc + 0) * 65 + n], tl[(kc + 1) * 65 + n]); w.y = cvtpk(tl[(kc + 2) * 65 + n], tl[(kc + 3) * 65 + n]);
    w.z = cvtpk(tl[(kc + 4) * 65 + n], tl[(kc + 5) * 65 + n]); w.w = cvtpk(tl[(kc + 6) * 65 + n], tl[(kc + 7) * 65 + n]);
    *(uint4*)(dst + (long)(n0 + n) * ld_dst + k0 + kc) = w;
  }
  __syncthreads();
}
constexpr int TR_WOUT = DEPTH * (MIX_W / 64) * (D / 64);
constexpr int TR_WIN = DEPTH * (D / 64) * 16;
constexpr int TR_WGLU = DEPTH * (S5_W / 64) * (S5_W / 64);
DEVFN void ph_init_tr(const Params& p, char* smem) {
  PHASE_BEGIN;
  float* tl = (float*)smem;
  for (int item = bidx_; item < TR_WOUT + TR_WIN + TR_WGLU; item += gridDim.x) {
    if (item < TR_WOUT) {
      const int nt = item % (D / 64), kt = (item / (D / 64)) % (MIX_W / 64), l = item / ((D / 64) * (MIX_W / 64));
      transpose_tile(p.w_out + (long)l * MIX_W * D, D, p.woutt + (long)l * D * MIX_W, MIX_W, kt * 64, nt * 64, tl, tidx_);
    } else if (item < TR_WOUT + TR_WIN) {
      const int it = item - TR_WOUT;
      const int ct = it % 16, kt = (it / 16) % (D / 64), l = it / (16 * (D / 64));
      const int nsrc = ct < 12 ? ct * 64 : 1024 + (ct - 12) * 64;
      const int ndst = ct < 12 ? ct * 64 : PC_U + (ct - 12) * 64;
      transpose_tile(p.w_in + (long)l * D * IN_W + nsrc, IN_W, p.win2t + ((long)l * NP + ndst) * D, D, kt * 64, 0, tl, tidx_);
    } else {
      const int it = item - TR_WOUT - TR_WIN;
      const int nt = it % (S5_W / 64), kt = (it / (S5_W / 64)) % (S5_W / 64), l = it / ((S5_W / 64) * (S5_W / 64));
      transpose_tile(p.s5_w_glu + (long)l * S5_W * S5_W, S5_W, p.wglut + (long)l * S5_W * S5_W, S5_W, kt * 64, nt * 64, tl, tidx_);
    }
  }
}
DEVFN void ph_init_tab(const Params& p, char* smem) {
  PHASE_BEGIN;
  float* tab = (float*)smem;
  const long gt = GTID, gs = GSIZE;
  for (int j = tidx_; j < DSEQ; j += 256) {
    float s, c;
    sincosf(6.283185307179586f * (float)j / (float)DSEQ, &s, &c);
    tab[2 * j] = c; tab[2 * j + 1] = s;
  }
  __syncthreads();
  const float isl = 1.f / sqrtf((float)DSEQ), isc = 1.f / sqrtf((float)SEQ);
  for (long idx = gt; idx < (long)DSEQ * 2 * DSEQ; idx += gs) {
    const int n2 = idx % (2 * DSEQ), k = idx / (2 * DSEQ), n = n2 % DSEQ;
    const int j = (k * n) & (DSEQ - 1);
    p.dftl[idx] = f2bf((n2 < DSEQ ? tab[2 * j] : -tab[2 * j + 1]) * isl);
  }
  for (long idx = gt; idx < (long)SEQ * 2 * SEQ; idx += gs) {
    const int n2 = idx % (2 * SEQ), k = idx / (2 * SEQ), n = n2 % SEQ;
    const int j = ((k * n) & (SEQ - 1)) * (DSEQ / SEQ);
    p.dftc[idx] = f2bf((n2 < SEQ ? tab[2 * j] : -tab[2 * j + 1]) * isc);
  }
  for (long idx = gt; idx < (long)DEPTH * 256 * 256; idx += gs) {
    const int i = idx % 256, j = (idx / 256) % 256, l = idx / (256 * 256);
    const int hd = i >> 6, c = i & 63;
    const float* wf = p.w_fourier + ((long)l * 256 + hd * 64) * 256 + j;
    float w[64];
#pragma unroll
    for (int m = 0; m < 64; ++m) w[m] = wf[(long)m * 256];
    float ac = 0.f, as = 0.f;
#pragma unroll
    for (int m = 0; m < 64; ++m) {
      const f32x2_t cs = *(const f32x2_t*)(tab + 2 * (((m * c) & 63) * (DSEQ / 64)));
      ac += cs[0] * w[m]; as += cs[1] * w[m];
    }
    p.wcst[((long)l * 512 + j) * 256 + i] = f2bf(ac * 0.125f);
    p.wcst[((long)l * 512 + 256 + j) * 256 + i] = f2bf(as * 0.125f);
  }
  for (long idx = gs - 1 - gt - (long)DEPTH * 2 * SG * SP; idx >= 0 && idx < 64 * 16; idx += gs) {
    int fi = idx % 16, pos = idx / 16;
    float freq = powf(10000.f, -(float)fi / 16.f);
    float ang = (float)pos * freq;
    p.rope[idx * 2] = cosf(ang); p.rope[idx * 2 + 1] = sinf(ang);
  }
  for (long idx = gs - 1 - gt; idx < (long)DEPTH * 2 * SG * SP; idx += gs) {
    int pp = idx % SP; int g = (idx / SP) % SG; long ld = idx / (SP * SG);
    double are = p.s5_a_re[idx], aim = p.s5_a_im[idx];
    double dt = exp((double)p.s5_log_dt[ld * SG + g]);
    double er = exp(are * dt), cr = er * cos(aim * dt), ci = er * sin(aim * dt);
    p.abar[idx * 2] = (float)cr; p.abar[idx * 2 + 1] = (float)ci;
    double nr = cr - 1.0, ni = ci, den = are * are + aim * aim;
    double fr = (nr * are + ni * aim) / den, fi = (ni * are - nr * aim) / den;
    for (int h = 0; h < SH; ++h) {
      double br = p.s5_b_re[idx * SH + h], bi = p.s5_b_im[idx * SH + h];
      p.bbn[((ld * SG + g) * 128 + 2 * pp) * 16 + h] = f2bf((float)(fr * br - fi * bi));
      p.bbn[((ld * SG + g) * 128 + 2 * pp + 1) * 16 + h] = f2bf((float)(fr * bi + fi * br));
    }
  }
  for (long idx = gt; idx < (long)DEPTH * 2 * SG * SH * 128; idx += gs) {
    int k = idx % 128; long row = idx / 128;
    p.cn[idx] = f2bf((k & 1) ? -p.s5_c_im[row * SP + (k >> 1)] : p.s5_c_re[row * SP + (k >> 1)]);
  }
}
struct RowLoaderF32 {
  const float *r0, *r1, *r2, *r3;
  DEVFN uint4 one(const float* r, int kt) const {
    f32x4 a = *(const f32x4*)(r + kt * 64), b = *(const f32x4*)(r + kt * 64 + 4);
    uint4 w; w.x = cvtpk(a[0], a[1]); w.y = cvtpk(a[2], a[3]); w.z = cvtpk(b[0], b[1]); w.w = cvtpk(b[2], b[3]);
    return w;
  }
  DEVFN U4x4 operator()(int kt) const { U4x4 v; v.a = one(r0, kt); v.b = one(r1, kt); v.c = one(r2, kt); v.d = one(r3, kt); return v; }
};
DEVFN void ph_init_fold(const Params& p, char* smem) {
  PHASE_BEGIN;
  constexpr int NT_M = 512 / 128, NT_N = D / 128;
  for (int tile = bidx_; tile < DEPTH * NT_M * NT_N; tile += gridDim.x) {
    const int tn = tile % NT_N, tm = (tile / NT_N) % NT_M, l = tile / (NT_N * NT_M);
    RowLoader A = make_rows(tidx_, p.wcst + (long)l * 512 * 256, tm * 128, 256);
    RowLoaderF32 B;
    {
      const float* b0 = p.w_in + ((long)l * D + tn * 128 + (tidx_ >> 3)) * IN_W + 768 + (tidx_ & 7) * 8;
      B.r0 = b0; B.r1 = b0 + 32L * IN_W; B.r2 = b0 + 64L * IN_W; B.r3 = b0 + 96L * IN_W;
    }
    const bool odd = tidx_ & 1;
    bf16_t* dst = p.win2t + ((long)l * NP + PC_P + tm * 128) * D + tn * 128;
    gemm_tile1(smem, tidx_, A, B, 256 / 64, [&](int nt, int row, int col, float v0, float v1, float v2, float v3) {
      float v[4] = {v0, v1, v2, v3};
#pragma unroll
      for (int i = 0; i < 4; ++i) {
        float pr = shx1(v[i]);
        if (!odd) *(unsigned*)(dst + (long)(row + i) * D + col) = cvtpk(v[i], pr);
      }
    });
  }
}

constexpr int TR_EXP = NE * 3 * (D / 64) * (FF / 64);
struct ConvTile { const float* src; bf16_t* dst; };
DEVFN ConvTile conv_tile(const Params& p, int l, int item) {
  const int nt = item % 16, kt = (item / 16) % 16, m = (item / 256) % 3, e = item / 768;
  ConvTile c;
  const float* sb = (m == 0 ? p.w_gate : m == 1 ? p.w_up : p.w_down) + ((long)l * NE + e) * D * FF;
  bf16_t* db = (m == 0 ? p.wgt : m == 1 ? p.wut : p.wdt) + ((long)(l & 1) * NE + e) * FF * D;
  c.src = sb + (long)(kt * 64) * FF + nt * 64;
  c.dst = db + (long)(nt * 64) * D + kt * 64;
  return c;
}
DEVFN void conv_range(const Params& p, int l, int first, int count, char* smem, int tid) {
  static_assert(D == FF, "expert matrices assumed square");
  float* tl = (float*)smem;
  const int lr = tid >> 4, lc = (tid & 15) * 4;
  int item = first; const int end = first + count;
  f32x4 v0, v1, v2, v3;
  ConvTile c = conv_tile(p, l, item);
  {
    const float* s = c.src + (long)lr * FF + lc;
    v0 = *(const f32x4*)s; v1 = *(const f32x4*)(s + 16L * FF); v2 = *(const f32x4*)(s + 32L * FF); v3 = *(const f32x4*)(s + 48L * FF);
  }
  while (item < end) {
    float* t0 = tl + lr * 65 + lc;
    t0[0] = v0[0]; t0[1] = v0[1]; t0[2] = v0[2]; t0[3] = v0[3];
    t0[16 * 65] = v1[0]; t0[16 * 65 + 1] = v1[1]; t0[16 * 65 + 2] = v1[2]; t0[16 * 65 + 3] = v1[3];
    t0[32 * 65] = v2[0]; t0[32 * 65 + 1] = v2[1]; t0[32 * 65 + 2] = v2[2]; t0[32 * 65 + 3] = v2[3];
    t0[48 * 65] = v3[0]; t0[48 * 65 + 1] = v3[1]; t0[48 * 65 + 2] = v3[2]; t0[48 * 65 + 3] = v3[3];
    __syncthreads();
    bf16_t* dst = c.dst;
    const int nxt = item + 1;
    if (nxt < end) {
      c = conv_tile(p, l, nxt);
      const float* s = c.src + (long)lr * FF + lc;
      v0 = *(const f32x4*)s; v1 = *(const f32x4*)(s + 16L * FF); v2 = *(const f32x4*)(s + 32L * FF); v3 = *(const f32x4*)(s + 48L * FF);
    }
#pragma unroll
    for (int i = 0; i < 2; ++i) {
      const int n = (tid >> 3) + 32 * i, kc = (tid & 7) * 8;
      uint4 w;
      w.x = cvtpk(tl[(kc + 0) * 65 + n], tl[(kc + 1) * 65 + n]); w.y = cvtpk(tl[(kc + 2) * 65 + n], tl[(kc + 3) * 65 + n]);
      w.z = cvtpk(tl[(kc + 4) * 65 + n], tl[(kc + 5) * 65 + n]); w.w = cvtpk(tl[(kc + 6) * 65 + n], tl[(kc + 7) * 65 + n]);
      *(uint4*)(dst + (long)n * D + kc) = w;
    }
    __syncthreads();
    item = nxt;
  }
}

DEVFN void conv_wait(int n) {
  switch (n) {
    case 0:  asm volatile("s_waitcnt vmcnt(0) lgkmcnt(0)\n\ts_barrier" ::: "memory"); break;
    case 4:  asm volatile("s_waitcnt vmcnt(4) lgkmcnt(0)\n\ts_barrier" ::: "memory"); break;
    case 8:  asm volatile("s_waitcnt vmcnt(8) lgkmcnt(0)\n\ts_barrier" ::: "memory"); break;
    case 12: asm volatile("s_waitcnt vmcnt(12) lgkmcnt(0)\n\ts_barrier" ::: "memory"); break;
    case 16: asm volatile("s_waitcnt vmcnt(16) lgkmcnt(0)\n\ts_barrier" ::: "memory"); break;
    default: asm volatile("s_waitcnt vmcnt(20) lgkmcnt(0)\n\ts_barrier" ::: "memory"); break;
  }
}
DEVFN void conv_issue(const Params& p, int l, int item, unsigned lds_ws, int lane, int wave) {
  ConvTile c = conv_tile(p, l, item);
#pragma unroll
  for (int i = 0; i < 4; ++i) {
    const int k = 16 * wave + 4 * i + (lane >> 4);
    const int chunk = ((lane & 15) - (4 * wave + i)) & 15;
    glds16_nt((const bf16_t*)(c.src + (long)k * FF + chunk * 4), lds_ws + i * 1024);
  }
}
template <int MODE>
DEVFN void conv_ring(const Params& p, int l, int first, int count, char* smem, int tid) {
  constexpr int LPT = MODE == 2 ? 0 : 4, SPT = MODE == 1 ? 0 : 4;
  const int lane = tid & 63, wave = tid >> 6;
  const int kq = tid & 15, nq = tid >> 4;
  const unsigned lbase = (unsigned)__builtin_amdgcn_readfirstlane((int)(lds_addr(smem) + wave * 4096));
  __syncthreads();
  if (LPT) for (int s = 0; s < 3 && s < count; ++s) conv_issue(p, l, first + s, lbase + s * 16384, lane, wave);
  for (int t = 0; t < count; ++t) {
    const int st = t < 3 ? t : 3;
    int ld = count - 1 - t; if (ld > 2) ld = 2;
    conv_wait(SPT * st + LPT * ld);
    if (LPT && t + 3 < count) conv_issue(p, l, first + t + 3, lbase + ((t + 3) & 3) * 16384, lane, wave);
    const char* sl = smem + (t & 3) * 16384 + (4 * kq) * 256 + ((nq + kq) & 15) * 16;
    f32x4 v0 = *(const f32x4*)sl, v1 = *(const f32x4*)(sl + 256), v2 = *(const f32x4*)(sl + 512), v3 = *(const f32x4*)(sl + 768);
    bf16_t* d = conv_tile(p, l, first + t).dst + (long)(4 * nq) * D + 4 * kq;
#pragma unroll
    for (int i = 0; i < 4; ++i) {
      uint2 w; w.x = cvtpk(v0[i], v1[i]); w.y = cvtpk(v2[i], v3[i]);
      if (SPT) { typedef __attribute__((ext_vector_type(2))) unsigned u32x2_t; u32x2_t wv = {w.x, w.y}; __builtin_nontemporal_store(wv, (u32x2_t*)(d + (long)i * D)); }
    }
  }
}

struct ConvOwn { int per, first, cnt; };
DEVFN ConvOwn conv_own(int bidx) {
  ConvOwn o;
  const int nb = gridDim.x;
  o.per = (TR_EXP + nb - 1) / nb; o.first = bidx * o.per;
  int c = TR_EXP - o.first; o.cnt = c > o.per ? o.per : (c < 0 ? 0 : c);
  return o;
}
DEVFN void conv_span(const Params& p, int L, const ConvOwn& o, int idx, int n, char* smem, int tid) {
  int nv = o.cnt - idx; if (nv > n) nv = n;
  if (nv > 0) conv_ring<0>(p, L, o.first + idx, nv, smem, tid);
}
DEVFN void conv_fill(const Params& p, int l, int ph, int& cdone, char* smem, int tid, int bidx) {
  const ConvOwn o = conv_own(bidx);
  const int L = cdone / o.per;
  if (L > l + 1 || L >= DEPTH) return;
  const int idx = cdone - L * o.per;
  const int fill = 2; (void)ph;
  int n = o.per - idx; if (n > fill) n = fill;
  conv_span(p, L, o, idx, n, smem, tid);
  cdone += n;
}
DEVFN void ph_conv_catchup(const Params& p, int l, int& cdone, char* smem) {
  PHASE_BEGIN;
  const ConvOwn o = conv_own(bidx_);
  const int target = (l + 1) * o.per;
  if (cdone < target) {
    const int idx = cdone - l * o.per;
    conv_span(p, l, o, idx, o.per - idx, smem, tidx_);
    cdone = target;
  }
}
constexpr int S5_SROW = 288;
constexpr int N_S5_LAT = DB * SG * 2 / 2, N_S5_CTX = BATCH * SG * 2 / 4;
template <int DIR, int CH>
DEVFN void s5_wave(const Params& p, int l, int lat, int u, char* wl, int lane) {
  constexpr int BU_BYTES = CH * 128 * 4;
  const int g = (u >> 1) % SG, b = u / (2 * SG);
  const int N = lat ? DSEQ : SEQ, t0 = lat ? TC + b * DSEQ : b * SEQ, nch = N / CH;
  float* BU = (float*)wl;
  char* SS = wl + BU_BYTES;
  const long pidx = (((long)l * 2 + DIR) * SG + g);
  const float ar = p.abar[(pidx * SP + lane) * 2], ai = p.abar[(pidx * SP + lane) * 2 + 1];
  const float nai = -ai;
  float sr = 0.f, si = 0.f;
  if (lat) { long si0 = ((((long)b * DEPTH + l) * 2 + DIR) * SG + g) * SP + lane; sr = p.st_re[si0]; si = p.st_im[si0]; }
  bf16x8 bfr[4], cfr[4];
#pragma unroll
  for (int nt = 0; nt < 4; ++nt) bfr[nt] = *(const bf16x8*)(p.bbn + ((pidx * 128 + nt * 32 + (lane & 31)) * 16 + 8 * (lane >> 5)));
#pragma unroll
  for (int ks = 0; ks < 4; ++ks) cfr[ks] = *(const bf16x8*)(p.cn + ((pidx * 16 + (lane & 15)) * 128 + ks * 32 + 8 * (lane >> 4)));
  const bf16_t* ub = p.proj + (long)t0 * NPJ + PJ_U + g * 16 + 8 * (lane >> 5);
  const int urow = lane & (CH - 1);
  bf16x8 ufr = *(const bf16x8*)(ub + (long)((DIR ? N - CH : 0) + urow) * NPJ);
  float* const ybase = p.ypart + ((long)DIR * T + t0 + (lane >> 4) * 4) * S5_W + g * 16 + (lane & 15);
  for (int c = 0; c <= nch; ++c) {
    if (c < nch) {
      const bf16x8 ucur = ufr;
      if (c + 1 < nch) ufr = *(const bf16x8*)(ub + (long)((DIR ? N - CH * (c + 2) : CH * (c + 1)) + urow) * NPJ);
#pragma unroll
      for (int np = 0; np < 2; ++np) {
        f32x16 z0, z1;
#pragma unroll
        for (int r = 0; r < 16; ++r) { z0[r] = 0.f; z1[r] = 0.f; }
        z0 = __builtin_amdgcn_mfma_f32_32x32x16_bf16(ucur, bfr[2 * np], z0, 0, 0, 0);
        z1 = __builtin_amdgcn_mfma_f32_32x32x16_bf16(ucur, bfr[2 * np + 1], z1, 0, 0, 0);
#pragma unroll
        for (int r = 0; r < CH / 2; ++r) {
          const int row = (r & 3) + 8 * (r >> 2) + 4 * (lane >> 5);
          BU[row * 128 + (2 * np) * 32 + (lane & 31)] = z0[r];
          BU[row * 128 + (2 * np + 1) * 32 + (lane & 31)] = z1[r];
        }
      }
    }
    __builtin_amdgcn_fence(__ATOMIC_RELEASE, "wavefront");
    __builtin_amdgcn_wave_barrier();
    __builtin_amdgcn_fence(__ATOMIC_ACQUIRE, "wavefront");
    if (c >= 1) {
      const char* ss = SS + ((c - 1) & 1) * (CH * S5_SROW);
      const int pb = DIR ? N - CH * c : CH * (c - 1);
#pragma unroll
      for (int mt = 0; mt < CH / 16; ++mt) {
        f32x4 acc = {0.f, 0.f, 0.f, 0.f};
#pragma unroll
        for (int ks = 0; ks < 4; ++ks) {
          bf16x8 a = *(const bf16x8*)(ss + (mt * 16 + (lane & 15)) * S5_SROW + ks * 64 + 16 * (lane >> 4));
          acc = __builtin_amdgcn_mfma_f32_16x16x32_bf16(a, cfr[ks], acc, 0, 0, 0);
        }
        float* yo = ybase + (long)(pb + mt * 16) * S5_W;
#pragma unroll
        for (int r = 0; r < 4; ++r) yo[(long)r * S5_W] = acc[r];
      }
    }
    if (c < nch) {
      char* ss = SS + (c & 1) * (CH * S5_SROW);
      f32x2_t bu[CH];
#pragma unroll
      for (int k = 0; k < CH; ++k) { const int r = DIR ? CH - 1 - k : k; bu[k] = *(const f32x2_t*)(BU + r * 128 + 2 * lane); }
#pragma unroll
      for (int k = 0; k < CH; ++k) {
        const int r = DIR ? CH - 1 - k : k;
        const float nr = __builtin_fmaf(ar, sr, __builtin_fmaf(nai, si, bu[k][0]));
        const float ni = __builtin_fmaf(ar, si, __builtin_fmaf(ai, sr, bu[k][1]));
        sr = nr; si = ni;
        *(unsigned*)(ss + r * S5_SROW + lane * 4) = cvtpk(sr, si);
      }
    }
    __builtin_amdgcn_fence(__ATOMIC_RELEASE, "wavefront");
    __builtin_amdgcn_wave_barrier();
    __builtin_amdgcn_fence(__ATOMIC_ACQUIRE, "wavefront");
  }
  if (!lat) {
    long oo = ((((long)b * DEPTH + l) * 2 + DIR) * SG + g) * SP + lane;
    p.out[O_SRE + oo] = sr; p.out[O_SIM + oo] = si;
  }
}
DEVFN void s5_unit(const Params& p, int l, int lat, int item, char* smem, int tidx_) {
  const int wave = tidx_ >> 6, lane = tidx_ & 63;
  if (lat) {
    if (wave < 2) {
      const int u = item * 2 + wave;
      char* wl = smem + wave * (32 * 128 * 4 + 2 * 32 * S5_SROW);
      if (u & 1) s5_wave<1, 32>(p, l, 1, u, wl, lane); else s5_wave<0, 32>(p, l, 1, u, wl, lane);
    }
  } else {
    const int u = item * 4 + wave;
    char* wl = smem + wave * (16 * 128 * 4 + 2 * 16 * S5_SROW);
    if (u & 1) s5_wave<1, 16>(p, l, 0, u, wl, lane); else s5_wave<0, 16>(p, l, 0, u, wl, lane);
  }
  __syncthreads();
}

constexpr int AT_KROW = 144, AT_VROW = 72, AT_KB = 32 * AT_KROW, AT_STAGE = AT_KB + 64 * AT_VROW;
constexpr int N_AT_LAT = DB * NKV * (DSEQ / 32), N_AT_CTX = BATCH * NKV * (SEQ / 32);
DEVFN void attn_item(const Params& p, int l, int lat, int item, char* smem, int tidx_) {
  const int NQB = (lat ? DSEQ : SEQ) / 32;
  const int qb = item % NQB, kvh = (item / NQB) % NKV, b = item / (NQB * NKV);
  const int N = lat ? DSEQ : SEQ, t0 = lat ? TC + b * DSEQ : b * SEQ, q0 = qb * 32;
  const int wave = tidx_ >> 6, lane = tidx_ & 63, hl = lane >> 5, head = kvh * GQA + wave;
  bf16x8 qf[4];
#pragma unroll
  for (int s = 0; s < 4; ++s) qf[s] = *(const bf16x8*)(p.proj + (long)(t0 + q0 + (lane & 31)) * NPJ + PJ_Q + head * HD + 16 * s + 8 * hl);
  const int ks0 = lat ? (q0 - WINDOW < 0 ? 0 : q0 - WINDOW) : 0;
  const int ke0 = lat ? (q0 + 32 + WINDOW > N ? N : q0 + 32 + WINDOW) : N;
  const int nwin = (ke0 - ks0) / 32, ntiles = nwin + (lat ? PAST / 32 : 0);
  float m = p.attn_sink[l * NH + head], lsum = 1.f;
  f32x16 O[2];
#pragma unroll
  for (int i = 0; i < 2; ++i)
#pragma unroll
    for (int r = 0; r < 16; ++r) O[i][r] = 0.f;
  const int kkey = tidx_ >> 3, kch = tidx_ & 7;
  const int vkey = tidx_ & 31, vch = tidx_ >> 5;
  struct KV { f32x4 k0, k1, v0, v1; };
  auto tile_load = [&](int ti) -> KV {
    KV r; r.k1 = r.k0 = (f32x4){0.f, 0.f, 0.f, 0.f}; r.v1 = r.v0 = r.k0;
    if (ti < nwin) {
      const int kp = ks0 + ti * 32;
      uint4 a = *(const uint4*)(p.proj + (long)(t0 + kp + kkey) * NPJ + PJ_K + kvh * HD + kch * 8);
      uint4 c = *(const uint4*)(p.proj + (long)(t0 + kp + vkey) * NPJ + PJ_V + kvh * HD + vch * 8);
      r.k0 = __builtin_bit_cast(f32x4, a); r.v0 = __builtin_bit_cast(f32x4, c);
    } else {
      const int s0 = (ti - nwin) * 32;
      const float* kb = p.cache_k + ((((long)b * DEPTH + l) * PAST + s0 + kkey) * NKV + kvh) * HD + kch * 8;
      const float* vb = p.cache_v + ((((long)b * DEPTH + l) * PAST + s0 + vkey) * NKV + kvh) * HD + vch * 8;
      r.k0 = *(const f32x4*)kb; r.k1 = *(const f32x4*)(kb + 4);
      r.v0 = *(const f32x4*)vb; r.v1 = *(const f32x4*)(vb + 4);
    }
    return r;
  };
  auto tile_store = [&](int ti, char* st, const KV r) {
    uint4 kq, vq;
    if (ti < nwin) { kq = __builtin_bit_cast(uint4, r.k0); vq = __builtin_bit_cast(uint4, r.v0); }
    else {
      kq.x = cvtpk(r.k0[0], r.k0[1]); kq.y = cvtpk(r.k0[2], r.k0[3]); kq.z = cvtpk(r.k1[0], r.k1[1]); kq.w = cvtpk(r.k1[2], r.k1[3]);
      vq.x = cvtpk(r.v0[0], r.v0[1]); vq.y = cvtpk(r.v0[2], r.v0[3]); vq.z = cvtpk(r.v1[0], r.v1[1]); vq.w = cvtpk(r.v1[2], r.v1[3]);
    }
    *(uint4*)(st + kkey * AT_KROW + kch * 16) = kq;
    char* vt = st + AT_KB + (vch * 8) * AT_VROW + vkey * 2;
    *(bf16_t*)(vt + 0 * AT_VROW) = (bf16_t)(vq.x & 0xffffu); *(bf16_t*)(vt + 1 * AT_VROW) = (bf16_t)(vq.x >> 16);
    *(bf16_t*)(vt + 2 * AT_VROW) = (bf16_t)(vq.y & 0xffffu); *(bf16_t*)(vt + 3 * AT_VROW) = (bf16_t)(vq.y >> 16);
    *(bf16_t*)(vt + 4 * AT_VROW) = (bf16_t)(vq.z & 0xffffu); *(bf16_t*)(vt + 5 * AT_VROW) = (bf16_t)(vq.z >> 16);
    *(bf16_t*)(vt + 6 * AT_VROW) = (bf16_t)(vq.w & 0xffffu); *(bf16_t*)(vt + 7 * AT_VROW) = (bf16_t)(vq.w >> 16);
  };
  KV sa_ = tile_load(0), sb_ = sa_;
  tile_store(0, smem, sa_);
  if (ntiles > 1) sb_ = tile_load(1);
  __syncthreads();
  const int qp = q0 + (lane & 31);
  auto compute = [&](int ti) {
    const char* st = smem + (ti & 1) * AT_STAGE;
    f32x16 sa;
#pragma unroll
    for (int r = 0; r < 16; ++r) sa[r] = 0.f;
#pragma unroll
    for (int s = 0; s < 4; ++s) {
      bf16x8 kf = *(const bf16x8*)(st + (lane & 31) * AT_KROW + (2 * s + hl) * 16);
      sa = __builtin_amdgcn_mfma_f32_32x32x16_bf16(kf, qf[s], sa, 0, 0, 0);
    }
    float tmax = -1e30f;
    if (lat && ti < nwin) {
      const int kp0 = ks0 + ti * 32 + 4 * hl;
#pragma unroll
      for (int r = 0; r < 16; ++r) {
        const int kp = kp0 + (r & 3) + 8 * (r >> 2);
        const int df = kp - qp;
        const bool ok = (df <= WINDOW) && (df >= -WINDOW);
        sa[r] = ok ? sa[r] * 0.125f : -1e30f;
        tmax = fmaxf(tmax, sa[r]);
      }
    } else {
#pragma unroll
      for (int r = 0; r < 16; ++r) { sa[r] *= 0.125f; tmax = fmaxf(tmax, sa[r]); }
    }
    tmax = fmaxf(tmax, __shfl_xor(tmax, 32));
    const float mnew = fmaxf(m, tmax);
    const float sc = __expf(m - mnew);
    float rs = 0.f;
#pragma unroll
    for (int r = 0; r < 16; ++r) { sa[r] = __expf(sa[r] - mnew); rs += sa[r]; }
    rs += __shfl_xor(rs, 32);
    lsum = lsum * sc + rs; m = mnew;
#pragma unroll
    for (int i = 0; i < 2; ++i)
#pragma unroll
      for (int r = 0; r < 16; ++r) O[i][r] *= sc;
    bf16x8 pb[2];
#pragma unroll
    for (int s2 = 0; s2 < 2; ++s2) {
      uint4 w;
      w.x = cvtpk(sa[8 * s2 + 0], sa[8 * s2 + 1]); w.y = cvtpk(sa[8 * s2 + 2], sa[8 * s2 + 3]);
      w.z = cvtpk(sa[8 * s2 + 4], sa[8 * s2 + 5]); w.w = cvtpk(sa[8 * s2 + 6], sa[8 * s2 + 7]);
      pb[s2] = __builtin_bit_cast(bf16x8, w);
    }
#pragma unroll
    for (int mt = 0; mt < 2; ++mt)
#pragma unroll
      for (int s2 = 0; s2 < 2; ++s2) {
        const char* vp = st + AT_KB + (mt * 32 + (lane & 31)) * AT_VROW + (16 * s2 + 4 * hl) * 2;
        uint2 lo = *(const uint2*)vp, hi = *(const uint2*)(vp + 16);
        uint4 w; w.x = lo.x; w.y = lo.y; w.z = hi.x; w.w = hi.y;
        O[mt] = __builtin_amdgcn_mfma_f32_32x32x16_bf16(__builtin_bit_cast(bf16x8, w), pb[s2], O[mt], 0, 0, 0);
      }
  };
  for (int ti = 0; ti < ntiles; ti += 2) {
    if (ti + 2 < ntiles) sa_ = tile_load(ti + 2);
    compute(ti);
    if (ti + 1 < ntiles) tile_store(ti + 1, smem + AT_STAGE, sb_);
    __syncthreads();
    if (ti + 1 >= ntiles) break;
    if (ti + 3 < ntiles) sb_ = tile_load(ti + 3);
    compute(ti + 1);
    if (ti + 2 < ntiles) tile_store(ti + 2, smem, sa_);
    __syncthreads();
  }
  const float inv = 1.f / lsum;
  bf16_t* orow = p.mixcat + (long)(t0 + qp) * MIX_W + head * HD;
#pragma unroll
  for (int mt = 0; mt < 2; ++mt)
#pragma unroll
    for (int q = 0; q < 4; ++q) {
      uint2 w;
      w.x = cvtpk(O[mt][4 * q] * inv, O[mt][4 * q + 1] * inv); w.y = cvtpk(O[mt][4 * q + 2] * inv, O[mt][4 * q + 3] * inv);
      *(uint2*)(orow + mt * 32 + 8 * q + 4 * hl) = w;
    }
}

constexpr int N_FO_LAT = DB * (DSEQ / 128) * 2 * 2, N_FO_CTX = BATCH * (SEQ / 128) * 2;
constexpr int MIX_CORE = N_S5_LAT + N_FO_LAT + N_AT_LAT + N_S5_CTX + N_FO_CTX + N_AT_CTX;
constexpr int CONV_PER_ITEM = 8, N_CONV_ITEMS = TR_EXP / CONV_PER_ITEM;
constexpr int MIX_ITEMS = MIX_CORE;
DEVFN void ph_mix_fast(const Params& p, int l, char* smem, int* s_item, int rep = 0, int lo = 0, int hi = MIX_ITEMS) {
  PHASE_BEGIN;
  unsigned* ctr = p.bar + 4096 + 64 * l + 16 * rep;
  bool first = true;
  for (;;) {
    if (tidx_ == 0) *s_item = lo + (first ? bidx_ : (int)(gridDim.x + atomicAdd(ctr, 1u)));
    first = false;
    __syncthreads();
    int item = *s_item;
    __syncthreads();
    if (item >= hi) break;
    int tidl = tidx_;
    asm volatile("" : "+v"(tidl));
    if (item < N_S5_LAT) { s5_unit(p, l, 1, item, smem, tidl); continue; }
    item -= N_S5_LAT;
    if (item < N_FO_LAT) { fourier_tile(p, item, smem, tidl); continue; }
    item -= N_FO_LAT;
    if (item < N_AT_LAT) { attn_item(p, l, 1, item, smem, tidl); continue; }
    item -= N_AT_LAT;
    if (item < N_S5_CTX) { s5_unit(p, l, 0, item, smem, tidl); continue; }
    item -= N_S5_CTX;
    if (item < N_FO_CTX) { fourier_tile(p, N_FO_LAT + item, smem, tidl); continue; }
    item -= N_FO_CTX;
    if (item < N_AT_CTX) { attn_item(p, l, 0, item, smem, tidl); continue; }
    item -= N_AT_CTX;
    conv_range(p, l, item * CONV_PER_ITEM, CONV_PER_ITEM, smem, tidl);
  }
}

DEVFN float s5_g(const Params& p, int l, long t, int c) {
  float y = p.ypart[t * S5_W + c] + p.ypart[((long)T + t) * S5_W + c] + p.s5_d[l * S5_W + c] * bf2f(p.proj[t * NPJ + PJ_U + c]);
  return gelu_fast(y);
}
struct GluALoader {
  const float* ypart; const float* s5d; const bf16_t* proj; long m0; int tid;
  DEVFN uint4 one(int kt, int i) const {
    const int kc = tid & 7, r0 = tid >> 3;
    const int c0 = kt * 64 + kc * 8;
    f32x4 d0 = *(const f32x4*)(s5d + c0), d1 = *(const f32x4*)(s5d + c0 + 4);
    const long t = m0 + r0 + 32 * i;
    const float* y0 = ypart + t * S5_W + c0; const float* y1 = ypart + ((long)T + t) * S5_W + c0;
    f32x4 a0 = *(const f32x4*)y0, a1 = *(const f32x4*)(y0 + 4), b0 = *(const f32x4*)y1, b1 = *(const f32x4*)(y1 + 4);
    uint4 u = *(const uint4*)(proj + t * NPJ + PJ_U + c0);
    float g0 = gelu_fast(a0[0] + b0[0] + d0[0] * bflo(u.x)), g1 = gelu_fast(a0[1] + b0[1] + d0[1] * bfhi(u.x));
    float g2 = gelu_fast(a0[2] + b0[2] + d0[2] * bflo(u.y)), g3 = gelu_fast(a0[3] + b0[3] + d0[3] * bfhi(u.y));
    float g4 = gelu_fast(a1[0] + b1[0] + d1[0] * bflo(u.z)), g5 = gelu_fast(a1[1] + b1[1] + d1[1] * bfhi(u.z));
    float g6 = gelu_fast(a1[2] + b1[2] + d1[2] * bflo(u.w)), g7 = gelu_fast(a1[3] + b1[3] + d1[3] * bfhi(u.w));
    uint4 w; w.x = cvtpk(g0, g1); w.y = cvtpk(g2, g3); w.z = cvtpk(g4, g5); w.w = cvtpk(g6, g7);
    return w;
  }
  DEVFN U4x4 operator()(int kt) const { U4x4 v; v.a = one(kt, 0); v.b = one(kt, 1); v.c = one(kt, 2); v.d = one(kt, 3); return v; }
};
DEVFN void ph_glu_fast3(const Params& p, int l, char* smem) {
  PHASE_BEGIN;
  const int lane = tidx_ & 63, wave = tidx_ >> 6;
  const bf16_t* wg = p.wglut + (long)l * S5_W * S5_W;
  const bf16_t* const wbase = wg + (long)(tidx_ >> 3) * S5_W + g_chunk(tidx_);
  auto stage_b = [&](char* st, int kt) {
    const bf16_t* bb = wbase;
    asm volatile("" : "+v"(bb));
    GRows X0, X1;
    X0.r0 = bb; X0.r1 = bb + 32 * S5_W; X0.r2 = bb + 64 * S5_W; X0.r3 = bb + 96 * S5_W;
    X1.r0 = bb + 128 * S5_W; X1.r1 = bb + 160 * S5_W; X1.r2 = bb + 192 * S5_W; X1.r3 = bb + 224 * S5_W;
    g_stage(st, wave, X0, X1, kt);
  };
  const int sw = (lane >> 1) & 7, h = lane >> 5;
  int off[4];
#pragma unroll
  for (int ks = 0; ks < 4; ++ks) off[ks] = (lane & 31) * 128 + (((2 * ks + h) ^ sw) * 16);
  char* img = smem + GL_STAGEB;
  for (int tile = bidx_; tile < T / 32; tile += gridDim.x) {
    const int m0 = tile * 32;
    __syncthreads();
    stage_b(smem, 0);
    {
      const int c0 = (tidx_ & 31) * 8, r0 = tidx_ >> 5;
      f32x4 d0 = *(const f32x4*)(p.s5_d + l * S5_W + c0), d1 = *(const f32x4*)(p.s5_d + l * S5_W + c0 + 4);
      f32x4 a0[4], a1[4], b0[4], b1[4]; uint4 u[4];
#pragma unroll
      for (int k = 0; k < 4; ++k) {
        const long t = m0 + r0 + 8 * k;
        const float* y0 = p.ypart + t * S5_W + c0; const float* y1 = p.ypart + ((long)T + t) * S5_W + c0;
        a0[k] = *(const f32x4*)y0; a1[k] = *(const f32x4*)(y0 + 4); b0[k] = *(const f32x4*)y1; b1[k] = *(const f32x4*)(y1 + 4);
        u[k] = *(const uint4*)(p.proj + t * NPJ + PJ_U + c0);
      }
      const int kt = (tidx_ & 31) >> 3, c = tidx_ & 7;
#pragma unroll
      for (int k = 0; k < 4; ++k) {
        const int r = r0 + 8 * k;
        float g0 = gelu_fast(a0[k][0] + b0[k][0] + d0[0] * bflo(u[k].x)), g1 = gelu_fast(a0[k][1] + b0[k][1] + d0[1] * bfhi(u[k].x));
        float g2 = gelu_fast(a0[k][2] + b0[k][2] + d0[2] * bflo(u[k].y)), g3 = gelu_fast(a0[k][3] + b0[k][3] + d0[3] * bfhi(u[k].y));
        float g4 = gelu_fast(a1[k][0] + b1[k][0] + d1[0] * bflo(u[k].z)), g5 = gelu_fast(a1[k][1] + b1[k][1] + d1[1] * bfhi(u[k].z));
        float g6 = gelu_fast(a1[k][2] + b1[k][2] + d1[2] * bflo(u[k].w)), g7 = gelu_fast(a1[k][3] + b1[k][3] + d1[3] * bfhi(u[k].w));
        uint4 w; w.x = cvtpk(g0, g1); w.y = cvtpk(g2, g3); w.z = cvtpk(g4, g5); w.w = cvtpk(g6, g7);
        *(uint4*)(img + kt * 4096 + r * 128 + ((c ^ ((r >> 1) & 7)) * 16)) = w;
      }
    }
    __syncthreads();
    bf16x8 af[16];
#pragma unroll
    for (int kt = 0; kt < 4; ++kt)
#pragma unroll
      for (int ks = 0; ks < 4; ++ks) af[kt * 4 + ks] = *(const bf16x8*)(img + kt * 4096 + off[ks]);
    unsigned ge[2][8];
#pragma unroll
    for (int nt = 0; nt < 2; ++nt)
#pragma unroll
      for (int q = 0; q < 4; ++q)
#pragma unroll
        for (int i2 = 0; i2 < 2; ++i2) {
          const int row = 8 * q + 4 * (lane >> 5) + 2 * i2, jc = 32 * nt + (lane & 31);
          const char* gp = img + wave * 4096 + row * 128 + (((jc >> 3) ^ ((row >> 1) & 7)) * 16) + (jc & 7) * 2;
          ge[nt][2 * q + i2] = (unsigned)*(const unsigned short*)gp | ((unsigned)*(const unsigned short*)(gp + 128) << 16);
        }
    asm volatile("s_waitcnt vmcnt(0)" ::: "memory");
    __syncthreads();
    f32x16 acc0, acc1;
#pragma unroll
    for (int r = 0; r < 16; ++r) { acc0[r] = 0.f; acc1[r] = 0.f; }
#pragma unroll
    for (int kt = 0; kt < 4; ++kt) {
      if (kt < 3) stage_b(smem + ((kt + 1) & 1) * GL_STAGEB, kt + 1);
      const char* sB = smem + (kt & 1) * GL_STAGEB + (wave >> 1) * GL_TILEB + (wave & 1) * 64 * 128;
#pragma unroll
      for (int ks = 0; ks < 4; ++ks) {
        const bf16x8 fb0 = *(const bf16x8*)(sB + off[ks]), fb1 = *(const bf16x8*)(sB + 32 * 128 + off[ks]);
        acc0 = __builtin_amdgcn_mfma_f32_32x32x16_bf16(af[kt * 4 + ks], fb0, acc0, 0, 0, 0);
        acc1 = __builtin_amdgcn_mfma_f32_32x32x16_bf16(af[kt * 4 + ks], fb1, acc1, 0, 0, 0);
      }
      asm volatile("s_waitcnt vmcnt(0)" ::: "memory");
      __syncthreads();
    }
    const bool odd = tidx_ & 1;
#pragma unroll
    for (int nt = 0; nt < 2; ++nt)
#pragma unroll
      for (int q = 0; q < 4; ++q) {
        const int row = 8 * q + 4 * (lane >> 5), j = 64 * wave + 32 * nt + (lane & 31);
        float r[4];
#pragma unroll
        for (int i = 0; i < 4; ++i) {
          const float v = nt ? acc1[4 * q + i] : acc0[4 * q + i];
          const unsigned gw = ge[nt][2 * q + (i >> 1)];
          r[i] = ((i & 1) ? bfhi(gw) : bflo(gw)) * sigmoid_fast(v);
        }
        store4_bf16(p.mixcat + (long)(m0 + row) * MIX_W + ATTN_W + FOUR_W + j, MIX_W, odd, r[0], r[1], r[2], r[3]);
      }
  }
}
DEVFN void ph_four_reduce(const Params& p) {
  PHASE_BEGIN;
  {
    const int nb = gridDim.x;
    int ridx = bidx_ - (T / 32) % nb; if (ridx < 0) ridx += nb;
    for (int it = ridx; it < DB * DSEQ / 16; it += nb) {
#pragma unroll
      for (int k = 0; k < 2; ++k) {
        const int ch = it * 512 + k * 256 + tidx_;
        const int row = ch >> 5, c8 = (ch & 31) * 8;
        const float* a = p.win2 + (long)row * FOUR_W + c8; const float* b = a + (long)DB * DSEQ * FOUR_W;
        const f32x4 a0 = *(const f32x4*)a, a1 = *(const f32x4*)(a + 4), b0 = *(const f32x4*)b, b1 = *(const f32x4*)(b + 4);
        uint4 w;
        w.x = cvtpk(a0[0] + b0[0], a0[1] + b0[1]); w.y = cvtpk(a0[2] + b0[2], a0[3] + b0[3]);
        w.z = cvtpk(a1[0] + b1[0], a1[1] + b1[1]); w.w = cvtpk(a1[2] + b1[2], a1[3] + b1[3]);
        *(uint4*)(p.mixcat + (long)(TC + row) * MIX_W + ATTN_W + c8) = w;
      }
    }
  }
}

DEVFN void ph_glu_fast2(const Params& p, int l, char* smem) {
  PHASE_BEGIN;
  constexpr int NT_N = S5_W / 128, NT_M = T / 128;
  for (int tile = bidx_; tile < NT_M * NT_N; tile += gridDim.x) {
    const int tm = tile / NT_N, tn = tile % NT_N;
    const int m0 = tm * 128, n0 = tn * 128;
    {
      const int c0 = (tidx_ & 31) * 8, r0 = tidx_ >> 5;
      f32x4 d0 = *(const f32x4*)(p.s5_d + l * S5_W + c0), d1 = *(const f32x4*)(p.s5_d + l * S5_W + c0 + 4);
#pragma unroll 1
      for (int i4 = 0; i4 < 4; ++i4) {
        f32x4 a0[4], a1[4], b0[4], b1[4]; uint4 u[4];
#pragma unroll
        for (int k = 0; k < 4; ++k) {
          const long t = m0 + r0 + 8 * (4 * i4 + k);
          const float* y0 = p.ypart + t * S5_W + c0; const float* y1 = p.ypart + ((long)T + t) * S5_W + c0;
          a0[k] = *(const f32x4*)y0; a1[k] = *(const f32x4*)(y0 + 4); b0[k] = *(const f32x4*)y1; b1[k] = *(const f32x4*)(y1 + 4);
          u[k] = *(const uint4*)(p.proj + t * NPJ + PJ_U + c0);
        }
#pragma unroll
        for (int k = 0; k < 4; ++k) {
          const long t = m0 + r0 + 8 * (4 * i4 + k);
          float g0 = gelu_fast(a0[k][0] + b0[k][0] + d0[0] * bflo(u[k].x)), g1 = gelu_fast(a0[k][1] + b0[k][1] + d0[1] * bfhi(u[k].x));
          float g2 = gelu_fast(a0[k][2] + b0[k][2] + d0[2] * bflo(u[k].y)), g3 = gelu_fast(a0[k][3] + b0[k][3] + d0[3] * bfhi(u[k].y));
          float g4 = gelu_fast(a1[k][0] + b1[k][0] + d1[0] * bflo(u[k].z)), g5 = gelu_fast(a1[k][1] + b1[k][1] + d1[1] * bfhi(u[k].z));
          float g6 = gelu_fast(a1[k][2] + b1[k][2] + d1[2] * bflo(u[k].w)), g7 = gelu_fast(a1[k][3] + b1[k][3] + d1[3] * bfhi(u[k].w));
          uint4 w; w.x = cvtpk(g0, g1); w.y = cvtpk(g2, g3); w.z = cvtpk(g4, g5); w.w = cvtpk(g6, g7);
          *(uint4*)(p.gbuf + t * S5_W + c0) = w;
        }
      }
    }
    asm volatile("s_waitcnt vmcnt(0)" ::: "memory");
    __syncthreads();
    GRows A = make_grows(tidx_, p.gbuf, m0, S5_W);
    GRows B = make_grows(tidx_, p.wglut + (long)l * S5_W * S5_W, n0, S5_W);
    const bool odd = tidx_ & 1;
    bool staged = false;
    bf16_t* gl = (bf16_t*)smem;
    gemm_tile_g(smem, tidx_, A, B, S5_W / 64, [&](int nt, int row, int col, float v0, float v1, float v2, float v3) {
      if (!staged) {
        uint4 t8[8];
#pragma unroll
        for (int i = 0; i < 8; ++i) { const int c = tidx_ + 256 * i; t8[i] = *(const uint4*)(p.gbuf + (long)(m0 + (c >> 4)) * S5_W + n0 + (c & 15) * 8); }
#pragma unroll
        for (int i = 0; i < 8; ++i) { const int c = tidx_ + 256 * i; *(uint4*)(gl + (c >> 4) * 128 + (c & 15) * 8) = t8[i]; }
        __syncthreads();
        staged = true;
      }
      const int j = n0 + col;
      float v[4] = {v0, v1, v2, v3};
      float gg[4];
#pragma unroll
      for (int i = 0; i < 4; ++i) gg[i] = bf2f(gl[(row + i) * 128 + col]);
#pragma unroll
      for (int i = 0; i < 4; ++i) {
        long t = m0 + row + i;
        float r = gg[i] * sigmoid_fast(v[i]);
        float pr = shx1(r);
        if (!odd) *(unsigned*)(p.mixcat + t * MIX_W + ATTN_W + FOUR_W + j) = cvtpk(r, pr);
      }
    });
  }
}

__global__ void __launch_bounds__(256, 2) __attribute__((amdgpu_waves_per_eu(2, 2))) mega(Params p) {
  __shared__ __attribute__((aligned(16))) char smem[SMEM_BYTES];
  __shared__ uint4 xb_words;
  __shared__ int s_item;
  if (threadIdx.x == 0) xb_words = make_uint4(0u, 0u, 0u, 0u);
  __syncthreads();
  XcdBarrier xb = xcd_barrier_post(p.bar, (volatile LAS unsigned*)&xb_words);
  volatile LAS unsigned* lead = (volatile LAS unsigned*)&xb_words + 2;
  volatile LAS int* s_cd = (volatile LAS int*)&xb_words + 3;
  ph_adaln_part(p, smem); ph_init_tr(p, smem); ph_init_tab(p, smem); xcd_barrier(xb);
  ph_adaln_reduce(p); ph_init_fold(p, smem); xcd_barrier(xb);
  int l = 0, ph = 0;
#pragma unroll 1
  for (;;) {
    if (ph == 0) { ph_row1_fast(p, l, smem); if (l == DEPTH) break; }
    else if (ph == 1) ph_gemm_in_fast(p, l, smem);
    else if (ph == 2) ph_mix_fast(p, l, smem, &s_item);
    else if (ph == 3) { ph_glu_fast3(p, l, smem); ph_four_reduce(p); }
    else if (ph == 4) ph_gemm_out_fast(p, l, smem);
    else if (ph == 5) ph_row2_fast(p, l, smem);
    else if (ph == 6) { ph_topk_fast(p, l, smem); int cd = *s_cd; __syncthreads(); ph_conv_catchup(p, l, cd, smem); if (threadIdx.x == 0) *s_cd = cd; }
    else if (ph == 7) ph_moe1_fast(p, l, smem);
    else ph_moe2_fast(p, l, smem);
    xcd_barrier_fill(xb, lead, [&]() {
      int tf = threadIdx.x, bf = blockIdx.x;
      asm volatile("" : "+v"(tf), "+s"(bf));
      int cd = *s_cd;
      __syncthreads();
      conv_fill(p, l, ph, cd, smem, tf, bf);
      if (tf == 0) *s_cd = cd;
    });
    if (++ph == 9) { ph = 0; ++l; }
  }
}

extern "C" void kernel_launch(void* const* d_in, const int* in_sizes, int n_in, void* d_out, int out_size, void* d_ws,
                              size_t ws_size, hipStream_t stream) {
  Params p{};
  const float** pp = (const float**)&p;
  for (int i = 0; i < 33; ++i) pp[i] = (const float*)d_in[i];
  p.out = (float*)d_out;
  char* w = (char*)d_ws;
  size_t off = 0;
  auto al = [&](size_t bytes) { void* r = w + off; off += (bytes + 255) & ~(size_t)255; return r; };
  p.bar = (unsigned*)al(64 * 1024);
  p.x = (float*)al((size_t)T * D * 4); p.mod = (float*)al((size_t)DEPTH * NCOND * 6 * D * 4);
  p.states = nullptr; p.ypart = (float*)al((size_t)2 * T * S5_W * 4); p.ybuf = (float*)al((size_t)T * D * 4); p.aff = (float*)al((size_t)T * NE * 4);
  p.wcs = (float*)al((size_t)DEPTH * 256 * 512 * 4); p.win2 = (float*)al((size_t)DEPTH * D * NP * 4);
  p.abar = (float*)al((size_t)DEPTH * 2 * SG * SP * 2 * 4); p.bbar = (float*)al((size_t)DEPTH * 2 * SG * SP * SH * 2 * 4);
  p.twc = (float*)al(SEQ * 2 * 4); p.twl = (float*)al(DSEQ * 2 * 4); p.selgate = (float*)al((size_t)NE * NS * 4);
  p.modpart = (float*)al((size_t)ADA_KC * DEPTH * NCOND * 6 * D * 4); p.afft = (float*)al((size_t)NE * T * 4); p.rope = (float*)al(64 * 16 * 2 * 4);
  p.h = (act_t*)al((size_t)T * D * sizeof(act_t)); p.proj = (act_t*)al((size_t)T * NPJ * sizeof(act_t));
  p.pqt = (act_t*)al((size_t)T * 512 * sizeof(act_t)); p.mixcat = (act_t*)al((size_t)T * MIX_W * sizeof(act_t));
  p.gbuf = (act_t*)al((size_t)T * S5_W * sizeof(act_t)); p.h2 = (act_t*)al((size_t)T * D * sizeof(act_t));
  p.hid = (act_t*)al((size_t)NE * NS * FF * sizeof(act_t)); p.ys = (act_t*)al((size_t)NE * NS * D * sizeof(act_t));
  p.win2t = (bf16_t*)al((size_t)DEPTH * NP * D * 2); p.woutt = (bf16_t*)al((size_t)DEPTH * D * MIX_W * 2);
  p.wglut = (bf16_t*)al((size_t)DEPTH * S5_W * S5_W * 2); p.dftc = (bf16_t*)al((size_t)SEQ * 2 * SEQ * 2);
  p.dftl = (bf16_t*)al((size_t)DSEQ * 2 * DSEQ * 2); p.wcst = (bf16_t*)al((size_t)DEPTH * 512 * 256 * 2);
  p.wgt = (bf16_t*)al((size_t)2 * NE * FF * D * 2); p.wut = (bf16_t*)al((size_t)2 * NE * FF * D * 2); p.wdt = (bf16_t*)al((size_t)2 * NE * D * FF * 2);
  p.bbn = (bf16_t*)al((size_t)DEPTH * 2 * SG * 128 * 16 * 2); p.cn = (bf16_t*)al((size_t)DEPTH * 2 * SG * SH * 128 * 2);
  p.seltok = (int*)al((size_t)NE * NS * 4); p.inv = (int*)al((size_t)T * NE * 4);
  static int grid_blocks = 0;
  if (!grid_blocks) {
    int dev = 0, cus = 0, per_cu = 0;
    (void)hipGetDevice(&dev);
    (void)hipDeviceGetAttribute(&cus, hipDeviceAttributeMultiprocessorCount, dev);
    (void)hipOccupancyMaxActiveBlocksPerMultiprocessor(&per_cu, mega, 256, 0);
    if (per_cu > 2) per_cu = 2;
    grid_blocks = cus * per_cu;
  }
  (void)hipMemsetAsync(p.bar, 0, 32768, stream);
  void* args[] = {&p};
  hipError_t e = hipLaunchCooperativeKernel((void*)mega, dim3(grid_blocks), dim3(256), args, 0, stream);
  if (e != hipSuccess) fprintf(stderr, "cooperative launch failed: %s (grid %d)\n", hipGetErrorString(e), grid_blocks);
}
```

```cpp
#include <hip/hip_runtime.h>
#include <hip/hip_cooperative_groups.h>
#include <cstdio>
#include <cstdint>
namespace cg = cooperative_groups;
#define DEVFN __device__ __forceinline__
#define PHASE_BEGIN int tidx_ = threadIdx.x; int bidx_ = blockIdx.x; asm volatile("" : "+v"(tidx_), "+s"(bidx_))
#define GTID ((long)bidx_ * 256 + tidx_)
#define GSIZE ((long)gridDim.x * 256)
#define ACT_BF16 1
#define HAVE_FAST 1

#ifdef CFG_SMALL
constexpr int D = 128, BATCH = 2, SEQ = 64, DEPTH = 2, DB = 2, DSEQ = 384, PAST = 64, FF = 64;
#else
constexpr int D = 1024, BATCH = 16, SEQ = 256, DEPTH = 4, DB = 4, DSEQ = 1024, PAST = 512, FF = 1024;
#endif
constexpr int GRID_W = 64, NH = 8, NKV = 2, HD = 64, GQA = 4, ATTN_W = 512, KV_W = 128, WINDOW = 128;
constexpr int FOUR_W = 256, S5_W = 256, SG = 16, SH = 16, SP = 64;
constexpr int MIX_W = 1024, IN_W = 1280, NE = 16;
constexpr int NP = 1536;
constexpr int PC_Q = 0, PC_K = 512, PC_V = 640, PC_P = 768, PC_QQ = 1024, PC_U = 1280;
constexpr int NPJ = 1024, PJ_Q = 0, PJ_K = 512, PJ_V = 640, PJ_U = 768;
constexpr int TC = BATCH * SEQ, TL = DB * DSEQ, T = TC + TL;
constexpr int NCOND = 1 + DB;
constexpr int CAPC = 2 * SEQ / NE, CAPL = 2 * DSEQ / NE;
constexpr int NS = BATCH * CAPC + DB * CAPL;
constexpr int NSEQ = BATCH + DB;
constexpr float LN_EPS = 1e-5f;
#ifdef CFG_SMALL
constexpr float ALPHA = 1.4142135623730951f;
#else
constexpr float ALPHA = 1.681792830507429f;
#endif

constexpr long O_YP = 0, O_YS = (long)TC * D, O_K = (long)T * D, O_V = O_K + (long)BATCH * DEPTH * SEQ * KV_W,
               O_SRE = O_V + (long)BATCH * DEPTH * SEQ * KV_W, O_SIM = O_SRE + (long)BATCH * DEPTH * 2 * SG * SP,
               O_END = O_SIM + (long)BATCH * DEPTH * 2 * SG * SP;

typedef unsigned short bf16_t;
#ifdef HOST_EMU
static inline unsigned f_as_u(float f) { unsigned u; memcpy(&u, &f, 4); return u; }
static inline float u_as_f(unsigned u) { float f; memcpy(&f, &u, 4); return f; }
#else
DEVFN unsigned f_as_u(float f) { return __float_as_uint(f); }
DEVFN float u_as_f(unsigned u) { return __uint_as_float(u); }
#endif
DEVFN bf16_t f2bf(float f) { unsigned u = f_as_u(f); u += 0x7fffu + ((u >> 16) & 1u); return (bf16_t)(u >> 16); }
DEVFN float bf2f(bf16_t b) { return u_as_f((unsigned)b << 16); }
#ifdef ACT_BF16
typedef bf16_t act_t;
DEVFN float lda(const act_t* p) { return bf2f(*p); }
DEVFN void sta(act_t* p, float v) { *p = f2bf(v); }
#else
typedef float act_t;
DEVFN float lda(const act_t* p) { return *p; }
DEVFN void sta(act_t* p, float v) { *p = v; }
#endif
struct Params {
  const float *x_prompt, *x_sample, *cache_k, *cache_v, *st_re, *st_im, *c, *c_ctx, *ln_in_g, *ln_in_b, *w_ada, *b_ada,
      *w_in, *w_fourier, *attn_sink, *s5_a_re, *s5_a_im, *s5_log_dt, *s5_b_re, *s5_b_im, *s5_c_re, *s5_c_im, *s5_d,
      *s5_w_glu, *w_out, *ln1_g, *ln1_b, *w_router, *w_gate, *w_up, *w_down, *ln2_g, *ln2_b;
  float* out;
  float *x, *mod, *states, *ybuf, *aff, *wcs, *win2, *abar, *bbar, *twc, *twl, *selgate, *modpart, *rope, *afft, *ypart;
  act_t *h, *proj, *pqt, *mixcat, *gbuf, *h2, *hid, *ys;
  bf16_t *win2t, *woutt, *wglut, *dftc, *dftl, *bbn, *cn, *wcst, *wgt, *wut, *wdt;
  int *seltok, *inv;
  unsigned* bar;
};

DEVFN float silu_f(float x) { return x / (1.f + expf(-x)); }
DEVFN float sigmoid_f(float x) { return 1.f / (1.f + expf(-x)); }
DEVFN float gelu_f(float x) { return 0.5f * x * (1.f + tanhf(0.7978845608028654f * (x + 0.044715f * x * x * x))); }

struct TokInfo { int lat, b, n, N, ci, t0; };
DEVFN TokInfo tokinfo(int t) {
  TokInfo r;
  if (t < TC) { r.lat = 0; r.b = t / SEQ; r.n = t % SEQ; r.N = SEQ; r.ci = 0; r.t0 = r.b * SEQ; }
  else { int tl = t - TC; r.lat = 1; r.b = tl / DSEQ; r.n = tl % DSEQ; r.N = DSEQ; r.ci = 1 + r.b; r.t0 = TC + r.b * DSEQ; }
  return r;
}
DEVFN const float* modp(const Params& p, int l, int ci, int chunk) { return p.mod + (((long)l * NCOND + ci) * 6 + chunk) * D; }

DEVFN void ph_init0(const Params& p) {
  PHASE_BEGIN;
  const long gt = GTID, gs = GSIZE;
#ifndef HAVE_FAST
  for (long idx = gt; idx < (long)DEPTH * 6 * D; idx += gs) {
    int l = idx / (6 * D), j = idx % (6 * D);
    float acc[NCOND];
#pragma unroll
    for (int c = 0; c < NCOND; ++c) acc[c] = 0.f;
    const float* w = p.w_ada + (long)l * D * 6 * D + j;
    for (int d = 0; d < D; ++d) {
      float wv = w[(long)d * 6 * D];
      acc[0] += silu_f(p.c_ctx[d]) * wv;
#pragma unroll
      for (int c = 1; c < NCOND; ++c) acc[c] += silu_f(p.c[(c - 1) * D + d]) * wv;
    }
    float bb = p.b_ada[(long)l * 6 * D + j];
#pragma unroll
    for (int c = 0; c < NCOND; ++c) p.mod[((long)l * NCOND + c) * 6 * D + j] = acc[c] + bb;
  }
#endif
  for (long idx = gt; idx < (long)DEPTH * 2 * SG * SP; idx += gs) {
    int pp = idx % SP; int g = (idx / SP) % SG; long ld = idx / (SP * SG);
    double are = p.s5_a_re[idx], aim = p.s5_a_im[idx];
    double dt = exp((double)p.s5_log_dt[ld * SG + g]);
    double er = exp(are * dt), cr = er * cos(aim * dt), ci = er * sin(aim * dt);
    p.abar[idx * 2] = (float)cr; p.abar[idx * 2 + 1] = (float)ci;
    double nr = cr - 1.0, ni = ci, den = are * are + aim * aim;
    double fr = (nr * are + ni * aim) / den, fi = (ni * are - nr * aim) / den;
    for (int h = 0; h < SH; ++h) {
      double br = p.s5_b_re[idx * SH + h], bi = p.s5_b_im[idx * SH + h];
      p.bbar[(idx * SH + h) * 2] = (float)(fr * br - fi * bi);
      p.bbar[(idx * SH + h) * 2 + 1] = (float)(fr * bi + fi * br);
#ifdef HAVE_FAST
      p.bbn[((ld * SG + g) * 128 + 2 * pp) * 16 + h] = f2bf((float)(fr * br - fi * bi));
      p.bbn[((ld * SG + g) * 128 + 2 * pp + 1) * 16 + h] = f2bf((float)(fr * bi + fi * br));
#endif
    }
  }
#ifdef HAVE_FAST
  for (long idx = gt; idx < (long)DEPTH * 2 * SG * SH * 128; idx += gs) {
    int k = idx % 128; long row = idx / 128;
    p.cn[idx] = f2bf((k & 1) ? -p.s5_c_im[row * SP + (k >> 1)] : p.s5_c_re[row * SP + (k >> 1)]);
  }
#endif
  for (long idx = gt; idx < SEQ; idx += gs) {
    double a = 6.283185307179586476925 * (double)idx / SEQ;
    p.twc[idx * 2] = (float)cos(a); p.twc[idx * 2 + 1] = (float)sin(a);
  }
  for (long idx = gt; idx < DSEQ; idx += gs) {
    double a = 6.283185307179586476925 * (double)idx / DSEQ;
    p.twl[idx * 2] = (float)cos(a); p.twl[idx * 2 + 1] = (float)sin(a);
  }
  for (long idx = gt; idx < (long)DEPTH * 256 * 256; idx += gs) {
    int j = idx % 256; int i = (idx / 256) % 256; int l = idx / (256 * 256);
    int hd = i / 64, c = i % 64;
    float sc = 0.f, ss = 0.f;
    for (int m = 0; m < 64; ++m) {
      int k = (m * c) & 63;
      float ang = 6.283185307179586f * (float)k / 64.f;
      float wv = p.w_fourier[((long)l * 256 + hd * 64 + m) * 256 + j];
      sc += cosf(ang) * wv; ss += sinf(ang) * wv;
    }
    p.wcs[((long)l * 256 + i) * 512 + j] = sc * 0.125f;
    p.wcs[((long)l * 256 + i) * 512 + 256 + j] = ss * 0.125f;
  }
}
DEVFN void ph_init1(const Params& p) {
  PHASE_BEGIN;
  const long gt = GTID, gs = GSIZE;
  for (long idx = gt; idx < (long)DEPTH * D * NP; idx += gs) {
    int j = idx % NP; int d = (idx / NP) % D; int l = idx / ((long)NP * D);
    const float* wrow = p.w_in + ((long)l * D + d) * IN_W;
    float v;
    if (j < PC_P) v = wrow[j];
    else if (j >= PC_U) v = wrow[1024 + (j - PC_U)];
    else {
      int jj = j - PC_P;
      float acc = 0.f;
      for (int i = 0; i < 256; ++i) acc += wrow[768 + i] * p.wcs[((long)l * 256 + i) * 512 + jj];
      v = acc;
    }
    p.win2[idx] = v;
#ifdef HAVE_FAST
    p.win2t[((long)l * NP + j) * D + d] = f2bf(v);
#endif
  }
}

DEVFN long pqt_base(int lat, int b) { return lat ? (long)TC * 512 + (long)b * 512 * DSEQ : (long)b * 512 * SEQ; }
DEVFN void ph_row1(const Params& p, int l) {
  PHASE_BEGIN;
  for (long t = GTID; t < T; t += GSIZE) {
    TokInfo ti = tokinfo((int)t);
    float* yb = p.ybuf + t * D;
    const float *g, *b;
    float sum = 0.f;
    if (l == 0) {
      const float* src = ti.lat ? p.x_sample + (t - TC) * D : p.x_prompt + t * D;
      for (int d = 0; d < D; ++d) { float v = src[d]; yb[d] = v; sum += v; }
      g = p.ln_in_g; b = p.ln_in_b;
    } else {
      const float* gate2 = modp(p, l - 1, ti.ci, 5);
      const float* xr = p.x + t * D;
      for (int d = 0; d < D; ++d) {
        float m = 0.f;
        for (int e = 0; e < NE; ++e) {
          int s = p.inv[t * NE + e];
          if (s >= 0) m += lda(p.ys + ((long)e * NS + s) * D + d);
        }
        float v = ALPHA * xr[d] + gate2[d] * m;
        yb[d] = v; sum += v;
      }
      g = p.ln2_g + (long)(l - 1) * D; b = p.ln2_b + (long)(l - 1) * D;
    }
    float mu = sum / D, var = 0.f;
    for (int d = 0; d < D; ++d) { float dv = yb[d] - mu; var += dv * dv; }
    float rs = 1.f / sqrtf(var / D + LN_EPS);
    if (l < DEPTH) {
      const float* sh = modp(p, l, ti.ci, 0); const float* sc = modp(p, l, ti.ci, 1);
      for (int d = 0; d < D; ++d) {
        float xv = (yb[d] - mu) * rs * g[d] + b[d];
        p.x[t * D + d] = xv;
        sta(p.h + t * D + d, xv * (1.f + sc[d]) + sh[d]);
      }
    } else {
      float* o = p.out + (ti.lat ? O_YS + (t - TC) * D : O_YP + t * D);
      for (int d = 0; d < D; ++d) o[d] = (yb[d] - mu) * rs * g[d] + b[d];
    }
  }
}

DEVFN void inproj_store(const Params& p, int l, long t, const TokInfo& ti, int j, float a0, float a1) {
  if (ti.lat && j < PC_V) {
    int i = (j % HD) / 2;
    int pos = (i < 16) ? (ti.n / GRID_W) : (ti.n % GRID_W);
    int fi = i & 15;
    float freq = powf(10000.f, -(float)fi / 16.f);
    float ang = (float)pos * freq;
    float cs = cosf(ang), sn = sinf(ang);
    float r0 = a0 * cs - a1 * sn, r1 = a0 * sn + a1 * cs;
    a0 = r0; a1 = r1;
  }
  if (j < PC_P) { sta(p.proj + t * NPJ + j, a0); sta(p.proj + t * NPJ + j + 1, a1); }
  else if (j >= PC_U) { sta(p.proj + t * NPJ + PJ_U + (j - PC_U), a0); sta(p.proj + t * NPJ + PJ_U + (j - PC_U) + 1, a1); }
  else {
    int jj = j - PC_P; int isq = jj >= 256; int jc = jj & 255;
    act_t* dst = p.pqt + pqt_base(ti.lat, ti.b) + (long)jc * 2 * ti.N + (isq ? ti.N : 0) + ti.n;
    sta(dst, a0); sta(dst + 2 * ti.N, a1);
  }
  if (!ti.lat && j >= PC_K && j < PC_P) {
    long base = (((long)ti.b * DEPTH + l) * SEQ + ti.n) * KV_W;
    if (j < PC_V) { p.out[O_K + base + (j - PC_K)] = a0; p.out[O_K + base + (j - PC_K) + 1] = a1; }
    else { p.out[O_V + base + (j - PC_V)] = a0; p.out[O_V + base + (j - PC_V) + 1] = a1; }
  }
}
DEVFN void ph_gemm_in(const Params& p, int l) {
  PHASE_BEGIN;
  for (long idx = GTID; idx < (long)T * (NP / 2); idx += GSIZE) {
    int jp = idx % (NP / 2); long t = idx / (NP / 2);
    int j = jp * 2;
    const act_t* hr = p.h + t * D;
    const float* w = p.win2 + (long)l * D * NP + j;
    float a0 = 0.f, a1 = 0.f;
    for (int d = 0; d < D; ++d) { float hv = lda(hr + d); a0 += hv * w[(long)d * NP]; a1 += hv * w[(long)d * NP + 1]; }
    TokInfo ti = tokinfo((int)t);
    inproj_store(p, l, t, ti, j, a0, a1);
  }
}

DEVFN float ldv(const float* p) { return *p; }
#ifdef ACT_BF16
DEVFN float ldv(const bf16_t* p) { return bf2f(*p); }
#endif
template <class KT>
DEVFN void attn_key(const float* q, const KT* kr, const KT* vr, float& m, float& den, float* acc) {
  float s = 0.f;
#pragma unroll
  for (int d = 0; d < HD; ++d) s += q[d] * ldv(kr + d);
  s *= 0.125f;
  if (s > m) {
    float f = expf(m - s);
    den *= f;
#pragma unroll
    for (int d = 0; d < HD; ++d) acc[d] *= f;
    m = s;
  }
  float pw = expf(s - m);
  den += pw;
#pragma unroll
  for (int d = 0; d < HD; ++d) acc[d] += pw * ldv(vr + d);
}
DEVFN void ph_attn(const Params& p, int l) {
  PHASE_BEGIN;
  for (long idx = GTID; idx < (long)T * NH; idx += GSIZE) {
    int hh = idx % NH; long t = idx / NH;
    TokInfo ti = tokinfo((int)t);
    int kvh = hh / GQA;
    float q[HD], acc[HD];
#pragma unroll
    for (int d = 0; d < HD; ++d) { q[d] = lda(p.proj + t * NPJ + PJ_Q + hh * HD + d); acc[d] = 0.f; }
    float m = p.attn_sink[l * NH + hh], den = 1.f;
    int j0 = 0, j1 = ti.N;
    if (ti.lat) { j0 = ti.n - WINDOW < 0 ? 0 : ti.n - WINDOW; j1 = ti.n + WINDOW + 1 > ti.N ? ti.N : ti.n + WINDOW + 1; }
    for (int j = j0; j < j1; ++j) {
      const act_t* kr = p.proj + (long)(ti.t0 + j) * NPJ + PJ_K + kvh * HD;
      const act_t* vr = p.proj + (long)(ti.t0 + j) * NPJ + PJ_V + kvh * HD;
      attn_key(q, kr, vr, m, den, acc);
    }
    if (ti.lat) {
      for (int s_ = 0; s_ < PAST; ++s_) {
        long base = ((((long)ti.b * DEPTH + l) * PAST + s_) * NKV + kvh) * HD;
        attn_key(q, p.cache_k + base, p.cache_v + base, m, den, acc);
      }
    }
    float inv = 1.f / den;
#pragma unroll
    for (int d = 0; d < HD; ++d) sta(p.mixcat + t * MIX_W + hh * HD + d, acc[d] * inv);
  }
}
DEVFN void ph_fourier(const Params& p, int l) {
  PHASE_BEGIN;
  for (long idx = GTID; idx < (long)T * FOUR_W; idx += GSIZE) {
    int j = idx % FOUR_W; long t = idx / FOUR_W;
    TokInfo ti = tokinfo((int)t);
    const float* tw = ti.lat ? p.twl : p.twc;
    const act_t* pr = p.pqt + pqt_base(ti.lat, ti.b) + (long)j * 2 * ti.N;
    float acc = 0.f;
    for (int n = 0; n < ti.N; ++n) {
      int k = (int)(((long)ti.n * n) % ti.N);
      acc += tw[k * 2] * lda(pr + n) - tw[k * 2 + 1] * lda(pr + ti.N + n);
    }
    sta(p.mixcat + t * MIX_W + ATTN_W + j, acc / sqrtf((float)ti.N));
  }
}
DEVFN void ph_s5scan(const Params& p, int l) {
  PHASE_BEGIN;
  for (long idx = GTID; idx < (long)NSEQ * 2 * SG * SP; idx += GSIZE) {
    int pp = idx % SP; int g = (idx / SP) % SG; int dir = (idx / (SP * SG)) % 2; int sq = idx / (SP * SG * 2);
    int lat = sq >= BATCH; int b = lat ? sq - BATCH : sq; int N = lat ? DSEQ : SEQ; int t0 = lat ? TC + b * DSEQ : b * SEQ;
    long pi = (((long)l * 2 + dir) * SG + g) * SP + pp;
    float ar = p.abar[pi * 2], ai = p.abar[pi * 2 + 1];
    float br[SH], bi[SH];
#pragma unroll
    for (int h = 0; h < SH; ++h) { br[h] = p.bbar[(pi * SH + h) * 2]; bi[h] = p.bbar[(pi * SH + h) * 2 + 1]; }
    float sr = 0.f, si = 0.f;
    if (lat) {
      long si0 = ((((long)b * DEPTH + l) * 2 + dir) * SG + g) * SP + pp;
      sr = p.st_re[si0]; si = p.st_im[si0];
    }
    for (int k = 0; k < N; ++k) {
      int n = dir ? N - 1 - k : k;
      const act_t* u = p.proj + (long)(t0 + n) * NPJ + PJ_U + g * SH;
      float bur = 0.f, bui = 0.f;
#pragma unroll
      for (int h = 0; h < SH; ++h) { float uv = lda(u + h); bur += br[h] * uv; bui += bi[h] * uv; }
      float nr = ar * sr - ai * si + bur, ni = ar * si + ai * sr + bui;
      sr = nr; si = ni;
      long so = ((((long)(t0 + n) * 2 + dir) * SG + g) * SP + pp) * 2;
      p.states[so] = sr; p.states[so + 1] = si;
    }
    if (!lat) {
      long oo = ((((long)b * DEPTH + l) * 2 + dir) * SG + g) * SP + pp;
      p.out[O_SRE + oo] = sr; p.out[O_SIM + oo] = si;
    }
  }
}
DEVFN void ph_s5y(const Params& p, int l) {
  PHASE_BEGIN;
  for (long idx = GTID; idx < (long)T * S5_W; idx += GSIZE) {
    int c = idx % S5_W; long t = idx / S5_W;
    int g = c / SH, h = c % SH;
    float y = p.s5_d[l * S5_W + c] * lda(p.proj + t * NPJ + PJ_U + c);
    for (int dir = 0; dir < 2; ++dir) {
      const float* cre = p.s5_c_re + ((((long)l * 2 + dir) * SG + g) * SH + h) * SP;
      const float* cim = p.s5_c_im + ((((long)l * 2 + dir) * SG + g) * SH + h) * SP;
      const float* st = p.states + ((((long)t * 2 + dir) * SG + g) * SP) * 2;
      for (int pp = 0; pp < SP; ++pp) y += cre[pp] * st[pp * 2] - cim[pp] * st[pp * 2 + 1];
    }
    sta(p.gbuf + t * S5_W + c, gelu_f(y));
  }
}
DEVFN void ph_s5glu(const Params& p, int l) {
  PHASE_BEGIN;
  for (long idx = GTID; idx < (long)T * S5_W; idx += GSIZE) {
    int j = idx % S5_W; long t = idx / S5_W;
    const act_t* gr = p.gbuf + t * S5_W;
    const float* w = p.s5_w_glu + (long)l * S5_W * S5_W + j;
    float z = 0.f;
    for (int i = 0; i < S5_W; ++i) z += lda(gr + i) * w[(long)i * S5_W];
    sta(p.mixcat + t * MIX_W + ATTN_W + FOUR_W + j, lda(gr + j) * sigmoid_f(z));
  }
}
DEVFN void ph_gemm_out(const Params& p, int l) {
  PHASE_BEGIN;
  for (long idx = GTID; idx < (long)T * D; idx += GSIZE) {
    int j = idx % D; long t = idx / D;
    const act_t* mr = p.mixcat + t * MIX_W;
    const float* w = p.w_out + (long)l * MIX_W * D + j;
    float acc = 0.f;
    for (int i = 0; i < MIX_W; ++i) acc += lda(mr + i) * w[(long)i * D];
    TokInfo ti = tokinfo((int)t);
    p.ybuf[idx] = ALPHA * p.x[idx] + modp(p, l, ti.ci, 2)[j] * acc;
  }
}
DEVFN void ph_row2(const Params& p, int l) {
  PHASE_BEGIN;
  for (long t = GTID; t < T; t += GSIZE) {
    TokInfo ti = tokinfo((int)t);
    const float* yb = p.ybuf + t * D;
    float sum = 0.f;
    for (int d = 0; d < D; ++d) sum += yb[d];
    float mu = sum / D, var = 0.f;
    for (int d = 0; d < D; ++d) { float dv = yb[d] - mu; var += dv * dv; }
    float rs = 1.f / sqrtf(var / D + LN_EPS);
    const float* g = p.ln1_g + (long)l * D; const float* b = p.ln1_b + (long)l * D;
    const float* sh = modp(p, l, ti.ci, 3); const float* sc = modp(p, l, ti.ci, 4);
    float lg[NE];
#pragma unroll
    for (int e = 0; e < NE; ++e) lg[e] = 0.f;
    for (int d = 0; d < D; ++d) {
      float xv = (yb[d] - mu) * rs * g[d] + b[d];
      p.x[t * D + d] = xv;
      float hv = xv * (1.f + sc[d]) + sh[d];
      sta(p.h2 + t * D + d, hv);
      const float* wr = p.w_router + ((long)l * D + d) * NE;
#pragma unroll
      for (int e = 0; e < NE; ++e) lg[e] += hv * wr[e];
    }
    float mx = lg[0];
#pragma unroll
    for (int e = 1; e < NE; ++e) mx = fmaxf(mx, lg[e]);
    float se = 0.f;
#pragma unroll
    for (int e = 0; e < NE; ++e) { lg[e] = expf(lg[e] - mx); se += lg[e]; }
    float is = 1.f / se;
#pragma unroll
    for (int e = 0; e < NE; ++e) p.aff[t * NE + e] = lg[e] * is;
  }
}
DEVFN void ph_topk(const Params& p, int l) {
  PHASE_BEGIN;
  for (long idx = GTID; idx < (long)T * NE; idx += GSIZE) {
    int e = idx % NE; long t = idx / NE;
    TokInfo ti = tokinfo((int)t);
    float a = p.aff[t * NE + e];
    int rank = 0;
    for (int j = 0; j < ti.N; ++j) {
      float aj = p.aff[(long)(ti.t0 + j) * NE + e];
      rank += (aj > a || (aj == a && j < ti.n)) ? 1 : 0;
    }
    int cap = ti.lat ? CAPL : CAPC;
    int slot = -1;
    if (rank < cap) {
      slot = ti.lat ? BATCH * CAPC + ti.b * CAPL + rank : ti.b * CAPC + rank;
      p.seltok[e * NS + slot] = (int)t;
      p.selgate[e * NS + slot] = a;
    }
    p.inv[t * NE + e] = slot;
  }
}
DEVFN void ph_moe1(const Params& p, int l) {
  PHASE_BEGIN;
  for (long idx = GTID; idx < (long)NE * NS * FF; idx += GSIZE) {
    int f = idx % FF; int s = (idx / FF) % NS; int e = idx / ((long)FF * NS);
    int tok = p.seltok[e * NS + s];
    const act_t* hr = p.h2 + (long)tok * D;
    const float* wg = p.w_gate + (((long)l * NE + e) * D) * FF + f;
    const float* wu = p.w_up + (((long)l * NE + e) * D) * FF + f;
    float ag = 0.f, au = 0.f;
    for (int d = 0; d < D; ++d) { float hv = lda(hr + d); ag += hv * wg[(long)d * FF]; au += hv * wu[(long)d * FF]; }
    sta(p.hid + idx, silu_f(ag) * au);
  }
}
DEVFN void ph_moe2(const Params& p, int l) {
  PHASE_BEGIN;
  for (long idx = GTID; idx < (long)NE * NS * D; idx += GSIZE) {
    int d = idx % D; int s = (idx / D) % NS; int e = idx / ((long)D * NS);
    const act_t* hr = p.hid + ((long)e * NS + s) * FF;
    const float* wd = p.w_down + (((long)l * NE + e) * FF) * D + d;
    float acc = 0.f;
    for (int f = 0; f < FF; ++f) acc += lda(hr + f) * wd[(long)f * D];
    sta(p.ys + idx, acc * p.selgate[e * NS + s]);
  }
}

constexpr int PH_PER_LAYER = 10;
constexpr int NPHASE = 2 + PH_PER_LAYER * DEPTH + 1;
#ifndef HAVE_FAST
DEVFN void run_phase(const Params& p, int ph) {
  if (ph == 0) { ph_init0(p); return; }
  if (ph == 1) { ph_init1(p); return; }
  int l = (ph - 2) / PH_PER_LAYER, s = (ph - 2) % PH_PER_LAYER;
  if (l == DEPTH) { ph_row1(p, DEPTH); return; }
  switch (s) {
    case 0: ph_row1(p, l); break;
    case 1: ph_gemm_in(p, l); break;
    case 2: ph_attn(p, l); ph_fourier(p, l); ph_s5scan(p, l); break;
    case 3: ph_s5y(p, l); break;
    case 4: ph_s5glu(p, l); break;
    case 5: ph_gemm_out(p, l); break;
    case 6: ph_row2(p, l); break;
    case 7: ph_topk(p, l); break;
    case 8: ph_moe1(p, l); break;
    case 9: ph_moe2(p, l); break;
  }
}
#endif
#define XB_TMO      128
#define XB_XCNT(j)  (256  + 64 * (j))
#define XB_XSUB(j)  (1280 + 64 * (j))
#define XB_XGEN(j)  (2304 + 64 * (j))
#define XB_TOP      3328
#define XB_TOPGEN   3392
#define XCD_BAR_WORDS 3456
#define XB_SPIN_CAP (1u << 20)
#define LAS __attribute__((address_space(3)))
DEVFN unsigned xb_ld(unsigned* p)              { return __hip_atomic_load(p, __ATOMIC_RELAXED, __HIP_MEMORY_SCOPE_AGENT); }
DEVFN unsigned xb_add(unsigned* p, unsigned v) { return __hip_atomic_fetch_add(p, v, __ATOMIC_RELAXED, __HIP_MEMORY_SCOPE_AGENT); }
DEVFN unsigned xb_xcc_id() { return (unsigned)__builtin_amdgcn_s_getreg((3 << 11) | 20) & 0xFu; }
#define XB_SPIN(cond, bar) do { unsigned _sp = 0; while (cond) { __builtin_amdgcn_s_sleep(1); \
    if ((++_sp & 255u) == 0u) { if (xb_ld(&(bar)[XB_TMO])) break; if (_sp > XB_SPIN_CAP) { atomicAdd(&(bar)[XB_TMO], 1u); break; } } } } while (0)
struct XcdBarrier { unsigned* bar; unsigned x; volatile LAS unsigned* st; };
DEVFN XcdBarrier xcd_barrier_post(unsigned* bar, volatile LAS unsigned* st) {
    XcdBarrier b; b.bar = bar; b.x = xb_xcc_id(); b.st = st;
    if (threadIdx.x == 0) (void)xb_add(&bar[XB_XCNT(b.x)], 1u);
    return b;
}
DEVFN void xcd_barrier_complete(unsigned* bar, unsigned x, unsigned& nloc, unsigned& nx) {
    const unsigned G = gridDim.x * gridDim.y * gridDim.z;
    unsigned sum, cnt, mine, sp = 0u;
    for (;;) {
        sum = 0u; cnt = 0u; mine = 0u;
#pragma unroll
        for (unsigned j = 0; j < 16; ++j) { const unsigned c = xb_ld(&bar[XB_XCNT(j)]); sum += c; cnt += (c > 0u) ? 1u : 0u; mine = (j == x) ? c : mine; }
        if (sum == G) break;
        __builtin_amdgcn_s_sleep(1);
        if ((++sp & 255u) == 0u) { if (xb_ld(&bar[XB_TMO])) break; if (sp > XB_SPIN_CAP) { atomicAdd(&bar[XB_TMO], 1u); break; } }
    }
    nloc = mine > 0u ? mine : 1u; nx = cnt > 0u ? cnt : 1u;
}
DEVFN void xcd_barrier(const XcdBarrier& b) {
    asm volatile("s_waitcnt vmcnt(0)" ::: "memory");
    __syncthreads();
    if (threadIdx.x == 0) {
        unsigned* bar = b.bar;
        __builtin_amdgcn_s_waitcnt(0);
        unsigned nloc = b.st[0], nx = b.st[1];
        if (nloc == 0u) { xcd_barrier_complete(bar, b.x, nloc, nx); b.st[0] = nloc; b.st[1] = nx; }
        const unsigned old = xb_add(&bar[XB_XSUB(b.x)], 1u);
        const unsigned gen = old / nloc;
        if (old + 1u == (gen + 1u) * nloc) {
            __builtin_amdgcn_fence(__ATOMIC_RELEASE, "agent");
            asm volatile("s_waitcnt vmcnt(0)" ::: "memory");
            const unsigned og = xb_add(&bar[XB_TOP], 1u);
            const unsigned tg = og / nx;
            if (og + 1u == (tg + 1u) * nx) xb_add(&bar[XB_TOPGEN], 1u);
            else XB_SPIN(xb_ld(&bar[XB_TOPGEN]) == tg, bar);
            __builtin_amdgcn_fence(__ATOMIC_ACQUIRE, "agent");
            xb_add(&bar[XB_XGEN(b.x)], 1u);
            asm volatile("s_waitcnt vmcnt(0)" ::: "memory");
        } else {
            XB_SPIN(xb_ld(&bar[XB_XGEN(b.x)]) == gen, bar);
            __builtin_amdgcn_fence(__ATOMIC_ACQUIRE, "agent");
            asm volatile("s_waitcnt vmcnt(0)" ::: "memory");
        }
    }
    __syncthreads();
}

template <class Fill>
DEVFN void xcd_barrier_fill(const XcdBarrier& b, volatile LAS unsigned* lead, Fill fill) {
    asm volatile("s_waitcnt vmcnt(0)" ::: "memory");
    __syncthreads();
    unsigned gen = 0u, nloc = 1u, nx = 1u;
    unsigned* bar = b.bar; unsigned bx = b.x;
    asm volatile("" : "+s"(bar), "+s"(bx));
    if (threadIdx.x == 0) {
        __builtin_amdgcn_s_waitcnt(0);
        nloc = b.st[0]; nx = b.st[1];
        if (nloc == 0u) { xcd_barrier_complete(bar, bx, nloc, nx); b.st[0] = nloc; b.st[1] = nx; }
        const unsigned old = xb_add(&bar[XB_XSUB(bx)], 1u);
        gen = old / nloc;
        *lead = (old + 1u == (gen + 1u) * nloc) ? 1u : 0u;
    }
    __syncthreads();
    const unsigned role = *lead;
    const bool leader = role == 1u;
    if (role == 0u) fill();
    asm volatile("" : "+s"(bar), "+s"(bx));
    if (threadIdx.x == 0) {
        if (leader) {
            __builtin_amdgcn_fence(__ATOMIC_RELEASE, "agent");
            asm volatile("s_waitcnt vmcnt(0)" ::: "memory");
            const unsigned og = xb_add(&bar[XB_TOP], 1u);
            const unsigned tg = og / nx;
            if (og + 1u == (tg + 1u) * nx) xb_add(&bar[XB_TOPGEN], 1u);
            else XB_SPIN(xb_ld(&bar[XB_TOPGEN]) == tg, bar);
            __builtin_amdgcn_fence(__ATOMIC_ACQUIRE, "agent");
            xb_add(&bar[XB_XGEN(bx)], 1u);
            asm volatile("s_waitcnt vmcnt(0)" ::: "memory");
        } else {
            XB_SPIN(xb_ld(&bar[XB_XGEN(bx)]) == gen, bar);
            __builtin_amdgcn_fence(__ATOMIC_ACQUIRE, "agent");
            asm volatile("s_waitcnt vmcnt(0)" ::: "memory");
        }
    }
    __syncthreads();
}
typedef __attribute__((ext_vector_type(8))) short bf16x8;
typedef __attribute__((ext_vector_type(16))) float f32x16;
typedef __attribute__((ext_vector_type(4))) float f32x4;

DEVFN float sigmoid_fast(float x) { return __frcp_rn(1.f + __expf(-x)); }
DEVFN float silu_fast(float x) { return x * sigmoid_fast(x); }
DEVFN float gelu_fast(float x) { float u = 0.7978845608028654f * (x + 0.044715f * x * x * x); return x * sigmoid_fast(2.f * u); }
typedef __attribute__((ext_vector_type(2))) float f32x2_t;
typedef __attribute__((ext_vector_type(2))) __bf16 bf16x2_t;
DEVFN unsigned cvtpk(float lo, float hi) { f32x2_t v = {lo, hi}; bf16x2_t b = __builtin_convertvector(v, bf16x2_t); return __builtin_bit_cast(unsigned, b); }

constexpr int G_ROWB = 144, G_TILEB = 128 * G_ROWB, G_STAGEB = 2 * G_TILEB;
constexpr int SMEM_BYTES = 2 * G_STAGEB;

struct U4x4 { uint4 a, b, c, d; };
struct F4x8 { f32x4 f0, f1, f2, f3, f4, f5, f6, f7; };
struct RowLoader {
  const bf16_t *r0, *r1, *r2, *r3;
  DEVFN U4x4 operator()(int kt) const {
    U4x4 v;
    v.a = *(const uint4*)(r0 + kt * 64); v.b = *(const uint4*)(r1 + kt * 64);
    v.c = *(const uint4*)(r2 + kt * 64); v.d = *(const uint4*)(r3 + kt * 64);
    return v;
  }
};
struct BF32Loader { const float* bp; long ldb; };

DEVFN void rl_store(char* tile, int tid, const U4x4& v) {
  char* d = tile + (tid >> 3) * G_ROWB + (tid & 7) * 16;
  *(uint4*)(d) = v.a; *(uint4*)(d + 32 * G_ROWB) = v.b; *(uint4*)(d + 64 * G_ROWB) = v.c; *(uint4*)(d + 96 * G_ROWB) = v.d;
}
DEVFN F4x8 bf_load(const BF32Loader& L, int kt) {
  F4x8 f;
  const float* b = L.bp + (long)(kt * 64) * L.ldb;
  f.f0 = *(const f32x4*)(b); f.f1 = *(const f32x4*)(b + L.ldb); f.f2 = *(const f32x4*)(b + 2 * L.ldb); f.f3 = *(const f32x4*)(b + 3 * L.ldb);
  f.f4 = *(const f32x4*)(b + 4 * L.ldb); f.f5 = *(const f32x4*)(b + 5 * L.ldb); f.f6 = *(const f32x4*)(b + 6 * L.ldb); f.f7 = *(const f32x4*)(b + 7 * L.ldb);
  return f;
}
template <int I>
DEVFN uint4 bf_pack(const F4x8& f) {
  uint4 wv;
  wv.x = cvtpk(f.f0[I], f.f1[I]); wv.y = cvtpk(f.f2[I], f.f3[I]); wv.z = cvtpk(f.f4[I], f.f5[I]); wv.w = cvtpk(f.f6[I], f.f7[I]);
  return wv;
}
DEVFN void bf_store(char* tile, int tid, const F4x8& f) {
  int lane = tid & 63, w = tid >> 6, kg = lane & 7, ng = w * 8 + (lane >> 3);
  char* d = tile + (4 * ng) * G_ROWB + kg * 16;
  *(uint4*)(d) = bf_pack<0>(f); *(uint4*)(d + G_ROWB) = bf_pack<1>(f); *(uint4*)(d + 2 * G_ROWB) = bf_pack<2>(f); *(uint4*)(d + 3 * G_ROWB) = bf_pack<3>(f);
}

DEVFN void gemm_compute(const char* st, int wm, int wn, int fro, f32x16 (&acc)[2][2]) {
  const char* sA = st + wm * 64 * G_ROWB + fro;
  const char* sB = st + G_TILEB + wn * 64 * G_ROWB + fro;
#pragma unroll
  for (int ks = 0; ks < 4; ++ks) {
    bf16x8 a0 = *(const bf16x8*)(sA + ks * 32);
    bf16x8 a1 = *(const bf16x8*)(sA + 32 * G_ROWB + ks * 32);
    bf16x8 b0 = *(const bf16x8*)(sB + ks * 32);
    bf16x8 b1 = *(const bf16x8*)(sB + 32 * G_ROWB + ks * 32);
    acc[0][0] = __builtin_amdgcn_mfma_f32_32x32x16_bf16(a0, b0, acc[0][0], 0, 0, 0);
    acc[0][1] = __builtin_amdgcn_mfma_f32_32x32x16_bf16(a0, b1, acc[0][1], 0, 0, 0);
    acc[1][0] = __builtin_amdgcn_mfma_f32_32x32x16_bf16(a1, b0, acc[1][0], 0, 0, 0);
    acc[1][1] = __builtin_amdgcn_mfma_f32_32x32x16_bf16(a1, b1, acc[1][1], 0, 0, 0);
  }
}
template <class ALd, class BLd, class Epi>
DEVFN void gemm_tile(char* smem, int tidx_, const ALd& A, const BLd& B, int KT, Epi epi) {
  const int tid = tidx_, lane = tid & 63, wave = tid >> 6, wm = wave >> 1, wn = wave & 1;
  f32x16 acc[2][2];
#pragma unroll
  for (int i = 0; i < 2; ++i)
#pragma unroll
    for (int j = 0; j < 2; ++j)
#pragma unroll
      for (int r = 0; r < 16; ++r) acc[i][j][r] = 0.f;
  const int fro = (lane & 31) * G_ROWB + (lane >> 5) * 16;
  U4x4 a0 = A(0), b0 = B(0);
  U4x4 a1 = A(1), b1 = B(1);
  rl_store(smem, tid, a0); rl_store(smem + G_TILEB, tid, b0);
  __syncthreads();
  for (int kt = 0; kt < KT; kt += 2) {
    if (kt + 2 < KT) { a0 = A(kt + 2); b0 = B(kt + 2); }
    gemm_compute(smem, wm, wn, fro, acc);
    rl_store(smem + G_STAGEB, tid, a1); rl_store(smem + G_STAGEB + G_TILEB, tid, b1);
    __syncthreads();
    if (kt + 3 < KT) { a1 = A(kt + 3); b1 = B(kt + 3); }
    gemm_compute(smem + G_STAGEB, wm, wn, fro, acc);
    if (kt + 2 < KT) { rl_store(smem, tid, a0); rl_store(smem + G_TILEB, tid, b0); }
    __syncthreads();
  }
#pragma unroll
  for (int mt = 0; mt < 2; ++mt)
#pragma unroll
    for (int q = 0; q < 4; ++q)
#pragma unroll
      for (int nt = 0; nt < 2; ++nt) {
        int row = wm * 64 + mt * 32 + 8 * q + 4 * (lane >> 5);
        int col = wn * 64 + nt * 32 + (lane & 31);
        epi(nt, row, col, acc[mt][nt][4 * q], acc[mt][nt][4 * q + 1], acc[mt][nt][4 * q + 2], acc[mt][nt][4 * q + 3]);
      }
}

template <class ALd, class BLd, class Epi>
DEVFN void gemm_tile1(char* smem, int tidx_, const ALd& A, const BLd& B, int KT, Epi epi) {
  const int tid = tidx_, lane = tid & 63, wave = tid >> 6, wm = wave >> 1, wn = wave & 1;
  f32x16 acc[2][2];
#pragma unroll
  for (int i = 0; i < 2; ++i)
#pragma unroll
    for (int j = 0; j < 2; ++j)
#pragma unroll
      for (int r = 0; r < 16; ++r) acc[i][j][r] = 0.f;
  const int fro = (lane & 31) * G_ROWB + (lane >> 5) * 16;
  U4x4 av = A(0), bv = B(0);
  rl_store(smem, tid, av); rl_store(smem + G_TILEB, tid, bv);
  __syncthreads();
  for (int kt = 0; kt < KT; ++kt) {
    const int cur = kt & 1;
    const bool more = kt + 1 < KT;
    if (more) { av = A(kt + 1); bv = B(kt + 1); }
    gemm_compute(smem + cur * G_STAGEB, wm, wn, fro, acc);
    if (more) { char* st = smem + (cur ^ 1) * G_STAGEB; rl_store(st, tid, av); rl_store(st + G_TILEB, tid, bv); }
    __syncthreads();
  }
#pragma unroll
  for (int mt = 0; mt < 2; ++mt)
#pragma unroll
    for (int q = 0; q < 4; ++q)
#pragma unroll
      for (int nt = 0; nt < 2; ++nt) {
        int row = wm * 64 + mt * 32 + 8 * q + 4 * (lane >> 5);
        int col = wn * 64 + nt * 32 + (lane & 31);
        epi(nt, row, col, acc[mt][nt][4 * q], acc[mt][nt][4 * q + 1], acc[mt][nt][4 * q + 2], acc[mt][nt][4 * q + 3]);
      }
}

constexpr int GL_TILEB = 128 * 128, GL_STAGEB = 2 * GL_TILEB;
struct GRows { const bf16_t *r0, *r1, *r2, *r3; };
DEVFN int g_chunk(int tid) { return ((tid & 7) ^ ((tid >> 4) & 7)) * 8; }
DEVFN GRows make_grows(int tid, const bf16_t* base, long row0, long ld) {
  GRows L;
  const bf16_t* b0 = base + (row0 + (tid >> 3)) * ld + g_chunk(tid);
  L.r0 = b0; L.r1 = b0 + 32 * ld; L.r2 = b0 + 64 * ld; L.r3 = b0 + 96 * ld;
  return L;
}
DEVFN void glds16_nt(const bf16_t* src, unsigned lds_dst) {
  unsigned keep;
  asm volatile("s_mov_b32 %0, m0\n\ts_mov_b32 m0, %2\n\ts_nop 0\n\tglobal_load_lds_dwordx4 %1, off nt\n\ts_mov_b32 m0, %0"
               : "=&s"(keep) : "v"(src), "s"(lds_dst));
}
DEVFN void glds16(const bf16_t* src, unsigned lds_dst) {
  unsigned keep;
  asm volatile("s_mov_b32 %0, m0\n\ts_mov_b32 m0, %2\n\ts_nop 0\n\tglobal_load_lds_dwordx4 %1, off\n\ts_mov_b32 m0, %0"
               : "=&s"(keep) : "v"(src), "s"(lds_dst));
}
DEVFN unsigned lds_addr(const char* p) { return (unsigned)(unsigned long)(const __attribute__((address_space(3))) char*)p; }
DEVFN void g_stage(char* st, int wave, const GRows& A, const GRows& B, int kt) {
  const unsigned sa = (unsigned)__builtin_amdgcn_readfirstlane((int)(lds_addr(st) + wave * 1024));
  const unsigned sb = sa + GL_TILEB;
  glds16(A.r0 + kt * 64, sa); glds16(A.r1 + kt * 64, sa + 4096); glds16(A.r2 + kt * 64, sa + 8192); glds16(A.r3 + kt * 64, sa + 12288);
  glds16(B.r0 + kt * 64, sb); glds16(B.r1 + kt * 64, sb + 4096); glds16(B.r2 + kt * 64, sb + 8192); glds16(B.r3 + kt * 64, sb + 12288);
}
template <int I>
DEVFN void g_stage_part(unsigned sa, const GRows& A, const GRows& B, int kt) {
  const bf16_t* ar = I == 0 ? A.r0 : I == 1 ? A.r1 : I == 2 ? A.r2 : A.r3;
  const bf16_t* br = I == 0 ? B.r0 : I == 1 ? B.r1 : I == 2 ? B.r2 : B.r3;
  glds16(ar + kt * 64, sa + I * 4096);
  glds16(br + kt * 64, sa + GL_TILEB + I * 4096);
}
template <class Epi>
DEVFN void gemm_tile_g(char* smem, int tidx_, const GRows& A, const GRows& B, int KT, Epi epi, int koff = 0) {
  const int tid = tidx_, lane = tid & 63, wave = tid >> 6, wm = wave >> 1, wn = wave & 1;
  f32x16 acc[2][2];
#pragma unroll
  for (int i = 0; i < 2; ++i)
#pragma unroll
    for (int j = 0; j < 2; ++j)
#pragma unroll
      for (int r = 0; r < 16; ++r) acc[i][j][r] = 0.f;
  const int sw = (lane >> 1) & 7, h = lane >> 5;
  int off[4];
#pragma unroll
  for (int ks = 0; ks < 4; ++ks) off[ks] = (lane & 31) * 128 + ((((2 * ks) ^ (sw & 6)) | (h ^ (sw & 1))) * 16);
  const unsigned sbase = (unsigned)__builtin_amdgcn_readfirstlane((int)(lds_addr(smem) + wave * 1024));
  g_stage(smem, wave, A, B, koff & (KT - 1));
  asm volatile("s_waitcnt vmcnt(0)" ::: "memory");
  __syncthreads();
  for (int kt = 0; kt < KT; ++kt) {
    const int cur = kt & 1;
    const bool more = kt + 1 < KT;
    const int ktn = (kt + 1 + koff) & (KT - 1);
    const unsigned san = sbase + (cur ^ 1) * GL_STAGEB;
    const char* sA = smem + cur * GL_STAGEB + wm * 64 * 128;
    const char* sB = smem + cur * GL_STAGEB + GL_TILEB + wn * 64 * 128;
    bf16x8 fa0[2], fa1[2], fb0[2], fb1[2];
    fa0[0] = *(const bf16x8*)(sA + off[0]); fa1[0] = *(const bf16x8*)(sA + 32 * 128 + off[0]);
    fb0[0] = *(const bf16x8*)(sB + off[0]); fb1[0] = *(const bf16x8*)(sB + 32 * 128 + off[0]);
#pragma unroll
    for (int ks = 0; ks < 4; ++ks) {
      const int c = ks & 1, n = c ^ 1;
      if (ks < 3) {
        fa0[n] = *(const bf16x8*)(sA + off[ks + 1]); fa1[n] = *(const bf16x8*)(sA + 32 * 128 + off[ks + 1]);
        fb0[n] = *(const bf16x8*)(sB + off[ks + 1]); fb1[n] = *(const bf16x8*)(sB + 32 * 128 + off[ks + 1]);
      }
      __builtin_amdgcn_sched_barrier(0);
      if (more) {
        if (ks == 0) { g_stage_part<0>(san, A, B, ktn); g_stage_part<1>(san, A, B, ktn); }
        else if (ks == 1) { g_stage_part<2>(san, A, B, ktn); g_stage_part<3>(san, A, B, ktn); }
      }
      acc[0][0] = __builtin_amdgcn_mfma_f32_32x32x16_bf16(fa0[c], fb0[c], acc[0][0], 0, 0, 0);
      acc[0][1] = __builtin_amdgcn_mfma_f32_32x32x16_bf16(fa0[c], fb1[c], acc[0][1], 0, 0, 0);
      acc[1][0] = __builtin_amdgcn_mfma_f32_32x32x16_bf16(fa1[c], fb0[c], acc[1][0], 0, 0, 0);
      acc[1][1] = __builtin_amdgcn_mfma_f32_32x32x16_bf16(fa1[c], fb1[c], acc[1][1], 0, 0, 0);
      __builtin_amdgcn_sched_barrier(0);
    }
    asm volatile("s_waitcnt vmcnt(0)" ::: "memory");
    __syncthreads();
  }
#pragma unroll
  for (int mt = 0; mt < 2; ++mt)
#pragma unroll
    for (int q = 0; q < 4; ++q)
#pragma unroll
      for (int nt = 0; nt < 2; ++nt) {
        int row = wm * 64 + mt * 32 + 8 * q + 4 * (lane >> 5);
        int col = wn * 64 + nt * 32 + (lane & 31);
        epi(nt, row, col, acc[mt][nt][4 * q], acc[mt][nt][4 * q + 1], acc[mt][nt][4 * q + 2], acc[mt][nt][4 * q + 3]);
      }
}

DEVFN int xcd_order(int v, int nblocks, int grp) {
  if (nblocks != 512) return v;
  const int it = v / nblocks, b = v % nblocks;
  const int x = b & 7, slot = b >> 3, per = nblocks >> 3;
  const int q = it * per + slot;
  return ((q / grp) * 8 + x) * grp + (q % grp);
}
struct PatchTile { int tm, tn, koff; };
DEVFN PatchTile patch8(int v, int nblocks, int& pidx) {
  const int it = v / nblocks, b = v % nblocks;
  const int x = b & 7, slot = b >> 3;
  PatchTile t; t.tm = slot & 7; t.tn = slot >> 3; t.koff = (t.tm + t.tn) & 7;
  pidx = it * 8 + x;
  return t;
}
DEVFN RowLoader make_rows(int tidx_, const bf16_t* base, long row0, long ld) {
  RowLoader L; int tid = tidx_;
  const bf16_t* b0 = base + (row0 + (tid >> 3)) * ld + (tid & 7) * 8;
  L.r0 = b0; L.r1 = b0 + 32 * ld; L.r2 = b0 + 64 * ld; L.r3 = b0 + 96 * ld;
  return L;
}
DEVFN float shx1(float v) { return __builtin_bit_cast(float, __builtin_amdgcn_mov_dpp(__builtin_bit_cast(int, v), 0xB1, 0xF, 0xF, true)); }
DEVFN void store4_bf16(bf16_t* p0, long ld, bool odd, float v0, float v1, float v2, float v3) {
  bf16_t* q = odd ? p0 + ld - 1 : p0;
  const float y0 = shx1(odd ? v0 : v1), y1 = shx1(odd ? v2 : v3);
  *(unsigned*)q = cvtpk(odd ? y0 : v0, odd ? v1 : y0);
  *(unsigned*)(q + 2 * ld) = cvtpk(odd ? y1 : v2, odd ? v3 : y1);
}

DEVFN void ph_init_fast(const Params& p) {
  PHASE_BEGIN;
  const long gt = GTID, gs = GSIZE;
  for (long idx = gt; idx < (long)DEPTH * D * MIX_W; idx += gs) {
    int k = idx % MIX_W; int n = (idx / MIX_W) % D; int l = idx / ((long)MIX_W * D);
    p.woutt[idx] = f2bf(p.w_out[((long)l * MIX_W + k) * D + n]);
  }
  for (long idx = gt; idx < (long)DEPTH * S5_W * S5_W; idx += gs) {
    int k = idx % S5_W; int n = (idx / S5_W) % S5_W; int l = idx / (S5_W * S5_W);
    p.wglut[idx] = f2bf(p.s5_w_glu[((long)l * S5_W + k) * S5_W + n]);
  }
  for (long idx = gt; idx < (long)SEQ * 2 * SEQ; idx += gs) {
    int n2 = idx % (2 * SEQ), k = idx / (2 * SEQ); int n = n2 % SEQ;
    double a = 6.283185307179586476925 * (double)(((long)k * n) % SEQ) / SEQ;
    double v = (n2 < SEQ ? cos(a) : -sin(a)) / sqrt((double)SEQ);
    p.dftc[idx] = f2bf((float)v);
  }
  for (long idx = gt; idx < (long)DSEQ * 2 * DSEQ; idx += gs) {
    int n2 = idx % (2 * DSEQ), k = idx / (2 * DSEQ); int n = n2 % DSEQ;
    double a = 6.283185307179586476925 * (double)(((long)k * n) % DSEQ) / DSEQ;
    double v = (n2 < DSEQ ? cos(a) : -sin(a)) / sqrt((double)DSEQ);
    p.dftl[idx] = f2bf((float)v);
  }
  for (long idx = gt; idx < 64 * 16; idx += gs) {
    int fi = idx % 16, pos = idx / 16;
    float freq = powf(10000.f, -(float)fi / 16.f);
    float ang = (float)pos * freq;
    p.rope[idx * 2] = cosf(ang); p.rope[idx * 2 + 1] = sinf(ang);
  }
}
DEVFN void ph_init_fast2(const Params& p) {
  PHASE_BEGIN;
  const long gt = GTID, gs = GSIZE;
  for (long idx = gt; idx < (long)DEPTH * NP * D; idx += gs) {
    int k = idx % D; int n = (idx / D) % NP; int l = idx / ((long)D * NP);
    p.win2t[idx] = f2bf(p.win2[((long)l * D + k) * NP + n]);
  }
}

constexpr int CONV_EARLY = 14;
DEVFN void conv_range(const Params& p, int l, int first, int count, char* smem, int tid);
DEVFN void ph_gemm_in_fast(const Params& p, int l, char* smem) {
  PHASE_BEGIN;
  constexpr int NT_N = NP / 128, NT_M = T / 128;
  float* ropes = (float*)(smem + 2 * GL_STAGEB);
  for (int i = tidx_; i < 64 * 16 * 2 / 4; i += 256) ((f32x4*)ropes)[i] = ((const f32x4*)p.rope)[i];
  __syncthreads();
  for (int v = bidx_; v < NT_M * NT_N; v += gridDim.x) {
    const int tile = xcd_order(v, gridDim.x, 8 * NT_N);
    const int tm = tile / NT_N, tn = tile % NT_N;
    const int koff = gridDim.x == 512 ? (tm + tn) & 15 : 0;
    const int m0 = tm * 128, n0 = tn * 128;
    GRows A = make_grows(tidx_, p.h, m0, D);
    GRows B = make_grows(tidx_, p.win2t + (long)l * NP * D, n0, D);
    const TokInfo t0i = tokinfo(m0);
    const int lane = tidx_ & 63;
    const bool odd = lane & 1;
    gemm_tile_g(smem, tidx_, A, B, D / 64, [&](int nt, int row, int col, float v0, float v1, float v2, float v3) {
      const int j = n0 + col;
      const long t = m0 + row;
      const int n = t0i.n + row;
      float v[4] = {v0, v1, v2, v3};
      if (n0 >= PC_P && n0 < PC_U) {
        int jj = j - PC_P; int isq = jj >= 256; int jc = jj & 255;
        bf16_t* dst = p.pqt + pqt_base(t0i.lat, t0i.b) + (long)jc * 2 * t0i.N + (isq ? t0i.N : 0) + n;
        uint2 pk; pk.x = cvtpk(v[0], v[1]); pk.y = cvtpk(v[2], v[3]);
        *(uint2*)dst = pk;
        return;
      }
      float pr[4];
#pragma unroll
      for (int i = 0; i < 4; ++i) pr[i] = shx1(v[i]);
      if (t0i.lat && n0 < PC_V) {
        int pi = (j & 63) >> 1; int fi = pi & 15;
#pragma unroll
        for (int i = 0; i < 4; ++i) {
          int pos = (pi < 16) ? ((n + i) >> 6) : ((n + i) & 63);
          const f32x2_t csn = *(const f32x2_t*)(ropes + (pos * 16 + fi) * 2); const float cs = csn[0], sn = csn[1];
          float x1 = odd ? pr[i] : v[i], x2 = odd ? v[i] : pr[i];
          float r0 = x1 * cs - x2 * sn, r1 = x1 * sn + x2 * cs;
          v[i] = odd ? r1 : r0; pr[i] = odd ? r0 : r1;
        }
      }
      const int pj = (n0 < PC_P) ? j : PJ_U + (j - PC_U);
      {
        bf16_t* q = p.proj + (t + (odd ? 1 : 0)) * NPJ + (pj & ~1);
        *(unsigned*)q = odd ? cvtpk(pr[1], v[1]) : cvtpk(v[0], pr[0]);
        *(unsigned*)(q + 2 * NPJ) = odd ? cvtpk(pr[3], v[3]) : cvtpk(v[2], pr[2]);
      }
      if (!t0i.lat && n0 >= PC_K && n0 < PC_P) {
        float* ob = p.out + (n0 < PC_V ? O_K + (j - PC_K) : O_V + (j - PC_V));
#pragma unroll
        for (int i = 0; i < 4; ++i) ob[(((long)t0i.b * DEPTH + l) * SEQ + n + i) * KV_W] = v[i];
      }
    }, koff);
  }
}
DEVFN void ph_gemm_out_fast(const Params& p, int l, char* smem) {
  PHASE_BEGIN;
  constexpr int NT_N = D / 128, NT_M = T / 128;
  for (int v = bidx_; v < NT_M * NT_N; v += gridDim.x) {
    int tm, tn, koff = 0;
    if (gridDim.x == 512) { int pidx; PatchTile pt = patch8(v, 512, pidx); tm = pidx * 8 + pt.tm; tn = pt.tn; koff = pt.koff; }
    else { tm = v / NT_N; tn = v % NT_N; }
    const int m0 = tm * 128, n0 = tn * 128;
    GRows A = make_grows(tidx_, p.mixcat, m0, MIX_W);
    GRows B = make_grows(tidx_, p.woutt + (long)l * D * MIX_W, n0, MIX_W);
    const TokInfo t0i = tokinfo(m0);
    const float* gate1 = modp(p, l, t0i.ci, 2);
    const int lane_ = tidx_ & 63, cb = n0 + ((tidx_ >> 6) & 1) * 64 + (lane_ & 31);
    const float g0 = gate1[cb], g1 = gate1[cb + 32];
    gemm_tile_g(smem, tidx_, A, B, MIX_W / 64, [&](int nt, int row, int col, float v0, float v1, float v2, float v3) {
      const float g = nt ? g1 : g0;
      store4_bf16((bf16_t*)p.ybuf + (long)(m0 + row) * D + n0 + col, D, lane_ & 1, g * v0, g * v1, g * v2, g * v3);
    }, koff);
  }
}
DEVFN void ph_glu_fast(const Params& p, int l, char* smem) {
  PHASE_BEGIN;
  constexpr int NT_N = S5_W / 128, NT_M = T / 128;
  for (int tile = bidx_; tile < NT_M * NT_N; tile += gridDim.x) {
    const int tm = tile / NT_N, tn = tile % NT_N;
    const int m0 = tm * 128, n0 = tn * 128;
    RowLoader A = make_rows(tidx_, p.gbuf, m0, S5_W);
    RowLoader B = make_rows(tidx_, p.wglut + (long)l * S5_W * S5_W, n0, S5_W);
    const bool odd = tidx_ & 1;
    gemm_tile(smem, tidx_, A, B, S5_W / 64, [&](int nt, int row, int col, float v0, float v1, float v2, float v3) {
      const int j = n0 + col;
      float v[4] = {v0, v1, v2, v3};
#pragma unroll
      for (int i = 0; i < 4; ++i) {
        long t = m0 + row + i;
        float g = bf2f(p.gbuf[t * S5_W + j]);
        float r = g * sigmoid_f(v[i]);
        float pr = shx1(r);
        if (!odd) *(unsigned*)(p.mixcat + t * MIX_W + ATTN_W + FOUR_W + j) = cvtpk(r, pr);
      }
    });
  }
}
DEVFN void fourier_tile(const Params& p, int item, char* smem, int tidx_) {
  constexpr int NL = DB * (DSEQ / 128) * 2 * 2;
  int lat, b, tm, tn, N, hk, KT;
  if (item < NL) { lat = 1; N = DSEQ; hk = item & 1; tn = (item >> 1) & 1; tm = (item >> 2) % (DSEQ / 128); b = item / (4 * (DSEQ / 128)); KT = DSEQ / 64; }
  else { int it = item - NL; lat = 0; N = SEQ; hk = 0; tn = it & 1; tm = (it >> 1) % (SEQ / 128); b = it / (2 * (SEQ / 128)); KT = 2 * SEQ / 64; }
  const int t0 = lat ? TC + b * DSEQ : b * SEQ;
  GRows A = make_grows(tidx_, (lat ? p.dftl : p.dftc) + hk * DSEQ, tm * 128, 2 * N);
  GRows B = make_grows(tidx_, p.pqt + pqt_base(lat, b) + hk * DSEQ, tn * 128, 2 * N);
  const bool odd = tidx_ & 1;
  float* dst = p.win2 + ((long)hk * DB * DSEQ + b * DSEQ + tm * 128) * FOUR_W + tn * 128;
  gemm_tile_g(smem, tidx_, A, B, KT, [&](int nt, int row, int col, float v0, float v1, float v2, float v3) {
    if (lat) {
      float* d = dst + (long)row * FOUR_W + col;
      d[0] = v0; d[FOUR_W] = v1; d[2 * FOUR_W] = v2; d[3 * FOUR_W] = v3;
    } else {
      store4_bf16(p.mixcat + (long)(t0 + tm * 128 + row) * MIX_W + ATTN_W + tn * 128 + col, MIX_W, odd, v0, v1, v2, v3);
    }
  });
}
constexpr int N_FOURIER_ITEMS = DB * (DSEQ / 128) * 2 + BATCH * (SEQ / 128) * 2;
DEVFN void ph_fourier_fast(const Params& p, int l, char* smem) {
  PHASE_BEGIN;
  for (int item = bidx_; item < N_FOURIER_ITEMS; item += gridDim.x) fourier_tile(p, item, smem, tidx_);
}
DEVFN void ph_moe1_fast(const Params& p, int l, char* smem) {
  PHASE_BEGIN;
  constexpr int NT_M = NS / 128, NT_N = FF / 64;
  const int tid = tidx_, lane = tid & 63;
  auto decode = [&](int v, int& tm, int& tn, int& e, int& koff) {
    koff = 0;
    if (gridDim.x == 512) { int pidx; PatchTile pt = patch8(v, 512, pidx); e = pidx >> 1; tm = pt.tm; tn = (pidx & 1) * 8 + pt.tn; koff = pt.koff; }
    else { tm = v % NT_M; tn = (v / NT_M) % NT_N; e = v / (NT_M * NT_N); }
  };
  int sn0 = 0, sn1 = 0, sn2 = 0, sn3 = 0;
  if (bidx_ < NE * NT_M * NT_N) {
    int tm, tn, e, koff; decode(bidx_, tm, tn, e, koff);
    const int* stp = p.seltok + e * NS + tm * 128 + (tid >> 3);
    sn0 = stp[0]; sn1 = stp[32]; sn2 = stp[64]; sn3 = stp[96];
  }
  for (int v = bidx_; v < NE * NT_M * NT_N; v += gridDim.x) {
    int tm, tn, e, koff;
    decode(v, tm, tn, e, koff);
    const int s0 = tm * 128, f0 = tn * 64;
    GRows A;
    {
      const bf16_t* hb = p.h2 + g_chunk(tid);
      A.r0 = hb + (long)sn0 * D; A.r1 = hb + (long)sn1 * D; A.r2 = hb + (long)sn2 * D; A.r3 = hb + (long)sn3 * D;
    }
    if (v + (int)gridDim.x < NE * NT_M * NT_N) {
      int tm2, tn2, e2, koff2; decode(v + gridDim.x, tm2, tn2, e2, koff2);
      const int* stp = p.seltok + e2 * NS + tm2 * 128 + (tid >> 3);
      sn0 = stp[0]; sn1 = stp[32]; sn2 = stp[64]; sn3 = stp[96];
    }
    GRows B;
    {
      const long o = (((long)(l & 1) * NE + e) * FF + f0 + (tid >> 3)) * D + g_chunk(tid);
      B.r0 = p.wgt + o; B.r1 = p.wut + o; B.r2 = p.wgt + o + 32L * D; B.r3 = p.wut + o + 32L * D;
    }
    const bool odd = lane & 1;
    float gsave[4];
    gemm_tile_g(smem, tidx_, A, B, D / 64, [&](int nt, int row, int col, float v0, float v1, float v2, float v3) {
      if (nt == 0) { gsave[0] = v0; gsave[1] = v1; gsave[2] = v2; gsave[3] = v3; return; }
      float v[4] = {v0, v1, v2, v3};
      const int ff = f0 + 32 * (col >> 6) + (col & 31);
      store4_bf16(p.hid + ((long)e * NS + s0 + row) * FF + ff, FF, odd, silu_fast(gsave[0]) * v[0], silu_fast(gsave[1]) * v[1],
                  silu_fast(gsave[2]) * v[2], silu_fast(gsave[3]) * v[3]);
    }, koff);
  }
}
DEVFN void ph_moe2_fast(const Params& p, int l, char* smem) {
  PHASE_BEGIN;
  constexpr int NT_M = NS / 128, NT_N = D / 128;
  const int lane = tidx_ & 63;
  for (int v = bidx_; v < NE * NT_M * NT_N; v += gridDim.x) {
    int tm, tn, e, koff = 0;
    if (gridDim.x == 512) { int pidx; PatchTile pt = patch8(v, 512, pidx); e = pidx; tm = pt.tm; tn = pt.tn; koff = pt.koff; }
    else { tm = v % NT_M; tn = (v / NT_M) % NT_N; e = v / (NT_M * NT_N); }
    const int s0 = tm * 128, n0 = tn * 128;
    GRows A = make_grows(tidx_, p.hid + (long)e * NS * FF, s0, FF);
    GRows B = make_grows(tidx_, p.wdt + ((long)(l & 1) * NE + e) * D * FF, n0, FF);
    const bool odd = lane & 1;
    gemm_tile_g(smem, tidx_, A, B, FF / 64, [&](int nt, int row, int col, float v0, float v1, float v2, float v3) {
      store4_bf16(p.ys + ((long)e * NS + s0 + row) * D + n0 + col, D, odd, v0, v1, v2, v3);
    }, koff);
  }
}
template <int CTRL> DEVFN float dppf(float v) {
  return __builtin_bit_cast(float, __builtin_amdgcn_mov_dpp(__builtin_bit_cast(int, v), CTRL, 0xF, 0xF, true));
}
DEVFN float rdlane(float v, int l) { return __builtin_bit_cast(float, __builtin_amdgcn_readlane(__builtin_bit_cast(int, v), l)); }
DEVFN float wave_sum(float v) {
  v += dppf<0xB1>(v);
  v += dppf<0x4E>(v);
  v += dppf<0x141>(v);
  v += dppf<0x140>(v);
  return (rdlane(v, 0) + rdlane(v, 16)) + (rdlane(v, 32) + rdlane(v, 48));
}
DEVFN float bflo(unsigned u) { return u_as_f(u << 16); }
DEVFN float bfhi(unsigned u) { return u_as_f(u & 0xffff0000u); }

struct RowX { f32x4 a0, a1, a2, a3; };
struct RowG { uint2 u00, u01, u02, u03, u10, u11, u12, u13, u20, u21, u22, u23, u30, u31, u32, u33; float g0, g1, g2, g3; unsigned rest; };
DEVFN void ph_row1_fast(const Params& p, int l, char* smem) {
  PHASE_BEGIN;
  const int lane = tidx_ & 63, d0 = 4 * lane;
  float* prm = (float*)smem;
  for (int t4 = (bidx_ * 4 + (tidx_ >> 6)) * 4; t4 < T; t4 += gridDim.x * 16) {
    TokInfo ti = tokinfo(t4);
    const float *pxs = p.x_sample, *pxp = p.x_prompt, *px = p.x, *pg0 = p.ln_in_g, *pb0 = p.ln_in_b, *pg2 = p.ln2_g, *pb2 = p.ln2_b;
    asm volatile("" : "+s"(pxs), "+s"(pxp), "+s"(px), "+s"(pg0), "+s"(pb0), "+s"(pg2), "+s"(pb2));
    const float* src4 = l == 0 ? (ti.lat ? pxs + (long)(t4 - TC) * D : pxp + (long)t4 * D) : px + (long)t4 * D;
    const float* g = l == 0 ? pg0 : pg2 + (long)(l - 1) * D;
    const float* b = l == 0 ? pb0 : pb2 + (long)(l - 1) * D;
    const float* gate2 = modp(p, l > 0 ? l - 1 : 0, ti.ci, 5);
    const int lm = l < DEPTH ? l : DEPTH - 1;
    const float* sh = modp(p, lm, ti.ci, 0); const float* sc = modp(p, lm, ti.ci, 1);
    int iv0 = -1, iv1 = -1, iv2 = -1, iv3 = -1;
    if (l > 0 && lane < NE) {
      const int* ip = p.inv + (long)t4 * NE + lane;
      iv0 = ip[0]; iv1 = ip[NE]; iv2 = ip[2 * NE]; iv3 = ip[3 * NE];
    }
    __syncthreads();
    {
      const f32x4 a0 = *(const f32x4*)(g + 4 * tidx_), a1 = *(const f32x4*)(b + 4 * tidx_), a2 = *(const f32x4*)(gate2 + 4 * tidx_);
      const f32x4 a3 = *(const f32x4*)(sh + 4 * tidx_), a4 = *(const f32x4*)(sc + 4 * tidx_);
      *(f32x4*)(prm + 4 * tidx_) = a0; *(f32x4*)(prm + D + 4 * tidx_) = a1; *(f32x4*)(prm + 2 * D + 4 * tidx_) = a2;
      *(f32x4*)(prm + 3 * D + 4 * tidx_) = a3; *(f32x4*)(prm + 4 * D + 4 * tidx_) = a4;
    }
    __syncthreads();
    auto xload = [&](int k) -> RowX {
      const float* s_ = src4 + (long)k * D + d0;
      RowX r; r.a0 = *(const f32x4*)s_; r.a1 = *(const f32x4*)(s_ + 256); r.a2 = *(const f32x4*)(s_ + 512); r.a3 = *(const f32x4*)(s_ + 768);
      return r;
    };
    auto gather = [&](int myinv) -> RowG {
      RowG r;
      const uint2 z = make_uint2(0u, 0u);
      r.u00 = r.u01 = r.u02 = r.u03 = r.u10 = r.u11 = r.u12 = r.u13 = r.u20 = r.u21 = r.u22 = r.u23 = r.u30 = r.u31 = r.u32 = r.u33 = z;
      r.g0 = r.g1 = r.g2 = r.g3 = 0.f;
      unsigned mask = (unsigned)__ballot(myinv >= 0) & 0xffffu;
      if (mask) {
        const int e = __builtin_ctz(mask); mask &= mask - 1; const int s_ = __builtin_amdgcn_readlane(myinv, e);
        const bf16_t* yr = p.ys + ((long)e * NS + s_) * D + d0; r.g0 = p.selgate[e * NS + s_];
        r.u00 = *(const uint2*)yr; r.u01 = *(const uint2*)(yr + 256); r.u02 = *(const uint2*)(yr + 512); r.u03 = *(const uint2*)(yr + 768);
      }
      if (mask) {
        const int e = __builtin_ctz(mask); mask &= mask - 1; const int s_ = __builtin_amdgcn_readlane(myinv, e);
        const bf16_t* yr = p.ys + ((long)e * NS + s_) * D + d0; r.g1 = p.selgate[e * NS + s_];
        r.u10 = *(const uint2*)yr; r.u11 = *(const uint2*)(yr + 256); r.u12 = *(const uint2*)(yr + 512); r.u13 = *(const uint2*)(yr + 768);
      }
      if (mask) {
        const int e = __builtin_ctz(mask); mask &= mask - 1; const int s_ = __builtin_amdgcn_readlane(myinv, e);
        const bf16_t* yr = p.ys + ((long)e * NS + s_) * D + d0; r.g2 = p.selgate[e * NS + s_];
        r.u20 = *(const uint2*)yr; r.u21 = *(const uint2*)(yr + 256); r.u22 = *(const uint2*)(yr + 512); r.u23 = *(const uint2*)(yr + 768);
      }
      if (mask) {
        const int e = __builtin_ctz(mask); mask &= mask - 1; const int s_ = __builtin_amdgcn_readlane(myinv, e);
        const bf16_t* yr = p.ys + ((long)e * NS + s_) * D + d0; r.g3 = p.selgate[e * NS + s_];
        r.u30 = *(const uint2*)yr; r.u31 = *(const uint2*)(yr + 256); r.u32 = *(const uint2*)(yr + 512); r.u33 = *(const uint2*)(yr + 768);
      }
      r.rest = mask;
      return r;
    };
    RowX xc = xload(0);
    RowG gc; gc.rest = 0u;
    if (l > 0) gc = gather(iv0);
#pragma unroll 1
    for (int k = 0; k < 4; ++k) {
      const int t = t4 + k;
      const int ivc = k == 0 ? iv0 : k == 1 ? iv1 : k == 2 ? iv2 : iv3;
      const int ivn = k == 0 ? iv1 : k == 1 ? iv2 : iv3;
      RowX xn = xc; RowG gn = gc;
      if (k < 3) { xn = xload(k + 1); if (l > 0) gn = gather(ivn); }
      const f32x4 xa[4] = {xc.a0, xc.a1, xc.a2, xc.a3};
      float v[16];
      if (l == 0) {
#pragma unroll
        for (int i = 0; i < 4; ++i) { v[4 * i] = xa[i][0]; v[4 * i + 1] = xa[i][1]; v[4 * i + 2] = xa[i][2]; v[4 * i + 3] = xa[i][3]; }
      } else {
        float m[16];
        {
          const uint2 u0[4] = {gc.u00, gc.u01, gc.u02, gc.u03}, u1[4] = {gc.u10, gc.u11, gc.u12, gc.u13};
          const uint2 u2[4] = {gc.u20, gc.u21, gc.u22, gc.u23}, u3[4] = {gc.u30, gc.u31, gc.u32, gc.u33};
#pragma unroll
          for (int i = 0; i < 4; ++i) {
            m[4 * i] = gc.g0 * bflo(u0[i].x) + gc.g1 * bflo(u1[i].x) + gc.g2 * bflo(u2[i].x) + gc.g3 * bflo(u3[i].x);
            m[4 * i + 1] = gc.g0 * bfhi(u0[i].x) + gc.g1 * bfhi(u1[i].x) + gc.g2 * bfhi(u2[i].x) + gc.g3 * bfhi(u3[i].x);
            m[4 * i + 2] = gc.g0 * bflo(u0[i].y) + gc.g1 * bflo(u1[i].y) + gc.g2 * bflo(u2[i].y) + gc.g3 * bflo(u3[i].y);
            m[4 * i + 3] = gc.g0 * bfhi(u0[i].y) + gc.g1 * bfhi(u1[i].y) + gc.g2 * bfhi(u2[i].y) + gc.g3 * bfhi(u3[i].y);
          }
        }
        unsigned mask = gc.rest;
        while (mask) {
          const int e = __builtin_ctz(mask); mask &= mask - 1;
          const int s_ = __builtin_amdgcn_readlane(ivc, e);
          const bf16_t* yr = p.ys + ((long)e * NS + s_) * D + d0;
          const float gk = p.selgate[e * NS + s_];
#pragma unroll
          for (int i = 0; i < 4; ++i) {
            const uint2 u = *(const uint2*)(yr + 256 * i);
            m[4 * i] += gk * bflo(u.x); m[4 * i + 1] += gk * bfhi(u.x); m[4 * i + 2] += gk * bflo(u.y); m[4 * i + 3] += gk * bfhi(u.y);
          }
        }
#pragma unroll
        for (int i = 0; i < 4; ++i) {
          const f32x4 g2 = *(const f32x4*)(prm + 2 * D + 256 * i + d0);
#pragma unroll
          for (int c = 0; c < 4; ++c) v[4 * i + c] = ALPHA * xa[i][c] + g2[c] * m[4 * i + c];
        }
      }
      float s = 0.f;
#pragma unroll
      for (int i = 0; i < 16; ++i) s += v[i];
      const float mu = wave_sum(s) * (1.f / D);
      float q = 0.f;
#pragma unroll
      for (int i = 0; i < 16; ++i) { float dv = v[i] - mu; q += dv * dv; }
      const float rs = 1.f / sqrtf(wave_sum(q) * (1.f / D) + LN_EPS);
      if (l < DEPTH) {
#pragma unroll
        for (int i = 0; i < 4; ++i) {
          f32x4 xo; float hv[4];
          const f32x4 lg = *(const f32x4*)(prm + 256 * i + d0), lb = *(const f32x4*)(prm + D + 256 * i + d0);
          const f32x4 ls = *(const f32x4*)(prm + 3 * D + 256 * i + d0), lc = *(const f32x4*)(prm + 4 * D + 256 * i + d0);
#pragma unroll
          for (int c = 0; c < 4; ++c) { xo[c] = (v[4 * i + c] - mu) * rs * lg[c] + lb[c]; hv[c] = xo[c] * (1.f + lc[c]) + ls[c]; }
          *(f32x4*)(p.x + (long)t * D + 256 * i + d0) = xo;
          uint2 pk; pk.x = cvtpk(hv[0], hv[1]); pk.y = cvtpk(hv[2], hv[3]);
          *(uint2*)(p.h + (long)t * D + 256 * i + d0) = pk;
        }
      } else {
        float* o = p.out + (ti.lat ? O_YS + (long)(t - TC) * D : O_YP + (long)t * D);
#pragma unroll
        for (int i = 0; i < 4; ++i) {
          f32x4 xo;
          const f32x4 lg = *(const f32x4*)(prm + 256 * i + d0), lb = *(const f32x4*)(prm + D + 256 * i + d0);
#pragma unroll
          for (int c = 0; c < 4; ++c) xo[c] = (v[4 * i + c] - mu) * rs * lg[c] + lb[c];
          *(f32x4*)(o + 256 * i + d0) = xo;
        }
      }
      xc = xn; gc = gn;
    }
  }
}

DEVFN void ph_row2_fast(const Params& p, int l, char* smem) {
  PHASE_BEGIN;
  const int lane = tidx_ & 63;
  float* wrt = (float*)smem;
#pragma unroll
  for (int q = tidx_; q < D * NE / 4; q += 256) {
    f32x4 v = *(const f32x4*)(p.w_router + (long)l * D * NE + q * 4);
    const int d = q >> 2, e4 = (q & 3) * 4;
    wrt[(e4 + 0) * D + d] = v[0]; wrt[(e4 + 1) * D + d] = v[1]; wrt[(e4 + 2) * D + d] = v[2]; wrt[(e4 + 3) * D + d] = v[3];
  }
  __syncthreads();
  for (int t4 = (bidx_ * 4 + (tidx_ >> 6)) * 4; t4 < T; t4 += gridDim.x * 16) {
    TokInfo ti = tokinfo(t4);
    const float* g = p.ln1_g + (long)l * D; const float* b = p.ln1_b + (long)l * D;
    const float* sh = modp(p, l, ti.ci, 3); const float* sc = modp(p, l, ti.ci, 4);
    uint2 ya[4]; f32x4 xa[4], lg[4], lb[4], ls[4], lc[4];
#pragma unroll
    for (int i = 0; i < 4; ++i) {
      const int dd = 256 * i + 4 * lane;
      ya[i] = *(const uint2*)((const bf16_t*)p.ybuf + (long)t4 * D + dd); xa[i] = *(const f32x4*)(p.x + (long)t4 * D + dd);
      lg[i] = *(const f32x4*)(g + dd); lb[i] = *(const f32x4*)(b + dd); ls[i] = *(const f32x4*)(sh + dd); lc[i] = *(const f32x4*)(sc + dd);
    }
#pragma unroll 1
   for (int k = 0; k < 4; ++k) {
    const int t = t4 + k;
    uint2 yn[4]; f32x4 xn[4];
#pragma unroll
    for (int i = 0; i < 4; ++i) { yn[i] = ya[i]; xn[i] = xa[i]; }
    if (k < 3) {
#pragma unroll
      for (int i = 0; i < 4; ++i) {
        const int dd = 256 * i + 4 * lane;
        yn[i] = *(const uint2*)((const bf16_t*)p.ybuf + (long)(t + 1) * D + dd); xn[i] = *(const f32x4*)(p.x + (long)(t + 1) * D + dd);
      }
    }
    float v[16];
#pragma unroll
    for (int i = 0; i < 4; ++i) {
      v[4 * i] = ALPHA * xa[i][0] + bflo(ya[i].x); v[4 * i + 1] = ALPHA * xa[i][1] + bfhi(ya[i].x);
      v[4 * i + 2] = ALPHA * xa[i][2] + bflo(ya[i].y); v[4 * i + 3] = ALPHA * xa[i][3] + bfhi(ya[i].y);
    }
    float s = 0.f;
#pragma unroll
    for (int i = 0; i < 16; ++i) s += v[i];
    const float mu = wave_sum(s) * (1.f / D);
    float q = 0.f;
#pragma unroll
    for (int i = 0; i < 16; ++i) { float dv = v[i] - mu; q += dv * dv; }
    const float rs = 1.f / sqrtf(wave_sum(q) * (1.f / D) + LN_EPS);
    float lgt[NE];
#pragma unroll
    for (int e = 0; e < NE; ++e) lgt[e] = 0.f;
#pragma unroll
    for (int i = 0; i < 4; ++i) {
      const int d0 = 256 * i + 4 * lane;
      f32x4 xo; float hv[4];
#pragma unroll
      for (int c = 0; c < 4; ++c) { xo[c] = (v[4 * i + c] - mu) * rs * lg[i][c] + lb[i][c]; hv[c] = xo[c] * (1.f + lc[i][c]) + ls[i][c]; }
      *(f32x4*)(p.x + (long)t * D + d0) = xo;
      uint2 pk; pk.x = cvtpk(hv[0], hv[1]); pk.y = cvtpk(hv[2], hv[3]);
      *(uint2*)(p.h2 + (long)t * D + d0) = pk;
#pragma unroll
      for (int e = 0; e < NE; ++e) {
        f32x4 w = *(const f32x4*)(wrt + e * D + d0);
        lgt[e] += hv[0] * w[0] + hv[1] * w[1] + hv[2] * w[2] + hv[3] * w[3];
      }
      asm volatile("" ::: "memory");
    }
#pragma unroll
    for (int e = 0; e < NE; ++e) lgt[e] = wave_sum(lgt[e]);
    float mx = lgt[0];
#pragma unroll
    for (int e = 1; e < NE; ++e) mx = fmaxf(mx, lgt[e]);
    float se = 0.f;
#pragma unroll
    for (int e = 0; e < NE; ++e) { lgt[e] = expf(lgt[e] - mx); se += lgt[e]; }
    const float is = 1.f / se;
    float mine = 0.f;
#pragma unroll
    for (int e = 0; e < NE; ++e) mine = (lane == e) ? lgt[e] * is : mine;
    if (lane < NE) { p.aff[(long)t * NE + lane] = mine; p.afft[(long)lane * T + t] = mine; }
#pragma unroll
    for (int i = 0; i < 4; ++i) { ya[i] = yn[i]; xa[i] = xn[i]; }
   }
  }
  __syncthreads();
}

DEVFN void ph_topk_fast(const Params& p, int l, char* smem) {
  PHASE_BEGIN;
  float* vals = (float*)smem;
  constexpr int NITEM = BATCH * NE * (SEQ / 256) + DB * NE * (DSEQ / 256);
  for (int item = bidx_; item < NITEM; item += gridDim.x) {
    int lat, b, e, chunk, N;
    if (item < BATCH * NE * (SEQ / 256)) { lat = 0; N = SEQ; e = item % NE; chunk = (item / NE) % (SEQ / 256); b = item / (NE * (SEQ / 256)); }
    else { int it = item - BATCH * NE * (SEQ / 256); lat = 1; N = DSEQ; e = it % NE; chunk = (it / NE) % (DSEQ / 256); b = it / (NE * (DSEQ / 256)); }
    const int t0 = lat ? TC + b * DSEQ : b * SEQ;
    {
      const float* src = p.afft + (long)e * T + t0 + tidx_;
      if (lat) {
        const float a0 = src[0], a1 = src[256], a2 = src[512], a3 = src[768];
        vals[tidx_] = a0; vals[tidx_ + 256] = a1; vals[tidx_ + 512] = a2; vals[tidx_ + 768] = a3;
      } else {
        vals[tidx_] = src[0];
      }
    }
    __syncthreads();
    const int n = chunk * 256 + tidx_;
    const float a = vals[n];
    const int w16 = __builtin_amdgcn_readfirstlane((chunk * 256 + (tidx_ & 192)) >> 4);
    int rank = 0;
    for (int j16 = 0; j16 < w16; ++j16) {
      f32x4 vv[4];
#pragma unroll
      for (int q = 0; q < 4; ++q) vv[q] = ((const f32x4*)vals)[4 * j16 + q];
#pragma unroll
      for (int q = 0; q < 4; ++q)
#pragma unroll
        for (int c = 0; c < 4; ++c) rank += (int)(vv[q][c] >= a);
    }
#pragma unroll
    for (int j16 = 0; j16 < 4; ++j16) {
      f32x4 vv[4];
#pragma unroll
      for (int q = 0; q < 4; ++q) vv[q] = ((const f32x4*)vals)[4 * (w16 + j16) + q];
#pragma unroll
      for (int q = 0; q < 4; ++q)
#pragma unroll
        for (int c = 0; c < 4; ++c) {
          const int jl = 16 * j16 + 4 * q + c;
          rank += (int)(vv[q][c] > a) | ((int)(vv[q][c] == a) & (int)(jl < (tidx_ & 63)));
        }
    }
    for (int j16 = w16 + 4; j16 < N / 16; ++j16) {
      f32x4 vv[4];
#pragma unroll
      for (int q = 0; q < 4; ++q) vv[q] = ((const f32x4*)vals)[4 * j16 + q];
#pragma unroll
      for (int q = 0; q < 4; ++q)
#pragma unroll
        for (int c = 0; c < 4; ++c) rank += (int)(vv[q][c] > a);
    }
    const int cap = lat ? CAPL : CAPC;
    int slot = -1;
    if (rank < cap) {
      slot = lat ? BATCH * CAPC + b * CAPL + rank : b * CAPC + rank;
      p.seltok[e * NS + slot] = t0 + n;
      p.selgate[e * NS + slot] = a;
    }
    p.inv[(long)(t0 + n) * NE + e] = slot;
    __syncthreads();
  }
}

constexpr int ADA_KC = 16, ADA_ROWS = D / ADA_KC;
DEVFN void ph_adaln_part(const Params& p, char* smem) {
  PHASE_BEGIN;
  float* sil = (float*)smem;
  constexpr int NJG = 6 * D / 4 / 256;
  constexpr int NITEM = DEPTH * NJG * ADA_KC;
  if (bidx_ < NITEM) {
#pragma unroll
    for (int i = tidx_; i < NCOND * D; i += 256) {
      int c = i / D, d = i % D;
      sil[i] = silu_f(c == 0 ? p.c_ctx[d] : p.c[(c - 1) * D + d]);
    }
    __syncthreads();
  }
  for (int item = bidx_; item < NITEM; item += gridDim.x) {
    const int kc = item % ADA_KC, jb = (item / ADA_KC) % NJG, l = item / (ADA_KC * NJG);
    const int j0 = (jb * 256 + tidx_) * 4;
    const float* w = p.w_ada + ((long)l * D + kc * ADA_ROWS) * 6 * D + j0;
    f32x4 acc[NCOND];
#pragma unroll
    for (int c = 0; c < NCOND; ++c) acc[c] = (f32x4){0.f, 0.f, 0.f, 0.f};
#pragma unroll 16
    for (int r = 0; r < ADA_ROWS; ++r) {
      f32x4 wv = *(const f32x4*)(w + (long)r * 6 * D);
#pragma unroll
      for (int c = 0; c < NCOND; ++c) { float sv = sil[c * D + kc * ADA_ROWS + r]; acc[c] += sv * wv; }
    }
#pragma unroll
    for (int c = 0; c < NCOND; ++c) *(f32x4*)(p.modpart + (((long)kc * DEPTH + l) * NCOND + c) * 6 * D + j0) = acc[c];
  }
  __syncthreads();
}
DEVFN void ph_adaln_reduce(const Params& p) {
  PHASE_BEGIN;
  for (long idx = GTID; idx < (long)DEPTH * NCOND * 6 * D; idx += GSIZE) {
    int j = idx % (6 * D); int l = idx / ((long)NCOND * 6 * D);
    float s = p.b_ada[(long)l * 6 * D + j];
#pragma unroll
    for (int kc = 0; kc < ADA_KC; ++kc) s += p.modpart[(long)kc * DEPTH * NCOND * 6 * D + idx];
    p.mod[idx] = s;
  }
}
DEVFN void transpose_tile(const float* src, long ld_src, bf16_t* dst, long ld_dst, int k0, int n0, float* tl, int tid) {
#pragma unroll
  for (int i = 0; i < 4; ++i) {
    const int r = (tid >> 4) + 16 * i, c4 = (tid & 15) * 4;
    f32x4 v = *(const f32x4*)(src + (long)(k0 + r) * ld_src + n0 + c4);
    tl[r * 65 + c4] = v[0]; tl[r * 65 + c4 + 1] = v[1]; tl[r * 65 + c4 + 2] = v[2]; tl[r * 65 + c4 + 3] = v[3];
  }
  __syncthreads();
#pragma unroll
  for (int i = 0; i < 2; ++i) {
    const int n = (tid >> 3) + 32 * i, kc = (tid & 7) * 8;
    uint4 w;
    w.x = cvtpk(tl[(kc + 0) * 65 + n], tl[(kc + 1) * 65 + n]); w.y = cvtpk(tl[(kc + 2) * 65 + n], tl[(kc + 3) * 65 + n]);
    w.z = cvtpk(tl[(kc + 4) * 65 + n], tl[(kc + 5) * 65 + n]); w.w = cvtpk(tl[(kc + 6) * 65 + n], tl[(kc + 7) * 65 + n]);
    *(uint4*)(dst + (long)(n0 + n) * ld_dst + k0 + kc) = w;
  }
  __syncthreads();
}
constexpr int TR_WOUT = DEPTH * (MIX_W / 64) * (D / 64);
constexpr int TR_WIN = DEPTH * (D / 64) * 16;
constexpr int TR_WGLU = DEPTH * (S5_W / 64) * (S5_W / 64);
DEVFN void ph_init_tr(const Params& p, char* smem) {
  PHASE_BEGIN;
  float* tl = (float*)smem;
  for (int item = bidx_; item < TR_WOUT + TR_WIN + TR_WGLU; item += gridDim.x) {
    if (item < TR_WOUT) {
      const int nt = item % (D / 64), kt = (item / (D / 64)) % (MIX_W / 64), l = item / ((D / 64) * (MIX_W / 64));
      transpose_tile(p.w_out + (long)l * MIX_W * D, D, p.woutt + (long)l * D * MIX_W, MIX_W, kt * 64, nt * 64, tl, tidx_);
    } else if (item < TR_WOUT + TR_WIN) {
      const int it = item - TR_WOUT;
      const int ct = it % 16, kt = (it / 16) % (D / 64), l = it / (16 * (D / 64));
      const int nsrc = ct < 12 ? ct * 64 : 1024 + (ct - 12) * 64;
      const int ndst = ct < 12 ? ct * 64 : PC_U + (ct - 12) * 64;
      transpose_tile(p.w_in + (long)l * D * IN_W + nsrc, IN_W, p.win2t + ((long)l * NP + ndst) * D, D, kt * 64, 0, tl, tidx_);
    } else {
      const int it = item - TR_WOUT - TR_WIN;
      const int nt = it % (S5_W / 64), kt = (it / (S5_W / 64)) % (S5_W / 64), l = it / ((S5_W / 64) * (S5_W / 64));
      transpose_tile(p.s5_w_glu + (long)l * S5_W * S5_W, S5_W, p.wglut + (long)l * S5_W * S5_W, S5_W, kt * 64, nt * 64, tl, tidx_);
    }
  }
}
DEVFN void ph_init_tab(const Params& p, char* smem) {
  PHASE_BEGIN;
  float* tab = (float*)smem;
  const long gt = GTID, gs = GSIZE;
  for (int j = tidx_; j < DSEQ; j += 256) {
    float s, c;
    sincosf(6.283185307179586f * (float)j / (float)DSEQ, &s, &c);
    tab[2 * j] = c; tab[2 * j + 1] = s;
  }
  __syncthreads();
  const float isl = 1.f / sqrtf((float)DSEQ), isc = 1.f / sqrtf((float)SEQ);
  for (long idx = gt; idx < (long)DSEQ * 2 * DSEQ; idx += gs) {
    const int n2 = idx % (2 * DSEQ), k = idx / (2 * DSEQ), n = n2 % DSEQ;
    const int j = (k * n) & (DSEQ - 1);
    p.dftl[idx] = f2bf((n2 < DSEQ ? tab[2 * j] : -tab[2 * j + 1]) * isl);
  }
  for (long idx = gt; idx < (long)SEQ * 2 * SEQ; idx += gs) {
    const int n2 = idx % (2 * SEQ), k = idx / (2 * SEQ), n = n2 % SEQ;
    const int j = ((k * n) & (SEQ - 1)) * (DSEQ / SEQ);
    p.dftc[idx] = f2bf((n2 < SEQ ? tab[2 * j] : -tab[2 * j + 1]) * isc);
  }
  for (long idx = gt; idx < (long)DEPTH * 256 * 256; idx += gs) {
    const int i = idx % 256, j = (idx / 256) % 256, l = idx / (256 * 256);
    const int hd = i >> 6, c = i & 63;
    const float* wf = p.w_fourier + ((long)l * 256 + hd * 64) * 256 + j;
    float w[64];
#pragma unroll
    for (int m = 0; m < 64; ++m) w[m] = wf[(long)m * 256];
    float ac = 0.f, as = 0.f;
#pragma unroll
    for (int m = 0; m < 64; ++m) {
      const f32x2_t cs = *(const f32x2_t*)(tab + 2 * (((m * c) & 63) * (DSEQ / 64)));
      ac += cs[0] * w[m]; as += cs[1] * w[m];
    }
    p.wcst[((long)l * 512 + j) * 256 + i] = f2bf(ac * 0.125f);
    p.wcst[((long)l * 512 + 256 + j) * 256 + i] = f2bf(as * 0.125f);
  }
  for (long idx = gs - 1 - gt - (long)DEPTH * 2 * SG * SP; idx >= 0 && idx < 64 * 16; idx += gs) {
    int fi = idx % 16, pos = idx / 16;
    float freq = powf(10000.f, -(float)fi / 16.f);
    float ang = (float)pos * freq;
    p.rope[idx * 2] = cosf(ang); p.rope[idx * 2 + 1] = sinf(ang);
  }
  for (long idx = gs - 1 - gt; idx < (long)DEPTH * 2 * SG * SP; idx += gs) {
    int pp = idx % SP; int g = (idx / SP) % SG; long ld = idx / (SP * SG);
    double are = p.s5_a_re[idx], aim = p.s5_a_im[idx];
    double dt = exp((double)p.s5_log_dt[ld * SG + g]);
    double er = exp(are * dt), cr = er * cos(aim * dt), ci = er * sin(aim * dt);
    p.abar[idx * 2] = (float)cr; p.abar[idx * 2 + 1] = (float)ci;
    double nr = cr - 1.0, ni = ci, den = are * are + aim * aim;
    double fr = (nr * are + ni * aim) / den, fi = (ni * are - nr * aim) / den;
    for (int h = 0; h < SH; ++h) {
      double br = p.s5_b_re[idx * SH + h], bi = p.s5_b_im[idx * SH + h];
      p.bbn[((ld * SG + g) * 128 + 2 * pp) * 16 + h] = f2bf((float)(fr * br - fi * bi));
      p.bbn[((ld * SG + g) * 128 + 2 * pp + 1) * 16 + h] = f2bf((float)(fr * bi + fi * br));
    }
  }
  for (long idx = gt; idx < (long)DEPTH * 2 * SG * SH * 128; idx += gs) {
    int k = idx % 128; long row = idx / 128;
    p.cn[idx] = f2bf((k & 1) ? -p.s5_c_im[row * SP + (k >> 1)] : p.s5_c_re[row * SP + (k >> 1)]);
  }
}
struct RowLoaderF32 {
  const float *r0, *r1, *r2, *r3;
  DEVFN uint4 one(const float* r, int kt) const {
    f32x4 a = *(const f32x4*)(r + kt * 64), b = *(const f32x4*)(r + kt * 64 + 4);
    uint4 w; w.x = cvtpk(a[0], a[1]); w.y = cvtpk(a[2], a[3]); w.z = cvtpk(b[0], b[1]); w.w = cvtpk(b[2], b[3]);
    return w;
  }
  DEVFN U4x4 operator()(int kt) const { U4x4 v; v.a = one(r0, kt); v.b = one(r1, kt); v.c = one(r2, kt); v.d = one(r3, kt); return v; }
};
DEVFN void ph_init_fold(const Params& p, char* smem) {
  PHASE_BEGIN;
  constexpr int NT_M = 512 / 128, NT_N = D / 128;
  for (int tile = bidx_; tile < DEPTH * NT_M * NT_N; tile += gridDim.x) {
    const int tn = tile % NT_N, tm = (tile / NT_N) % NT_M, l = tile / (NT_N * NT_M);
    RowLoader A = make_rows(tidx_, p.wcst + (long)l * 512 * 256, tm * 128, 256);
    RowLoaderF32 B;
    {
      const float* b0 = p.w_in + ((long)l * D + tn * 128 + (tidx_ >> 3)) * IN_W + 768 + (tidx_ & 7) * 8;
      B.r0 = b0; B.r1 = b0 + 32L * IN_W; B.r2 = b0 + 64L * IN_W; B.r3 = b0 + 96L * IN_W;
    }
    const bool odd = tidx_ & 1;
    bf16_t* dst = p.win2t + ((long)l * NP + PC_P + tm * 128) * D + tn * 128;
    gemm_tile1(smem, tidx_, A, B, 256 / 64, [&](int nt, int row, int col, float v0, float v1, float v2, float v3) {
      float v[4] = {v0, v1, v2, v3};
#pragma unroll
      for (int i = 0; i < 4; ++i) {
        float pr = shx1(v[i]);
        if (!odd) *(unsigned*)(dst + (long)(row + i) * D + col) = cvtpk(v[i], pr);
      }
    });
  }
}

constexpr int TR_EXP = NE * 3 * (D / 64) * (FF / 64);
struct ConvTile { const float* src; bf16_t* dst; };
DEVFN ConvTile conv_tile(const Params& p, int l, int item) {
  const int nt = item % 16, kt = (item / 16) % 16, m = (item / 256) % 3, e = item / 768;
  ConvTile c;
  const float* sb = (m == 0 ? p.w_gate : m == 1 ? p.w_up : p.w_down) + ((long)l * NE + e) * D * FF;
  bf16_t* db = (m == 0 ? p.wgt : m == 1 ? p.wut : p.wdt) + ((long)(l & 1) * NE + e) * FF * D;
  c.src = sb + (long)(kt * 64) * FF + nt * 64;
  c.dst = db + (long)(nt * 64) * D + kt * 64;
  return c;
}
DEVFN void conv_range(const Params& p, int l, int first, int count, char* smem, int tid) {
  static_assert(D == FF, "expert matrices assumed square");
  float* tl = (float*)smem;
  const int lr = tid >> 4, lc = (tid & 15) * 4;
  int item = first; const int end = first + count;
  f32x4 v0, v1, v2, v3;
  ConvTile c = conv_tile(p, l, item);
  {
    const float* s = c.src + (long)lr * FF + lc;
    v0 = *(const f32x4*)s; v1 = *(const f32x4*)(s + 16L * FF); v2 = *(const f32x4*)(s + 32L * FF); v3 = *(const f32x4*)(s + 48L * FF);
  }
  while (item < end) {
    float* t0 = tl + lr * 65 + lc;
    t0[0] = v0[0]; t0[1] = v0[1]; t0[2] = v0[2]; t0[3] = v0[3];
    t0[16 * 65] = v1[0]; t0[16 * 65 + 1] = v1[1]; t0[16 * 65 + 2] = v1[2]; t0[16 * 65 + 3] = v1[3];
    t0[32 * 65] = v2[0]; t0[32 * 65 + 1] = v2[1]; t0[32 * 65 + 2] = v2[2]; t0[32 * 65 + 3] = v2[3];
    t0[48 * 65] = v3[0]; t0[48 * 65 + 1] = v3[1]; t0[48 * 65 + 2] = v3[2]; t0[48 * 65 + 3] = v3[3];
    __syncthreads();
    bf16_t* dst = c.dst;
    const int nxt = item + 1;
    if (nxt < end) {
      c = conv_tile(p, l, nxt);
      const float* s = c.src + (long)lr * FF + lc;
      v0 = *(const f32x4*)s; v1 = *(const f32x4*)(s + 16L * FF); v2 = *(const f32x4*)(s + 32L * FF); v3 = *(const f32x4*)(s + 48L * FF);
    }
#pragma unroll
    for (int i = 0; i < 2; ++i) {
      const int n = (tid >> 3) + 32 * i, kc = (tid & 7) * 8;
      uint4 w;
      w.x = cvtpk(tl[(kc + 0) * 65 + n], tl[(kc + 1) * 65 + n]); w.y = cvtpk(tl[(kc + 2) * 65 + n], tl[(kc + 3) * 65 + n]);
      w.z = cvtpk(tl[(kc + 4) * 65 + n], tl[(kc + 5) * 65 + n]); w.w = cvtpk(tl[(kc + 6) * 65 + n], tl[(kc + 7) * 65 + n]);
      *(uint4*)(dst + (long)n * D + kc) = w;
    }
    __syncthreads();
    item = nxt;
  }
}

DEVFN void conv_wait(int n) {
  switch (n) {
    case 0:  asm volatile("s_waitcnt vmcnt(0) lgkmcnt(0)\n\ts_barrier" ::: "memory"); break;
    case 4:  asm volatile("s_waitcnt vmcnt(4) lgkmcnt(0)\n\ts_barrier" ::: "memory"); break;
    case 8:  asm volatile("s_waitcnt vmcnt(8) lgkmcnt(0)\n\ts_barrier" ::: "memory"); break;
    case 12: asm volatile("s_waitcnt vmcnt(12) lgkmcnt(0)\n\ts_barrier" ::: "memory"); break;
    case 16: asm volatile("s_waitcnt vmcnt(16) lgkmcnt(0)\n\ts_barrier" ::: "memory"); break;
    default: asm volatile("s_waitcnt vmcnt(20) lgkmcnt(0)\n\ts_barrier" ::: "memory"); break;
  }
}
DEVFN void conv_issue(const Params& p, int l, int item, unsigned lds_ws, int lane, int wave) {
  ConvTile c = conv_tile(p, l, item);
#pragma unroll
  for (int i = 0; i < 4; ++i) {
    const int k = 16 * wave + 4 * i + (lane >> 4);
    const int chunk = ((lane & 15) - (4 * wave + i)) & 15;
    glds16_nt((const bf16_t*)(c.src + (long)k * FF + chunk * 4), lds_ws + i * 1024);
  }
}
template <int MODE>
DEVFN void conv_ring(const Params& p, int l, int first, int count, char* smem, int tid) {
  constexpr int LPT = MODE == 2 ? 0 : 4, SPT = MODE == 1 ? 0 : 4;
  const int lane = tid & 63, wave = tid >> 6;
  const int kq = tid & 15, nq = tid >> 4;
  const unsigned lbase = (unsigned)__builtin_amdgcn_readfirstlane((int)(lds_addr(smem) + wave * 4096));
  __syncthreads();
  if (LPT) for (int s = 0; s < 3 && s < count; ++s) conv_issue(p, l, first + s, lbase + s * 16384, lane, wave);
  for (int t = 0; t < count; ++t) {
    const int st = t < 3 ? t : 3;
    int ld = count - 1 - t; if (ld > 2) ld = 2;
    conv_wait(SPT * st + LPT * ld);
    if (LPT && t + 3 < count) conv_issue(p, l, first + t + 3, lbase + ((t + 3) & 3) * 16384, lane, wave);
    const char* sl = smem + (t & 3) * 16384 + (4 * kq) * 256 + ((nq + kq) & 15) * 16;
    f32x4 v0 = *(const f32x4*)sl, v1 = *(const f32x4*)(sl + 256), v2 = *(const f32x4*)(sl + 512), v3 = *(const f32x4*)(sl + 768);
    bf16_t* d = conv_tile(p, l, first + t).dst + (long)(4 * nq) * D + 4 * kq;
#pragma unroll
    for (int i = 0; i < 4; ++i) {
      uint2 w; w.x = cvtpk(v0[i], v1[i]); w.y = cvtpk(v2[i], v3[i]);
      if (SPT) { typedef __attribute__((ext_vector_type(2))) unsigned u32x2_t; u32x2_t wv = {w.x, w.y}; __builtin_nontemporal_store(wv, (u32x2_t*)(d + (long)i * D)); }
    }
  }
}

struct ConvOwn { int per, first, cnt; };
DEVFN ConvOwn conv_own(int bidx) {
  ConvOwn o;
  const int nb = gridDim.x;
  if (nb == 512) {
    const bool up = bidx >= 256;
    o.per = up ? 30 : 18; o.first = up ? 256 * 18 + (bidx - 256) * 30 : bidx * 18; o.cnt = o.per;
  } else {
    o.per = (TR_EXP + nb - 1) / nb; o.first = bidx * o.per;
    int c = TR_EXP - o.first; o.cnt = c > o.per ? o.per : (c < 0 ? 0 : c);
  }
  return o;
}
DEVFN void conv_span(const Params& p, int L, const ConvOwn& o, int idx, int n, char* smem, int tid) {
  int nv = o.cnt - idx; if (nv > n) nv = n;
  if (nv > 0) conv_ring<0>(p, L, o.first + idx, nv, smem, tid);
}
DEVFN void conv_fill(const Params& p, int l, int ph, int& cdone, char* smem, int tid, int bidx) {
  const ConvOwn o = conv_own(bidx);
  const int L = cdone / o.per;
  if (L > l + 1 || L >= DEPTH) return;
  const int idx = cdone - L * o.per;
  const bool up = gridDim.x == 512 && bidx >= 256;
  const int fill = ph == 1 ? (up ? 10 : 2) : ph == 3 ? (up ? 6 : 2) : 2;
  int n = o.per - idx; if (n > fill) n = fill;
  conv_span(p, L, o, idx, n, smem, tid);
  cdone += n;
}
DEVFN void ph_conv_catchup(const Params& p, int l, int& cdone, char* smem) {
  PHASE_BEGIN;
  const ConvOwn o = conv_own(bidx_);
  const int target = (l + 1) * o.per;
  if (cdone < target) {
    const int idx = cdone - l * o.per;
    conv_span(p, l, o, idx, o.per - idx, smem, tidx_);
    cdone = target;
  }
}
constexpr int S5_SROW = 288;
constexpr int N_S5_LAT = DB * SG * 2 / 2, N_S5_CTX = BATCH * SG * 2 / 4;
template <int DIR, int CH>
DEVFN void s5_wave(const Params& p, int l, int lat, int u, char* wl, int lane) {
  constexpr int BU_BYTES = CH * 128 * 4;
  const int g = (u >> 1) % SG, b = u / (2 * SG);
  const int N = lat ? DSEQ : SEQ, t0 = lat ? TC + b * DSEQ : b * SEQ, nch = N / CH;
  float* BU = (float*)wl;
  char* SS = wl + BU_BYTES;
  const long pidx = (((long)l * 2 + DIR) * SG + g);
  const float ar = p.abar[(pidx * SP + lane) * 2], ai = p.abar[(pidx * SP + lane) * 2 + 1];
  const float nai = -ai;
  float sr = 0.f, si = 0.f;
  if (lat) { long si0 = ((((long)b * DEPTH + l) * 2 + DIR) * SG + g) * SP + lane; sr = p.st_re[si0]; si = p.st_im[si0]; }
  bf16x8 bfr[4], cfr[4];
#pragma unroll
  for (int nt = 0; nt < 4; ++nt) bfr[nt] = *(const bf16x8*)(p.bbn + ((pidx * 128 + nt * 32 + (lane & 31)) * 16 + 8 * (lane >> 5)));
#pragma unroll
  for (int ks = 0; ks < 4; ++ks) cfr[ks] = *(const bf16x8*)(p.cn + ((pidx * 16 + (lane & 15)) * 128 + ks * 32 + 8 * (lane >> 4)));
  const bf16_t* ub = p.proj + (long)t0 * NPJ + PJ_U + g * 16 + 8 * (lane >> 5);
  const int urow = lane & (CH - 1);
  bf16x8 ufr = *(const bf16x8*)(ub + (long)((DIR ? N - CH : 0) + urow) * NPJ);
  float* const ybase = p.ypart + ((long)DIR * T + t0 + (lane >> 4) * 4) * S5_W + g * 16 + (lane & 15);
  for (int c = 0; c <= nch; ++c) {
    if (c < nch) {
      const bf16x8 ucur = ufr;
      if (c + 1 < nch) ufr = *(const bf16x8*)(ub + (long)((DIR ? N - CH * (c + 2) : CH * (c + 1)) + urow) * NPJ);
#pragma unroll
      for (int np = 0; np < 2; ++np) {
        f32x16 z0, z1;
#pragma unroll
        for (int r = 0; r < 16; ++r) { z0[r] = 0.f; z1[r] = 0.f; }
        z0 = __builtin_amdgcn_mfma_f32_32x32x16_bf16(ucur, bfr[2 * np], z0, 0, 0, 0);
        z1 = __builtin_amdgcn_mfma_f32_32x32x16_bf16(ucur, bfr[2 * np + 1], z1, 0, 0, 0);
#pragma unroll
        for (int r = 0; r < CH / 2; ++r) {
          const int row = (r & 3) + 8 * (r >> 2) + 4 * (lane >> 5);
          BU[row * 128 + (2 * np) * 32 + (lane & 31)] = z0[r];
          BU[row * 128 + (2 * np + 1) * 32 + (lane & 31)] = z1[r];
        }
      }
    }
    __builtin_amdgcn_fence(__ATOMIC_RELEASE, "wavefront");
    __builtin_amdgcn_wave_barrier();
    __builtin_amdgcn_fence(__ATOMIC_ACQUIRE, "wavefront");
    if (c >= 1) {
      const char* ss = SS + ((c - 1) & 1) * (CH * S5_SROW);
      const int pb = DIR ? N - CH * c : CH * (c - 1);
#pragma unroll
      for (int mt = 0; mt < CH / 16; ++mt) {
        f32x4 acc = {0.f, 0.f, 0.f, 0.f};
#pragma unroll
        for (int ks = 0; ks < 4; ++ks) {
          bf16x8 a = *(const bf16x8*)(ss + (mt * 16 + (lane & 15)) * S5_SROW + ks * 64 + 16 * (lane >> 4));
          acc = __builtin_amdgcn_mfma_f32_16x16x32_bf16(a, cfr[ks], acc, 0, 0, 0);
        }
        float* yo = ybase + (long)(pb + mt * 16) * S5_W;
#pragma unroll
        for (int r = 0; r < 4; ++r) yo[(long)r * S5_W] = acc[r];
      }
    }
    if (c < nch) {
      char* ss = SS + (c & 1) * (CH * S5_SROW);
      f32x2_t bu[CH];
#pragma unroll
      for (int k = 0; k < CH; ++k) { const int r = DIR ? CH - 1 - k : k; bu[k] = *(const f32x2_t*)(BU + r * 128 + 2 * lane); }
#pragma unroll
      for (int k = 0; k < CH; ++k) {
        const int r = DIR ? CH - 1 - k : k;
        const float nr = __builtin_fmaf(ar, sr, __builtin_fmaf(nai, si, bu[k][0]));
        const float ni = __builtin_fmaf(ar, si, __builtin_fmaf(ai, sr, bu[k][1]));
        sr = nr; si = ni;
        *(unsigned*)(ss + r * S5_SROW + lane * 4) = cvtpk(sr, si);
      }
    }
    __builtin_amdgcn_fence(__ATOMIC_RELEASE, "wavefront");
    __builtin_amdgcn_wave_barrier();
    __builtin_amdgcn_fence(__ATOMIC_ACQUIRE, "wavefront");
  }
  if (!lat) {
    long oo = ((((long)b * DEPTH + l) * 2 + DIR) * SG + g) * SP + lane;
    p.out[O_SRE + oo] = sr; p.out[O_SIM + oo] = si;
  }
}
DEVFN void s5_unit(const Params& p, int l, int lat, int item, char* smem, int tidx_) {
  const int wave = tidx_ >> 6, lane = tidx_ & 63;
  if (lat) {
    if (wave < 2) {
      const int u = item * 2 + wave;
      char* wl = smem + wave * (32 * 128 * 4 + 2 * 32 * S5_SROW);
      if (u & 1) s5_wave<1, 32>(p, l, 1, u, wl, lane); else s5_wave<0, 32>(p, l, 1, u, wl, lane);
    }
  } else {
    const int u = item * 4 + wave;
    char* wl = smem + wave * (16 * 128 * 4 + 2 * 16 * S5_SROW);
    if (u & 1) s5_wave<1, 16>(p, l, 0, u, wl, lane); else s5_wave<0, 16>(p, l, 0, u, wl, lane);
  }
  __syncthreads();
}

constexpr int AT_KROW = 144, AT_VROW = 72, AT_KB = 32 * AT_KROW, AT_STAGE = AT_KB + 64 * AT_VROW;
constexpr int N_AT_LAT = DB * NKV * (DSEQ / 32), N_AT_CTX = BATCH * NKV * (SEQ / 32);
DEVFN void attn_item(const Params& p, int l, int lat, int item, char* smem, int tidx_) {
  const int NQB = (lat ? DSEQ : SEQ) / 32;
  const int qb = item % NQB, kvh = (item / NQB) % NKV, b = item / (NQB * NKV);
  const int N = lat ? DSEQ : SEQ, t0 = lat ? TC + b * DSEQ : b * SEQ, q0 = qb * 32;
  const int wave = tidx_ >> 6, lane = tidx_ & 63, hl = lane >> 5, head = kvh * GQA + wave;
  bf16x8 qf[4];
#pragma unroll
  for (int s = 0; s < 4; ++s) qf[s] = *(const bf16x8*)(p.proj + (long)(t0 + q0 + (lane & 31)) * NPJ + PJ_Q + head * HD + 16 * s + 8 * hl);
  const int ks0 = lat ? (q0 - WINDOW < 0 ? 0 : q0 - WINDOW) : 0;
  const int ke0 = lat ? (q0 + 32 + WINDOW > N ? N : q0 + 32 + WINDOW) : N;
  const int nwin = (ke0 - ks0) / 32, ntiles = nwin + (lat ? PAST / 32 : 0);
  float m = p.attn_sink[l * NH + head], lsum = 1.f;
  f32x16 O[2];
#pragma unroll
  for (int i = 0; i < 2; ++i)
#pragma unroll
    for (int r = 0; r < 16; ++r) O[i][r] = 0.f;
  const int kkey = tidx_ >> 3, kch = tidx_ & 7;
  const int vkey = tidx_ & 31, vch = tidx_ >> 5;
  struct KV { f32x4 k0, k1, v0, v1; };
  auto tile_load = [&](int ti) -> KV {
    KV r; r.k1 = r.k0 = (f32x4){0.f, 0.f, 0.f, 0.f}; r.v1 = r.v0 = r.k0;
    if (ti < nwin) {
      const int kp = ks0 + ti * 32;
      uint4 a = *(const uint4*)(p.proj + (long)(t0 + kp + kkey) * NPJ + PJ_K + kvh * HD + kch * 8);
      uint4 c = *(const uint4*)(p.proj + (long)(t0 + kp + vkey) * NPJ + PJ_V + kvh * HD + vch * 8);
      r.k0 = __builtin_bit_cast(f32x4, a); r.v0 = __builtin_bit_cast(f32x4, c);
    } else {
      const int s0 = (ti - nwin) * 32;
      const float* kb = p.cache_k + ((((long)b * DEPTH + l) * PAST + s0 + kkey) * NKV + kvh) * HD + kch * 8;
      const float* vb = p.cache_v + ((((long)b * DEPTH + l) * PAST + s0 + vkey) * NKV + kvh) * HD + vch * 8;
      r.k0 = *(const f32x4*)kb; r.k1 = *(const f32x4*)(kb + 4);
      r.v0 = *(const f32x4*)vb; r.v1 = *(const f32x4*)(vb + 4);
    }
    return r;
  };
  auto tile_store = [&](int ti, char* st, const KV r) {
    uint4 kq, vq;
    if (ti < nwin) { kq = __builtin_bit_cast(uint4, r.k0); vq = __builtin_bit_cast(uint4, r.v0); }
    else {
      kq.x = cvtpk(r.k0[0], r.k0[1]); kq.y = cvtpk(r.k0[2], r.k0[3]); kq.z = cvtpk(r.k1[0], r.k1[1]); kq.w = cvtpk(r.k1[2], r.k1[3]);
      vq.x = cvtpk(r.v0[0], r.v0[1]); vq.y = cvtpk(r.v0[2], r.v0[3]); vq.z = cvtpk(r.v1[0], r.v1[1]); vq.w = cvtpk(r.v1[2], r.v1[3]);
    }
    *(uint4*)(st + kkey * AT_KROW + kch * 16) = kq;
    char* vt = st + AT_KB + (vch * 8) * AT_VROW + vkey * 2;
    *(bf16_t*)(vt + 0 * AT_VROW) = (bf16_t)(vq.x & 0xffffu); *(bf16_t*)(vt + 1 * AT_VROW) = (bf16_t)(vq.x >> 16);
    *(bf16_t*)(vt + 2 * AT_VROW) = (bf16_t)(vq.y & 0xffffu); *(bf16_t*)(vt + 3 * AT_VROW) = (bf16_t)(vq.y >> 16);
    *(bf16_t*)(vt + 4 * AT_VROW) = (bf16_t)(vq.z & 0xffffu); *(bf16_t*)(vt + 5 * AT_VROW) = (bf16_t)(vq.z >> 16);
    *(bf16_t*)(vt + 6 * AT_VROW) = (bf16_t)(vq.w & 0xffffu); *(bf16_t*)(vt + 7 * AT_VROW) = (bf16_t)(vq.w >> 16);
  };
  KV sa_ = tile_load(0), sb_ = sa_;
  tile_store(0, smem, sa_);
  if (ntiles > 1) sb_ = tile_load(1);
  __syncthreads();
  const int qp = q0 + (lane & 31);
  auto compute = [&](int ti) {
    const char* st = smem + (ti & 1) * AT_STAGE;
    f32x16 sa;
#pragma unroll
    for (int r = 0; r < 16; ++r) sa[r] = 0.f;
#pragma unroll
    for (int s = 0; s < 4; ++s) {
      bf16x8 kf = *(const bf16x8*)(st + (lane & 31) * AT_KROW + (2 * s + hl) * 16);
      sa = __builtin_amdgcn_mfma_f32_32x32x16_bf16(kf, qf[s], sa, 0, 0, 0);
    }
    float tmax = -1e30f;
    if (lat && ti < nwin) {
      const int kp0 = ks0 + ti * 32 + 4 * hl;
#pragma unroll
      for (int r = 0; r < 16; ++r) {
        const int kp = kp0 + (r & 3) + 8 * (r >> 2);
        const int df = kp - qp;
        const bool ok = (df <= WINDOW) && (df >= -WINDOW);
        sa[r] = ok ? sa[r] * 0.125f : -1e30f;
        tmax = fmaxf(tmax, sa[r]);
      }
    } else {
#pragma unroll
      for (int r = 0; r < 16; ++r) { sa[r] *= 0.125f; tmax = fmaxf(tmax, sa[r]); }
    }
    tmax = fmaxf(tmax, __shfl_xor(tmax, 32));
    const float mnew = fmaxf(m, tmax);
    const float sc = __expf(m - mnew);
    float rs = 0.f;
#pragma unroll
    for (int r = 0; r < 16; ++r) { sa[r] = __expf(sa[r] - mnew); rs += sa[r]; }
    rs += __shfl_xor(rs, 32);
    lsum = lsum * sc + rs; m = mnew;
#pragma unroll
    for (int i = 0; i < 2; ++i)
#pragma unroll
      for (int r = 0; r < 16; ++r) O[i][r] *= sc;
    bf16x8 pb[2];
#pragma unroll
    for (int s2 = 0; s2 < 2; ++s2) {
      uint4 w;
      w.x = cvtpk(sa[8 * s2 + 0], sa[8 * s2 + 1]); w.y = cvtpk(sa[8 * s2 + 2], sa[8 * s2 + 3]);
      w.z = cvtpk(sa[8 * s2 + 4], sa[8 * s2 + 5]); w.w = cvtpk(sa[8 * s2 + 6], sa[8 * s2 + 7]);
      pb[s2] = __builtin_bit_cast(bf16x8, w);
    }
#pragma unroll
    for (int mt = 0; mt < 2; ++mt)
#pragma unroll
      for (int s2 = 0; s2 < 2; ++s2) {
        const char* vp = st + AT_KB + (mt * 32 + (lane & 31)) * AT_VROW + (16 * s2 + 4 * hl) * 2;
        uint2 lo = *(const uint2*)vp, hi = *(const uint2*)(vp + 16);
        uint4 w; w.x = lo.x; w.y = lo.y; w.z = hi.x; w.w = hi.y;
        O[mt] = __builtin_amdgcn_mfma_f32_32x32x16_bf16(__builtin_bit_cast(bf16x8, w), pb[s2], O[mt], 0, 0, 0);
      }
  };
  for (int ti = 0; ti < ntiles; ti += 2) {
    if (ti + 2 < ntiles) sa_ = tile_load(ti + 2);
    compute(ti);
    if (ti + 1 < ntiles) tile_store(ti + 1, smem + AT_STAGE, sb_);
    __syncthreads();
    if (ti + 1 >= ntiles) break;
    if (ti + 3 < ntiles) sb_ = tile_load(ti + 3);
    compute(ti + 1);
    if (ti + 2 < ntiles) tile_store(ti + 2, smem, sa_);
    __syncthreads();
  }
  const float inv = 1.f / lsum;
  bf16_t* orow = p.mixcat + (long)(t0 + qp) * MIX_W + head * HD;
#pragma unroll
  for (int mt = 0; mt < 2; ++mt)
#pragma unroll
    for (int q = 0; q < 4; ++q) {
      uint2 w;
      w.x = cvtpk(O[mt][4 * q] * inv, O[mt][4 * q + 1] * inv); w.y = cvtpk(O[mt][4 * q + 2] * inv, O[mt][4 * q + 3] * inv);
      *(uint2*)(orow + mt * 32 + 8 * q + 4 * hl) = w;
    }
}

constexpr int N_FO_LAT = DB * (DSEQ / 128) * 2 * 2, N_FO_CTX = BATCH * (SEQ / 128) * 2;
constexpr int MIX_CORE = N_S5_LAT + N_FO_LAT + N_AT_LAT + N_S5_CTX + N_FO_CTX + N_AT_CTX;
constexpr int CONV_PER_ITEM = 8, N_CONV_ITEMS = TR_EXP / CONV_PER_ITEM;
constexpr int MIX_ITEMS = MIX_CORE;
DEVFN void ph_mix_fast(const Params& p, int l, char* smem, int* s_item, int rep = 0, int lo = 0, int hi = MIX_ITEMS) {
  PHASE_BEGIN;
  unsigned* ctr = p.bar + 4096 + 64 * l + 16 * rep;
  bool first = true;
  for (;;) {
    if (tidx_ == 0) *s_item = lo + (first ? bidx_ : (int)(gridDim.x + atomicAdd(ctr, 1u)));
    first = false;
    __syncthreads();
    int item = *s_item;
    __syncthreads();
    if (item >= hi) break;
    int tidl = tidx_;
    asm volatile("" : "+v"(tidl));
    if (item < N_S5_LAT) { s5_unit(p, l, 1, item, smem, tidl); continue; }
    item -= N_S5_LAT;
    if (item < N_FO_LAT) { fourier_tile(p, item, smem, tidl); continue; }
    item -= N_FO_LAT;
    if (item < N_AT_LAT) { attn_item(p, l, 1, item, smem, tidl); continue; }
    item -= N_AT_LAT;
    if (item < N_S5_CTX) { s5_unit(p, l, 0, item, smem, tidl); continue; }
    item -= N_S5_CTX;
    if (item < N_FO_CTX) { fourier_tile(p, N_FO_LAT + item, smem, tidl); continue; }
    item -= N_FO_CTX;
    if (item < N_AT_CTX) { attn_item(p, l, 0, item, smem, tidl); continue; }
    item -= N_AT_CTX;
    conv_range(p, l, item * CONV_PER_ITEM, CONV_PER_ITEM, smem, tidl);
  }
}

DEVFN float s5_g(const Params& p, int l, long t, int c) {
  float y = p.ypart[t * S5_W + c] + p.ypart[((long)T + t) * S5_W + c] + p.s5_d[l * S5_W + c] * bf2f(p.proj[t * NPJ + PJ_U + c]);
  return gelu_fast(y);
}
struct GluALoader {
  const float* ypart; const float* s5d; const bf16_t* proj; long m0; int tid;
  DEVFN uint4 one(int kt, int i) const {
    const int kc = tid & 7, r0 = tid >> 3;
    const int c0 = kt * 64 + kc * 8;
    f32x4 d0 = *(const f32x4*)(s5d + c0), d1 = *(const f32x4*)(s5d + c0 + 4);
    const long t = m0 + r0 + 32 * i;
    const float* y0 = ypart + t * S5_W + c0; const float* y1 = ypart + ((long)T + t) * S5_W + c0;
    f32x4 a0 = *(const f32x4*)y0, a1 = *(const f32x4*)(y0 + 4), b0 = *(const f32x4*)y1, b1 = *(const f32x4*)(y1 + 4);
    uint4 u = *(const uint4*)(proj + t * NPJ + PJ_U + c0);
    float g0 = gelu_fast(a0[0] + b0[0] + d0[0] * bflo(u.x)), g1 = gelu_fast(a0[1] + b0[1] + d0[1] * bfhi(u.x));
    float g2 = gelu_fast(a0[2] + b0[2] + d0[2] * bflo(u.y)), g3 = gelu_fast(a0[3] + b0[3] + d0[3] * bfhi(u.y));
    float g4 = gelu_fast(a1[0] + b1[0] + d1[0] * bflo(u.z)), g5 = gelu_fast(a1[1] + b1[1] + d1[1] * bfhi(u.z));
    float g6 = gelu_fast(a1[2] + b1[2] + d1[2] * bflo(u.w)), g7 = gelu_fast(a1[3] + b1[3] + d1[3] * bfhi(u.w));
    uint4 w; w.x = cvtpk(g0, g1); w.y = cvtpk(g2, g3); w.z = cvtpk(g4, g5); w.w = cvtpk(g6, g7);
    return w;
  }
  DEVFN U4x4 operator()(int kt) const { U4x4 v; v.a = one(kt, 0); v.b = one(kt, 1); v.c = one(kt, 2); v.d = one(kt, 3); return v; }
};
DEVFN void ph_glu_fast3(const Params& p, int l, char* smem) {
  PHASE_BEGIN;
  const int lane = tidx_ & 63, wave = tidx_ >> 6;
  const bf16_t* wg = p.wglut + (long)l * S5_W * S5_W;
  const bf16_t* const wbase = wg + (long)(tidx_ >> 3) * S5_W + g_chunk(tidx_);
  auto stage_b = [&](char* st, int kt) {
    const bf16_t* bb = wbase;
    asm volatile("" : "+v"(bb));
    GRows X0, X1;
    X0.r0 = bb; X0.r1 = bb + 32 * S5_W; X0.r2 = bb + 64 * S5_W; X0.r3 = bb + 96 * S5_W;
    X1.r0 = bb + 128 * S5_W; X1.r1 = bb + 160 * S5_W; X1.r2 = bb + 192 * S5_W; X1.r3 = bb + 224 * S5_W;
    g_stage(st, wave, X0, X1, kt);
  };
  const int sw = (lane >> 1) & 7, h = lane >> 5;
  int off[4];
#pragma unroll
  for (int ks = 0; ks < 4; ++ks) off[ks] = (lane & 31) * 128 + (((2 * ks + h) ^ sw) * 16);
  char* img = smem + GL_STAGEB;
  for (int tile = bidx_; tile < T / 32; tile += gridDim.x) {
    const int m0 = tile * 32;
    __syncthreads();
    stage_b(smem, 0);
    {
      const int c0 = (tidx_ & 31) * 8, r0 = tidx_ >> 5;
      f32x4 d0 = *(const f32x4*)(p.s5_d + l * S5_W + c0), d1 = *(const f32x4*)(p.s5_d + l * S5_W + c0 + 4);
      f32x4 a0[4], a1[4], b0[4], b1[4]; uint4 u[4];
#pragma unroll
      for (int k = 0; k < 4; ++k) {
        const long t = m0 + r0 + 8 * k;
        const float* y0 = p.ypart + t * S5_W + c0; const float* y1 = p.ypart + ((long)T + t) * S5_W + c0;
        a0[k] = *(const f32x4*)y0; a1[k] = *(const f32x4*)(y0 + 4); b0[k] = *(const f32x4*)y1; b1[k] = *(const f32x4*)(y1 + 4);
        u[k] = *(const uint4*)(p.proj + t * NPJ + PJ_U + c0);
      }
      const int kt = (tidx_ & 31) >> 3, c = tidx_ & 7;
#pragma unroll
      for (int k = 0; k < 4; ++k) {
        const int r = r0 + 8 * k;
        float g0 = gelu_fast(a0[k][0] + b0[k][0] + d0[0] * bflo(u[k].x)), g1 = gelu_fast(a0[k][1] + b0[k][1] + d0[1] * bfhi(u[k].x));
        float g2 = gelu_fast(a0[k][2] + b0[k][2] + d0[2] * bflo(u[k].y)), g3 = gelu_fast(a0[k][3] + b0[k][3] + d0[3] * bfhi(u[k].y));
        float g4 = gelu_fast(a1[k][0] + b1[k][0] + d1[0] * bflo(u[k].z)), g5 = gelu_fast(a1[k][1] + b1[k][1] + d1[1] * bfhi(u[k].z));
        float g6 = gelu_fast(a1[k][2] + b1[k][2] + d1[2] * bflo(u[k].w)), g7 = gelu_fast(a1[k][3] + b1[k][3] + d1[3] * bfhi(u[k].w));
        uint4 w; w.x = cvtpk(g0, g1); w.y = cvtpk(g2, g3); w.z = cvtpk(g4, g5); w.w = cvtpk(g6, g7);
        *(uint4*)(img + kt * 4096 + r * 128 + ((c ^ ((r >> 1) & 7)) * 16)) = w;
      }
    }
    __syncthreads();
    bf16x8 af[16];
#pragma unroll
    for (int kt = 0; kt < 4; ++kt)
#pragma unroll
      for (int ks = 0; ks < 4; ++ks) af[kt * 4 + ks] = *(const bf16x8*)(img + kt * 4096 + off[ks]);
    unsigned ge[2][8];
#pragma unroll
    for (int nt = 0; nt < 2; ++nt)
#pragma unroll
      for (int q = 0; q < 4; ++q)
#pragma unroll
        for (int i2 = 0; i2 < 2; ++i2) {
          const int row = 8 * q + 4 * (lane >> 5) + 2 * i2, jc = 32 * nt + (lane & 31);
          const char* gp = img + wave * 4096 + row * 128 + (((jc >> 3) ^ ((row >> 1) & 7)) * 16) + (jc & 7) * 2;
          ge[nt][2 * q + i2] = (unsigned)*(const unsigned short*)gp | ((unsigned)*(const unsigned short*)(gp + 128) << 16);
        }
    asm volatile("s_waitcnt vmcnt(0)" ::: "memory");
    __syncthreads();
    f32x16 acc0, acc1;
#pragma unroll
    for (int r = 0; r < 16; ++r) { acc0[r] = 0.f; acc1[r] = 0.f; }
#pragma unroll
    for (int kt = 0; kt < 4; ++kt) {
      if (kt < 3) stage_b(smem + ((kt + 1) & 1) * GL_STAGEB, kt + 1);
      const char* sB = smem + (kt & 1) * GL_STAGEB + (wave >> 1) * GL_TILEB + (wave & 1) * 64 * 128;
#pragma unroll
      for (int ks = 0; ks < 4; ++ks) {
        const bf16x8 fb0 = *(const bf16x8*)(sB + off[ks]), fb1 = *(const bf16x8*)(sB + 32 * 128 + off[ks]);
        acc0 = __builtin_amdgcn_mfma_f32_32x32x16_bf16(af[kt * 4 + ks], fb0, acc0, 0, 0, 0);
        acc1 = __builtin_amdgcn_mfma_f32_32x32x16_bf16(af[kt * 4 + ks], fb1, acc1, 0, 0, 0);
      }
      asm volatile("s_waitcnt vmcnt(0)" ::: "memory");
      __syncthreads();
    }
    const bool odd = tidx_ & 1;
#pragma unroll
    for (int nt = 0; nt < 2; ++nt)
#pragma unroll
      for (int q = 0; q < 4; ++q) {
        const int row = 8 * q + 4 * (lane >> 5), j = 64 * wave + 32 * nt + (lane & 31);
        float r[4];
#pragma unroll
        for (int i = 0; i < 4; ++i) {
          const float v = nt ? acc1[4 * q + i] : acc0[4 * q + i];
          const unsigned gw = ge[nt][2 * q + (i >> 1)];
          r[i] = ((i & 1) ? bfhi(gw) : bflo(gw)) * sigmoid_fast(v);
        }
        store4_bf16(p.mixcat + (long)(m0 + row) * MIX_W + ATTN_W + FOUR_W + j, MIX_W, odd, r[0], r[1], r[2], r[3]);
      }
  }
}
DEVFN void ph_four_reduce(const Params& p) {
  PHASE_BEGIN;
  {
    const int nb = gridDim.x;
    int ridx = bidx_ - (T / 32) % nb; if (ridx < 0) ridx += nb;
    for (int it = ridx; it < DB * DSEQ / 16; it += nb) {
#pragma unroll
      for (int k = 0; k < 2; ++k) {
        const int ch = it * 512 + k * 256 + tidx_;
        const int row = ch >> 5, c8 = (ch & 31) * 8;
        const float* a = p.win2 + (long)row * FOUR_W + c8; const float* b = a + (long)DB * DSEQ * FOUR_W;
        const f32x4 a0 = *(const f32x4*)a, a1 = *(const f32x4*)(a + 4), b0 = *(const f32x4*)b, b1 = *(const f32x4*)(b + 4);
        uint4 w;
        w.x = cvtpk(a0[0] + b0[0], a0[1] + b0[1]); w.y = cvtpk(a0[2] + b0[2], a0[3] + b0[3]);
        w.z = cvtpk(a1[0] + b1[0], a1[1] + b1[1]); w.w = cvtpk(a1[2] + b1[2], a1[3] + b1[3]);
        *(uint4*)(p.mixcat + (long)(TC + row) * MIX_W + ATTN_W + c8) = w;
      }
    }
  }
}

DEVFN void ph_glu_fast2(const Params& p, int l, char* smem) {
  PHASE_BEGIN;
  constexpr int NT_N = S5_W / 128, NT_M = T / 128;
  for (int tile = bidx_; tile < NT_M * NT_N; tile += gridDim.x) {
    const int tm = tile / NT_N, tn = tile % NT_N;
    const int m0 = tm * 128, n0 = tn * 128;
    {
      const int c0 = (tidx_ & 31) * 8, r0 = tidx_ >> 5;
      f32x4 d0 = *(const f32x4*)(p.s5_d + l * S5_W + c0), d1 = *(const f32x4*)(p.s5_d + l * S5_W + c0 + 4);
#pragma unroll 1
      for (int i4 = 0; i4 < 4; ++i4) {
        f32x4 a0[4], a1[4], b0[4], b1[4]; uint4 u[4];
#pragma unroll
        for (int k = 0; k < 4; ++k) {
          const long t = m0 + r0 + 8 * (4 * i4 + k);
          const float* y0 = p.ypart + t * S5_W + c0; const float* y1 = p.ypart + ((long)T + t) * S5_W + c0;
          a0[k] = *(const f32x4*)y0; a1[k] = *(const f32x4*)(y0 + 4); b0[k] = *(const f32x4*)y1; b1[k] = *(const f32x4*)(y1 + 4);
          u[k] = *(const uint4*)(p.proj + t * NPJ + PJ_U + c0);
        }
#pragma unroll
        for (int k = 0; k < 4; ++k) {
          const long t = m0 + r0 + 8 * (4 * i4 + k);
          float g0 = gelu_fast(a0[k][0] + b0[k][0] + d0[0] * bflo(u[k].x)), g1 = gelu_fast(a0[k][1] + b0[k][1] + d0[1] * bfhi(u[k].x));
          float g2 = gelu_fast(a0[k][2] + b0[k][2] + d0[2] * bflo(u[k].y)), g3 = gelu_fast(a0[k][3] + b0[k][3] + d0[3] * bfhi(u[k].y));
          float g4 = gelu_fast(a1[k][0] + b1[k][0] + d1[0] * bflo(u[k].z)), g5 = gelu_fast(a1[k][1] + b1[k][1] + d1[1] * bfhi(u[k].z));
          float g6 = gelu_fast(a1[k][2] + b1[k][2] + d1[2] * bflo(u[k].w)), g7 = gelu_fast(a1[k][3] + b1[k][3] + d1[3] * bfhi(u[k].w));
          uint4 w; w.x = cvtpk(g0, g1); w.y = cvtpk(g2, g3); w.z = cvtpk(g4, g5); w.w = cvtpk(g6, g7);
          *(uint4*)(p.gbuf + t * S5_W + c0) = w;
        }
      }
    }
    asm volatile("s_waitcnt vmcnt(0)" ::: "memory");
    __syncthreads();
    GRows A = make_grows(tidx_, p.gbuf, m0, S5_W);
    GRows B = make_grows(tidx_, p.wglut + (long)l * S5_W * S5_W, n0, S5_W);
    const bool odd = tidx_ & 1;
    bool staged = false;
    bf16_t* gl = (bf16_t*)smem;
    gemm_tile_g(smem, tidx_, A, B, S5_W / 64, [&](int nt, int row, int col, float v0, float v1, float v2, float v3) {
      if (!staged) {
        uint4 t8[8];
#pragma unroll
        for (int i = 0; i < 8; ++i) { const int c = tidx_ + 256 * i; t8[i] = *(const uint4*)(p.gbuf + (long)(m0 + (c >> 4)) * S5_W + n0 + (c & 15) * 8); }
#pragma unroll
        for (int i = 0; i < 8; ++i) { const int c = tidx_ + 256 * i; *(uint4*)(gl + (c >> 4) * 128 + (c & 15) * 8) = t8[i]; }
        __syncthreads();
        staged = true;
      }
      const int j = n0 + col;
      float v[4] = {v0, v1, v2, v3};
      float gg[4];
#pragma unroll
      for (int i = 0; i < 4; ++i) gg[i] = bf2f(gl[(row + i) * 128 + col]);
#pragma unroll
      for (int i = 0; i < 4; ++i) {
        long t = m0 + row + i;
        float r = gg[i] * sigmoid_fast(v[i]);
        float pr = shx1(r);
        if (!odd) *(unsigned*)(p.mixcat + t * MIX_W + ATTN_W + FOUR_W + j) = cvtpk(r, pr);
      }
    });
  }
}

__global__ void __launch_bounds__(256, 2) __attribute__((amdgpu_waves_per_eu(2, 2))) mega(Params p) {
  __shared__ __attribute__((aligned(16))) char smem[SMEM_BYTES];
  __shared__ uint4 xb_words;
  __shared__ int s_item;
  if (threadIdx.x == 0) xb_words = make_uint4(0u, 0u, 0u, 0u);
  __syncthreads();
  XcdBarrier xb = xcd_barrier_post(p.bar, (volatile LAS unsigned*)&xb_words);
  volatile LAS unsigned* lead = (volatile LAS unsigned*)&xb_words + 2;
  volatile LAS int* s_cd = (volatile LAS int*)&xb_words + 3;
  ph_adaln_part(p, smem); ph_init_tr(p, smem); ph_init_tab(p, smem); xcd_barrier(xb);
  ph_adaln_reduce(p); ph_init_fold(p, smem); xcd_barrier(xb);
  int l = 0, ph = 0;
#pragma unroll 1
  for (;;) {
    if (ph == 0) { ph_row1_fast(p, l, smem); if (l == DEPTH) break; }
    else if (ph == 1) ph_gemm_in_fast(p, l, smem);
    else if (ph == 2) ph_mix_fast(p, l, smem, &s_item);
    else if (ph == 3) { ph_glu_fast3(p, l, smem); ph_four_reduce(p); }
    else if (ph == 4) ph_gemm_out_fast(p, l, smem);
    else if (ph == 5) ph_row2_fast(p, l, smem);
    else if (ph == 6) { ph_topk_fast(p, l, smem); int cd = *s_cd; __syncthreads(); ph_conv_catchup(p, l, cd, smem); if (threadIdx.x == 0) *s_cd = cd; }
    else if (ph == 7) ph_moe1_fast(p, l, smem);
    else ph_moe2_fast(p, l, smem);
    xcd_barrier_fill(xb, lead, [&]() {
      int tf = threadIdx.x, bf = blockIdx.x;
      asm volatile("" : "+v"(tf), "+s"(bf));
      int cd = *s_cd;
      __syncthreads();
      conv_fill(p, l, ph, cd, smem, tf, bf);
      if (tf == 0) *s_cd = cd;
    });
    if (++ph == 9) { ph = 0; ++l; }
  }
}

extern "C" void kernel_launch(void* const* d_in, const int* in_sizes, int n_in, void* d_out, int out_size, void* d_ws,
                              size_t ws_size, hipStream_t stream) {
  Params p{};
  const float** pp = (const float**)&p;
  for (int i = 0; i < 33; ++i) pp[i] = (const float*)d_in[i];
  p.out = (float*)d_out;
  char* w = (char*)d_ws;
  size_t off = 0;
  auto al = [&](size_t bytes) { void* r = w + off; off += (bytes + 255) & ~(size_t)255; return r; };
  p.bar = (unsigned*)al(64 * 1024);
  p.x = (float*)al((size_t)T * D * 4); p.mod = (float*)al((size_t)DEPTH * NCOND * 6 * D * 4);
  p.states = nullptr; p.ypart = (float*)al((size_t)2 * T * S5_W * 4); p.ybuf = (float*)al((size_t)T * D * 4); p.aff = (float*)al((size_t)T * NE * 4);
  p.wcs = (float*)al((size_t)DEPTH * 256 * 512 * 4); p.win2 = (float*)al((size_t)DEPTH * D * NP * 4);
  p.abar = (float*)al((size_t)DEPTH * 2 * SG * SP * 2 * 4); p.bbar = (float*)al((size_t)DEPTH * 2 * SG * SP * SH * 2 * 4);
  p.twc = (float*)al(SEQ * 2 * 4); p.twl = (float*)al(DSEQ * 2 * 4); p.selgate = (float*)al((size_t)NE * NS * 4);
  p.modpart = (float*)al((size_t)ADA_KC * DEPTH * NCOND * 6 * D * 4); p.afft = (float*)al((size_t)NE * T * 4); p.rope = (float*)al(64 * 16 * 2 * 4);
  p.h = (act_t*)al((size_t)T * D * sizeof(act_t)); p.proj = (act_t*)al((size_t)T * NPJ * sizeof(act_t));
  p.pqt = (act_t*)al((size_t)T * 512 * sizeof(act_t)); p.mixcat = (act_t*)al((size_t)T * MIX_W * sizeof(act_t));
  p.gbuf = (act_t*)al((size_t)T * S5_W * sizeof(act_t)); p.h2 = (act_t*)al((size_t)T * D * sizeof(act_t));
  p.hid = (act_t*)al((size_t)NE * NS * FF * sizeof(act_t)); p.ys = (act_t*)al((size_t)NE * NS * D * sizeof(act_t));
  p.win2t = (bf16_t*)al((size_t)DEPTH * NP * D * 2); p.woutt = (bf16_t*)al((size_t)DEPTH * D * MIX_W * 2);
  p.wglut = (bf16_t*)al((size_t)DEPTH * S5_W * S5_W * 2); p.dftc = (bf16_t*)al((size_t)SEQ * 2 * SEQ * 2);
  p.dftl = (bf16_t*)al((size_t)DSEQ * 2 * DSEQ * 2); p.wcst = (bf16_t*)al((size_t)DEPTH * 512 * 256 * 2);
  p.wgt = (bf16_t*)al((size_t)2 * NE * FF * D * 2); p.wut = (bf16_t*)al((size_t)2 * NE * FF * D * 2); p.wdt = (bf16_t*)al((size_t)2 * NE * D * FF * 2);
  p.bbn = (bf16_t*)al((size_t)DEPTH * 2 * SG * 128 * 16 * 2); p.cn = (bf16_t*)al((size_t)DEPTH * 2 * SG * SH * 128 * 2);
  p.seltok = (int*)al((size_t)NE * NS * 4); p.inv = (int*)al((size_t)T * NE * 4);
  static int grid_blocks = 0;
  if (!grid_blocks) {
    int dev = 0, cus = 0, per_cu = 0;
    (void)hipGetDevice(&dev);
    (void)hipDeviceGetAttribute(&cus, hipDeviceAttributeMultiprocessorCount, dev);
    (void)hipOccupancyMaxActiveBlocksPerMultiprocessor(&per_cu, mega, 256, 0);
    if (per_cu > 2) per_cu = 2;
    grid_blocks = cus * per_cu;
  }
  (void)hipMemsetAsync(p.bar, 0, 32768, stream);
  void* args[] = {&p};
  hipError_t e = hipLaunchCooperativeKernel((void*)mega, dim3(grid_blocks), dim3(256), args, 0, stream);
  if (e != hipSuccess) fprintf(stderr, "cooperative launch failed: %s (grid %d)\n", hipGetErrorString(e), grid_blocks);
}
```

```cpp
#include <hip/hip_runtime.h>
#include <hip/hip_cooperative_groups.h>
#include <cstdio>
#include <cstdint>
namespace cg = cooperative_groups;
#define DEVFN __device__ __forceinline__
#define PHASE_BEGIN int tidx_ = threadIdx.x; int bidx_ = blockIdx.x; asm volatile("" : "+v"(tidx_), "+s"(bidx_))
#define GTID ((long)bidx_ * 256 + tidx_)
#define GSIZE ((long)gridDim.x * 256)
#define ACT_BF16 1
#define HAVE_FAST 1

#ifdef CFG_SMALL
constexpr int D = 128, BATCH = 2, SEQ = 64, DEPTH = 2, DB = 2, DSEQ = 384, PAST = 64, FF = 64;
#else
constexpr int D = 1024, BATCH = 16, SEQ = 256, DEPTH = 4, DB = 4, DSEQ = 1024, PAST = 512, FF = 1024;
#endif
constexpr int GRID_W = 64, NH = 8, NKV = 2, HD = 64, GQA = 4, ATTN_W = 512, KV_W = 128, WINDOW = 128;
constexpr int FOUR_W = 256, S5_W = 256, SG = 16, SH = 16, SP = 64;
constexpr int MIX_W = 1024, IN_W = 1280, NE = 16;
constexpr int NP = 1536;
constexpr int PC_Q = 0, PC_K = 512, PC_V = 640, PC_P = 768, PC_QQ = 1024, PC_U = 1280;
constexpr int NPJ = 1024, PJ_Q = 0, PJ_K = 512, PJ_V = 640, PJ_U = 768;
constexpr int TC = BATCH * SEQ, TL = DB * DSEQ, T = TC + TL;
constexpr int NCOND = 1 + DB;
constexpr int CAPC = 2 * SEQ / NE, CAPL = 2 * DSEQ / NE;
constexpr int NS = BATCH * CAPC + DB * CAPL;
constexpr int NSEQ = BATCH + DB;
constexpr float LN_EPS = 1e-5f;
#ifdef CFG_SMALL
constexpr float ALPHA = 1.4142135623730951f;
#else
constexpr float ALPHA = 1.681792830507429f;
#endif

constexpr long O_YP = 0, O_YS = (long)TC * D, O_K = (long)T * D, O_V = O_K + (long)BATCH * DEPTH * SEQ * KV_W,
               O_SRE = O_V + (long)BATCH * DEPTH * SEQ * KV_W, O_SIM = O_SRE + (long)BATCH * DEPTH * 2 * SG * SP,
               O_END = O_SIM + (long)BATCH * DEPTH * 2 * SG * SP;

typedef unsigned short bf16_t;
#ifdef HOST_EMU
static inline unsigned f_as_u(float f) { unsigned u; memcpy(&u, &f, 4); return u; }
static inline float u_as_f(unsigned u) { float f; memcpy(&f, &u, 4); return f; }
#else
DEVFN unsigned f_as_u(float f) { return __float_as_uint(f); }
DEVFN float u_as_f(unsigned u) { return __uint_as_float(u); }
#endif
DEVFN bf16_t f2bf(float f) { unsigned u = f_as_u(f); u += 0x7fffu + ((u >> 16) & 1u); return (bf16_t)(u >> 16); }
DEVFN float bf2f(bf16_t b) { return u_as_f((unsigned)b << 16); }
#ifdef ACT_BF16
typedef bf16_t act_t;
DEVFN float lda(const act_t* p) { return bf2f(*p); }
DEVFN void sta(act_t* p, float v) { *p = f2bf(v); }
#else
typedef float act_t;
DEVFN float lda(const act_t* p) { return *p; }
DEVFN void sta(act_t* p, float v) { *p = v; }
#endif
struct Params {
  const float *x_prompt, *x_sample, *cache_k, *cache_v, *st_re, *st_im, *c, *c_ctx, *ln_in_g, *ln_in_b, *w_ada, *b_ada,
      *w_in, *w_fourier, *attn_sink, *s5_a_re, *s5_a_im, *s5_log_dt, *s5_b_re, *s5_b_im, *s5_c_re, *s5_c_im, *s5_d,
      *s5_w_glu, *w_out, *ln1_g, *ln1_b, *w_router, *w_gate, *w_up, *w_down, *ln2_g, *ln2_b;
  float* out;
  float *x, *mod, *states, *ybuf, *aff, *wcs, *win2, *abar, *bbar, *twc, *twl, *selgate, *modpart, *rope, *afft, *ypart;
  act_t *h, *proj, *pqt, *mixcat, *gbuf, *h2, *hid, *ys;
  bf16_t *win2t, *woutt, *wglut, *dftc, *dftl, *bbn, *cn, *wcst, *wgt, *wut, *wdt;
  int *seltok, *inv;
  unsigned* bar;
};

DEVFN float silu_f(float x) { return x / (1.f + expf(-x)); }
DEVFN float sigmoid_f(float x) { return 1.f / (1.f + expf(-x)); }
DEVFN float gelu_f(float x) { return 0.5f * x * (1.f + tanhf(0.7978845608028654f * (x + 0.044715f * x * x * x))); }

struct TokInfo { int lat, b, n, N, ci, t0; };
DEVFN TokInfo tokinfo(int t) {
  TokInfo r;
  if (t < TC) { r.lat = 0; r.b = t / SEQ; r.n = t % SEQ; r.N = SEQ; r.ci = 0; r.t0 = r.b * SEQ; }
  else { int tl = t - TC; r.lat = 1; r.b = tl / DSEQ; r.n = tl % DSEQ; r.N = DSEQ; r.ci = 1 + r.b; r.t0 = TC + r.b * DSEQ; }
  return r;
}
DEVFN const float* modp(const Params& p, int l, int ci, int chunk) { return p.mod + (((long)l * NCOND + ci) * 6 + chunk) * D; }

DEVFN void ph_init0(const Params& p) {
  PHASE_BEGIN;
  const long gt = GTID, gs = GSIZE;
#ifndef HAVE_FAST
  for (long idx = gt; idx < (long)DEPTH * 6 * D; idx += gs) {
    int l = idx / (6 * D), j = idx % (6 * D);
    float acc[NCOND];
#pragma unroll
    for (int c = 0; c < NCOND; ++c) acc[c] = 0.f;
    const float* w = p.w_ada + (long)l * D * 6 * D + j;
    for (int d = 0; d < D; ++d) {
      float wv = w[(long)d * 6 * D];
      acc[0] += silu_f(p.c_ctx[d]) * wv;
#pragma unroll
      for (int c = 1; c < NCOND; ++c) acc[c] += silu_f(p.c[(c - 1) * D + d]) * wv;
    }
    float bb = p.b_ada[(long)l * 6 * D + j];
#pragma unroll
    for (int c = 0; c < NCOND; ++c) p.mod[((long)l * NCOND + c) * 6 * D + j] = acc[c] + bb;
  }
#endif
  for (long idx = gt; idx < (long)DEPTH * 2 * SG * SP; idx += gs) {
    int pp = idx % SP; int g = (idx / SP) % SG; long ld = idx / (SP * SG);
    double are = p.s5_a_re[idx], aim = p.s5_a_im[idx];
    double dt = exp((double)p.s5_log_dt[ld * SG + g]);
    double er = exp(are * dt), cr = er * cos(aim * dt), ci = er * sin(aim * dt);
    p.abar[idx * 2] = (float)cr; p.abar[idx * 2 + 1] = (float)ci;
    double nr = cr - 1.0, ni = ci, den = are * are + aim * aim;
    double fr = (nr * are + ni * aim) / den, fi = (ni * are - nr * aim) / den;
    for (int h = 0; h < SH; ++h) {
      double br = p.s5_b_re[idx * SH + h], bi = p.s5_b_im[idx * SH + h];
      p.bbar[(idx * SH + h) * 2] = (float)(fr * br - fi * bi);
      p.bbar[(idx * SH + h) * 2 + 1] = (float)(fr * bi + fi * br);
#ifdef HAVE_FAST
      p.bbn[((ld * SG + g) * 128 + 2 * pp) * 16 + h] = f2bf((float)(fr * br - fi * bi));
      p.bbn[((ld * SG + g) * 128 + 2 * pp + 1) * 16 + h] = f2bf((float)(fr * bi + fi * br));
#endif
    }
  }
#ifdef HAVE_FAST
  for (long idx = gt; idx < (long)DEPTH * 2 * SG * SH * 128; idx += gs) {
    int k = idx % 128; long row = idx / 128;
    p.cn[idx] = f2bf((k & 1) ? -p.s5_c_im[row * SP + (k >> 1)] : p.s5_c_re[row * SP + (k >> 1)]);
  }
#endif
  for (long idx = gt; idx < SEQ; idx += gs) {
    double a = 6.283185307179586476925 * (double)idx / SEQ;
    p.twc[idx * 2] = (float)cos(a); p.twc[idx * 2 + 1] = (float)sin(a);
  }
  for (long idx = gt; idx < DSEQ; idx += gs) {
    double a = 6.283185307179586476925 * (double)idx / DSEQ;
    p.twl[idx * 2] = (float)cos(a); p.twl[idx * 2 + 1] = (float)sin(a);
  }
  for (long idx = gt; idx < (long)DEPTH * 256 * 256; idx += gs) {
    int j = idx % 256; int i = (idx / 256) % 256; int l = idx / (256 * 256);
    int hd = i / 64, c = i % 64;
    float sc = 0.f, ss = 0.f;
    for (int m = 0; m < 64; ++m) {
      int k = (m * c) & 63;
      float ang = 6.283185307179586f * (float)k / 64.f;
      float wv = p.w_fourier[((long)l * 256 + hd * 64 + m) * 256 + j];
      sc += cosf(ang) * wv; ss += sinf(ang) * wv;
    }
    p.wcs[((long)l * 256 + i) * 512 + j] = sc * 0.125f;
    p.wcs[((long)l * 256 + i) * 512 + 256 + j] = ss * 0.125f;
  }
}
DEVFN void ph_init1(const Params& p) {
  PHASE_BEGIN;
  const long gt = GTID, gs = GSIZE;
  for (long idx = gt; idx < (long)DEPTH * D * NP; idx += gs) {
    int j = idx % NP; int d = (idx / NP) % D; int l = idx / ((long)NP * D);
    const float* wrow = p.w_in + ((long)l * D + d) * IN_W;
    float v;
    if (j < PC_P) v = wrow[j];
    else if (j >= PC_U) v = wrow[1024 + (j - PC_U)];
    else {
      int jj = j - PC_P;
      float acc = 0.f;
      for (int i = 0; i < 256; ++i) acc += wrow[768 + i] * p.wcs[((long)l * 256 + i) * 512 + jj];
      v = acc;
    }
    p.win2[idx] = v;
#ifdef HAVE_FAST
    p.win2t[((long)l * NP + j) * D + d] = f2bf(v);
#endif
  }
}

DEVFN long pqt_base(int lat, int b) { return lat ? (long)TC * 512 + (long)b * 512 * DSEQ : (long)b * 512 * SEQ; }
DEVFN void ph_row1(const Params& p, int l) {
  PHASE_BEGIN;
  for (long t = GTID; t < T; t += GSIZE) {
    TokInfo ti = tokinfo((int)t);
    float* yb = p.ybuf + t * D;
    const float *g, *b;
    float sum = 0.f;
    if (l == 0) {
      const float* src = ti.lat ? p.x_sample + (t - TC) * D : p.x_prompt + t * D;
      for (int d = 0; d < D; ++d) { float v = src[d]; yb[d] = v; sum += v; }
      g = p.ln_in_g; b = p.ln_in_b;
    } else {
      const float* gate2 = modp(p, l - 1, ti.ci, 5);
      const float* xr = p.x + t * D;
      for (int d = 0; d < D; ++d) {
        float m = 0.f;
        for (int e = 0; e < NE; ++e) {
          int s = p.inv[t * NE + e];
          if (s >= 0) m += lda(p.ys + ((long)e * NS + s) * D + d);
        }
        float v = ALPHA * xr[d] + gate2[d] * m;
        yb[d] = v; sum += v;
      }
      g = p.ln2_g + (long)(l - 1) * D; b = p.ln2_b + (long)(l - 1) * D;
    }
    float mu = sum / D, var = 0.f;
    for (int d = 0; d < D; ++d) { float dv = yb[d] - mu; var += dv * dv; }
    float rs = 1.f / sqrtf(var / D + LN_EPS);
    if (l < DEPTH) {
      const float* sh = modp(p, l, ti.ci, 0); const float* sc = modp(p, l, ti.ci, 1);
      for (int d = 0; d < D; ++d) {
        float xv = (yb[d] - mu) * rs * g[d] + b[d];
        p.x[t * D + d] = xv;
        sta(p.h + t * D + d, xv * (1.f + sc[d]) + sh[d]);
      }
    } else {
      float* o = p.out + (ti.lat ? O_YS + (t - TC) * D : O_YP + t * D);
      for (int d = 0; d < D; ++d) o[d] = (yb[d] - mu) * rs * g[d] + b[d];
    }
  }
}

DEVFN void inproj_store(const Params& p, int l, long t, const TokInfo& ti, int j, float a0, float a1) {
  if (ti.lat && j < PC_V) {
    int i = (j % HD) / 2;
    int pos = (i < 16) ? (ti.n / GRID_W) : (ti.n % GRID_W);
    int fi = i & 15;
    float freq = powf(10000.f, -(float)fi / 16.f);
    float ang = (float)pos * freq;
    float cs = cosf(ang), sn = sinf(ang);
    float r0 = a0 * cs - a1 * sn, r1 = a0 * sn + a1 * cs;
    a0 = r0; a1 = r1;
  }
  if (j < PC_P) { sta(p.proj + t * NPJ + j, a0); sta(p.proj + t * NPJ + j + 1, a1); }
  else if (j >= PC_U) { sta(p.proj + t * NPJ + PJ_U + (j - PC_U), a0); sta(p.proj + t * NPJ + PJ_U + (j - PC_U) + 1, a1); }
  else {
    int jj = j - PC_P; int isq = jj >= 256; int jc = jj & 255;
    act_t* dst = p.pqt + pqt_base(ti.lat, ti.b) + (long)jc * 2 * ti.N + (isq ? ti.N : 0) + ti.n;
    sta(dst, a0); sta(dst + 2 * ti.N, a1);
  }
  if (!ti.lat && j >= PC_K && j < PC_P) {
    long base = (((long)ti.b * DEPTH + l) * SEQ + ti.n) * KV_W;
    if (j < PC_V) { p.out[O_K + base + (j - PC_K)] = a0; p.out[O_K + base + (j - PC_K) + 1] = a1; }
    else { p.out[O_V + base + (j - PC_V)] = a0; p.out[O_V + base + (j - PC_V) + 1] = a1; }
  }
}
DEVFN void ph_gemm_in(const Params& p, int l) {
  PHASE_BEGIN;
  for (long idx = GTID; idx < (long)T * (NP / 2); idx += GSIZE) {
    int jp = idx % (NP / 2); long t = idx / (NP / 2);
    int j = jp * 2;
    const act_t* hr = p.h + t * D;
    const float* w = p.win2 + (long)l * D * NP + j;
    float a0 = 0.f, a1 = 0.f;
    for (int d = 0; d < D; ++d) { float hv = lda(hr + d); a0 += hv * w[(long)d * NP]; a1 += hv * w[(long)d * NP + 1]; }
    TokInfo ti = tokinfo((int)t);
    inproj_store(p, l, t, ti, j, a0, a1);
  }
}

DEVFN float ldv(const float* p) { return *p; }
#ifdef ACT_BF16
DEVFN float ldv(const bf16_t* p) { return bf2f(*p); }
#endif
template <class KT>
DEVFN void attn_key(const float* q, const KT* kr, const KT* vr, float& m, float& den, float* acc) {
  float s = 0.f;
#pragma unroll
  for (int d = 0; d < HD; ++d) s += q[d] * ldv(kr + d);
  s *= 0.125f;
  if (s > m) {
    float f = expf(m - s);
    den *= f;
#pragma unroll
    for (int d = 0; d < HD; ++d) acc[d] *= f;
    m = s;
  }
  float pw = expf(s - m);
  den += pw;
#pragma unroll
  for (int d = 0; d < HD; ++d) acc[d] += pw * ldv(vr + d);
}
DEVFN void ph_attn(const Params& p, int l) {
  PHASE_BEGIN;
  for (long idx = GTID; idx < (long)T * NH; idx += GSIZE) {
    int hh = idx % NH; long t = idx / NH;
    TokInfo ti = tokinfo((int)t);
    int kvh = hh / GQA;
    float q[HD], acc[HD];
#pragma unroll
    for (int d = 0; d < HD; ++d) { q[d] = lda(p.proj + t * NPJ + PJ_Q + hh * HD + d); acc[d] = 0.f; }
    float m = p.attn_sink[l * NH + hh], den = 1.f;
    int j0 = 0, j1 = ti.N;
    if (ti.lat) { j0 = ti.n - WINDOW < 0 ? 0 : ti.n - WINDOW; j1 = ti.n + WINDOW + 1 > ti.N ? ti.N : ti.n + WINDOW + 1; }
    for (int j = j0; j < j1; ++j) {
      const act_t* kr = p.proj + (long)(ti.t0 + j) * NPJ + PJ_K + kvh * HD;
      const act_t* vr = p.proj + (long)(ti.t0 + j) * NPJ + PJ_V + kvh * HD;
      attn_key(q, kr, vr, m, den, acc);
    }
    if (ti.lat) {
      for (int s_ = 0; s_ < PAST; ++s_) {
        long base = ((((long)ti.b * DEPTH + l) * PAST + s_) * NKV + kvh) * HD;
        attn_key(q, p.cache_k + base, p.cache_v + base, m, den, acc);
      }
    }
    float inv = 1.f / den;
#pragma unroll
    for (int d = 0; d < HD; ++d) sta(p.mixcat + t * MIX_W + hh * HD + d, acc[d] * inv);
  }
}
DEVFN void ph_fourier(const Params& p, int l) {
  PHASE_BEGIN;
  for (long idx = GTID; idx < (long)T * FOUR_W; idx += GSIZE) {
    int j = idx % FOUR_W; long t = idx / FOUR_W;
    TokInfo ti = tokinfo((int)t);
    const float* tw = ti.lat ? p.twl : p.twc;
    const act_t* pr = p.pqt + pqt_base(ti.lat, ti.b) + (long)j * 2 * ti.N;
    float acc = 0.f;
    for (int n = 0; n < ti.N; ++n) {
      int k = (int)(((long)ti.n * n) % ti.N);
      acc += tw[k * 2] * lda(pr + n) - tw[k * 2 + 1] * lda(pr + ti.N + n);
    }
    sta(p.mixcat + t * MIX_W + ATTN_W + j, acc / sqrtf((float)ti.N));
  }
}
DEVFN void ph_s5scan(const Params& p, int l) {
  PHASE_BEGIN;
  for (long idx = GTID; idx < (long)NSEQ * 2 * SG * SP; idx += GSIZE) {
    int pp = idx % SP; int g = (idx / SP) % SG; int dir = (idx / (SP * SG)) % 2; int sq = idx / (SP * SG * 2);
    int lat = sq >= BATCH; int b = lat ? sq - BATCH : sq; int N = lat ? DSEQ : SEQ; int t0 = lat ? TC + b * DSEQ : b * SEQ;
    long pi = (((long)l * 2 + dir) * SG + g) * SP + pp;
    float ar = p.abar[pi * 2], ai = p.abar[pi * 2 + 1];
    float br[SH], bi[SH];
#pragma unroll
    for (int h = 0; h < SH; ++h) { br[h] = p.bbar[(pi * SH + h) * 2]; bi[h] = p.bbar[(pi * SH + h) * 2 + 1]; }
    float sr = 0.f, si = 0.f;
    if (lat) {
      long si0 = ((((long)b * DEPTH + l) * 2 + dir) * SG + g) * SP + pp;
      sr = p.st_re[si0]; si = p.st_im[si0];
    }
    for (int k = 0; k < N; ++k) {
      int n = dir ? N - 1 - k : k;
      const act_t* u = p.proj + (long)(t0 + n) * NPJ + PJ_U + g * SH;
      float bur = 0.f, bui = 0.f;
#pragma unroll
      for (int h = 0; h < SH; ++h) { float uv = lda(u + h); bur += br[h] * uv; bui += bi[h] * uv; }
      float nr = ar * sr - ai * si + bur, ni = ar * si + ai * sr + bui;
      sr = nr; si = ni;
      long so = ((((long)(t0 + n) * 2 + dir) * SG + g) * SP + pp) * 2;
      p.states[so] = sr; p.states[so + 1] = si;
    }
    if (!lat) {
      long oo = ((((long)b * DEPTH + l) * 2 + dir) * SG + g) * SP + pp;
      p.out[O_SRE + oo] = sr; p.out[O_SIM + oo] = si;
    }
  }
}
DEVFN void ph_s5y(const Params& p, int l) {
  PHASE_BEGIN;
  for (long idx = GTID; idx < (long)T * S5_W; idx += GSIZE) {
    int c = idx % S5_W; long t = idx / S5_W;
    int g = c / SH, h = c % SH;
    float y = p.s5_d[l * S5_W + c] * lda(p.proj + t * NPJ + PJ_U + c);
    for (int dir = 0; dir < 2; ++dir) {
      const float* cre = p.s5_c_re + ((((long)l * 2 + dir) * SG + g) * SH + h) * SP;
      const float* cim = p.s5_c_im + ((((long)l * 2 + dir) * SG + g) * SH + h) * SP;
      const float* st = p.states + ((((long)t * 2 + dir) * SG + g) * SP) * 2;
      for (int pp = 0; pp < SP; ++pp) y += cre[pp] * st[pp * 2] - cim[pp] * st[pp * 2 + 1];
    }
    sta(p.gbuf + t * S5_W + c, gelu_f(y));
  }
}
DEVFN void ph_s5glu(const Params& p, int l) {
  PHASE_BEGIN;
  for (long idx = GTID; idx < (long)T * S5_W; idx += GSIZE) {
    int j = idx % S5_W; long t = idx / S5_W;
    const act_t* gr = p.gbuf + t * S5_W;
    const float* w = p.s5_w_glu + (long)l * S5_W * S5_W + j;
    float z = 0.f;
    for (int i = 0; i < S5_W; ++i) z += lda(gr + i) * w[(long)i * S5_W];
    sta(p.mixcat + t * MIX_W + ATTN_W + FOUR_W + j, lda(gr + j) * sigmoid_f(z));
  }
}
DEVFN void ph_gemm_out(const Params& p, int l) {
  PHASE_BEGIN;
  for (long idx = GTID; idx < (long)T * D; idx += GSIZE) {
    int j = idx % D; long t = idx / D;
    const act_t* mr = p.mixcat + t * MIX_W;
    const float* w = p.w_out + (long)l * MIX_W * D + j;
    float acc = 0.f;
    for (int i = 0; i < MIX_W; ++i) acc += lda(mr + i) * w[(long)i * D];
    TokInfo ti = tokinfo((int)t);
    p.ybuf[idx] = ALPHA * p.x[idx] + modp(p, l, ti.ci, 2)[j] * acc;
  }
}
DEVFN void ph_row2(const Params& p, int l) {
  PHASE_BEGIN;
  for (long t = GTID; t < T; t += GSIZE) {
    TokInfo ti = tokinfo((int)t);
    const float* yb = p.ybuf + t * D;
    float sum = 0.f;
    for (int d = 0; d < D; ++d) sum += yb[d];
    float mu = sum / D, var = 0.f;
    for (int d = 0; d < D; ++d) { float dv = yb[d] - mu; var += dv * dv; }
    float rs = 1.f / sqrtf(var / D + LN_EPS);
    const float* g = p.ln1_g + (long)l * D; const float* b = p.ln1_b + (long)l * D;
    const float* sh = modp(p, l, ti.ci, 3); const float* sc = modp(p, l, ti.ci, 4);
    float lg[NE];
#pragma unroll
    for (int e = 0; e < NE; ++e) lg[e] = 0.f;
    for (int d = 0; d < D; ++d) {
      float xv = (yb[d] - mu) * rs * g[d] + b[d];
      p.x[t * D + d] = xv;
      float hv = xv * (1.f + sc[d]) + sh[d];
      sta(p.h2 + t * D + d, hv);
      const float* wr = p.w_router + ((long)l * D + d) * NE;
#pragma unroll
      for (int e = 0; e < NE; ++e) lg[e] += hv * wr[e];
    }
    float mx = lg[0];
#pragma unroll
    for (int e = 1; e < NE; ++e) mx = fmaxf(mx, lg[e]);
    float se = 0.f;
#pragma unroll
    for (int e = 0; e < NE; ++e) { lg[e] = expf(lg[e] - mx); se += lg[e]; }
    float is = 1.f / se;
#pragma unroll
    for (int e = 0; e < NE; ++e) p.aff[t * NE + e] = lg[e] * is;
  }
}
DEVFN void ph_topk(const Params& p, int l) {
  PHASE_BEGIN;
  for (long idx = GTID; idx < (long)T * NE; idx += GSIZE) {
    int e = idx % NE; long t = idx / NE;
    TokInfo ti = tokinfo((int)t);
    float a = p.aff[t * NE + e];
    int rank = 0;
    for (int j = 0; j < ti.N; ++j) {
      float aj = p.aff[(long)(ti.t0 + j) * NE + e];
      rank += (aj > a || (aj == a && j < ti.n)) ? 1 : 0;
    }
    int cap = ti.lat ? CAPL : CAPC;
    int slot = -1;
    if (rank < cap) {
      slot = ti.lat ? BATCH * CAPC + ti.b * CAPL + rank : ti.b * CAPC + rank;
      p.seltok[e * NS + slot] = (int)t;
      p.selgate[e * NS + slot] = a;
    }
    p.inv[t * NE + e] = slot;
  }
}
DEVFN void ph_moe1(const Params& p, int l) {
  PHASE_BEGIN;
  for (long idx = GTID; idx < (long)NE * NS * FF; idx += GSIZE) {
    int f = idx % FF; int s = (idx / FF) % NS; int e = idx / ((long)FF * NS);
    int tok = p.seltok[e * NS + s];
    const act_t* hr = p.h2 + (long)tok * D;
    const float* wg = p.w_gate + (((long)l * NE + e) * D) * FF + f;
    const float* wu = p.w_up + (((long)l * NE + e) * D) * FF + f;
    float ag = 0.f, au = 0.f;
    for (int d = 0; d < D; ++d) { float hv = lda(hr + d); ag += hv * wg[(long)d * FF]; au += hv * wu[(long)d * FF]; }
    sta(p.hid + idx, silu_f(ag) * au);
  }
}
DEVFN void ph_moe2(const Params& p, int l) {
  PHASE_BEGIN;
  for (long idx = GTID; idx < (long)NE * NS * D; idx += GSIZE) {
    int d = idx % D; int s = (idx / D) % NS; int e = idx / ((long)D * NS);
    const act_t* hr = p.hid + ((long)e * NS + s) * FF;
    const float* wd = p.w_down + (((long)l * NE + e) * FF) * D + d;
    float acc = 0.f;
    for (int f = 0; f < FF; ++f) acc += lda(hr + f) * wd[(long)f * D];
    sta(p.ys + idx, acc * p.selgate[e * NS + s]);
  }
}

constexpr int PH_PER_LAYER = 10;
constexpr int NPHASE = 2 + PH_PER_LAYER * DEPTH + 1;
#ifndef HAVE_FAST
DEVFN void run_phase(const Params& p, int ph) {
  if (ph == 0) { ph_init0(p); return; }
  if (ph == 1) { ph_init1(p); return; }
  int l = (ph - 2) / PH_PER_LAYER, s = (ph - 2) % PH_PER_LAYER;
  if (l == DEPTH) { ph_row1(p, DEPTH); return; }
  switch (s) {
    case 0: ph_row1(p, l); break;
    case 1: ph_gemm_in(p, l); break;
    case 2: ph_attn(p, l); ph_fourier(p, l); ph_s5scan(p, l); break;
    case 3: ph_s5y(p, l); break;
    case 4: ph_s5glu(p, l); break;
    case 5: ph_gemm_out(p, l); break;
    case 6: ph_row2(p, l); break;
    case 7: ph_topk(p, l); break;
    case 8: ph_moe1(p, l); break;
    case 9: ph_moe2(p, l); break;
  }
}
#endif
#define XB_TMO      128
#define XB_XCNT(j)  (256  + 64 * (j))
#define XB_XSUB(j)  (1280 + 64 * (j))
#define XB_XGEN(j)  (2304 + 64 * (j))
#define XB_TOP      3328
#define XB_TOPGEN   3392
#define XCD_BAR_WORDS 3456
#define XB_SPIN_CAP (1u << 20)
#define LAS __attribute__((address_space(3)))
DEVFN unsigned xb_ld(unsigned* p)              { return __hip_atomic_load(p, __ATOMIC_RELAXED, __HIP_MEMORY_SCOPE_AGENT); }
DEVFN unsigned xb_add(unsigned* p, unsigned v) { return __hip_atomic_fetch_add(p, v, __ATOMIC_RELAXED, __HIP_MEMORY_SCOPE_AGENT); }
DEVFN unsigned xb_xcc_id() { return (unsigned)__builtin_amdgcn_s_getreg((3 << 11) | 20) & 0xFu; }
#define XB_SPIN(cond, bar) do { unsigned _sp = 0; while (cond) { __builtin_amdgcn_s_sleep(1); \
    if ((++_sp & 255u) == 0u) { if (xb_ld(&(bar)[XB_TMO])) break; if (_sp > XB_SPIN_CAP) { atomicAdd(&(bar)[XB_TMO], 1u); break; } } } } while (0)
struct XcdBarrier { unsigned* bar; unsigned x; volatile LAS unsigned* st; };
DEVFN XcdBarrier xcd_barrier_post(unsigned* bar, volatile LAS unsigned* st) {
    XcdBarrier b; b.bar = bar; b.x = xb_xcc_id(); b.st = st;
    if (threadIdx.x == 0) (void)xb_add(&bar[XB_XCNT(b.x)], 1u);
    return b;
}
DEVFN void xcd_barrier_complete(unsigned* bar, unsigned x, unsigned& nloc, unsigned& nx) {
    const unsigned G = gridDim.x * gridDim.y * gridDim.z;
    unsigned sum, cnt, mine, sp = 0u;
    for (;;) {
        sum = 0u; cnt = 0u; mine = 0u;
#pragma unroll
        for (unsigned j = 0; j < 16; ++j) { const unsigned c = xb_ld(&bar[XB_XCNT(j)]); sum += c; cnt += (c > 0u) ? 1u : 0u; mine = (j == x) ? c : mine; }
        if (sum == G) break;
        __builtin_amdgcn_s_sleep(1);
        if ((++sp & 255u) == 0u) { if (xb_ld(&bar[XB_TMO])) break; if (sp > XB_SPIN_CAP) { atomicAdd(&bar[XB_TMO], 1u); break; } }
    }
    nloc = mine > 0u ? mine : 1u; nx = cnt > 0u ? cnt : 1u;
}
DEVFN void xcd_barrier(const XcdBarrier& b) {
    asm volatile("s_waitcnt vmcnt(0)" ::: "memory");
    __syncthreads();
    if (threadIdx.x == 0) {
        unsigned* bar = b.bar;
        __builtin_amdgcn_s_waitcnt(0);
        unsigned nloc = b.st[0], nx = b.st[1];
        if (nloc == 0u) { xcd_barrier_complete(bar, b.x, nloc, nx); b.st[0] = nloc; b.st[1] = nx; }
        const unsigned old = xb_add(&bar[XB_XSUB(b.x)], 1u);
        const unsigned gen = old / nloc;
        if (old + 1u == (gen + 1u) * nloc) {
            __builtin_amdgcn_fence(__ATOMIC_RELEASE, "agent");
            asm volatile("s_waitcnt vmcnt(0)" ::: "memory");
            const unsigned og = xb_add(&bar[XB_TOP], 1u);
            const unsigned tg = og / nx;
            if (og + 1u == (tg + 1u) * nx) xb_add(&bar[XB_TOPGEN], 1u);
            else XB_SPIN(xb_ld(&bar[XB_TOPGEN]) == tg, bar);
            __builtin_amdgcn_fence(__ATOMIC_ACQUIRE, "agent");
            xb_add(&bar[XB_XGEN(b.x)], 1u);
            asm volatile("s_waitcnt vmcnt(0)" ::: "memory");
        } else {
            XB_SPIN(xb_ld(&bar[XB_XGEN(b.x)]) == gen, bar);
            __builtin_amdgcn_fence(__ATOMIC_ACQUIRE, "agent");
            asm volatile("s_waitcnt vmcnt(0)" ::: "memory");
        }
    }
    __syncthreads();
}

template <class Fill>
DEVFN void xcd_barrier_fill(const XcdBarrier& b, volatile LAS unsigned* lead, bool early, Fill fill) {
    asm volatile("s_waitcnt vmcnt(0)" ::: "memory");
    __syncthreads();
    unsigned gen = 0u, nloc = 1u, nx = 1u;
    unsigned* bar = b.bar; unsigned bx = b.x;
    asm volatile("" : "+s"(bar), "+s"(bx));
    if (threadIdx.x == 0) {
        __builtin_amdgcn_s_waitcnt(0);
        nloc = b.st[0]; nx = b.st[1];
        if (nloc == 0u) { xcd_barrier_complete(bar, bx, nloc, nx); b.st[0] = nloc; b.st[1] = nx; }
        const unsigned old = xb_add(&bar[XB_XSUB(bx)], 1u);
        gen = old / nloc;
        const unsigned pos = old - gen * nloc;
        *lead = (pos + 1u == nloc) ? 1u : ((early && pos == (nloc * 3u) / 4u) ? 2u : 0u);
    }
    __syncthreads();
    const unsigned role = *lead;
    const bool leader = role == 1u;
    if (role == 2u && threadIdx.x == 0) __builtin_amdgcn_fence(__ATOMIC_RELEASE, "agent");
    if (role != 1u) fill();
    asm volatile("" : "+s"(bar), "+s"(bx));
    if (threadIdx.x == 0) {
        if (leader) {
            __builtin_amdgcn_fence(__ATOMIC_RELEASE, "agent");
            asm volatile("s_waitcnt vmcnt(0)" ::: "memory");
            const unsigned og = xb_add(&bar[XB_TOP], 1u);
            const unsigned tg = og / nx;
            if (og + 1u == (tg + 1u) * nx) {
#pragma unroll
                for (unsigned j = 0; j < 16; ++j) (void)xb_add(&bar[XB_XGEN(j)], 1u);
            } else XB_SPIN(xb_ld(&bar[XB_XGEN(bx)]) == gen, bar);
        } else {
            XB_SPIN(xb_ld(&bar[XB_XGEN(bx)]) == gen, bar);
        }
    }
    __syncthreads();
}
typedef __attribute__((ext_vector_type(8))) short bf16x8;
typedef __attribute__((ext_vector_type(16))) float f32x16;
typedef __attribute__((ext_vector_type(4))) float f32x4;

typedef unsigned nc_u4 __attribute__((ext_vector_type(4)));
DEVFN unsigned long long ldnc_q(const void* p) { return __hip_atomic_load((const unsigned long long*)p, __ATOMIC_RELAXED, __HIP_MEMORY_SCOPE_AGENT); }
DEVFN uint2 ldnc_u2(const void* p) { const unsigned long long q = ldnc_q(p); return make_uint2((unsigned)q, (unsigned)(q >> 32)); }
DEVFN uint4 ldnc_u4(const void* p) {
  const unsigned long long a = ldnc_q(p), b = ldnc_q((const char*)p + 8);
  return make_uint4((unsigned)a, (unsigned)(a >> 32), (unsigned)b, (unsigned)(b >> 32));
}
DEVFN f32x4 ldnc_f4(const float* p) { const uint4 v = ldnc_u4(p); return (f32x4){u_as_f(v.x), u_as_f(v.y), u_as_f(v.z), u_as_f(v.w)}; }
DEVFN bf16x8 ldnc_h8(const void* p) { const uint4 v = ldnc_u4(p); nc_u4 w = {v.x, v.y, v.z, v.w}; return __builtin_bit_cast(bf16x8, w); }
DEVFN void stwt_u2(void* p, uint2 v) { __hip_atomic_store((unsigned long long*)p, (unsigned long long)v.x | ((unsigned long long)v.y << 32), __ATOMIC_RELAXED, __HIP_MEMORY_SCOPE_AGENT); }
DEVFN int ldnc_i(const int* p) { return __hip_atomic_load(p, __ATOMIC_RELAXED, __HIP_MEMORY_SCOPE_AGENT); }
DEVFN float ldnc_f(const float* p) { return __hip_atomic_load(p, __ATOMIC_RELAXED, __HIP_MEMORY_SCOPE_AGENT); }

DEVFN float sigmoid_fast(float x) { return __frcp_rn(1.f + __expf(-x)); }
DEVFN float silu_fast(float x) { return x * sigmoid_fast(x); }
DEVFN float gelu_fast(float x) { float u = 0.7978845608028654f * (x + 0.044715f * x * x * x); return x * sigmoid_fast(2.f * u); }
typedef __attribute__((ext_vector_type(2))) float f32x2_t;
typedef __attribute__((ext_vector_type(2))) __bf16 bf16x2_t;
DEVFN unsigned cvtpk(float lo, float hi) { f32x2_t v = {lo, hi}; bf16x2_t b = __builtin_convertvector(v, bf16x2_t); return __builtin_bit_cast(unsigned, b); }

constexpr int G_ROWB = 144, G_TILEB = 128 * G_ROWB, G_STAGEB = 2 * G_TILEB;
constexpr int SMEM_BYTES = 2 * G_STAGEB;

struct U4x4 { uint4 a, b, c, d; };
struct F4x8 { f32x4 f0, f1, f2, f3, f4, f5, f6, f7; };
struct RowLoader {
  const bf16_t *r0, *r1, *r2, *r3;
  DEVFN U4x4 operator()(int kt) const {
    U4x4 v;
    v.a = *(const uint4*)(r0 + kt * 64); v.b = *(const uint4*)(r1 + kt * 64);
    v.c = *(const uint4*)(r2 + kt * 64); v.d = *(const uint4*)(r3 + kt * 64);
    return v;
  }
};
struct BF32Loader { const float* bp; long ldb; };

DEVFN void rl_store(char* tile, int tid, const U4x4& v) {
  char* d = tile + (tid >> 3) * G_ROWB + (tid & 7) * 16;
  *(uint4*)(d) = v.a; *(uint4*)(d + 32 * G_ROWB) = v.b; *(uint4*)(d + 64 * G_ROWB) = v.c; *(uint4*)(d + 96 * G_ROWB) = v.d;
}
DEVFN F4x8 bf_load(const BF32Loader& L, int kt) {
  F4x8 f;
  const float* b = L.bp + (long)(kt * 64) * L.ldb;
  f.f0 = *(const f32x4*)(b); f.f1 = *(const f32x4*)(b + L.ldb); f.f2 = *(const f32x4*)(b + 2 * L.ldb); f.f3 = *(const f32x4*)(b + 3 * L.ldb);
  f.f4 = *(const f32x4*)(b + 4 * L.ldb); f.f5 = *(const f32x4*)(b + 5 * L.ldb); f.f6 = *(const f32x4*)(b + 6 * L.ldb); f.f7 = *(const f32x4*)(b + 7 * L.ldb);
  return f;
}
template <int I>
DEVFN uint4 bf_pack(const F4x8& f) {
  uint4 wv;
  wv.x = cvtpk(f.f0[I], f.f1[I]); wv.y = cvtpk(f.f2[I], f.f3[I]); wv.z = cvtpk(f.f4[I], f.f5[I]); wv.w = cvtpk(f.f6[I], f.f7[I]);
  return wv;
}
DEVFN void bf_store(char* tile, int tid, const F4x8& f) {
  int lane = tid & 63, w = tid >> 6, kg = lane & 7, ng = w * 8 + (lane >> 3);
  char* d = tile + (4 * ng) * G_ROWB + kg * 16;
  *(uint4*)(d) = bf_pack<0>(f); *(uint4*)(d + G_ROWB) = bf_pack<1>(f); *(uint4*)(d + 2 * G_ROWB) = bf_pack<2>(f); *(uint4*)(d + 3 * G_ROWB) = bf_pack<3>(f);
}

DEVFN void gemm_compute(const char* st, int wm, int wn, int fro, f32x16 (&acc)[2][2]) {
  const char* sA = st + wm * 64 * G_ROWB + fro;
  const char* sB = st + G_TILEB + wn * 64 * G_ROWB + fro;
#pragma unroll
  for (int ks = 0; ks < 4; ++ks) {
    bf16x8 a0 = *(const bf16x8*)(sA + ks * 32);
    bf16x8 a1 = *(const bf16x8*)(sA + 32 * G_ROWB + ks * 32);
    bf16x8 b0 = *(const bf16x8*)(sB + ks * 32);
    bf16x8 b1 = *(const bf16x8*)(sB + 32 * G_ROWB + ks * 32);
    acc[0][0] = __builtin_amdgcn_mfma_f32_32x32x16_bf16(a0, b0, acc[0][0], 0, 0, 0);
    acc[0][1] = __builtin_amdgcn_mfma_f32_32x32x16_bf16(a0, b1, acc[0][1], 0, 0, 0);
    acc[1][0] = __builtin_amdgcn_mfma_f32_32x32x16_bf16(a1, b0, acc[1][0], 0, 0, 0);
    acc[1][1] = __builtin_amdgcn_mfma_f32_32x32x16_bf16(a1, b1, acc[1][1], 0, 0, 0);
  }
}
template <class ALd, class BLd, class Epi>
DEVFN void gemm_tile(char* smem, int tidx_, const ALd& A, const BLd& B, int KT, Epi epi) {
  const int tid = tidx_, lane = tid & 63, wave = tid >> 6, wm = wave >> 1, wn = wave & 1;
  f32x16 acc[2][2];
#pragma unroll
  for (int i = 0; i < 2; ++i)
#pragma unroll
    for (int j = 0; j < 2; ++j)
#pragma unroll
      for (int r = 0; r < 16; ++r) acc[i][j][r] = 0.f;
  const int fro = (lane & 31) * G_ROWB + (lane >> 5) * 16;
  U4x4 a0 = A(0), b0 = B(0);
  U4x4 a1 = A(1), b1 = B(1);
  rl_store(smem, tid, a0); rl_store(smem + G_TILEB, tid, b0);
  __syncthreads();
  for (int kt = 0; kt < KT; kt += 2) {
    if (kt + 2 < KT) { a0 = A(kt + 2); b0 = B(kt + 2); }
    gemm_compute(smem, wm, wn, fro, acc);
    rl_store(smem + G_STAGEB, tid, a1); rl_store(smem + G_STAGEB + G_TILEB, tid, b1);
    __syncthreads();
    if (kt + 3 < KT) { a1 = A(kt + 3); b1 = B(kt + 3); }
    gemm_compute(smem + G_STAGEB, wm, wn, fro, acc);
    if (kt + 2 < KT) { rl_store(smem, tid, a0); rl_store(smem + G_TILEB, tid, b0); }
    __syncthreads();
  }
#pragma unroll
  for (int mt = 0; mt < 2; ++mt)
#pragma unroll
    for (int q = 0; q < 4; ++q)
#pragma unroll
      for (int nt = 0; nt < 2; ++nt) {
        int row = wm * 64 + mt * 32 + 8 * q + 4 * (lane >> 5);
        int col = wn * 64 + nt * 32 + (lane & 31);
        epi(nt, row, col, acc[mt][nt][4 * q], acc[mt][nt][4 * q + 1], acc[mt][nt][4 * q + 2], acc[mt][nt][4 * q + 3]);
      }
}

template <class ALd, class BLd, class Epi>
DEVFN void gemm_tile1(char* smem, int tidx_, const ALd& A, const BLd& B, int KT, Epi epi) {
  const int tid = tidx_, lane = tid & 63, wave = tid >> 6, wm = wave >> 1, wn = wave & 1;
  f32x16 acc[2][2];
#pragma unroll
  for (int i = 0; i < 2; ++i)
#pragma unroll
    for (int j = 0; j < 2; ++j)
#pragma unroll
      for (int r = 0; r < 16; ++r) acc[i][j][r] = 0.f;
  const int fro = (lane & 31) * G_ROWB + (lane >> 5) * 16;
  U4x4 av = A(0), bv = B(0);
  rl_store(smem, tid, av); rl_store(smem + G_TILEB, tid, bv);
  __syncthreads();
  for (int kt = 0; kt < KT; ++kt) {
    const int cur = kt & 1;
    const bool more = kt + 1 < KT;
    if (more) { av = A(kt + 1); bv = B(kt + 1); }
    gemm_compute(smem + cur * G_STAGEB, wm, wn, fro, acc);
    if (more) { char* st = smem + (cur ^ 1) * G_STAGEB; rl_store(st, tid, av); rl_store(st + G_TILEB, tid, bv); }
    __syncthreads();
  }
#pragma unroll
  for (int mt = 0; mt < 2; ++mt)
#pragma unroll
    for (int q = 0; q < 4; ++q)
#pragma unroll
      for (int nt = 0; nt < 2; ++nt) {
        int row = wm * 64 + mt * 32 + 8 * q + 4 * (lane >> 5);
        int col = wn * 64 + nt * 32 + (lane & 31);
        epi(nt, row, col, acc[mt][nt][4 * q], acc[mt][nt][4 * q + 1], acc[mt][nt][4 * q + 2], acc[mt][nt][4 * q + 3]);
      }
}

constexpr int GL_TILEB = 128 * 128, GL_STAGEB = 2 * GL_TILEB;
struct GRows { const bf16_t *r0, *r1, *r2, *r3; };
DEVFN int g_chunk(int tid) { return ((tid & 7) ^ ((tid >> 4) & 7)) * 8; }
DEVFN GRows make_grows(int tid, const bf16_t* base, long row0, long ld) {
  GRows L;
  const bf16_t* b0 = base + (row0 + (tid >> 3)) * ld + g_chunk(tid);
  L.r0 = b0; L.r1 = b0 + 32 * ld; L.r2 = b0 + 64 * ld; L.r3 = b0 + 96 * ld;
  return L;
}
DEVFN void glds16_nt(const bf16_t* src, unsigned lds_dst) {
  unsigned keep;
  asm volatile("s_mov_b32 %0, m0\n\ts_mov_b32 m0, %2\n\ts_nop 0\n\tglobal_load_lds_dwordx4 %1, off nt\n\ts_mov_b32 m0, %0"
               : "=&s"(keep) : "v"(src), "s"(lds_dst));
}
DEVFN void glds16(const bf16_t* src, unsigned lds_dst) {
  unsigned keep;
  asm volatile("s_mov_b32 %0, m0\n\ts_mov_b32 m0, %2\n\ts_nop 0\n\tglobal_load_lds_dwordx4 %1, off sc1\n\ts_mov_b32 m0, %0"
               : "=&s"(keep) : "v"(src), "s"(lds_dst));
}
DEVFN unsigned lds_addr(const char* p) { return (unsigned)(unsigned long)(const __attribute__((address_space(3))) char*)p; }
DEVFN void g_stage(char* st, int wave, const GRows& A, const GRows& B, int kt) {
  const unsigned sa = (unsigned)__builtin_amdgcn_readfirstlane((int)(lds_addr(st) + wave * 1024));
  const unsigned sb = sa + GL_TILEB;
  glds16(A.r0 + kt * 64, sa); glds16(A.r1 + kt * 64, sa + 4096); glds16(A.r2 + kt * 64, sa + 8192); glds16(A.r3 + kt * 64, sa + 12288);
  glds16(B.r0 + kt * 64, sb); glds16(B.r1 + kt * 64, sb + 4096); glds16(B.r2 + kt * 64, sb + 8192); glds16(B.r3 + kt * 64, sb + 12288);
}
template <int I>
DEVFN void g_stage_part(unsigned sa, const GRows& A, const GRows& B, int kt) {
  const bf16_t* ar = I == 0 ? A.r0 : I == 1 ? A.r1 : I == 2 ? A.r2 : A.r3;
  const bf16_t* br = I == 0 ? B.r0 : I == 1 ? B.r1 : I == 2 ? B.r2 : B.r3;
  glds16(ar + kt * 64, sa + I * 4096);
  glds16(br + kt * 64, sa + GL_TILEB + I * 4096);
}
template <class Epi>
DEVFN void gemm_tile_g(char* smem, int tidx_, const GRows& A, const GRows& B, int KT, Epi epi, int koff = 0) {
  const int tid = tidx_, lane = tid & 63, wave = tid >> 6, wm = wave >> 1, wn = wave & 1;
  f32x16 acc[2][2];
#pragma unroll
  for (int i = 0; i < 2; ++i)
#pragma unroll
    for (int j = 0; j < 2; ++j)
#pragma unroll
      for (int r = 0; r < 16; ++r) acc[i][j][r] = 0.f;
  const int sw = (lane >> 1) & 7, h = lane >> 5;
  int off[4];
#pragma unroll
  for (int ks = 0; ks < 4; ++ks) off[ks] = (lane & 31) * 128 + ((((2 * ks) ^ (sw & 6)) | (h ^ (sw & 1))) * 16);
  const unsigned sbase = (unsigned)__builtin_amdgcn_readfirstlane((int)(lds_addr(smem) + wave * 1024));
  g_stage(smem, wave, A, B, koff & (KT - 1));
  asm volatile("s_waitcnt vmcnt(0)" ::: "memory");
  __syncthreads();
  for (int kt = 0; kt < KT; ++kt) {
    const int cur = kt & 1;
    const bool more = kt + 1 < KT;
    const int ktn = (kt + 1 + koff) & (KT - 1);
    const unsigned san = sbase + (cur ^ 1) * GL_STAGEB;
    const char* sA = smem + cur * GL_STAGEB + wm * 64 * 128;
    const char* sB = smem + cur * GL_STAGEB + GL_TILEB + wn * 64 * 128;
    bf16x8 fa0[2], fa1[2], fb0[2], fb1[2];
    fa0[0] = *(const bf16x8*)(sA + off[0]); fa1[0] = *(const bf16x8*)(sA + 32 * 128 + off[0]);
    fb0[0] = *(const bf16x8*)(sB + off[0]); fb1[0] = *(const bf16x8*)(sB + 32 * 128 + off[0]);
#pragma unroll
    for (int ks = 0; ks < 4; ++ks) {
      const int c = ks & 1, n = c ^ 1;
      if (ks < 3) {
        fa0[n] = *(const bf16x8*)(sA + off[ks + 1]); fa1[n] = *(const bf16x8*)(sA + 32 * 128 + off[ks + 1]);
        fb0[n] = *(const bf16x8*)(sB + off[ks + 1]); fb1[n] = *(const bf16x8*)(sB + 32 * 128 + off[ks + 1]);
      }
      __builtin_amdgcn_sched_barrier(0);
      if (more) {
        if (ks == 0) { g_stage_part<0>(san, A, B, ktn); g_stage_part<1>(san, A, B, ktn); }
        else if (ks == 1) { g_stage_part<2>(san, A, B, ktn); g_stage_part<3>(san, A, B, ktn); }
      }
      acc[0][0] = __builtin_amdgcn_mfma_f32_32x32x16_bf16(fa0[c], fb0[c], acc[0][0], 0, 0, 0);
      acc[0][1] = __builtin_amdgcn_mfma_f32_32x32x16_bf16(fa0[c], fb1[c], acc[0][1], 0, 0, 0);
      acc[1][0] = __builtin_amdgcn_mfma_f32_32x32x16_bf16(fa1[c], fb0[c], acc[1][0], 0, 0, 0);
      acc[1][1] = __builtin_amdgcn_mfma_f32_32x32x16_bf16(fa1[c], fb1[c], acc[1][1], 0, 0, 0);
      __builtin_amdgcn_sched_barrier(0);
    }
    asm volatile("s_waitcnt vmcnt(0)" ::: "memory");
    __syncthreads();
  }
#pragma unroll
  for (int mt = 0; mt < 2; ++mt)
#pragma unroll
    for (int q = 0; q < 4; ++q)
#pragma unroll
      for (int nt = 0; nt < 2; ++nt) {
        int row = wm * 64 + mt * 32 + 8 * q + 4 * (lane >> 5);
        int col = wn * 64 + nt * 32 + (lane & 31);
        epi(nt, row, col, acc[mt][nt][4 * q], acc[mt][nt][4 * q + 1], acc[mt][nt][4 * q + 2], acc[mt][nt][4 * q + 3]);
      }
}

DEVFN int xcd_order(int v, int nblocks, int grp) {
  if (nblocks != 512) return v;
  const int it = v / nblocks, b = v % nblocks;
  const int x = b & 7, slot = b >> 3, per = nblocks >> 3;
  const int q = it * per + slot;
  return ((q / grp) * 8 + x) * grp + (q % grp);
}
struct PatchTile { int tm, tn, koff; };
DEVFN PatchTile patch8(int v, int nblocks, int& pidx) {
  const int it = v / nblocks, b = v % nblocks;
  const int x = b & 7, slot = b >> 3;
  PatchTile t; t.tm = slot & 7; t.tn = slot >> 3; t.koff = (t.tm + t.tn) & 7;
  pidx = it * 8 + x;
  return t;
}
DEVFN RowLoader make_rows(int tidx_, const bf16_t* base, long row0, long ld) {
  RowLoader L; int tid = tidx_;
  const bf16_t* b0 = base + (row0 + (tid >> 3)) * ld + (tid & 7) * 8;
  L.r0 = b0; L.r1 = b0 + 32 * ld; L.r2 = b0 + 64 * ld; L.r3 = b0 + 96 * ld;
  return L;
}
DEVFN float shx1(float v) { return __builtin_bit_cast(float, __builtin_amdgcn_mov_dpp(__builtin_bit_cast(int, v), 0xB1, 0xF, 0xF, true)); }
DEVFN void store4_bf16(bf16_t* p0, long ld, bool odd, float v0, float v1, float v2, float v3) {
  bf16_t* q = odd ? p0 + ld - 1 : p0;
  const float y0 = shx1(odd ? v0 : v1), y1 = shx1(odd ? v2 : v3);
  *(unsigned*)q = cvtpk(odd ? y0 : v0, odd ? v1 : y0);
  *(unsigned*)(q + 2 * ld) = cvtpk(odd ? y1 : v2, odd ? v3 : y1);
}

DEVFN void ph_init_fast(const Params& p) {
  PHASE_BEGIN;
  const long gt = GTID, gs = GSIZE;
  for (long idx = gt; idx < (long)DEPTH * D * MIX_W; idx += gs) {
    int k = idx % MIX_W; int n = (idx / MIX_W) % D; int l = idx / ((long)MIX_W * D);
    p.woutt[idx] = f2bf(p.w_out[((long)l * MIX_W + k) * D + n]);
  }
  for (long idx = gt; idx < (long)DEPTH * S5_W * S5_W; idx += gs) {
    int k = idx % S5_W; int n = (idx / S5_W) % S5_W; int l = idx / (S5_W * S5_W);
    p.wglut[idx] = f2bf(p.s5_w_glu[((long)l * S5_W + k) * S5_W + n]);
  }
  for (long idx = gt; idx < (long)SEQ * 2 * SEQ; idx += gs) {
    int n2 = idx % (2 * SEQ), k = idx / (2 * SEQ); int n = n2 % SEQ;
    double a = 6.283185307179586476925 * (double)(((long)k * n) % SEQ) / SEQ;
    double v = (n2 < SEQ ? cos(a) : -sin(a)) / sqrt((double)SEQ);
    p.dftc[idx] = f2bf((float)v);
  }
  for (long idx = gt; idx < (long)DSEQ * 2 * DSEQ; idx += gs) {
    int n2 = idx % (2 * DSEQ), k = idx / (2 * DSEQ); int n = n2 % DSEQ;
    double a = 6.283185307179586476925 * (double)(((long)k * n) % DSEQ) / DSEQ;
    double v = (n2 < DSEQ ? cos(a) : -sin(a)) / sqrt((double)DSEQ);
    p.dftl[idx] = f2bf((float)v);
  }
  for (long idx = gt; idx < 64 * 16; idx += gs) {
    int fi = idx % 16, pos = idx / 16;
    float freq = powf(10000.f, -(float)fi / 16.f);
    float ang = (float)pos * freq;
    p.rope[idx * 2] = cosf(ang); p.rope[idx * 2 + 1] = sinf(ang);
  }
}
DEVFN void ph_init_fast2(const Params& p) {
  PHASE_BEGIN;
  const long gt = GTID, gs = GSIZE;
  for (long idx = gt; idx < (long)DEPTH * NP * D; idx += gs) {
    int k = idx % D; int n = (idx / D) % NP; int l = idx / ((long)D * NP);
    p.win2t[idx] = f2bf(p.win2[((long)l * D + k) * NP + n]);
  }
}

constexpr int CONV_EARLY = 14;
DEVFN void conv_range(const Params& p, int l, int first, int count, char* smem, int tid);
DEVFN void ph_gemm_in_fast(const Params& p, int l, char* smem) {
  PHASE_BEGIN;
  constexpr int NT_N = NP / 128, NT_M = T / 128;
  float* ropes = (float*)(smem + 2 * GL_STAGEB);
  for (int i = tidx_; i < 64 * 16 * 2 / 4; i += 256) ((f32x4*)ropes)[i] = ((const f32x4*)p.rope)[i];
  __syncthreads();
  for (int v = bidx_; v < NT_M * NT_N; v += gridDim.x) {
    const int tile = xcd_order(v, gridDim.x, 8 * NT_N);
    const int tm = tile / NT_N, tn = tile % NT_N;
    const int koff = gridDim.x == 512 ? (tm + tn) & 15 : 0;
    const int m0 = tm * 128, n0 = tn * 128;
    GRows A = make_grows(tidx_, p.h, m0, D);
    GRows B = make_grows(tidx_, p.win2t + (long)l * NP * D, n0, D);
    const TokInfo t0i = tokinfo(m0);
    const int lane = tidx_ & 63;
    const bool odd = lane & 1;
    gemm_tile_g(smem, tidx_, A, B, D / 64, [&](int nt, int row, int col, float v0, float v1, float v2, float v3) {
      const int j = n0 + col;
      const long t = m0 + row;
      const int n = t0i.n + row;
      float v[4] = {v0, v1, v2, v3};
      if (n0 >= PC_P && n0 < PC_U) {
        int jj = j - PC_P; int isq = jj >= 256; int jc = jj & 255;
        bf16_t* dst = p.pqt + pqt_base(t0i.lat, t0i.b) + (long)jc * 2 * t0i.N + (isq ? t0i.N : 0) + n;
        uint2 pk; pk.x = cvtpk(v[0], v[1]); pk.y = cvtpk(v[2], v[3]);
        *(uint2*)dst = pk;
        return;
      }
      float pr[4];
#pragma unroll
      for (int i = 0; i < 4; ++i) pr[i] = shx1(v[i]);
      if (t0i.lat && n0 < PC_V) {
        int pi = (j & 63) >> 1; int fi = pi & 15;
#pragma unroll
        for (int i = 0; i < 4; ++i) {
          int pos = (pi < 16) ? ((n + i) >> 6) : ((n + i) & 63);
          const f32x2_t csn = *(const f32x2_t*)(ropes + (pos * 16 + fi) * 2); const float cs = csn[0], sn = csn[1];
          float x1 = odd ? pr[i] : v[i], x2 = odd ? v[i] : pr[i];
          float r0 = x1 * cs - x2 * sn, r1 = x1 * sn + x2 * cs;
          v[i] = odd ? r1 : r0; pr[i] = odd ? r0 : r1;
        }
      }
      const int pj = (n0 < PC_P) ? j : PJ_U + (j - PC_U);
      {
        bf16_t* q = p.proj + (t + (odd ? 1 : 0)) * NPJ + (pj & ~1);
        *(unsigned*)q = odd ? cvtpk(pr[1], v[1]) : cvtpk(v[0], pr[0]);
        *(unsigned*)(q + 2 * NPJ) = odd ? cvtpk(pr[3], v[3]) : cvtpk(v[2], pr[2]);
      }
      if (!t0i.lat && n0 >= PC_K && n0 < PC_P) {
        float* ob = p.out + (n0 < PC_V ? O_K + (j - PC_K) : O_V + (j - PC_V));
#pragma unroll
        for (int i = 0; i < 4; ++i) ob[(((long)t0i.b * DEPTH + l) * SEQ + n + i) * KV_W] = v[i];
      }
    }, koff);
  }
}
DEVFN void ph_gemm_out_fast(const Params& p, int l, char* smem) {
  PHASE_BEGIN;
  constexpr int NT_N = D / 128, NT_M = T / 128;
  for (int v = bidx_; v < NT_M * NT_N; v += gridDim.x) {
    int tm, tn, koff = 0;
    if (gridDim.x == 512) { int pidx; PatchTile pt = patch8(v, 512, pidx); tm = pidx * 8 + pt.tm; tn = pt.tn; koff = pt.koff; }
    else { tm = v / NT_N; tn = v % NT_N; }
    const int m0 = tm * 128, n0 = tn * 128;
    GRows A = make_grows(tidx_, p.mixcat, m0, MIX_W);
    GRows B = make_grows(tidx_, p.woutt + (long)l * D * MIX_W, n0, MIX_W);
    const TokInfo t0i = tokinfo(m0);
    const float* gate1 = modp(p, l, t0i.ci, 2);
    const int lane_ = tidx_ & 63, cb = n0 + ((tidx_ >> 6) & 1) * 64 + (lane_ & 31);
    const float g0 = gate1[cb], g1 = gate1[cb + 32];
    gemm_tile_g(smem, tidx_, A, B, MIX_W / 64, [&](int nt, int row, int col, float v0, float v1, float v2, float v3) {
      const float g = nt ? g1 : g0;
      store4_bf16((bf16_t*)p.ybuf + (long)(m0 + row) * D + n0 + col, D, lane_ & 1, g * v0, g * v1, g * v2, g * v3);
    }, koff);
  }
}
DEVFN void ph_glu_fast(const Params& p, int l, char* smem) {
  PHASE_BEGIN;
  constexpr int NT_N = S5_W / 128, NT_M = T / 128;
  for (int tile = bidx_; tile < NT_M * NT_N; tile += gridDim.x) {
    const int tm = tile / NT_N, tn = tile % NT_N;
    const int m0 = tm * 128, n0 = tn * 128;
    RowLoader A = make_rows(tidx_, p.gbuf, m0, S5_W);
    RowLoader B = make_rows(tidx_, p.wglut + (long)l * S5_W * S5_W, n0, S5_W);
    const bool odd = tidx_ & 1;
    gemm_tile(smem, tidx_, A, B, S5_W / 64, [&](int nt, int row, int col, float v0, float v1, float v2, float v3) {
      const int j = n0 + col;
      float v[4] = {v0, v1, v2, v3};
#pragma unroll
      for (int i = 0; i < 4; ++i) {
        long t = m0 + row + i;
        float g = bf2f(p.gbuf[t * S5_W + j]);
        float r = g * sigmoid_f(v[i]);
        float pr = shx1(r);
        if (!odd) *(unsigned*)(p.mixcat + t * MIX_W + ATTN_W + FOUR_W + j) = cvtpk(r, pr);
      }
    });
  }
}
DEVFN void fourier_tile(const Params& p, int item, char* smem, int tidx_) {
  constexpr int NL = DB * (DSEQ / 128) * 2;
  int lat, b, tm, tn, N;
  if (item < NL) { lat = 1; N = DSEQ; tn = item & 1; tm = (item >> 1) % (DSEQ / 128); b = item / (2 * (DSEQ / 128)); }
  else { int it = item - NL; lat = 0; N = SEQ; tn = it & 1; tm = (it >> 1) % (SEQ / 128); b = it / (2 * (SEQ / 128)); }
  const int t0 = lat ? TC + b * DSEQ : b * SEQ;
  GRows A = make_grows(tidx_, lat ? p.dftl : p.dftc, tm * 128, 2 * N);
  GRows B = make_grows(tidx_, p.pqt + pqt_base(lat, b), tn * 128, 2 * N);
  const bool odd = tidx_ & 1;
  gemm_tile_g(smem, tidx_, A, B, 2 * N / 64, [&](int nt, int row, int col, float v0, float v1, float v2, float v3) {
    store4_bf16(p.mixcat + (long)(t0 + tm * 128 + row) * MIX_W + ATTN_W + tn * 128 + col, MIX_W, odd, v0, v1, v2, v3);
  });
}
constexpr int N_FOURIER_ITEMS = DB * (DSEQ / 128) * 2 + BATCH * (SEQ / 128) * 2;
DEVFN void ph_fourier_fast(const Params& p, int l, char* smem) {
  PHASE_BEGIN;
  for (int item = bidx_; item < N_FOURIER_ITEMS; item += gridDim.x) fourier_tile(p, item, smem, tidx_);
}
DEVFN void ph_moe1_fast(const Params& p, int l, char* smem) {
  PHASE_BEGIN;
  constexpr int NT_M = NS / 128, NT_N = FF / 64;
  const int tid = tidx_, lane = tid & 63;
  auto decode = [&](int v, int& tm, int& tn, int& e, int& koff) {
    koff = 0;
    if (gridDim.x == 512) { int pidx; PatchTile pt = patch8(v, 512, pidx); const int it = pidx >> 3, x = pidx & 7; e = x + 8 * (it >> 1); tm = pt.tm; tn = (it & 1) * 8 + pt.tn; koff = pt.koff; }
    else { tm = v % NT_M; tn = (v / NT_M) % NT_N; e = v / (NT_M * NT_N); }
  };
  int sn0 = 0, sn1 = 0, sn2 = 0, sn3 = 0;
  if (bidx_ < NE * NT_M * NT_N) {
    int tm, tn, e, koff; decode(bidx_, tm, tn, e, koff);
    const int* stp = p.seltok + e * NS + tm * 128 + (tid >> 3);
    sn0 = ldnc_i(stp); sn1 = ldnc_i(stp + 32); sn2 = ldnc_i(stp + 64); sn3 = ldnc_i(stp + 96);
  }
  for (int v = bidx_; v < NE * NT_M * NT_N; v += gridDim.x) {
    int tm, tn, e, koff;
    decode(v, tm, tn, e, koff);
    const int s0 = tm * 128, f0 = tn * 64;
    GRows A;
    {
      const bf16_t* hb = p.h2 + g_chunk(tid);
      A.r0 = hb + (long)sn0 * D; A.r1 = hb + (long)sn1 * D; A.r2 = hb + (long)sn2 * D; A.r3 = hb + (long)sn3 * D;
    }
    if (v + (int)gridDim.x < NE * NT_M * NT_N) {
      int tm2, tn2, e2, koff2; decode(v + gridDim.x, tm2, tn2, e2, koff2);
      const int* stp = p.seltok + e2 * NS + tm2 * 128 + (tid >> 3);
      sn0 = ldnc_i(stp); sn1 = ldnc_i(stp + 32); sn2 = ldnc_i(stp + 64); sn3 = ldnc_i(stp + 96);
    }
    GRows B;
    {
      const long o = (((long)(l & 1) * NE + e) * FF + f0 + (tid >> 3)) * D + g_chunk(tid);
      B.r0 = p.wgt + o; B.r1 = p.wut + o; B.r2 = p.wgt + o + 32L * D; B.r3 = p.wut + o + 32L * D;
    }
    const bool odd = lane & 1;
    float gsave[4];
    gemm_tile_g(smem, tidx_, A, B, D / 64, [&](int nt, int row, int col, float v0, float v1, float v2, float v3) {
      if (nt == 0) { gsave[0] = v0; gsave[1] = v1; gsave[2] = v2; gsave[3] = v3; return; }
      float v[4] = {v0, v1, v2, v3};
      const int ff = f0 + 32 * (col >> 6) + (col & 31);
      store4_bf16(p.hid + ((long)e * NS + s0 + row) * FF + ff, FF, odd, silu_fast(gsave[0]) * v[0], silu_fast(gsave[1]) * v[1],
                  silu_fast(gsave[2]) * v[2], silu_fast(gsave[3]) * v[3]);
    }, koff);
  }
}
DEVFN void ph_moe2_fast(const Params& p, int l, char* smem) {
  PHASE_BEGIN;
  constexpr int NT_M = NS / 128, NT_N = D / 128;
  const int lane = tidx_ & 63;
  for (int v = bidx_; v < NE * NT_M * NT_N; v += gridDim.x) {
    int tm, tn, e, koff = 0;
    if (gridDim.x == 512) { int pidx; PatchTile pt = patch8(v, 512, pidx); e = pidx; tm = pt.tm; tn = pt.tn; koff = pt.koff; }
    else { tm = v % NT_M; tn = (v / NT_M) % NT_N; e = v / (NT_M * NT_N); }
    const int s0 = tm * 128, n0 = tn * 128;
    GRows A = make_grows(tidx_, p.hid + (long)e * NS * FF, s0, FF);
    GRows B = make_grows(tidx_, p.wdt + ((long)(l & 1) * NE + e) * D * FF, n0, FF);
    const bool odd = lane & 1;
    gemm_tile_g(smem, tidx_, A, B, FF / 64, [&](int nt, int row, int col, float v0, float v1, float v2, float v3) {
      store4_bf16(p.ys + ((long)e * NS + s0 + row) * D + n0 + col, D, odd, v0, v1, v2, v3);
    }, koff);
  }
}
template <int CTRL> DEVFN float dppf(float v) {
  return __builtin_bit_cast(float, __builtin_amdgcn_mov_dpp(__builtin_bit_cast(int, v), CTRL, 0xF, 0xF, true));
}
DEVFN float rdlane(float v, int l) { return __builtin_bit_cast(float, __builtin_amdgcn_readlane(__builtin_bit_cast(int, v), l)); }
DEVFN float wave_sum(float v) {
  v += dppf<0xB1>(v);
  v += dppf<0x4E>(v);
  v += dppf<0x141>(v);
  v += dppf<0x140>(v);
  return (rdlane(v, 0) + rdlane(v, 16)) + (rdlane(v, 32) + rdlane(v, 48));
}
DEVFN float bflo(unsigned u) { return u_as_f(u << 16); }
DEVFN float bfhi(unsigned u) { return u_as_f(u & 0xffff0000u); }

struct RowX { f32x4 a0, a1, a2, a3; uint2 h0, h1, h2, h3; };
struct RowG { uint2 u00, u01, u02, u03, u10, u11, u12, u13, u20, u21, u22, u23, u30, u31, u32, u33; float g0, g1, g2, g3; unsigned rest; };
DEVFN void ph_row1_fast(const Params& p, int l, char* smem) {
  PHASE_BEGIN;
  const int rowblk = gridDim.x == 512 ? (bidx_ & 7) * 64 + (bidx_ >> 3) : bidx_;
  const int lane = tidx_ & 63, d0 = 4 * lane;
  float* prm = (float*)smem;
  for (int t4 = (rowblk * 4 + (tidx_ >> 6)) * 4; t4 < T; t4 += gridDim.x * 16) {
    TokInfo ti = tokinfo(t4);
    const float *pxs = p.x_sample, *pxp = p.x_prompt, *px = p.x, *pg0 = p.ln_in_g, *pb0 = p.ln_in_b, *pg2 = p.ln2_g, *pb2 = p.ln2_b;
    asm volatile("" : "+s"(pxs), "+s"(pxp), "+s"(px), "+s"(pg0), "+s"(pb0), "+s"(pg2), "+s"(pb2));
    const float* src4 = l == 0 ? (ti.lat ? pxs + (long)(t4 - TC) * D : pxp + (long)t4 * D) : px + (long)t4 * D;
    const float* g = l == 0 ? pg0 : pg2 + (long)(l - 1) * D;
    const float* b = l == 0 ? pb0 : pb2 + (long)(l - 1) * D;
    const float* gate2 = modp(p, l > 0 ? l - 1 : 0, ti.ci, 5);
    const int lm = l < DEPTH ? l : DEPTH - 1;
    const float* sh = modp(p, lm, ti.ci, 0); const float* sc = modp(p, lm, ti.ci, 1);
    int iv0 = -1, iv1 = -1, iv2 = -1, iv3 = -1;
    if (l > 0 && lane < NE) {
      const int* ip = p.inv + (long)t4 * NE + lane;
      iv0 = ldnc_i(ip); iv1 = ldnc_i(ip + NE); iv2 = ldnc_i(ip + 2 * NE); iv3 = ldnc_i(ip + 3 * NE);
    }
    __syncthreads();
    {
      const f32x4 a0 = *(const f32x4*)(g + 4 * tidx_), a1 = *(const f32x4*)(b + 4 * tidx_), a2 = *(const f32x4*)(gate2 + 4 * tidx_);
      const f32x4 a3 = *(const f32x4*)(sh + 4 * tidx_), a4 = *(const f32x4*)(sc + 4 * tidx_);
      *(f32x4*)(prm + 4 * tidx_) = a0; *(f32x4*)(prm + D + 4 * tidx_) = a1; *(f32x4*)(prm + 2 * D + 4 * tidx_) = a2;
      *(f32x4*)(prm + 3 * D + 4 * tidx_) = a3; *(f32x4*)(prm + 4 * D + 4 * tidx_) = a4;
    }
    __syncthreads();
    auto xload = [&](int k) -> RowX {
      RowX r;
      r.a0 = r.a1 = r.a2 = r.a3 = (f32x4){0.f, 0.f, 0.f, 0.f};
      r.h0 = r.h1 = r.h2 = r.h3 = make_uint2(0u, 0u);
      if (l == 0) {
        const float* s_ = src4 + (long)k * D + d0;
        r.a0 = *(const f32x4*)s_; r.a1 = *(const f32x4*)(s_ + 256); r.a2 = *(const f32x4*)(s_ + 512); r.a3 = *(const f32x4*)(s_ + 768);
      } else {
        const bf16_t* s_ = (const bf16_t*)px + (long)(t4 + k) * D + d0;
        r.h0 = ldnc_u2(s_); r.h1 = ldnc_u2(s_ + 256); r.h2 = ldnc_u2(s_ + 512); r.h3 = ldnc_u2(s_ + 768);
      }
      return r;
    };
    auto gather = [&](int myinv) -> RowG {
      RowG r;
      const uint2 z = make_uint2(0u, 0u);
      r.u00 = r.u01 = r.u02 = r.u03 = r.u10 = r.u11 = r.u12 = r.u13 = r.u20 = r.u21 = r.u22 = r.u23 = r.u30 = r.u31 = r.u32 = r.u33 = z;
      r.g0 = r.g1 = r.g2 = r.g3 = 0.f;
      unsigned mask = (unsigned)__ballot(myinv >= 0) & 0xffffu;
      if (mask) {
        const int e = __builtin_ctz(mask); mask &= mask - 1; const int s_ = __builtin_amdgcn_readlane(myinv, e);
        const bf16_t* yr = p.ys + ((long)e * NS + s_) * D + d0; r.g0 = ldnc_f(p.selgate + e * NS + s_);
        r.u00 = ldnc_u2(yr); r.u01 = ldnc_u2(yr + 256); r.u02 = ldnc_u2(yr + 512); r.u03 = ldnc_u2(yr + 768);
      }
      if (mask) {
        const int e = __builtin_ctz(mask); mask &= mask - 1; const int s_ = __builtin_amdgcn_readlane(myinv, e);
        const bf16_t* yr = p.ys + ((long)e * NS + s_) * D + d0; r.g1 = ldnc_f(p.selgate + e * NS + s_);
        r.u10 = ldnc_u2(yr); r.u11 = ldnc_u2(yr + 256); r.u12 = ldnc_u2(yr + 512); r.u13 = ldnc_u2(yr + 768);
      }
      if (mask) {
        const int e = __builtin_ctz(mask); mask &= mask - 1; const int s_ = __builtin_amdgcn_readlane(myinv, e);
        const bf16_t* yr = p.ys + ((long)e * NS + s_) * D + d0; r.g2 = ldnc_f(p.selgate + e * NS + s_);
        r.u20 = ldnc_u2(yr); r.u21 = ldnc_u2(yr + 256); r.u22 = ldnc_u2(yr + 512); r.u23 = ldnc_u2(yr + 768);
      }
      if (mask) {
        const int e = __builtin_ctz(mask); mask &= mask - 1; const int s_ = __builtin_amdgcn_readlane(myinv, e);
        const bf16_t* yr = p.ys + ((long)e * NS + s_) * D + d0; r.g3 = ldnc_f(p.selgate + e * NS + s_);
        r.u30 = ldnc_u2(yr); r.u31 = ldnc_u2(yr + 256); r.u32 = ldnc_u2(yr + 512); r.u33 = ldnc_u2(yr + 768);
      }
      r.rest = mask;
      return r;
    };
    RowX xc = xload(0);
    RowG gc; gc.rest = 0u;
    if (l > 0) gc = gather(iv0);
#pragma unroll 1
    for (int k = 0; k < 4; ++k) {
      const int t = t4 + k;
      const int ivc = k == 0 ? iv0 : k == 1 ? iv1 : k == 2 ? iv2 : iv3;
      const int ivn = k == 0 ? iv1 : k == 1 ? iv2 : iv3;
      RowX xn = xc; RowG gn = gc;
      if (k < 3) { xn = xload(k + 1); if (l > 0) gn = gather(ivn); }
      f32x4 xa[4] = {xc.a0, xc.a1, xc.a2, xc.a3};
      if (l != 0) {
        const uint2 xh[4] = {xc.h0, xc.h1, xc.h2, xc.h3};
#pragma unroll
        for (int i = 0; i < 4; ++i) xa[i] = (f32x4){bflo(xh[i].x), bfhi(xh[i].x), bflo(xh[i].y), bfhi(xh[i].y)};
      }
      float v[16];
      if (l == 0) {
#pragma unroll
        for (int i = 0; i < 4; ++i) { v[4 * i] = xa[i][0]; v[4 * i + 1] = xa[i][1]; v[4 * i + 2] = xa[i][2]; v[4 * i + 3] = xa[i][3]; }
      } else {
        float m[16];
        {
          const uint2 u0[4] = {gc.u00, gc.u01, gc.u02, gc.u03}, u1[4] = {gc.u10, gc.u11, gc.u12, gc.u13};
          const uint2 u2[4] = {gc.u20, gc.u21, gc.u22, gc.u23}, u3[4] = {gc.u30, gc.u31, gc.u32, gc.u33};
#pragma unroll
          for (int i = 0; i < 4; ++i) {
            m[4 * i] = gc.g0 * bflo(u0[i].x) + gc.g1 * bflo(u1[i].x) + gc.g2 * bflo(u2[i].x) + gc.g3 * bflo(u3[i].x);
            m[4 * i + 1] = gc.g0 * bfhi(u0[i].x) + gc.g1 * bfhi(u1[i].x) + gc.g2 * bfhi(u2[i].x) + gc.g3 * bfhi(u3[i].x);
            m[4 * i + 2] = gc.g0 * bflo(u0[i].y) + gc.g1 * bflo(u1[i].y) + gc.g2 * bflo(u2[i].y) + gc.g3 * bflo(u3[i].y);
            m[4 * i + 3] = gc.g0 * bfhi(u0[i].y) + gc.g1 * bfhi(u1[i].y) + gc.g2 * bfhi(u2[i].y) + gc.g3 * bfhi(u3[i].y);
          }
        }
        unsigned mask = gc.rest;
        while (mask) {
          const int e = __builtin_ctz(mask); mask &= mask - 1;
          const int s_ = __builtin_amdgcn_readlane(ivc, e);
          const bf16_t* yr = p.ys + ((long)e * NS + s_) * D + d0;
          const float gk = ldnc_f(p.selgate + e * NS + s_);
#pragma unroll
          for (int i = 0; i < 4; ++i) {
            const uint2 u = ldnc_u2(yr + 256 * i);
            m[4 * i] += gk * bflo(u.x); m[4 * i + 1] += gk * bfhi(u.x); m[4 * i + 2] += gk * bflo(u.y); m[4 * i + 3] += gk * bfhi(u.y);
          }
        }
#pragma unroll
        for (int i = 0; i < 4; ++i) {
          const f32x4 g2 = *(const f32x4*)(prm + 2 * D + 256 * i + d0);
#pragma unroll
          for (int c = 0; c < 4; ++c) v[4 * i + c] = ALPHA * xa[i][c] + g2[c] * m[4 * i + c];
        }
      }
      float s = 0.f;
#pragma unroll
      for (int i = 0; i < 16; ++i) s += v[i];
      const float mu = wave_sum(s) * (1.f / D);
      float q = 0.f;
#pragma unroll
      for (int i = 0; i < 16; ++i) { float dv = v[i] - mu; q += dv * dv; }
      const float rs = 1.f / sqrtf(wave_sum(q) * (1.f / D) + LN_EPS);
      if (l < DEPTH) {
#pragma unroll
        for (int i = 0; i < 4; ++i) {
          f32x4 xo; float hv[4];
          const f32x4 lg = *(const f32x4*)(prm + 256 * i + d0), lb = *(const f32x4*)(prm + D + 256 * i + d0);
          const f32x4 ls = *(const f32x4*)(prm + 3 * D + 256 * i + d0), lc = *(const f32x4*)(prm + 4 * D + 256 * i + d0);
#pragma unroll
          for (int c = 0; c < 4; ++c) { xo[c] = (v[4 * i + c] - mu) * rs * lg[c] + lb[c]; hv[c] = xo[c] * (1.f + lc[c]) + ls[c]; }
          { uint2 xk; xk.x = cvtpk(xo[0], xo[1]); xk.y = cvtpk(xo[2], xo[3]); stwt_u2((bf16_t*)p.x + (long)t * D + 256 * i + d0, xk); }
          uint2 pk; pk.x = cvtpk(hv[0], hv[1]); pk.y = cvtpk(hv[2], hv[3]);
          stwt_u2(p.h + (long)t * D + 256 * i + d0, pk);
        }
      } else {
        float* o = p.out + (ti.lat ? O_YS + (long)(t - TC) * D : O_YP + (long)t * D);
#pragma unroll
        for (int i = 0; i < 4; ++i) {
          f32x4 xo;
          const f32x4 lg = *(const f32x4*)(prm + 256 * i + d0), lb = *(const f32x4*)(prm + D + 256 * i + d0);
#pragma unroll
          for (int c = 0; c < 4; ++c) xo[c] = (v[4 * i + c] - mu) * rs * lg[c] + lb[c];
          *(f32x4*)(o + 256 * i + d0) = xo;
        }
      }
      xc = xn; gc = gn;
    }
  }
}

DEVFN void ph_row2_fast(const Params& p, int l, char* smem) {
  PHASE_BEGIN;
  const int rowblk = gridDim.x == 512 ? (bidx_ & 7) * 64 + (bidx_ >> 3) : bidx_;
  const int lane = tidx_ & 63;
  float* wrt = (float*)smem;
#pragma unroll
  for (int q = tidx_; q < D * NE / 4; q += 256) {
    f32x4 v = *(const f32x4*)(p.w_router + (long)l * D * NE + q * 4);
    const int d = q >> 2, e4 = (q & 3) * 4;
    wrt[(e4 + 0) * D + d] = v[0]; wrt[(e4 + 1) * D + d] = v[1]; wrt[(e4 + 2) * D + d] = v[2]; wrt[(e4 + 3) * D + d] = v[3];
  }
  __syncthreads();
  for (int t4 = (rowblk * 4 + (tidx_ >> 6)) * 4; t4 < T; t4 += gridDim.x * 16) {
    TokInfo ti = tokinfo(t4);
    const float* g = p.ln1_g + (long)l * D; const float* b = p.ln1_b + (long)l * D;
    const float* sh = modp(p, l, ti.ci, 3); const float* sc = modp(p, l, ti.ci, 4);
    uint2 ya[4], xa[4]; f32x4 lg[4], lb[4], ls[4], lc[4];
#pragma unroll
    for (int i = 0; i < 4; ++i) {
      const int dd = 256 * i + 4 * lane;
      ya[i] = ldnc_u2((const bf16_t*)p.ybuf + (long)t4 * D + dd); xa[i] = ldnc_u2((const bf16_t*)p.x + (long)t4 * D + dd);
      lg[i] = *(const f32x4*)(g + dd); lb[i] = *(const f32x4*)(b + dd); ls[i] = *(const f32x4*)(sh + dd); lc[i] = *(const f32x4*)(sc + dd);
    }
#pragma unroll 1
   for (int k = 0; k < 4; ++k) {
    const int t = t4 + k;
    uint2 yn[4], xn[4];
#pragma unroll
    for (int i = 0; i < 4; ++i) { yn[i] = ya[i]; xn[i] = xa[i]; }
    if (k < 3) {
#pragma unroll
      for (int i = 0; i < 4; ++i) {
        const int dd = 256 * i + 4 * lane;
        yn[i] = ldnc_u2((const bf16_t*)p.ybuf + (long)(t + 1) * D + dd); xn[i] = ldnc_u2((const bf16_t*)p.x + (long)(t + 1) * D + dd);
      }
    }
    float v[16];
#pragma unroll
    for (int i = 0; i < 4; ++i) {
      v[4 * i] = ALPHA * bflo(xa[i].x) + bflo(ya[i].x); v[4 * i + 1] = ALPHA * bfhi(xa[i].x) + bfhi(ya[i].x);
      v[4 * i + 2] = ALPHA * bflo(xa[i].y) + bflo(ya[i].y); v[4 * i + 3] = ALPHA * bfhi(xa[i].y) + bfhi(ya[i].y);
    }
    float s = 0.f;
#pragma unroll
    for (int i = 0; i < 16; ++i) s += v[i];
    const float mu = wave_sum(s) * (1.f / D);
    float q = 0.f;
#pragma unroll
    for (int i = 0; i < 16; ++i) { float dv = v[i] - mu; q += dv * dv; }
    const float rs = 1.f / sqrtf(wave_sum(q) * (1.f / D) + LN_EPS);
    float lgt[NE];
#pragma unroll
    for (int e = 0; e < NE; ++e) lgt[e] = 0.f;
#pragma unroll
    for (int i = 0; i < 4; ++i) {
      const int d0 = 256 * i + 4 * lane;
      f32x4 xo; float hv[4];
#pragma unroll
      for (int c = 0; c < 4; ++c) { xo[c] = (v[4 * i + c] - mu) * rs * lg[i][c] + lb[i][c]; hv[c] = xo[c] * (1.f + lc[i][c]) + ls[i][c]; }
      { uint2 xk; xk.x = cvtpk(xo[0], xo[1]); xk.y = cvtpk(xo[2], xo[3]); stwt_u2((bf16_t*)p.x + (long)t * D + d0, xk); }
      uint2 pk; pk.x = cvtpk(hv[0], hv[1]); pk.y = cvtpk(hv[2], hv[3]);
      stwt_u2(p.h2 + (long)t * D + d0, pk);
#pragma unroll
      for (int e = 0; e < NE; ++e) {
        f32x4 w = *(const f32x4*)(wrt + e * D + d0);
        lgt[e] += hv[0] * w[0] + hv[1] * w[1] + hv[2] * w[2] + hv[3] * w[3];
      }
      asm volatile("" ::: "memory");
    }
#pragma unroll
    for (int e = 0; e < NE; ++e) lgt[e] = wave_sum(lgt[e]);
    float mx = lgt[0];
#pragma unroll
    for (int e = 1; e < NE; ++e) mx = fmaxf(mx, lgt[e]);
    float se = 0.f;
#pragma unroll
    for (int e = 0; e < NE; ++e) { lgt[e] = expf(lgt[e] - mx); se += lgt[e]; }
    const float is = 1.f / se;
    float mine = 0.f;
#pragma unroll
    for (int e = 0; e < NE; ++e) mine = (lane == e) ? lgt[e] * is : mine;
    if (lane < NE) p.afft[(long)lane * T + t] = mine;
#pragma unroll
    for (int i = 0; i < 4; ++i) { ya[i] = yn[i]; xa[i] = xn[i]; }
   }
  }
  __syncthreads();
}

DEVFN void ph_topk_fast(const Params& p, int l, char* smem) {
  PHASE_BEGIN;
  float* vals = (float*)smem;
  constexpr int NITEM = BATCH * NE * (SEQ / 256) + DB * NE * (DSEQ / 256);
  for (int item = bidx_; item < NITEM; item += gridDim.x) {
    int lat, b, e, chunk, N;
    if (item < BATCH * NE * (SEQ / 256)) { lat = 0; N = SEQ; e = item % NE; chunk = (item / NE) % (SEQ / 256); b = item / (NE * (SEQ / 256)); }
    else { int it = item - BATCH * NE * (SEQ / 256); lat = 1; N = DSEQ; e = it % NE; chunk = (it / NE) % (DSEQ / 256); b = it / (NE * (DSEQ / 256)); }
    const int t0 = lat ? TC + b * DSEQ : b * SEQ;
    {
      const float* src = p.afft + (long)e * T + t0 + tidx_;
      if (lat) {
        const float a0 = ldnc_f(src), a1 = ldnc_f(src + 256), a2 = ldnc_f(src + 512), a3 = ldnc_f(src + 768);
        vals[tidx_] = a0; vals[tidx_ + 256] = a1; vals[tidx_ + 512] = a2; vals[tidx_ + 768] = a3;
      } else {
        vals[tidx_] = ldnc_f(src);
      }
    }
    __syncthreads();
    const int n = chunk * 256 + tidx_;
    const float a = vals[n];
    const int w16 = __builtin_amdgcn_readfirstlane((chunk * 256 + (tidx_ & 192)) >> 4);
    int rank = 0;
    for (int j16 = 0; j16 < w16; ++j16) {
      f32x4 vv[4];
#pragma unroll
      for (int q = 0; q < 4; ++q) vv[q] = ((const f32x4*)vals)[4 * j16 + q];
#pragma unroll
      for (int q = 0; q < 4; ++q)
#pragma unroll
        for (int c = 0; c < 4; ++c) rank += (int)(vv[q][c] >= a);
    }
#pragma unroll
    for (int j16 = 0; j16 < 4; ++j16) {
      f32x4 vv[4];
#pragma unroll
      for (int q = 0; q < 4; ++q) vv[q] = ((const f32x4*)vals)[4 * (w16 + j16) + q];
#pragma unroll
      for (int q = 0; q < 4; ++q)
#pragma unroll
        for (int c = 0; c < 4; ++c) {
          const int jl = 16 * j16 + 4 * q + c;
          rank += (int)(vv[q][c] > a) | ((int)(vv[q][c] == a) & (int)(jl < (tidx_ & 63)));
        }
    }
    for (int j16 = w16 + 4; j16 < N / 16; ++j16) {
      f32x4 vv[4];
#pragma unroll
      for (int q = 0; q < 4; ++q) vv[q] = ((const f32x4*)vals)[4 * j16 + q];
#pragma unroll
      for (int q = 0; q < 4; ++q)
#pragma unroll
        for (int c = 0; c < 4; ++c) rank += (int)(vv[q][c] > a);
    }
    const int cap = lat ? CAPL : CAPC;
    int slot = -1;
    if (rank < cap) {
      slot = lat ? BATCH * CAPC + b * CAPL + rank : b * CAPC + rank;
      p.seltok[e * NS + slot] = t0 + n;
      p.selgate[e * NS + slot] = a;
    }
    p.inv[(long)(t0 + n) * NE + e] = slot;
    __syncthreads();
  }
}

constexpr int ADA_KC = 16, ADA_ROWS = D / ADA_KC;
DEVFN void ph_adaln_part(const Params& p, char* smem) {
  PHASE_BEGIN;
  float* sil = (float*)smem;
  constexpr int NJG = 6 * D / 4 / 256;
  constexpr int NITEM = DEPTH * NJG * ADA_KC;
  if (bidx_ < NITEM) {
#pragma unroll
    for (int i = tidx_; i < NCOND * D; i += 256) {
      int c = i / D, d = i % D;
      sil[i] = silu_f(c == 0 ? p.c_ctx[d] : p.c[(c - 1) * D + d]);
    }
    __syncthreads();
  }
  for (int item = bidx_; item < NITEM; item += gridDim.x) {
    const int kc = item % ADA_KC, jb = (item / ADA_KC) % NJG, l = item / (ADA_KC * NJG);
    const int j0 = (jb * 256 + tidx_) * 4;
    const float* w = p.w_ada + ((long)l * D + kc * ADA_ROWS) * 6 * D + j0;
    f32x4 acc[NCOND];
#pragma unroll
    for (int c = 0; c < NCOND; ++c) acc[c] = (f32x4){0.f, 0.f, 0.f, 0.f};
#pragma unroll 16
    for (int r = 0; r < ADA_ROWS; ++r) {
      f32x4 wv = __builtin_nontemporal_load((const f32x4*)(w + (long)r * 6 * D));
#pragma unroll
      for (int c = 0; c < NCOND; ++c) { float sv = sil[c * D + kc * ADA_ROWS + r]; acc[c] += sv * wv; }
    }
#pragma unroll
    for (int c = 0; c < NCOND; ++c) *(f32x4*)(p.modpart + (((long)kc * DEPTH + l) * NCOND + c) * 6 * D + j0) = acc[c];
  }
  __syncthreads();
}
DEVFN void ph_adaln_reduce(const Params& p) {
  PHASE_BEGIN;
  for (long idx = GTID; idx < (long)DEPTH * NCOND * 6 * D; idx += GSIZE) {
    int j = idx % (6 * D); int l = idx / ((long)NCOND * 6 * D);
    float s = p.b_ada[(long)l * 6 * D + j];
#pragma unroll
    for (int kc = 0; kc < ADA_KC; ++kc) s += p.modpart[(long)kc * DEPTH * NCOND * 6 * D + idx];
    p.mod[idx] = s;
  }
}
DEVFN void transpose_tile(const float* src, long ld_src, bf16_t* dst, long ld_dst, int k0, int n0, float* tl, int tid) {
#pragma unroll
  for (int i = 0; i < 4; ++i) {
    const int r = (tid >> 4) + 16 * i, c4 = (tid & 15) * 4;
    f32x4 v = *(const f32x4*)(src + (long)(k0 + r) * ld_src + n0 + c4);
    tl[r * 65 + c4] = v[0]; tl[r * 65 + c4 + 1] = v[1]; tl[r * 65 + c4 + 2] = v[2]; tl[r * 65 + c4 + 3] = v[3];
  }
  __syncthreads();
#pragma unroll
  for (int i = 0; i < 2; ++i) {
    const int n = (tid >> 3) + 32 * i, kc = (tid & 7) * 8;
    uint4 w;
    w.x = cvtpk(tl[(kc + 0) * 65 + n], tl[(kc + 1) * 65 + n]); w.y = cvtpk(tl[(kc + 2) * 65 + n], tl[(kc + 3) * 65 + n]);
    w.z = cvtpk(tl[(kc + 4) * 65 + n], tl[(kc + 5) * 65 + n]); w.w = cvtpk(tl[(kc + 6) * 65 + n], tl[(kc + 7) * 65 + n]);
    *(uint4*)(dst + (long)(n0 + n) * ld_dst + k0 + kc) = w;
  }
  __syncthreads();
}
constexpr int TR_WOUT = DEPTH * (MIX_W / 64) * (D / 64);
constexpr int TR_WIN = DEPTH * (D / 64) * 16;
constexpr int TR_WGLU = DEPTH * (S5_W / 64) * (S5_W / 64);
DEVFN void ph_init_tr(const Params& p, char* smem) {
  PHASE_BEGIN;
  float* tl = (float*)smem;
  for (int item = bidx_; item < TR_WOUT + TR_WIN + TR_WGLU; item += gridDim.x) {
    if (item < TR_WOUT) {
      const int nt = item % (D / 64), kt = (item / (D / 64)) % (MIX_W / 64), l = item / ((D / 64) * (MIX_W / 64));
      transpose_tile(p.w_out + (long)l * MIX_W * D, D, p.woutt + (long)l * D * MIX_W, MIX_W, kt * 64, nt * 64, tl, tidx_);
    } else if (item < TR_WOUT + TR_WIN) {
      const int it = item - TR_WOUT;
      const int ct = it % 16, kt = (it / 16) % (D / 64), l = it / (16 * (D / 64));
      const int nsrc = ct < 12 ? ct * 64 : 1024 + (ct - 12) * 64;
      const int ndst = ct < 12 ? ct * 64 : PC_U + (ct - 12) * 64;
      transpose_tile(p.w_in + (long)l * D * IN_W + nsrc, IN_W, p.win2t + ((long)l * NP + ndst) * D, D, kt * 64, 0, tl, tidx_);
    } else {
      const int it = item - TR_WOUT - TR_WIN;
      const int nt = it % (S5_W / 64), kt = (it / (S5_W / 64)) % (S5_W / 64), l = it / ((S5_W / 64) * (S5_W / 64));
      transpose_tile(p.s5_w_glu + (long)l * S5_W * S5_W, S5_W, p.wglut + (long)l * S5_W * S5_W, S5_W, kt * 64, nt * 64, tl, tidx_);
    }
  }
}
DEVFN void ph_init_tab(const Params& p, char* smem) {
  PHASE_BEGIN;
  float* tab = (float*)smem;
  const long gt = GTID, gs = GSIZE;
  for (int j = tidx_; j < DSEQ; j += 256) {
    float s, c;
    sincosf(6.283185307179586f * (float)j / (float)DSEQ, &s, &c);
    tab[2 * j] = c; tab[2 * j + 1] = s;
  }
  __syncthreads();
  const float isl = 1.f / sqrtf((float)DSEQ), isc = 1.f / sqrtf((float)SEQ);
  for (long idx = gt; idx < (long)DSEQ * 2 * DSEQ; idx += gs) {
    const int n2 = idx % (2 * DSEQ), k = idx / (2 * DSEQ), n = n2 % DSEQ;
    const int j = (k * n) & (DSEQ - 1);
    p.dftl[idx] = f2bf((n2 < DSEQ ? tab[2 * j] : -tab[2 * j + 1]) * isl);
  }
  for (long idx = gt; idx < (long)SEQ * 2 * SEQ; idx += gs) {
    const int n2 = idx % (2 * SEQ), k = idx / (2 * SEQ), n = n2 % SEQ;
    const int j = ((k * n) & (SEQ - 1)) * (DSEQ / SEQ);
    p.dftc[idx] = f2bf((n2 < SEQ ? tab[2 * j] : -tab[2 * j + 1]) * isc);
  }
  for (long idx = gt; idx < (long)DEPTH * 256 * 256; idx += gs) {
    const int i = idx % 256, j = (idx / 256) % 256, l = idx / (256 * 256);
    const int hd = i >> 6, c = i & 63;
    const float* wf = p.w_fourier + ((long)l * 256 + hd * 64) * 256 + j;
    float w[64];
#pragma unroll
    for (int m = 0; m < 64; ++m) w[m] = wf[(long)m * 256];
    float ac = 0.f, as = 0.f;
#pragma unroll
    for (int m = 0; m < 64; ++m) {
      const f32x2_t cs = *(const f32x2_t*)(tab + 2 * (((m * c) & 63) * (DSEQ / 64)));
      ac += cs[0] * w[m]; as += cs[1] * w[m];
    }
    p.wcst[((long)l * 512 + j) * 256 + i] = f2bf(ac * 0.125f);
    p.wcst[((long)l * 512 + 256 + j) * 256 + i] = f2bf(as * 0.125f);
  }
  for (long idx = gs - 1 - gt - (long)DEPTH * 2 * SG * SP; idx >= 0 && idx < 64 * 16; idx += gs) {
    int fi = idx % 16, pos = idx / 16;
    float freq = powf(10000.f, -(float)fi / 16.f);
    float ang = (float)pos * freq;
    p.rope[idx * 2] = cosf(ang); p.rope[idx * 2 + 1] = sinf(ang);
  }
  for (long idx = gs - 1 - gt; idx < (long)DEPTH * 2 * SG * SP; idx += gs) {
    int pp = idx % SP; int g = (idx / SP) % SG; long ld = idx / (SP * SG);
    double are = p.s5_a_re[idx], aim = p.s5_a_im[idx];
    double dt = exp((double)p.s5_log_dt[ld * SG + g]);
    double er = exp(are * dt), cr = er * cos(aim * dt), ci = er * sin(aim * dt);
    p.abar[idx * 2] = (float)cr; p.abar[idx * 2 + 1] = (float)ci;
    double nr = cr - 1.0, ni = ci, den = are * are + aim * aim;
    double fr = (nr * are + ni * aim) / den, fi = (ni * are - nr * aim) / den;
    for (int h = 0; h < SH; ++h) {
      double br = p.s5_b_re[idx * SH + h], bi = p.s5_b_im[idx * SH + h];
      p.bbn[((ld * SG + g) * 128 + 2 * pp) * 16 + h] = f2bf((float)(fr * br - fi * bi));
      p.bbn[((ld * SG + g) * 128 + 2 * pp + 1) * 16 + h] = f2bf((float)(fr * bi + fi * br));
    }
  }
  for (long idx = gt; idx < (long)DEPTH * 2 * SG * SH * 128; idx += gs) {
    int k = idx % 128; long row = idx / 128;
    p.cn[idx] = f2bf((k & 1) ? -p.s5_c_im[row * SP + (k >> 1)] : p.s5_c_re[row * SP + (k >> 1)]);
  }
}
struct RowLoaderF32 {
  const float *r0, *r1, *r2, *r3;
  DEVFN uint4 one(const float* r, int kt) const {
    f32x4 a = *(const f32x4*)(r + kt * 64), b = *(const f32x4*)(r + kt * 64 + 4);
    uint4 w; w.x = cvtpk(a[0], a[1]); w.y = cvtpk(a[2], a[3]); w.z = cvtpk(b[0], b[1]); w.w = cvtpk(b[2], b[3]);
    return w;
  }
  DEVFN U4x4 operator()(int kt) const { U4x4 v; v.a = one(r0, kt); v.b = one(r1, kt); v.c = one(r2, kt); v.d = one(r3, kt); return v; }
};
DEVFN void ph_init_fold(const Params& p, char* smem) {
  PHASE_BEGIN;
  constexpr int NT_M = 512 / 128, NT_N = D / 128;
  for (int tile = bidx_; tile < DEPTH * NT_M * NT_N; tile += gridDim.x) {
    const int tn = tile % NT_N, tm = (tile / NT_N) % NT_M, l = tile / (NT_N * NT_M);
    RowLoader A = make_rows(tidx_, p.wcst + (long)l * 512 * 256, tm * 128, 256);
    RowLoaderF32 B;
    {
      const float* b0 = p.w_in + ((long)l * D + tn * 128 + (tidx_ >> 3)) * IN_W + 768 + (tidx_ & 7) * 8;
      B.r0 = b0; B.r1 = b0 + 32L * IN_W; B.r2 = b0 + 64L * IN_W; B.r3 = b0 + 96L * IN_W;
    }
    const bool odd = tidx_ & 1;
    bf16_t* dst = p.win2t + ((long)l * NP + PC_P + tm * 128) * D + tn * 128;
    gemm_tile1(smem, tidx_, A, B, 256 / 64, [&](int nt, int row, int col, float v0, float v1, float v2, float v3) {
      float v[4] = {v0, v1, v2, v3};
#pragma unroll
      for (int i = 0; i < 4; ++i) {
        float pr = shx1(v[i]);
        if (!odd) *(unsigned*)(dst + (long)(row + i) * D + col) = cvtpk(v[i], pr);
      }
    });
  }
}

constexpr int TR_EXP = NE * 3 * (D / 64) * (FF / 64);
struct ConvTile { const float* src; bf16_t* dst; };
DEVFN ConvTile conv_tile(const Params& p, int l, int item) {
  const int nt = item % 16, kt = (item / 16) % 16, m = (item / 256) % 3, e = item / 768;
  ConvTile c;
  const float* sb = (m == 0 ? p.w_gate : m == 1 ? p.w_up : p.w_down) + ((long)l * NE + e) * D * FF;
  bf16_t* db = (m == 0 ? p.wgt : m == 1 ? p.wut : p.wdt) + ((long)(l & 1) * NE + e) * FF * D;
  c.src = sb + (long)(kt * 64) * FF + nt * 64;
  c.dst = db + (long)(nt * 64) * D + kt * 64;
  return c;
}
DEVFN void conv_range(const Params& p, int l, int first, int count, char* smem, int tid) {
  static_assert(D == FF, "expert matrices assumed square");
  float* tl = (float*)smem;
  const int lr = tid >> 4, lc = (tid & 15) * 4;
  int item = first; const int end = first + count;
  f32x4 v0, v1, v2, v3;
  ConvTile c = conv_tile(p, l, item);
  {
    const float* s = c.src + (long)lr * FF + lc;
    v0 = *(const f32x4*)s; v1 = *(const f32x4*)(s + 16L * FF); v2 = *(const f32x4*)(s + 32L * FF); v3 = *(const f32x4*)(s + 48L * FF);
  }
  while (item < end) {
    float* t0 = tl + lr * 65 + lc;
    t0[0] = v0[0]; t0[1] = v0[1]; t0[2] = v0[2]; t0[3] = v0[3];
    t0[16 * 65] = v1[0]; t0[16 * 65 + 1] = v1[1]; t0[16 * 65 + 2] = v1[2]; t0[16 * 65 + 3] = v1[3];
    t0[32 * 65] = v2[0]; t0[32 * 65 + 1] = v2[1]; t0[32 * 65 + 2] = v2[2]; t0[32 * 65 + 3] = v2[3];
    t0[48 * 65] = v3[0]; t0[48 * 65 + 1] = v3[1]; t0[48 * 65 + 2] = v3[2]; t0[48 * 65 + 3] = v3[3];
    __syncthreads();
    bf16_t* dst = c.dst;
    const int nxt = item + 1;
    if (nxt < end) {
      c = conv_tile(p, l, nxt);
      const float* s = c.src + (long)lr * FF + lc;
      v0 = *(const f32x4*)s; v1 = *(const f32x4*)(s + 16L * FF); v2 = *(const f32x4*)(s + 32L * FF); v3 = *(const f32x4*)(s + 48L * FF);
    }
#pragma unroll
    for (int i = 0; i < 2; ++i) {
      const int n = (tid >> 3) + 32 * i, kc = (tid & 7) * 8;
      uint4 w;
      w.x = cvtpk(tl[(kc + 0) * 65 + n], tl[(kc + 1) * 65 + n]); w.y = cvtpk(tl[(kc + 2) * 65 + n], tl[(kc + 3) * 65 + n]);
      w.z = cvtpk(tl[(kc + 4) * 65 + n], tl[(kc + 5) * 65 + n]); w.w = cvtpk(tl[(kc + 6) * 65 + n], tl[(kc + 7) * 65 + n]);
      *(uint4*)(dst + (long)n * D + kc) = w;
    }
    __syncthreads();
    item = nxt;
  }
}

DEVFN void conv_wait(int n) {
  switch (n) {
    case 0:  asm volatile("s_waitcnt vmcnt(0) lgkmcnt(0)\n\ts_barrier" ::: "memory"); break;
    case 4:  asm volatile("s_waitcnt vmcnt(4) lgkmcnt(0)\n\ts_barrier" ::: "memory"); break;
    case 8:  asm volatile("s_waitcnt vmcnt(8) lgkmcnt(0)\n\ts_barrier" ::: "memory"); break;
    case 12: asm volatile("s_waitcnt vmcnt(12) lgkmcnt(0)\n\ts_barrier" ::: "memory"); break;
    case 16: asm volatile("s_waitcnt vmcnt(16) lgkmcnt(0)\n\ts_barrier" ::: "memory"); break;
    default: asm volatile("s_waitcnt vmcnt(20) lgkmcnt(0)\n\ts_barrier" ::: "memory"); break;
  }
}
DEVFN void conv_issue(const Params& p, int l, int item, unsigned lds_ws, int lane, int wave) {
  ConvTile c = conv_tile(p, l, item);
#pragma unroll
  for (int i = 0; i < 4; ++i) {
    const int k = 16 * wave + 4 * i + (lane >> 4);
    const int chunk = ((lane & 15) - (4 * wave + i)) & 15;
    glds16_nt((const bf16_t*)(c.src + (long)k * FF + chunk * 4), lds_ws + i * 1024);
  }
}
template <int MODE>
DEVFN void conv_ring(const Params& p, int l, int first, int count, char* smem, int tid) {
  constexpr int LPT = MODE == 2 ? 0 : 4, SPT = MODE == 1 ? 0 : 4;
  const int lane = tid & 63, wave = tid >> 6;
  const int kq = tid & 15, nq = tid >> 4;
  const unsigned lbase = (unsigned)__builtin_amdgcn_readfirstlane((int)(lds_addr(smem) + wave * 4096));
  __syncthreads();
  if (LPT) for (int s = 0; s < 3 && s < count; ++s) conv_issue(p, l, first + s, lbase + s * 16384, lane, wave);
  for (int t = 0; t < count; ++t) {
    const int st = t < 3 ? t : 3;
    int ld = count - 1 - t; if (ld > 2) ld = 2;
    conv_wait(SPT * st + LPT * ld);
    if (LPT && t + 3 < count) conv_issue(p, l, first + t + 3, lbase + ((t + 3) & 3) * 16384, lane, wave);
    const char* sl = smem + (t & 3) * 16384 + (4 * kq) * 256 + ((nq + kq) & 15) * 16;
    f32x4 v0 = *(const f32x4*)sl, v1 = *(const f32x4*)(sl + 256), v2 = *(const f32x4*)(sl + 512), v3 = *(const f32x4*)(sl + 768);
    bf16_t* d = conv_tile(p, l, first + t).dst + (long)(4 * nq) * D + 4 * kq;
#pragma unroll
    for (int i = 0; i < 4; ++i) {
      uint2 w; w.x = cvtpk(v0[i], v1[i]); w.y = cvtpk(v2[i], v3[i]);
      if (SPT) stwt_u2(d + (long)i * D, w);
    }
  }
}

struct ConvOwn { int per, first, cnt; };
DEVFN ConvOwn conv_own(int bidx) {
  ConvOwn o;
  const int nb = gridDim.x;
  if (nb == 512) {
    const bool up = bidx >= 256;
    o.per = up ? 32 : 16; o.first = up ? 256 * 16 + (bidx - 256) * 32 : bidx * 16; o.cnt = o.per;
  } else {
    o.per = (TR_EXP + nb - 1) / nb; o.first = bidx * o.per;
    int c = TR_EXP - o.first; o.cnt = c > o.per ? o.per : (c < 0 ? 0 : c);
  }
  return o;
}
DEVFN void conv_span(const Params& p, int L, const ConvOwn& o, int idx, int n, char* smem, int tid) {
  int nv = o.cnt - idx; if (nv > n) nv = n;
  if (nv > 0) conv_ring<0>(p, L, o.first + idx, nv, smem, tid);
}
DEVFN void conv_fill(const Params& p, int l, int ph, int& cdone, char* smem, int tid, int bidx) {
  const ConvOwn o = conv_own(bidx);
  const int L = cdone / o.per;
  if (L > l + 1 || L >= DEPTH) return;
  const int idx = cdone - L * o.per;
  const bool up = gridDim.x == 512 && bidx >= 256;
  const int fill = ph == 1 ? (up ? 10 : 2) : ph == 3 ? (up ? 8 : 2) : 2;
  int n = o.per - idx; if (n > fill) n = fill;
  conv_span(p, L, o, idx, n, smem, tid);
  cdone += n;
}
DEVFN void ph_conv_catchup(const Params& p, int l, int& cdone, char* smem) {
  PHASE_BEGIN;
  const ConvOwn o = conv_own(bidx_);
  const int target = (l + 1) * o.per;
  if (cdone < target) {
    const int idx = cdone - l * o.per;
    conv_span(p, l, o, idx, o.per - idx, smem, tidx_);
    cdone = target;
  }
}
constexpr int S5_SROW = 288;
constexpr int N_S5_LAT = DB * SG * 2 / 2, N_S5_CTX = BATCH * SG * 2 / 4;
template <int DIR, int CH>
DEVFN void s5_wave(const Params& p, int l, int lat, int u, char* wl, int lane) {
  constexpr int BU_BYTES = CH * 128 * 4;
  const int g = (u >> 1) % SG, b = u / (2 * SG);
  const int N = lat ? DSEQ : SEQ, t0 = lat ? TC + b * DSEQ : b * SEQ, nch = N / CH;
  float* BU = (float*)wl;
  char* SS = wl + BU_BYTES;
  const long pidx = (((long)l * 2 + DIR) * SG + g);
  const float ar = p.abar[(pidx * SP + lane) * 2], ai = p.abar[(pidx * SP + lane) * 2 + 1];
  const float nai = -ai;
  float sr = 0.f, si = 0.f;
  if (lat) { long si0 = ((((long)b * DEPTH + l) * 2 + DIR) * SG + g) * SP + lane; sr = p.st_re[si0]; si = p.st_im[si0]; }
  bf16x8 bfr[4], cfr[4];
#pragma unroll
  for (int nt = 0; nt < 4; ++nt) bfr[nt] = *(const bf16x8*)(p.bbn + ((pidx * 128 + nt * 32 + (lane & 31)) * 16 + 8 * (lane >> 5)));
#pragma unroll
  for (int ks = 0; ks < 4; ++ks) cfr[ks] = *(const bf16x8*)(p.cn + ((pidx * 16 + (lane & 15)) * 128 + ks * 32 + 8 * (lane >> 4)));
  const bf16_t* ub = p.proj + (long)t0 * NPJ + PJ_U + g * 16 + 8 * (lane >> 5);
  const int urow = lane & (CH - 1);
  bf16x8 ufr = ldnc_h8(ub + (long)((DIR ? N - CH : 0) + urow) * NPJ);
  float* const ybase = p.ypart + ((long)DIR * T + t0 + (lane >> 4) * 4) * S5_W + g * 16 + (lane & 15);
  for (int c = 0; c <= nch; ++c) {
    if (c < nch) {
      const bf16x8 ucur = ufr;
      if (c + 1 < nch) ufr = ldnc_h8(ub + (long)((DIR ? N - CH * (c + 2) : CH * (c + 1)) + urow) * NPJ);
#pragma unroll
      for (int np = 0; np < 2; ++np) {
        f32x16 z0, z1;
#pragma unroll
        for (int r = 0; r < 16; ++r) { z0[r] = 0.f; z1[r] = 0.f; }
        z0 = __builtin_amdgcn_mfma_f32_32x32x16_bf16(ucur, bfr[2 * np], z0, 0, 0, 0);
        z1 = __builtin_amdgcn_mfma_f32_32x32x16_bf16(ucur, bfr[2 * np + 1], z1, 0, 0, 0);
#pragma unroll
        for (int r = 0; r < CH / 2; ++r) {
          const int row = (r & 3) + 8 * (r >> 2) + 4 * (lane >> 5);
          BU[row * 128 + (2 * np) * 32 + (lane & 31)] = z0[r];
          BU[row * 128 + (2 * np + 1) * 32 + (lane & 31)] = z1[r];
        }
      }
    }
    __builtin_amdgcn_fence(__ATOMIC_RELEASE, "wavefront");
    __builtin_amdgcn_wave_barrier();
    __builtin_amdgcn_fence(__ATOMIC_ACQUIRE, "wavefront");
    if (c >= 1) {
      const char* ss = SS + ((c - 1) & 1) * (CH * S5_SROW);
      const int pb = DIR ? N - CH * c : CH * (c - 1);
#pragma unroll
      for (int mt = 0; mt < CH / 16; ++mt) {
        f32x4 acc = {0.f, 0.f, 0.f, 0.f};
#pragma unroll
        for (int ks = 0; ks < 4; ++ks) {
          bf16x8 a = *(const bf16x8*)(ss + (mt * 16 + (lane & 15)) * S5_SROW + ks * 64 + 16 * (lane >> 4));
          acc = __builtin_amdgcn_mfma_f32_16x16x32_bf16(a, cfr[ks], acc, 0, 0, 0);
        }
        float* yo = ybase + (long)(pb + mt * 16) * S5_W;
#pragma unroll
        for (int r = 0; r < 4; ++r) yo[(long)r * S5_W] = acc[r];
      }
    }
    if (c < nch) {
      char* ss = SS + (c & 1) * (CH * S5_SROW);
      f32x2_t bu[CH];
#pragma unroll
      for (int k = 0; k < CH; ++k) { const int r = DIR ? CH - 1 - k : k; bu[k] = *(const f32x2_t*)(BU + r * 128 + 2 * lane); }
#pragma unroll
      for (int k = 0; k < CH; ++k) {
        const int r = DIR ? CH - 1 - k : k;
        const float nr = __builtin_fmaf(ar, sr, __builtin_fmaf(nai, si, bu[k][0]));
        const float ni = __builtin_fmaf(ar, si, __builtin_fmaf(ai, sr, bu[k][1]));
        sr = nr; si = ni;
        *(unsigned*)(ss + r * S5_SROW + lane * 4) = cvtpk(sr, si);
      }
    }
    __builtin_amdgcn_fence(__ATOMIC_RELEASE, "wavefront");
    __builtin_amdgcn_wave_barrier();
    __builtin_amdgcn_fence(__ATOMIC_ACQUIRE, "wavefront");
  }
  if (!lat) {
    long oo = ((((long)b * DEPTH + l) * 2 + DIR) * SG + g) * SP + lane;
    p.out[O_SRE + oo] = sr; p.out[O_SIM + oo] = si;
  }
}
DEVFN void s5_unit(const Params& p, int l, int lat, int item, char* smem, int tidx_) {
  const int wave = tidx_ >> 6, lane = tidx_ & 63;
  if (lat) {
    if (wave < 2) {
      const int u = item * 2 + wave;
      char* wl = smem + wave * (32 * 128 * 4 + 2 * 32 * S5_SROW);
      if (u & 1) s5_wave<1, 32>(p, l, 1, u, wl, lane); else s5_wave<0, 32>(p, l, 1, u, wl, lane);
    }
  } else {
    const int u = item * 4 + wave;
    char* wl = smem + wave * (16 * 128 * 4 + 2 * 16 * S5_SROW);
    if (u & 1) s5_wave<1, 16>(p, l, 0, u, wl, lane); else s5_wave<0, 16>(p, l, 0, u, wl, lane);
  }
  __syncthreads();
}

constexpr int AT_KROW = 144, AT_VROW = 72, AT_KB = 32 * AT_KROW, AT_STAGE = AT_KB + 64 * AT_VROW;
constexpr int N_AT_LAT = DB * NKV * (DSEQ / 32), N_AT_CTX = BATCH * NKV * (SEQ / 32);
DEVFN void attn_item(const Params& p, int l, int lat, int item, char* smem, int tidx_) {
  const int NQB = (lat ? DSEQ : SEQ) / 32;
  const int qb = item % NQB, kvh = (item / NQB) % NKV, b = item / (NQB * NKV);
  const int N = lat ? DSEQ : SEQ, t0 = lat ? TC + b * DSEQ : b * SEQ, q0 = qb * 32;
  const int wave = tidx_ >> 6, lane = tidx_ & 63, hl = lane >> 5, head = kvh * GQA + wave;
  bf16x8 qf[4];
#pragma unroll
  for (int s = 0; s < 4; ++s) qf[s] = ldnc_h8(p.proj + (long)(t0 + q0 + (lane & 31)) * NPJ + PJ_Q + head * HD + 16 * s + 8 * hl);
  const int ks0 = lat ? (q0 - WINDOW < 0 ? 0 : q0 - WINDOW) : 0;
  const int ke0 = lat ? (q0 + 32 + WINDOW > N ? N : q0 + 32 + WINDOW) : N;
  const int nwin = (ke0 - ks0) / 32, ntiles = nwin + (lat ? PAST / 32 : 0);
  float m = p.attn_sink[l * NH + head], lsum = 1.f;
  f32x16 O[2];
#pragma unroll
  for (int i = 0; i < 2; ++i)
#pragma unroll
    for (int r = 0; r < 16; ++r) O[i][r] = 0.f;
  const int kkey = tidx_ >> 3, kch = tidx_ & 7;
  const int vkey = tidx_ & 31, vch = tidx_ >> 5;
  struct KV { f32x4 k0, k1, v0, v1; };
  const __amdgpu_buffer_rsrc_t proj_rsrc = __builtin_amdgcn_make_buffer_rsrc((void*)p.proj, (short)0, (int)((long)T * NPJ * 2), 0x00020000);
  auto tile_load = [&](int ti) -> KV {
    KV r; r.k1 = r.k0 = (f32x4){0.f, 0.f, 0.f, 0.f}; r.v1 = r.v0 = r.k0;
    if (ti < nwin) {
      const int kp = ks0 + ti * 32;
      const nc_u4 a_ = __builtin_amdgcn_raw_buffer_load_b128(proj_rsrc, (unsigned)(((long)(t0 + kp + kkey) * NPJ + PJ_K + kvh * HD + kch * 8) * 2), 0, 16);
      const nc_u4 c_ = __builtin_amdgcn_raw_buffer_load_b128(proj_rsrc, (unsigned)(((long)(t0 + kp + vkey) * NPJ + PJ_V + kvh * HD + vch * 8) * 2), 0, 16);
      uint4 a = make_uint4(a_[0], a_[1], a_[2], a_[3]), c = make_uint4(c_[0], c_[1], c_[2], c_[3]);
      r.k0 = __builtin_bit_cast(f32x4, a); r.v0 = __builtin_bit_cast(f32x4, c);
    } else {
      const int s0 = (ti - nwin) * 32;
      const float* kb = p.cache_k + ((((long)b * DEPTH + l) * PAST + s0 + kkey) * NKV + kvh) * HD + kch * 8;
      const float* vb = p.cache_v + ((((long)b * DEPTH + l) * PAST + s0 + vkey) * NKV + kvh) * HD + vch * 8;
      r.k0 = *(const f32x4*)kb; r.k1 = *(const f32x4*)(kb + 4);
      r.v0 = *(const f32x4*)vb; r.v1 = *(const f32x4*)(vb + 4);
    }
    return r;
  };
  auto tile_store = [&](int ti, char* st, const KV r) {
    uint4 kq, vq;
    if (ti < nwin) { kq = __builtin_bit_cast(uint4, r.k0); vq = __builtin_bit_cast(uint4, r.v0); }
    else {
      kq.x = cvtpk(r.k0[0], r.k0[1]); kq.y = cvtpk(r.k0[2], r.k0[3]); kq.z = cvtpk(r.k1[0], r.k1[1]); kq.w = cvtpk(r.k1[2], r.k1[3]);
      vq.x = cvtpk(r.v0[0], r.v0[1]); vq.y = cvtpk(r.v0[2], r.v0[3]); vq.z = cvtpk(r.v1[0], r.v1[1]); vq.w = cvtpk(r.v1[2], r.v1[3]);
    }
    *(uint4*)(st + kkey * AT_KROW + kch * 16) = kq;
    char* vt = st + AT_KB + (vch * 8) * AT_VROW + vkey * 2;
    *(bf16_t*)(vt + 0 * AT_VROW) = (bf16_t)(vq.x & 0xffffu); *(bf16_t*)(vt + 1 * AT_VROW) = (bf16_t)(vq.x >> 16);
    *(bf16_t*)(vt + 2 * AT_VROW) = (bf16_t)(vq.y & 0xffffu); *(bf16_t*)(vt + 3 * AT_VROW) = (bf16_t)(vq.y >> 16);
    *(bf16_t*)(vt + 4 * AT_VROW) = (bf16_t)(vq.z & 0xffffu); *(bf16_t*)(vt + 5 * AT_VROW) = (bf16_t)(vq.z >> 16);
    *(bf16_t*)(vt + 6 * AT_VROW) = (bf16_t)(vq.w & 0xffffu); *(bf16_t*)(vt + 7 * AT_VROW) = (bf16_t)(vq.w >> 16);
  };
  KV sa_ = tile_load(0), sb_ = sa_;
  tile_store(0, smem, sa_);
  if (ntiles > 1) sb_ = tile_load(1);
  __syncthreads();
  const int qp = q0 + (lane & 31);
  auto compute = [&](int ti) {
    const char* st = smem + (ti & 1) * AT_STAGE;
    f32x16 sa;
#pragma unroll
    for (int r = 0; r < 16; ++r) sa[r] = 0.f;
#pragma unroll
    for (int s = 0; s < 4; ++s) {
      bf16x8 kf = *(const bf16x8*)(st + (lane & 31) * AT_KROW + (2 * s + hl) * 16);
      sa = __builtin_amdgcn_mfma_f32_32x32x16_bf16(kf, qf[s], sa, 0, 0, 0);
    }
    float tmax = -1e30f;
    if (lat && ti < nwin) {
      const int kp0 = ks0 + ti * 32 + 4 * hl;
#pragma unroll
      for (int r = 0; r < 16; ++r) {
        const int kp = kp0 + (r & 3) + 8 * (r >> 2);
        const int df = kp - qp;
        const bool ok = (df <= WINDOW) && (df >= -WINDOW);
        sa[r] = ok ? sa[r] * 0.125f : -1e30f;
        tmax = fmaxf(tmax, sa[r]);
      }
    } else {
#pragma unroll
      for (int r = 0; r < 16; ++r) { sa[r] *= 0.125f; tmax = fmaxf(tmax, sa[r]); }
    }
    tmax = fmaxf(tmax, __shfl_xor(tmax, 32));
    const float mnew = fmaxf(m, tmax);
    const float sc = __expf(m - mnew);
    float rs = 0.f;
#pragma unroll
    for (int r = 0; r < 16; ++r) { sa[r] = __expf(sa[r] - mnew); rs += sa[r]; }
    rs += __shfl_xor(rs, 32);
    lsum = lsum * sc + rs; m = mnew;
#pragma unroll
    for (int i = 0; i < 2; ++i)
#pragma unroll
      for (int r = 0; r < 16; ++r) O[i][r] *= sc;
    bf16x8 pb[2];
#pragma unroll
    for (int s2 = 0; s2 < 2; ++s2) {
      uint4 w;
      w.x = cvtpk(sa[8 * s2 + 0], sa[8 * s2 + 1]); w.y = cvtpk(sa[8 * s2 + 2], sa[8 * s2 + 3]);
      w.z = cvtpk(sa[8 * s2 + 4], sa[8 * s2 + 5]); w.w = cvtpk(sa[8 * s2 + 6], sa[8 * s2 + 7]);
      pb[s2] = __builtin_bit_cast(bf16x8, w);
    }
#pragma unroll
    for (int mt = 0; mt < 2; ++mt)
#pragma unroll
      for (int s2 = 0; s2 < 2; ++s2) {
        const char* vp = st + AT_KB + (mt * 32 + (lane & 31)) * AT_VROW + (16 * s2 + 4 * hl) * 2;
        uint2 lo = *(const uint2*)vp, hi = *(const uint2*)(vp + 16);
        uint4 w; w.x = lo.x; w.y = lo.y; w.z = hi.x; w.w = hi.y;
        O[mt] = __builtin_amdgcn_mfma_f32_32x32x16_bf16(__builtin_bit_cast(bf16x8, w), pb[s2], O[mt], 0, 0, 0);
      }
  };
  for (int ti = 0; ti < ntiles; ti += 2) {
    if (ti + 2 < ntiles) sa_ = tile_load(ti + 2);
    compute(ti);
    if (ti + 1 < ntiles) tile_store(ti + 1, smem + AT_STAGE, sb_);
    __syncthreads();
    if (ti + 1 >= ntiles) break;
    if (ti + 3 < ntiles) sb_ = tile_load(ti + 3);
    compute(ti + 1);
    if (ti + 2 < ntiles) tile_store(ti + 2, smem, sa_);
    __syncthreads();
  }
  const float inv = 1.f / lsum;
  bf16_t* orow = p.mixcat + (long)(t0 + qp) * MIX_W + head * HD;
#pragma unroll
  for (int mt = 0; mt < 2; ++mt)
#pragma unroll
    for (int q = 0; q < 4; ++q) {
      uint2 w;
      w.x = cvtpk(O[mt][4 * q] * inv, O[mt][4 * q + 1] * inv); w.y = cvtpk(O[mt][4 * q + 2] * inv, O[mt][4 * q + 3] * inv);
      *(uint2*)(orow + mt * 32 + 8 * q + 4 * hl) = w;
    }
}

constexpr int N_FO_LAT = DB * (DSEQ / 128) * 2, N_FO_CTX = BATCH * (SEQ / 128) * 2;
constexpr int MIX_CORE = N_S5_LAT + N_FO_LAT + N_AT_LAT + N_S5_CTX + N_FO_CTX + N_AT_CTX;
constexpr int CONV_PER_ITEM = 8, N_CONV_ITEMS = TR_EXP / CONV_PER_ITEM;
constexpr int MIX_ITEMS = MIX_CORE;
DEVFN void ph_mix_fast(const Params& p, int l, char* smem, int* s_item, int rep = 0, int lo = 0, int hi = MIX_ITEMS) {
  PHASE_BEGIN;
  unsigned* ctr = p.bar + 4096 + 64 * l + 16 * rep;
  bool first = true;
  for (;;) {
    if (tidx_ == 0) *s_item = lo + (first ? bidx_ : (int)(gridDim.x + atomicAdd(ctr, 1u)));
    first = false;
    __syncthreads();
    int item = *s_item;
    __syncthreads();
    if (item >= hi) break;
    int tidl = tidx_;
    asm volatile("" : "+v"(tidl));
    if (item < N_S5_LAT) { s5_unit(p, l, 1, item, smem, tidl); continue; }
    item -= N_S5_LAT;
    if (item < N_FO_LAT) { fourier_tile(p, item, smem, tidl); continue; }
    item -= N_FO_LAT;
    if (item < N_AT_LAT) { attn_item(p, l, 1, item, smem, tidl); continue; }
    item -= N_AT_LAT;
    if (item < N_S5_CTX) { s5_unit(p, l, 0, item, smem, tidl); continue; }
    item -= N_S5_CTX;
    if (item < N_FO_CTX) { fourier_tile(p, N_FO_LAT + item, smem, tidl); continue; }
    item -= N_FO_CTX;
    if (item < N_AT_CTX) { attn_item(p, l, 0, item, smem, tidl); continue; }
    item -= N_AT_CTX;
    conv_range(p, l, item * CONV_PER_ITEM, CONV_PER_ITEM, smem, tidl);
  }
}

DEVFN float s5_g(const Params& p, int l, long t, int c) {
  float y = p.ypart[t * S5_W + c] + p.ypart[((long)T + t) * S5_W + c] + p.s5_d[l * S5_W + c] * bf2f(p.proj[t * NPJ + PJ_U + c]);
  return gelu_fast(y);
}
struct GluALoader {
  const float* ypart; const float* s5d; const bf16_t* proj; long m0; int tid;
  DEVFN uint4 one(int kt, int i) const {
    const int kc = tid & 7, r0 = tid >> 3;
    const int c0 = kt * 64 + kc * 8;
    f32x4 d0 = *(const f32x4*)(s5d + c0), d1 = *(const f32x4*)(s5d + c0 + 4);
    const long t = m0 + r0 + 32 * i;
    const float* y0 = ypart + t * S5_W + c0; const float* y1 = ypart + ((long)T + t) * S5_W + c0;
    f32x4 a0 = *(const f32x4*)y0, a1 = *(const f32x4*)(y0 + 4), b0 = *(const f32x4*)y1, b1 = *(const f32x4*)(y1 + 4);
    uint4 u = *(const uint4*)(proj + t * NPJ + PJ_U + c0);
    float g0 = gelu_fast(a0[0] + b0[0] + d0[0] * bflo(u.x)), g1 = gelu_fast(a0[1] + b0[1] + d0[1] * bfhi(u.x));
    float g2 = gelu_fast(a0[2] + b0[2] + d0[2] * bflo(u.y)), g3 = gelu_fast(a0[3] + b0[3] + d0[3] * bfhi(u.y));
    float g4 = gelu_fast(a1[0] + b1[0] + d1[0] * bflo(u.z)), g5 = gelu_fast(a1[1] + b1[1] + d1[1] * bfhi(u.z));
    float g6 = gelu_fast(a1[2] + b1[2] + d1[2] * bflo(u.w)), g7 = gelu_fast(a1[3] + b1[3] + d1[3] * bfhi(u.w));
    uint4 w; w.x = cvtpk(g0, g1); w.y = cvtpk(g2, g3); w.z = cvtpk(g4, g5); w.w = cvtpk(g6, g7);
    return w;
  }
  DEVFN U4x4 operator()(int kt) const { U4x4 v; v.a = one(kt, 0); v.b = one(kt, 1); v.c = one(kt, 2); v.d = one(kt, 3); return v; }
};
DEVFN void ph_glu_fast3(const Params& p, int l, char* smem) {
  PHASE_BEGIN;
  const int lane = tidx_ & 63, wave = tidx_ >> 6;
  const bf16_t* wg = p.wglut + (long)l * S5_W * S5_W;
  const bf16_t* const wbase = wg + (long)(tidx_ >> 3) * S5_W + g_chunk(tidx_);
  auto stage_b = [&](char* st, int kt) {
    const bf16_t* bb = wbase;
    asm volatile("" : "+v"(bb));
    GRows X0, X1;
    X0.r0 = bb; X0.r1 = bb + 32 * S5_W; X0.r2 = bb + 64 * S5_W; X0.r3 = bb + 96 * S5_W;
    X1.r0 = bb + 128 * S5_W; X1.r1 = bb + 160 * S5_W; X1.r2 = bb + 192 * S5_W; X1.r3 = bb + 224 * S5_W;
    g_stage(st, wave, X0, X1, kt);
  };
  const int sw = (lane >> 1) & 7, h = lane >> 5;
  int off[4];
#pragma unroll
  for (int ks = 0; ks < 4; ++ks) off[ks] = (lane & 31) * 128 + (((2 * ks + h) ^ sw) * 16);
  char* img = smem + GL_STAGEB;
  for (int tile = bidx_; tile < T / 32; tile += gridDim.x) {
    const int m0 = tile * 32;
    __syncthreads();
    stage_b(smem, 0);
    {
      const int c0 = (tidx_ & 31) * 8, r0 = tidx_ >> 5;
      f32x4 d0 = *(const f32x4*)(p.s5_d + l * S5_W + c0), d1 = *(const f32x4*)(p.s5_d + l * S5_W + c0 + 4);
      f32x4 a0[4], a1[4], b0[4], b1[4]; uint4 u[4];
#pragma unroll
      for (int k = 0; k < 4; ++k) {
        const long t = m0 + r0 + 8 * k;
        const float* y0 = p.ypart + t * S5_W + c0; const float* y1 = p.ypart + ((long)T + t) * S5_W + c0;
        a0[k] = ldnc_f4(y0); a1[k] = ldnc_f4(y0 + 4); b0[k] = ldnc_f4(y1); b1[k] = ldnc_f4(y1 + 4);
        u[k] = ldnc_u4(p.proj + t * NPJ + PJ_U + c0);
      }
      const int kt = (tidx_ & 31) >> 3, c = tidx_ & 7;
#pragma unroll
      for (int k = 0; k < 4; ++k) {
        const int r = r0 + 8 * k;
        float g0 = gelu_fast(a0[k][0] + b0[k][0] + d0[0] * bflo(u[k].x)), g1 = gelu_fast(a0[k][1] + b0[k][1] + d0[1] * bfhi(u[k].x));
        float g2 = gelu_fast(a0[k][2] + b0[k][2] + d0[2] * bflo(u[k].y)), g3 = gelu_fast(a0[k][3] + b0[k][3] + d0[3] * bfhi(u[k].y));
        float g4 = gelu_fast(a1[k][0] + b1[k][0] + d1[0] * bflo(u[k].z)), g5 = gelu_fast(a1[k][1] + b1[k][1] + d1[1] * bfhi(u[k].z));
        float g6 = gelu_fast(a1[k][2] + b1[k][2] + d1[2] * bflo(u[k].w)), g7 = gelu_fast(a1[k][3] + b1[k][3] + d1[3] * bfhi(u[k].w));
        uint4 w; w.x = cvtpk(g0, g1); w.y = cvtpk(g2, g3); w.z = cvtpk(g4, g5); w.w = cvtpk(g6, g7);
        *(uint4*)(img + kt * 4096 + r * 128 + ((c ^ ((r >> 1) & 7)) * 16)) = w;
      }
    }
    __syncthreads();
    bf16x8 af[16];
#pragma unroll
    for (int kt = 0; kt < 4; ++kt)
#pragma unroll
      for (int ks = 0; ks < 4; ++ks) af[kt * 4 + ks] = *(const bf16x8*)(img + kt * 4096 + off[ks]);
    unsigned ge[2][8];
#pragma unroll
    for (int nt = 0; nt < 2; ++nt)
#pragma unroll
      for (int q = 0; q < 4; ++q)
#pragma unroll
        for (int i2 = 0; i2 < 2; ++i2) {
          const int row = 8 * q + 4 * (lane >> 5) + 2 * i2, jc = 32 * nt + (lane & 31);
          const char* gp = img + wave * 4096 + row * 128 + (((jc >> 3) ^ ((row >> 1) & 7)) * 16) + (jc & 7) * 2;
          ge[nt][2 * q + i2] = (unsigned)*(const unsigned short*)gp | ((unsigned)*(const unsigned short*)(gp + 128) << 16);
        }
    asm volatile("s_waitcnt vmcnt(0)" ::: "memory");
    __syncthreads();
    f32x16 acc0, acc1;
#pragma unroll
    for (int r = 0; r < 16; ++r) { acc0[r] = 0.f; acc1[r] = 0.f; }
#pragma unroll
    for (int kt = 0; kt < 4; ++kt) {
      if (kt < 3) stage_b(smem + ((kt + 1) & 1) * GL_STAGEB, kt + 1);
      const char* sB = smem + (kt & 1) * GL_STAGEB + (wave >> 1) * GL_TILEB + (wave & 1) * 64 * 128;
#pragma unroll
      for (int ks = 0; ks < 4; ++ks) {
        const bf16x8 fb0 = *(const bf16x8*)(sB + off[ks]), fb1 = *(const bf16x8*)(sB + 32 * 128 + off[ks]);
        acc0 = __builtin_amdgcn_mfma_f32_32x32x16_bf16(af[kt * 4 + ks], fb0, acc0, 0, 0, 0);
        acc1 = __builtin_amdgcn_mfma_f32_32x32x16_bf16(af[kt * 4 + ks], fb1, acc1, 0, 0, 0);
      }
      asm volatile("s_waitcnt vmcnt(0)" ::: "memory");
      __syncthreads();
    }
    const bool odd = tidx_ & 1;
#pragma unroll
    for (int nt = 0; nt < 2; ++nt)
#pragma unroll
      for (int q = 0; q < 4; ++q) {
        const int row = 8 * q + 4 * (lane >> 5), j = 64 * wave + 32 * nt + (lane & 31);
        float r[4];
#pragma unroll
        for (int i = 0; i < 4; ++i) {
          const float v = nt ? acc1[4 * q + i] : acc0[4 * q + i];
          const unsigned gw = ge[nt][2 * q + (i >> 1)];
          r[i] = ((i & 1) ? bfhi(gw) : bflo(gw)) * sigmoid_fast(v);
        }
        store4_bf16(p.mixcat + (long)(m0 + row) * MIX_W + ATTN_W + FOUR_W + j, MIX_W, odd, r[0], r[1], r[2], r[3]);
      }
  }
}
DEVFN void ph_four_reduce(const Params& p) {
  PHASE_BEGIN;
  {
    const int nb = gridDim.x;
    int ridx = bidx_ - (T / 32) % nb; if (ridx < 0) ridx += nb;
    for (int it = ridx; it < DB * DSEQ / 16; it += nb) {
#pragma unroll
      for (int k = 0; k < 2; ++k) {
        const int ch = it * 512 + k * 256 + tidx_;
        const int row = ch >> 5, c8 = (ch & 31) * 8;
        const float* a = p.win2 + (long)row * FOUR_W + c8; const float* b = a + (long)DB * DSEQ * FOUR_W;
        const f32x4 a0 = ldnc_f4(a), a1 = ldnc_f4(a + 4), b0 = ldnc_f4(b), b1 = ldnc_f4(b + 4);
        uint4 w;
        w.x = cvtpk(a0[0] + b0[0], a0[1] + b0[1]); w.y = cvtpk(a0[2] + b0[2], a0[3] + b0[3]);
        w.z = cvtpk(a1[0] + b1[0], a1[1] + b1[1]); w.w = cvtpk(a1[2] + b1[2], a1[3] + b1[3]);
        *(uint4*)(p.mixcat + (long)(TC + row) * MIX_W + ATTN_W + c8) = w;
      }
    }
  }
}

DEVFN void ph_glu_fast2(const Params& p, int l, char* smem) {
  PHASE_BEGIN;
  constexpr int NT_N = S5_W / 128, NT_M = T / 128;
  for (int tile = bidx_; tile < NT_M * NT_N; tile += gridDim.x) {
    const int tm = tile / NT_N, tn = tile % NT_N;
    const int m0 = tm * 128, n0 = tn * 128;
    {
      const int c0 = (tidx_ & 31) * 8, r0 = tidx_ >> 5;
      f32x4 d0 = *(const f32x4*)(p.s5_d + l * S5_W + c0), d1 = *(const f32x4*)(p.s5_d + l * S5_W + c0 + 4);
#pragma unroll 1
      for (int i4 = 0; i4 < 4; ++i4) {
        f32x4 a0[4], a1[4], b0[4], b1[4]; uint4 u[4];
#pragma unroll
        for (int k = 0; k < 4; ++k) {
          const long t = m0 + r0 + 8 * (4 * i4 + k);
          const float* y0 = p.ypart + t * S5_W + c0; const float* y1 = p.ypart + ((long)T + t) * S5_W + c0;
          a0[k] = *(const f32x4*)y0; a1[k] = *(const f32x4*)(y0 + 4); b0[k] = *(const f32x4*)y1; b1[k] = *(const f32x4*)(y1 + 4);
          u[k] = *(const uint4*)(p.proj + t * NPJ + PJ_U + c0);
        }
#pragma unroll
        for (int k = 0; k < 4; ++k) {
          const long t = m0 + r0 + 8 * (4 * i4 + k);
          float g0 = gelu_fast(a0[k][0] + b0[k][0] + d0[0] * bflo(u[k].x)), g1 = gelu_fast(a0[k][1] + b0[k][1] + d0[1] * bfhi(u[k].x));
          float g2 = gelu_fast(a0[k][2] + b0[k][2] + d0[2] * bflo(u[k].y)), g3 = gelu_fast(a0[k][3] + b0[k][3] + d0[3] * bfhi(u[k].y));
          float g4 = gelu_fast(a1[k][0] + b1[k][0] + d1[0] * bflo(u[k].z)), g5 = gelu_fast(a1[k][1] + b1[k][1] + d1[1] * bfhi(u[k].z));
          float g6 = gelu_fast(a1[k][2] + b1[k][2] + d1[2] * bflo(u[k].w)), g7 = gelu_fast(a1[k][3] + b1[k][3] + d1[3] * bfhi(u[k].w));
          uint4 w; w.x = cvtpk(g0, g1); w.y = cvtpk(g2, g3); w.z = cvtpk(g4, g5); w.w = cvtpk(g6, g7);
          *(uint4*)(p.gbuf + t * S5_W + c0) = w;
        }
      }
    }
    asm volatile("s_waitcnt vmcnt(0)" ::: "memory");
    __syncthreads();
    GRows A = make_grows(tidx_, p.gbuf, m0, S5_W);
    GRows B = make_grows(tidx_, p.wglut + (long)l * S5_W * S5_W, n0, S5_W);
    const bool odd = tidx_ & 1;
    bool staged = false;
    bf16_t* gl = (bf16_t*)smem;
    gemm_tile_g(smem, tidx_, A, B, S5_W / 64, [&](int nt, int row, int col, float v0, float v1, float v2, float v3) {
      if (!staged) {
        uint4 t8[8];
#pragma unroll
        for (int i = 0; i < 8; ++i) { const int c = tidx_ + 256 * i; t8[i] = *(const uint4*)(p.gbuf + (long)(m0 + (c >> 4)) * S5_W + n0 + (c & 15) * 8); }
#pragma unroll
        for (int i = 0; i < 8; ++i) { const int c = tidx_ + 256 * i; *(uint4*)(gl + (c >> 4) * 128 + (c & 15) * 8) = t8[i]; }
        __syncthreads();
        staged = true;
      }
      const int j = n0 + col;
      float v[4] = {v0, v1, v2, v3};
      float gg[4];
#pragma unroll
      for (int i = 0; i < 4; ++i) gg[i] = bf2f(gl[(row + i) * 128 + col]);
#pragma unroll
      for (int i = 0; i < 4; ++i) {
        long t = m0 + row + i;
        float r = gg[i] * sigmoid_fast(v[i]);
        float pr = shx1(r);
        if (!odd) *(unsigned*)(p.mixcat + t * MIX_W + ATTN_W + FOUR_W + j) = cvtpk(r, pr);
      }
    });
  }
}

__global__ void __launch_bounds__(256, 2) __attribute__((amdgpu_waves_per_eu(2, 2))) mega(Params p) {
  __shared__ __attribute__((aligned(16))) char smem[SMEM_BYTES];
  __shared__ uint4 xb_words;
  __shared__ int s_item;
  if (threadIdx.x == 0) xb_words = make_uint4(0u, 0u, 0u, 0u);
  __syncthreads();
  XcdBarrier xb = xcd_barrier_post(p.bar, (volatile LAS unsigned*)&xb_words);
  volatile LAS unsigned* lead = (volatile LAS unsigned*)&xb_words + 2;
  volatile LAS int* s_cd = (volatile LAS int*)&xb_words + 3;
  ph_adaln_part(p, smem); ph_init_tr(p, smem); ph_init_tab(p, smem); xcd_barrier(xb);
  ph_adaln_reduce(p); ph_init_fold(p, smem); xcd_barrier(xb);
  int l = 0, ph = 0;
#pragma unroll 1
  for (;;) {
    if (ph == 0) { ph_row1_fast(p, l, smem); if (l == DEPTH) break; }
    else if (ph == 1) ph_gemm_in_fast(p, l, smem);
    else if (ph == 2) ph_mix_fast(p, l, smem, &s_item);
    else if (ph == 3) ph_glu_fast3(p, l, smem);
    else if (ph == 4) ph_gemm_out_fast(p, l, smem);
    else if (ph == 5) ph_row2_fast(p, l, smem);
    else if (ph == 6) { ph_topk_fast(p, l, smem); int cd = *s_cd; __syncthreads(); ph_conv_catchup(p, l, cd, smem); if (threadIdx.x == 0) *s_cd = cd; }
    else if (ph == 7) ph_moe1_fast(p, l, smem);
    else ph_moe2_fast(p, l, smem);
    xcd_barrier_fill(xb, lead, ph == 1, [&]() {
      int tf = threadIdx.x, bf = blockIdx.x;
      asm volatile("" : "+v"(tf), "+s"(bf));
      int cd = *s_cd;
      __syncthreads();
      conv_fill(p, l, ph, cd, smem, tf, bf);
      if (tf == 0) *s_cd = cd;
    });
    if (++ph == 9) { ph = 0; ++l; }
  }
}

extern "C" void kernel_launch(void* const* d_in, const int* in_sizes, int n_in, void* d_out, int out_size, void* d_ws,
                              size_t ws_size, hipStream_t stream) {
  Params p{};
  const float** pp = (const float**)&p;
  for (int i = 0; i < 33; ++i) pp[i] = (const float*)d_in[i];
  p.out = (float*)d_out;
  char* w = (char*)d_ws;
  size_t off = 0;
  auto al = [&](size_t bytes) { void* r = w + off; off += (bytes + 255) & ~(size_t)255; return r; };
  p.bar = (unsigned*)al(64 * 1024);
  p.x = (float*)al((size_t)T * D * 4); p.mod = (float*)al((size_t)DEPTH * NCOND * 6 * D * 4);
  p.states = nullptr; p.ypart = (float*)al((size_t)2 * T * S5_W * 4); p.ybuf = (float*)al((size_t)T * D * 4); p.aff = (float*)al((size_t)T * NE * 4);
  p.wcs = (float*)al((size_t)DEPTH * 256 * 512 * 4); p.win2 = (float*)al((size_t)DEPTH * D * NP * 4);
  p.abar = (float*)al((size_t)DEPTH * 2 * SG * SP * 2 * 4); p.bbar = (float*)al((size_t)DEPTH * 2 * SG * SP * SH * 2 * 4);
  p.twc = (float*)al(SEQ * 2 * 4); p.twl = (float*)al(DSEQ * 2 * 4); p.selgate = (float*)al((size_t)NE * NS * 4);
  p.modpart = (float*)al((size_t)ADA_KC * DEPTH * NCOND * 6 * D * 4); p.afft = (float*)al((size_t)NE * T * 4); p.rope = (float*)al(64 * 16 * 2 * 4);
  p.h = (act_t*)al((size_t)T * D * sizeof(act_t)); p.proj = (act_t*)al((size_t)T * NPJ * sizeof(act_t));
  p.pqt = (act_t*)al((size_t)T * 512 * sizeof(act_t)); p.mixcat = (act_t*)al((size_t)T * MIX_W * sizeof(act_t));
  p.gbuf = (act_t*)al((size_t)T * S5_W * sizeof(act_t)); p.h2 = (act_t*)al((size_t)T * D * sizeof(act_t));
  p.hid = (act_t*)al((size_t)NE * NS * FF * sizeof(act_t)); p.ys = (act_t*)al((size_t)NE * NS * D * sizeof(act_t));
  p.win2t = (bf16_t*)al((size_t)DEPTH * NP * D * 2); p.woutt = (bf16_t*)al((size_t)DEPTH * D * MIX_W * 2);
  p.wglut = (bf16_t*)al((size_t)DEPTH * S5_W * S5_W * 2); p.dftc = (bf16_t*)al((size_t)SEQ * 2 * SEQ * 2);
  p.dftl = (bf16_t*)al((size_t)DSEQ * 2 * DSEQ * 2); p.wcst = (bf16_t*)al((size_t)DEPTH * 512 * 256 * 2);
  p.wgt = (bf16_t*)al((size_t)2 * NE * FF * D * 2); p.wut = (bf16_t*)al((size_t)2 * NE * FF * D * 2); p.wdt = (bf16_t*)al((size_t)2 * NE * D * FF * 2);
  p.bbn = (bf16_t*)al((size_t)DEPTH * 2 * SG * 128 * 16 * 2); p.cn = (bf16_t*)al((size_t)DEPTH * 2 * SG * SH * 128 * 2);
  p.seltok = (int*)al((size_t)NE * NS * 4); p.inv = (int*)al((size_t)T * NE * 4);
  static int grid_blocks = 0;
  if (!grid_blocks) {
    int dev = 0, cus = 0, per_cu = 0;
    (void)hipGetDevice(&dev);
    (void)hipDeviceGetAttribute(&cus, hipDeviceAttributeMultiprocessorCount, dev);
    (void)hipOccupancyMaxActiveBlocksPerMultiprocessor(&per_cu, mega, 256, 0);
    if (per_cu > 2) per_cu = 2;
    grid_blocks = cus * per_cu;
  }
  (void)hipMemsetAsync(p.bar, 0, 32768, stream);
  void* args[] = {&p};
  hipError_t e = hipLaunchCooperativeKernel((void*)mega, dim3(grid_blocks), dim3(256), args, 0, stream);
  if (e != hipSuccess) fprintf(stderr, "cooperative launch failed: %s (grid %d)\n", hipGetErrorString(e), grid_blocks);
}
```
